# Optimizing an MI355X kernel written in HIP

```python
import jax, jax.numpy as jnp
from jax import lax
import numpy as np

D_MODEL = 1024
BATCH = 32
SEQ = 2048
DEPTH = 1

D_CONV = 512
CONV_GROUPS = 8
CONV_WIDTH = 3
HG_HEADS = 4
HG_KD = 128
HG_VD = 128
D_HG = HG_HEADS * HG_KD
D_MIX = D_CONV + D_HG
D_IN = 3 * D_CONV + 4 * D_HG
CHUNK = 32
PEER_HEADS = 8
N_KEYS = 128
N_EXPERTS = N_KEYS * N_KEYS
D_QUERY = 256
HALF_Q = D_QUERY // 2
PEER_TOPK = 16
TOKEN_BLOCK = 128
EPS = 1e-6

kernel_name = "hymba_conv_hgrn2_peer_block"


def rmsnorm(x, gain):
    x32 = x.astype(jnp.float32)
    y = x32 * lax.rsqrt(jnp.mean(x32 * x32, axis=-1, keepdims=True) + EPS)
    return (y * gain.astype(jnp.float32)).astype(x.dtype)


def group_rmsnorm(x, gain, groups):
    shp = x.shape
    xg = x.reshape(shp[:-1] + (groups, shp[-1] // groups)).astype(jnp.float32)
    y = xg * lax.rsqrt(jnp.mean(xg * xg, axis=-1, keepdims=True) + EPS)
    return (y.reshape(shp) * gain.astype(jnp.float32)).astype(x.dtype)


def short_conv_mixer(c_gate, h, b_gate, conv_w, gain):
    u = c_gate * h
    s = u.shape[1]
    up = jnp.pad(u, ((0, 0), (CONV_WIDTH - 1, 0), (0, 0)))
    y = conv_w[0] * up[:, 0:s]
    for j in range(1, CONV_WIDTH):
        y = y + conv_w[j] * up[:, j:j + s]
    y = b_gate * y
    return group_rmsnorm(y, gain, CONV_GROUPS)


def hgrn2_mixer(q, f_pre, v, g, lb, gain):
    f32 = jnp.float32
    bsz, s, _ = q.shape
    n_chunks = s // CHUNK

    def heads(t):
        return t.reshape(bsz, n_chunks, CHUNK, HG_HEADS, -1).transpose(0, 3, 1, 2, 4)

    qh = heads(jax.nn.silu(q.astype(f32)) * (HG_KD ** -0.5))
    f = lb + (1.0 - lb) * jax.nn.sigmoid(f_pre.astype(f32))
    kh = heads(1.0 - f)
    logf = heads(jnp.log(f))
    vh = heads(v.astype(f32))
    G = jnp.cumsum(logf, axis=3)
    G_last = G[:, :, :, -1:, :]
    q_dec = qh * jnp.exp(G)
    k_dec = kh * jnp.exp(-G)
    causal = jnp.tril(jnp.ones((CHUNK, CHUNK), dtype=bool))
    A = jnp.einsum('bhnck,bhnsk->bhncs', q_dec, k_dec)
    A = jnp.where(causal, A, 0.0)
    o_intra = jnp.einsum('bhncs,bhnsv->bhncv', A, vh)
    k_end = kh * jnp.exp(G_last - G)
    decay = jnp.exp(G_last[:, :, :, 0, :])

    def step(state, xs):
        dec_n, k_n, v_n, q_n = xs
        o_n = jnp.einsum('bhck,bhkv->bhcv', q_n, state)
        state = dec_n[..., None] * state + jnp.einsum('bhck,bhcv->bhkv', k_n, v_n)
        return state, o_n

    state0 = jnp.zeros((bsz, HG_HEADS, HG_KD, HG_VD), f32)
    _, o_inter = lax.scan(step, state0, (jnp.moveaxis(decay, 2, 0), jnp.moveaxis(k_end, 2, 0),
                                         jnp.moveaxis(vh, 2, 0), jnp.moveaxis(q_dec, 2, 0)))
    o = o_intra + jnp.moveaxis(o_inter, 0, 2)
    o = o * lax.rsqrt(jnp.mean(o * o, axis=-1, keepdims=True) + EPS) * gain.astype(f32)
    o = o * jax.nn.silu(heads(g.astype(f32)))
    o = o.transpose(0, 2, 3, 1, 4).reshape(bsz, s, HG_HEADS * HG_VD)
    return o.astype(q.dtype)


def peer_ffn(x, wq, keys, u_tab, v_tab):
    bsz, s, d = x.shape
    t = bsz * s
    xt = x.reshape(t, d)
    q = (xt @ wq).reshape(t, PEER_HEADS, 2, HALF_Q)
    scores = jnp.einsum('thpd,hpnd->thpn', q, keys).astype(jnp.float32)
    s_top, i_top = lax.top_k(scores, PEER_TOPK)
    cand = (s_top[:, :, 0, :, None] + s_top[:, :, 1, None, :]).reshape(t, PEER_HEADS, PEER_TOPK * PEER_TOPK)
    c_score, c_idx = lax.top_k(cand, PEER_TOPK)
    i1 = jnp.take_along_axis(i_top[:, :, 0], c_idx // PEER_TOPK, axis=-1)
    i2 = jnp.take_along_axis(i_top[:, :, 1], c_idx % PEER_TOPK, axis=-1)
    expert = i1 * N_KEYS + i2
    gates = jax.nn.softmax(c_score, axis=-1)
    n_blocks = t // TOKEN_BLOCK

    def block(args):
        xb, eb, gb = args
        u = jnp.take(u_tab, eb, axis=0)
        a = jax.nn.gelu(jnp.einsum('td,thkd->thk', xb, u).astype(jnp.float32), approximate=False)
        w = (gb * a).astype(xb.dtype)
        vv = jnp.take(v_tab, eb, axis=0)
        return jnp.einsum('thk,thkd->td', w, vv)

    y = lax.map(block, (xt.reshape(n_blocks, TOKEN_BLOCK, d),
                        expert.reshape(n_blocks, TOKEN_BLOCK, PEER_HEADS, PEER_TOPK),
                        gates.reshape(n_blocks, TOKEN_BLOCK, PEER_HEADS, PEER_TOPK)))
    return y.reshape(bsz, s, d)


def setup_inputs(seed: int = 0) -> dict:
    key = jax.random.key(seed)
    ks = jax.random.split(key, 16)
    f32 = jnp.float32
    nrm = lambda k, shp: jax.random.normal(k, shp, f32)
    return {
        "x": nrm(ks[0], (BATCH, SEQ, D_MODEL)),
        "norm_mix": 1.0 + 0.02 * nrm(ks[1], (DEPTH, D_MODEL)),
        "w_in": nrm(ks[2], (DEPTH, D_MODEL, D_IN)) * D_MODEL ** -0.5,
        "conv_w": nrm(ks[3], (DEPTH, CONV_WIDTH, D_CONV)) * CONV_WIDTH ** -0.5,
        "conv_gain": 1.0 + 0.02 * nrm(ks[4], (DEPTH, D_CONV)),
        "hg_lb_logits": 0.1 * nrm(ks[5], (DEPTH + 1, D_HG)),
        "hg_gain": 1.0 + 0.02 * nrm(ks[6], (DEPTH, HG_VD)),
        "w_out": nrm(ks[7], (DEPTH, D_MIX, D_MODEL)) * D_MIX ** -0.5,
        "norm_ffn": 1.0 + 0.02 * nrm(ks[8], (DEPTH, D_MODEL)),
        "peer_wq": nrm(ks[9], (DEPTH, D_MODEL, PEER_HEADS * D_QUERY)) * D_MODEL ** -0.5,
        "peer_keys": nrm(ks[10], (DEPTH, PEER_HEADS, 2, N_KEYS, HALF_Q)) * HALF_Q ** -0.5,
        "peer_u": nrm(ks[11], (DEPTH, N_EXPERTS, D_MODEL)) * D_MODEL ** -0.5,
        "peer_v": nrm(ks[12], (DEPTH, N_EXPERTS, D_MODEL)) * PEER_HEADS ** -0.5,
        "norm_f": 1.0 + 0.02 * nrm(ks[13], (D_MODEL,)),
    }


def reference(x, norm_mix, w_in, conv_w, conv_gain, hg_lb_logits, hg_gain, w_out,
              norm_ffn, peer_wq, peer_keys, peer_u, peer_v, norm_f):
    lb_all = jnp.cumsum(jax.nn.softmax(hg_lb_logits.astype(jnp.float32), axis=0), axis=0)
    splits = [D_CONV, 2 * D_CONV, 3 * D_CONV, 3 * D_CONV + D_HG, 3 * D_CONV + 2 * D_HG, 3 * D_CONV + 3 * D_HG]
    for l in range(DEPTH):
        h = rmsnorm(x, norm_mix[l])
        proj = h @ w_in[l]
        c_gate, hc, b_gate, q, f_pre, v, g = jnp.split(proj, splits, axis=-1)
        conv_out = short_conv_mixer(c_gate, hc, b_gate, conv_w[l], conv_gain[l])
        hg_out = hgrn2_mixer(q, f_pre, v, g, lb_all[l], hg_gain[l])
        mix = jnp.concatenate([conv_out, hg_out], axis=-1)
        x = x + mix @ w_out[l]
        h2 = rmsnorm(x, norm_ffn[l])
        x = x + peer_ffn(h2, peer_wq[l], peer_keys[l], peer_u[l], peer_v[l])
    return rmsnorm(x, norm_f)
```

```cpp
#include <hip/hip_runtime.h>
#include <cstdio>
#include <cstdint>
namespace pg8 {
#define PG8_LAS __attribute__((address_space(3)))
typedef unsigned short bf16_t;
typedef short bf16x8 __attribute__((ext_vector_type(8)));
typedef float f32x4 __attribute__((ext_vector_type(4)));
typedef unsigned u32x4 __attribute__((ext_vector_type(4)));
constexpr int BM = 256, BK = 64, HALF = 128, HTB = HALF * BK * 2  , STAGE_BYTES = 8 * HTB, NXCD = 8, WGM = 8;

__host__ __device__ __forceinline__ int lds_byte(int r, int c) { const int st = (r >> 4) * 2 + (c >> 5), rr = r & 15, cc = c & 31, ob = rr * 64 + cc * 2; return st * 1024 + (ob ^ (((ob >> 9) & 1) << 5)); }
__host__ __device__ __forceinline__ void stage_rc(int b, int& R, int& C) { const int st = b / 1024, sb = b % 1024, swz = sb ^ (((sb >> 9) & 1) << 5); R = (st >> 1) * 16 + swz / 64; C = (st & 1) * 32 + (swz % 64) / 2; }
__host__ __device__ __forceinline__ int perm32(int rho) { const int n = rho >> 4, i = rho & 15; return 8 * (i >> 2) + 4 * n + (i & 3); }

struct Unit { int pm, pn; };
struct Gemm { const bf16_t* A; const bf16_t* Bt; int M, N, K; };

struct StaticOrder {
    int nM, nN, nwg, G, c;
    __host__ __device__ void init(int M, int N, int G_, int c_) { nM = M / BM; nN = N / BM; nwg = nM * nN; G = G_; c = c_; }
    __host__ __device__ bool next(int i, Unit& u) const {
        const long L = (long)i * G + c; if (L >= nwg) return false;
        int wgid = (int)L; { const int q = nwg / NXCD, r = nwg % NXCD, xcd = wgid % NXCD, off = wgid / NXCD; wgid = (xcd < r ? xcd * (q + 1) : r * (q + 1) + (xcd - r) * q) + off; }
        const int nig = WGM * nN, gid = wgid / nig, fm = gid * WGM, gsz = (nM - fm) < WGM ? (nM - fm) : WGM;
        u.pm = fm + ((wgid % nig) % gsz); u.pn = (wgid % nig) / gsz; return true;
    }
    __device__ __forceinline__ void a_ready(const Unit&) const {}
    __device__ __forceinline__ void done(const Unit&) const {}
};

__device__ __forceinline__ unsigned cvt_pk_bf16(float lo, float hi) { unsigned r; asm volatile("v_cvt_pk_bf16_f32 %0, %1, %2" : "=v"(r) : "v"(lo), "v"(hi)); return r; }

template <int MODE> struct EpiScaleBf16 {
    static constexpr bool PERM = true, AFTER_DRAIN = false;
    bf16_t* O; int ldc; const float* rowv;
    __device__ __forceinline__ void operator()(const f32x4 (&acc)[2][2][4][2], const Unit& u, int wr, int wc, int fr, int fq) const {
        const int row0 = u.pm * BM + wr * 64 + fr, col0 = u.pn * BM + wc * 32 + 8 * fq;
#pragma unroll
        for (int ai = 0; ai < 2; ++ai)
#pragma unroll
            for (int m = 0; m < 4; ++m) { const int row = row0 + ai * HALF + m * 16; float s = rowv[row]; if (MODE == 1) s = 1.0f / sqrtf(s * (1.0f / 1024.0f) + 1e-6f);
                bf16_t* rowp = O + (size_t)row * ldc + col0;
#pragma unroll
                for (int bj = 0; bj < 2; ++bj) { const f32x4 v0 = acc[ai][bj][m][0] * s, v1 = acc[ai][bj][m][1] * s;
                    u32x4 w; w.x = cvt_pk_bf16(v0[0], v0[1]); w.y = cvt_pk_bf16(v0[2], v0[3]); w.z = cvt_pk_bf16(v1[0], v1[1]); w.w = cvt_pk_bf16(v1[2], v1[3]);
                    *(u32x4*)(rowp + bj * HALF) = w; } }
    }
};
struct EpiResid {
    static constexpr bool PERM = true, AFTER_DRAIN = false;
    const float* X; bf16_t* O; float* ss;
    __device__ __forceinline__ void operator()(const f32x4 (&acc)[2][2][4][2], const Unit& u, int wr, int wc, int fr, int fq) const {
        const int row0 = u.pm * BM + wr * 64 + fr, col0 = u.pn * BM + wc * 32 + 8 * fq;
#pragma unroll
        for (int ai = 0; ai < 2; ++ai)
#pragma unroll
            for (int m = 0; m < 4; ++m) { const int row = row0 + ai * HALF + m * 16; float part = 0.f;
#pragma unroll
                for (int bj = 0; bj < 2; ++bj) { const float* xp = X + (size_t)row * 1024 + col0 + bj * HALF;
                    const f32x4 v0 = acc[ai][bj][m][0] + *(const f32x4*)xp, v1 = acc[ai][bj][m][1] + *(const f32x4*)(xp + 4);
                    part += (v0[0] * v0[0] + v0[1] * v0[1]) + (v0[2] * v0[2] + v0[3] * v0[3]) + (v1[0] * v1[0] + v1[1] * v1[1]) + (v1[2] * v1[2] + v1[3] * v1[3]);
                    u32x4 w; w.x = cvt_pk_bf16(v0[0], v0[1]); w.y = cvt_pk_bf16(v0[2], v0[3]); w.z = cvt_pk_bf16(v1[0], v1[1]); w.w = cvt_pk_bf16(v1[2], v1[3]);
                    *(u32x4*)(O + (size_t)row * 1024 + col0 + bj * HALF) = w; }
                part += __shfl_xor(part, 16); part += __shfl_xor(part, 32);
                if (fq == 0) (void)__builtin_amdgcn_global_atomic_fadd_f32((__attribute__((address_space(1))) float*)(ss + row), part); }
    }
};

template <class Epi, class Sched, bool ALIGN_EPI = false, bool SP2 = false>
__device__ __forceinline__ void gemm_phase(PG8_LAS unsigned char* lds, const Gemm g, const Sched& S, const Epi& E) {
    const int tid = threadIdx.x, wid = __builtin_amdgcn_readfirstlane(tid >> 6), lane = tid & 63, wr = wid >> 2, wc = wid & 3, fr = lane & 15, fq = lane >> 4;
    const int K = g.K, nt = K / BK;
    unsigned voffA[2], voffB[2];
#pragma unroll
    for (int i = 0; i < 2; ++i) { int R, C; stage_rc(tid * 16 + i * 8192, R, C); const int Rb = Epi::PERM ? ((R & ~31) + perm32(R & 31)) : R;
        voffA[i] = (unsigned)(R * K + C) * 2u; voffB[i] = (unsigned)(Rb * K + C) * 2u; }
    const size_t kstep = (size_t)(BK * 2);
    const size_t hstep = (size_t)HALF * K * 2;
    const size_t tstep = 2 * hstep;
    const unsigned ldsw = (unsigned)wid * 1024u;
    const int aoff = lds_byte(wr * 64 + fr, fq * 8), boff = lds_byte(wc * 32 + fr, fq * 8);
#define PG8_SA(b, h) (((b) * 2 + (h)) * HTB)
#define PG8_SB(b, h) ((4 + (b) * 2 + (h)) * HTB)
#define PG8_STAGE(bufoff, gbase, voff) do { _Pragma("unroll") for (int _i = 0; _i < 2; ++_i) \
        __builtin_amdgcn_global_load_lds((const unsigned*)((const char*)(gbase) + (voff)[_i]), (PG8_LAS unsigned*)(lds + (bufoff) + ldsw + _i * 8192), 16, 0, 0); } while (0)
#define PG8_LDA(dst, b, h) do { _Pragma("unroll") for (int m = 0; m < 4; ++m) _Pragma("unroll") for (int k = 0; k < 2; ++k) dst[m][k] = *(const PG8_LAS bf16x8*)(lds + PG8_SA(b, h) + aoff + m * 2048 + k * 1024); } while (0)
#define PG8_LDB(dst, b, h) do { _Pragma("unroll") for (int n = 0; n < 2; ++n) _Pragma("unroll") for (int k = 0; k < 2; ++k) dst[n][k] = *(const PG8_LAS bf16x8*)(lds + PG8_SB(b, h) + boff + n * 2048 + k * 1024); } while (0)
#define PG8_MMA(ai, bj, At, Bt) do { __builtin_amdgcn_s_setprio(1); _Pragma("unroll") for (int m = 0; m < 4; ++m) _Pragma("unroll") for (int n = 0; n < 2; ++n) _Pragma("unroll") for (int k = 0; k < 2; ++k) \
        acc[ai][bj][m][n] = __builtin_amdgcn_mfma_f32_16x16x32_bf16(Bt[n][k], At[m][k], acc[ai][bj][m][n], 0, 0, 0); __builtin_amdgcn_s_setprio(0); } while (0)
#define PG8_WAIT_V(n) asm volatile("s_waitcnt vmcnt(" #n ")" ::: "memory")
#define PG8_WAIT_L(n) asm volatile("s_waitcnt lgkmcnt(" #n ")" ::: "memory")
#define PG8_BAR __builtin_amdgcn_s_barrier()
#define PG8_SCHED __builtin_amdgcn_sched_barrier(0)
    Unit cur, nxt; int ui = 0;
    if (!S.next(0, cur)) return;
    f32x4 acc[2][2][4][2];
#pragma unroll
    for (int a = 0; a < 2; ++a)
#pragma unroll
        for (int b = 0; b < 2; ++b)
#pragma unroll
            for (int m = 0; m < 4; ++m)
#pragma unroll
                for (int n = 0; n < 2; ++n) acc[a][b][m][n] = (f32x4){0.f, 0.f, 0.f, 0.f};
    bf16x8 At[4][2], B0[2][2], B1[2][2];
    const char* cA = (const char*)g.A + (size_t)cur.pm * tstep; const char* cB = (const char*)g.Bt + (size_t)cur.pn * tstep;
    S.a_ready(cur);
    if constexpr (SP2) {
        PG8_STAGE(PG8_SB(0, 0), cB, voffB); PG8_STAGE(PG8_SB(0, 1), cB + hstep, voffB); PG8_STAGE(PG8_SA(0, 0), cA, voffA); PG8_STAGE(PG8_SA(0, 1), cA + hstep, voffA);
        if (wr == 1) PG8_BAR;
        PG8_WAIT_V(2); PG8_BAR;
        PG8_STAGE(PG8_SB(1, 0), cB + kstep, voffB); PG8_STAGE(PG8_SA(1, 0), cA + kstep, voffA); PG8_STAGE(PG8_SB(1, 1), cB + hstep + kstep, voffB);
        PG8_WAIT_V(6); PG8_BAR;
    } else {
        PG8_STAGE(PG8_SB(0, 0), cB, voffB); PG8_STAGE(PG8_SA(0, 0), cA, voffA); PG8_STAGE(PG8_SB(0, 1), cB + hstep, voffB); PG8_STAGE(PG8_SA(0, 1), cA + hstep, voffA);
        if (wr == 1) PG8_BAR;
        PG8_WAIT_V(4); PG8_BAR;
        PG8_STAGE(PG8_SB(1, 0), cB + kstep, voffB); PG8_STAGE(PG8_SA(1, 0), cA + kstep, voffA); PG8_STAGE(PG8_SB(1, 1), cB + hstep + kstep, voffB);
        PG8_WAIT_V(6); PG8_BAR;
    }
    for (;;) {
        const bool has_next = S.next(ui + 1, nxt);
        const char* nA = has_next ? (const char*)g.A + (size_t)nxt.pm * tstep : cA; const char* nB = has_next ? (const char*)g.Bt + (size_t)nxt.pn * tstep : cB;
        for (int t = 0; t < nt; t += 2) {
            const bool last = (t == nt - 2);
            const char* a1 = cA + (size_t)(t + 1) * kstep;
            const char* a2 = last ? nA : cA + (size_t)(t + 2) * kstep; const char* b2 = last ? nB : cB + (size_t)(t + 2) * kstep;
            const char* a3 = a2 + kstep; const char* b3 = b2 + kstep;
            if (last && has_next) S.a_ready(nxt);
            if constexpr (SP2) {
            PG8_LDB(B0, 0, 0); PG8_LDB(B1, 0, 1); PG8_SCHED; PG8_LDA(At, 0, 0); PG8_STAGE(PG8_SA(1, 1), a1 + hstep, voffA);
            PG8_WAIT_V(8); PG8_WAIT_L(0); PG8_BAR; PG8_MMA(0, 0, At, B0); PG8_MMA(0, 1, At, B1); PG8_BAR; PG8_SCHED;
            PG8_LDA(At, 0, 1); PG8_STAGE(PG8_SB(0, 0), b2, voffB); PG8_STAGE(PG8_SB(0, 1), b2 + hstep, voffB); PG8_STAGE(PG8_SA(0, 0), a2, voffA);
            PG8_WAIT_V(8); PG8_WAIT_L(0); PG8_BAR; PG8_MMA(1, 0, At, B0); PG8_MMA(1, 1, At, B1); PG8_BAR; PG8_SCHED;
            PG8_LDB(B0, 1, 0); PG8_LDB(B1, 1, 1); PG8_SCHED; PG8_LDA(At, 1, 0); PG8_STAGE(PG8_SA(0, 1), a2 + hstep, voffA);
            PG8_WAIT_V(8); PG8_WAIT_L(0); PG8_BAR; PG8_MMA(0, 0, At, B0); PG8_MMA(0, 1, At, B1); PG8_BAR; PG8_SCHED;
            PG8_LDA(At, 1, 1); PG8_STAGE(PG8_SB(1, 0), b3, voffB); PG8_STAGE(PG8_SB(1, 1), b3 + hstep, voffB); PG8_STAGE(PG8_SA(1, 0), a3, voffA);
            PG8_WAIT_V(8); PG8_WAIT_L(0); PG8_BAR; PG8_MMA(1, 0, At, B0); PG8_MMA(1, 1, At, B1); PG8_BAR; PG8_SCHED;
            } else {
            PG8_LDB(B0, 0, 0); PG8_SCHED; PG8_LDA(At, 0, 0); PG8_STAGE(PG8_SA(1, 1), a1 + hstep, voffA);
            PG8_WAIT_L(8); PG8_BAR; PG8_WAIT_L(0); PG8_MMA(0, 0, At, B0); PG8_BAR; PG8_SCHED;
            PG8_LDB(B1, 0, 1); PG8_STAGE(PG8_SB(0, 0), b2, voffB);
            PG8_BAR; PG8_WAIT_L(0); PG8_MMA(0, 1, At, B1); PG8_BAR;
            PG8_LDA(At, 0, 1); PG8_STAGE(PG8_SA(0, 0), a2, voffA);
            PG8_BAR; PG8_WAIT_L(0); PG8_MMA(1, 0, At, B0); PG8_BAR; PG8_SCHED;
            PG8_STAGE(PG8_SB(0, 1), b2 + hstep, voffB);
            PG8_WAIT_V(6); PG8_BAR; PG8_MMA(1, 1, At, B1); PG8_BAR;
            PG8_LDB(B0, 1, 0); PG8_SCHED; PG8_LDA(At, 1, 0); PG8_STAGE(PG8_SA(0, 1), a2 + hstep, voffA);
            PG8_WAIT_L(8); PG8_BAR; PG8_WAIT_L(0); PG8_MMA(0, 0, At, B0); PG8_BAR; PG8_SCHED;
            PG8_LDB(B1, 1, 1); PG8_STAGE(PG8_SB(1, 0), b3, voffB);
            PG8_BAR; PG8_WAIT_L(0); PG8_MMA(0, 1, At, B1); PG8_BAR;
            PG8_LDA(At, 1, 1); PG8_STAGE(PG8_SA(1, 0), a3, voffA);
            PG8_BAR; PG8_WAIT_L(0); PG8_MMA(1, 0, At, B0); PG8_BAR; PG8_SCHED;
            PG8_STAGE(PG8_SB(1, 1), b3 + hstep, voffB);
            PG8_WAIT_V(6); PG8_BAR; PG8_MMA(1, 1, At, B1); PG8_BAR;
            }
        }
        if constexpr (ALIGN_EPI) { if (wr == 0) PG8_BAR; }
        if constexpr (!Epi::AFTER_DRAIN) { E(acc, cur, wr, wc, fr, fq); S.done(cur); }
        if (!has_next) break;
#pragma unroll
        for (int a = 0; a < 2; ++a)
#pragma unroll
            for (int b = 0; b < 2; ++b)
#pragma unroll
                for (int m = 0; m < 4; ++m)
#pragma unroll
                    for (int n = 0; n < 2; ++n) acc[a][b][m][n] = (f32x4){0.f, 0.f, 0.f, 0.f};
        cur = nxt; cA = nA; cB = nB; ++ui;
        if constexpr (ALIGN_EPI) { if (wr == 1) PG8_BAR; }
    }
    PG8_WAIT_V(0);
    if constexpr (!ALIGN_EPI) { if (wr == 0) PG8_BAR; }
    PG8_BAR;
    if constexpr (Epi::AFTER_DRAIN) { E.fused(acc, cur, wr, wc, fr, fq, lds, wid, lane); S.done(cur); }
#undef PG8_SA
#undef PG8_SB
#undef PG8_STAGE
#undef PG8_LDA
#undef PG8_LDB
#undef PG8_MMA
#undef PG8_WAIT_V
#undef PG8_WAIT_L
#undef PG8_BAR
#undef PG8_SCHED
}
}

#ifndef PG8_SP2
#define PG8_SP2 true
#endif
#ifndef PG8_ALIGN
#define PG8_ALIGN true
#endif
#ifndef MK_N_LAUNCHES
#define MK_N_LAUNCHES 9
#endif
constexpr int NWAVES = 8;
constexpr int NPHASES = 9;
constexpr int N_LAUNCHES = MK_N_LAUNCHES;

constexpr int NB = 32, SEQ = 2048, T = NB * SEQ, D = 1024, DIN = 3584;
constexpr int PC_C = 0, PC_H = 512, PC_B = 1024, PC_Q = 1536, PC_F = 2048, PC_V = 2560, PC_G = 3072;
constexpr int NEXP = 16384;
constexpr float EPS = 1e-6f;

constexpr size_t MiB = 1u << 20;
constexpr size_t WS_CTL = 0, CTL_ZERO_BYTES = 1 * MiB;
constexpr size_t WS_W1T = 2 * MiB, WS_WOT = 10 * MiB, WS_WQT = 12 * MiB, WS_RS1 = 16 * MiB, WS_SS2 = 17 * MiB;
constexpr size_t WS_U16 = 32 * MiB, WS_V16 = 64 * MiB, WS_EXP = 96 * MiB;
constexpr size_t WS_XB = 128 * MiB;
constexpr size_t WS_X1 = 256 * MiB;
constexpr size_t WS_PROJ = 384 * MiB;
constexpr size_t WS_F = 832 * MiB;
constexpr size_t WS_END = 960 * MiB;
constexpr int CW_BAR = 4096;

constexpr int RING_OFF = 0, RING_BYTES = 131072;
constexpr int LDSCTL_OFF = RING_BYTES, MISC_OFF = LDSCTL_OFF + 320;
constexpr int LDS_BYTES = 147456;

#define GAS __attribute__((address_space(1)))
#define LAS __attribute__((address_space(3)))
typedef unsigned short bf16;
typedef unsigned v4u __attribute__((ext_vector_type(4)));
typedef unsigned v2u __attribute__((ext_vector_type(2)));
typedef float f32x4 __attribute__((ext_vector_type(4)));
typedef float f32x2 __attribute__((ext_vector_type(2)));
typedef _Float16 h2_t __attribute__((ext_vector_type(2)));
typedef GAS unsigned gu32;
#define RLX_AGENT __ATOMIC_RELAXED, __HIP_MEMORY_SCOPE_AGENT
#define LDS_WAIT() asm volatile("s_waitcnt lgkmcnt(0)" ::: "memory")
#define VM_WAIT() asm volatile("s_waitcnt vmcnt(0)" ::: "memory")
__device__ __forceinline__ unsigned f2bf(float f) { unsigned u = __builtin_bit_cast(unsigned, f); return (u + 0x7fffu + ((u >> 16) & 1u)) >> 16; }
__device__ __forceinline__ unsigned pk2(float lo, float hi) { return f2bf(lo) | (f2bf(hi) << 16); }
__device__ __forceinline__ float bf_lo(unsigned w) { return __builtin_bit_cast(float, w << 16); }
__device__ __forceinline__ float bf_hi(unsigned w) { return __builtin_bit_cast(float, w & 0xffff0000u); }
__device__ __forceinline__ float bf1(bf16 v) { return __builtin_bit_cast(float, (unsigned)v << 16); }
__device__ __forceinline__ unsigned pkh2(float lo, float hi) { f32x2 v = {lo, hi}; h2_t h = __builtin_convertvector(v, h2_t); return __builtin_bit_cast(unsigned, h); }
__device__ __forceinline__ h2_t h2_of(unsigned w) { return __builtin_bit_cast(h2_t, w); }
__device__ __forceinline__ float wave_sum(float v) {
#pragma unroll
    for (int o = 1; o < 64; o <<= 1) v += __shfl_xor(v, o);
    return v;
}
__device__ __forceinline__ float sigmoidf_(float x) { return 1.0f / (1.0f + __expf(-x)); }

#define XB_TMO      128
#define XB_XCNT(j)  (256  + 64 * (j))
#define XB_XSUB(j)  (1280 + 64 * (j))
#define XB_XGEN(j)  (2304 + 64 * (j))
#define XB_TOP      3328
#define XB_TOPGEN   3392
#define XCD_BAR_WORDS 3456
#define XB_SPIN_CAP (1u << 18)

__device__ __forceinline__ unsigned xb_ld(unsigned* p)              { return __hip_atomic_load(p, __ATOMIC_RELAXED, __HIP_MEMORY_SCOPE_AGENT); }
__device__ __forceinline__ unsigned xb_add(unsigned* p, unsigned v) { return __hip_atomic_fetch_add(p, v, __ATOMIC_RELAXED, __HIP_MEMORY_SCOPE_AGENT); }
__device__ __forceinline__ unsigned xb_xcc_id() { return (unsigned)__builtin_amdgcn_s_getreg((3 << 11) | 20) & 0xFu; }
#define XB_SPIN(cond, bar) do { unsigned _sp = 0; while (cond) { __builtin_amdgcn_s_sleep(1); \
    if ((++_sp & 255u) == 0u) { if (xb_ld(&(bar)[XB_TMO])) break; if (_sp > XB_SPIN_CAP) { atomicAdd(&(bar)[XB_TMO], 1u); break; } } } } while (0)

struct XcdBarrier {
    unsigned* bar; unsigned x;
    volatile LAS unsigned* st;
};

__device__ __forceinline__ XcdBarrier xcd_barrier_post(unsigned* bar, volatile LAS unsigned* st) {
    XcdBarrier b; b.bar = bar; b.x = xb_xcc_id(); b.st = st;
    if (threadIdx.x == 0) (void)xb_add(&bar[XB_XCNT(b.x)], 1u);
    return b;
}
__device__ __forceinline__ void xcd_barrier_complete(unsigned* bar, unsigned x, unsigned& nloc, unsigned& nx) {
    const unsigned G = gridDim.x * gridDim.y * gridDim.z;
    unsigned sum, cnt, mine, sp = 0u;
    for (;;) {
        sum = 0u; cnt = 0u; mine = 0u;
#pragma unroll
        for (unsigned j = 0; j < 16; ++j) { const unsigned c = xb_ld(&bar[XB_XCNT(j)]); sum += c; cnt += (c > 0u) ? 1u : 0u; mine = (j == x) ? c : mine; }
        if (sum == G) break;
        __builtin_amdgcn_s_sleep(1);
        if ((++sp & 255u) == 0u) { if (xb_ld(&bar[XB_TMO])) break; if (sp > XB_SPIN_CAP) { atomicAdd(&bar[XB_TMO], 1u); break; } }
    }
    nloc = mine > 0u ? mine : 1u; nx = cnt > 0u ? cnt : 1u;
}

__device__ __forceinline__ void xcd_barrier(const XcdBarrier& b) {
    asm volatile("s_waitcnt vmcnt(0)" ::: "memory");
    __syncthreads();
    if (threadIdx.x == 0) {
        unsigned* bar = b.bar;
        __builtin_amdgcn_s_waitcnt(0);
        unsigned nloc = b.st[0], nx = b.st[1];
        if (nloc == 0u) { xcd_barrier_complete(bar, b.x, nloc, nx); b.st[0] = nloc; b.st[1] = nx; }
        const unsigned old = xb_add(&bar[XB_XSUB(b.x)], 1u);
        const unsigned gen = old / nloc;
        if (old + 1u == (gen + 1u) * nloc) {
            __builtin_amdgcn_fence(__ATOMIC_RELEASE, "agent");
            asm volatile("s_waitcnt vmcnt(0)" ::: "memory");
            const unsigned og = xb_add(&bar[XB_TOP], 1u);
            const unsigned tg = og / nx;
            if (og + 1u == (tg + 1u) * nx) xb_add(&bar[XB_TOPGEN], 1u);
            else XB_SPIN(xb_ld(&bar[XB_TOPGEN]) == tg, bar);
            __builtin_amdgcn_fence(__ATOMIC_ACQUIRE, "agent");
            xb_add(&bar[XB_XGEN(b.x)], 1u);
            asm volatile("s_waitcnt vmcnt(0)" ::: "memory");
        } else {
            XB_SPIN(xb_ld(&bar[XB_XGEN(b.x)]) == gen, bar);
            __builtin_amdgcn_fence(__ATOMIC_ACQUIRE, "agent");
            asm volatile("s_waitcnt vmcnt(0)" ::: "memory");
        }
    }
    __syncthreads();
}


__device__ __forceinline__ void p0_transpose_item(const float* W, int K, int N, const float* gain, bf16* WT, LAS float* scr, int item, int lane) {
    const int nblk = N / 32, kb = item / nblk, nb = item % nblk, k0 = 64 * kb, n0 = 32 * nb;
#pragma unroll 8
    for (int i = 0; i < 32; ++i) { const int kk = 2 * i + (lane >> 5); const float g = gain ? gain[k0 + kk] : 1.0f; scr[kk * 33 + (lane & 31)] = W[(size_t)(k0 + kk) * N + n0 + (lane & 31)] * g; }
    LDS_WAIT(); asm volatile("" ::: "memory");
    const int c = lane & 7;
#pragma unroll
    for (int j = 0; j < 4; ++j) { const int n = (lane >> 3) + 8 * j; const LAS float* s = scr + (8 * c) * 33 + n;
        v4u o; o.x = pk2(s[0 * 33], s[1 * 33]); o.y = pk2(s[2 * 33], s[3 * 33]); o.z = pk2(s[4 * 33], s[5 * 33]); o.w = pk2(s[6 * 33], s[7 * 33]);
        *(GAS v4u*)(WT + (size_t)(n0 + n) * K + k0 + 8 * c) = o; }
    LDS_WAIT(); asm volatile("" ::: "memory");
}

struct Args { const float* in[14]; float* out; unsigned char* ws; int ph_lo, ph_hi, li, pad; };

__global__ void __launch_bounds__(NWAVES * 64, 2) hymba_fwd(Args args) {
    extern __shared__ __attribute__((aligned(16))) unsigned char lds_raw[];
    LAS unsigned char* lds = (LAS unsigned char*)lds_raw;
    volatile LAS unsigned* MISC = (volatile LAS unsigned*)(lds + MISC_OFF);
    const int tid = threadIdx.x, lane = tid & 63, wave = __builtin_amdgcn_readfirstlane(tid >> 6);
    const int G = gridDim.x;
    const int gw = (int)blockIdx.x * NWAVES + wave, NGW = G * NWAVES;
    unsigned char* ws = args.ws;
    gu32* ctl = (gu32*)(ws + WS_CTL);
    const float* x = args.in[0]; const float* norm_mix = args.in[1]; const float* w_in = args.in[2]; const float* conv_w = args.in[3]; const float* conv_gain = args.in[4];
    const float* hg_lb = args.in[5]; const float* hg_gain = args.in[6]; const float* w_out = args.in[7]; const float* norm_ffn = args.in[8]; const float* peer_wq = args.in[9];
    const float* peer_keys = args.in[10]; const float* peer_u = args.in[11]; const float* peer_v = args.in[12]; const float* norm_f = args.in[13];
    float* out = args.out;
    bf16* W1T = (bf16*)(ws + WS_W1T); bf16* WOT = (bf16*)(ws + WS_WOT); bf16* WQT = (bf16*)(ws + WS_WQT);
    float* RS1 = (float*)(ws + WS_RS1); float* SS2 = (float*)(ws + WS_SS2);
    unsigned short* U16 = (unsigned short*)(ws + WS_U16); unsigned short* V16 = (unsigned short*)(ws + WS_V16); unsigned* EXPT = (unsigned*)(ws + WS_EXP);
    bf16* XB = (bf16*)(ws + WS_XB); bf16* MIX = (bf16*)(ws + WS_XB); bf16* X1 = (bf16*)(ws + WS_X1); float* QS = (float*)(ws + WS_X1);
    bf16* PROJ = (bf16*)(ws + WS_PROJ); bf16* QB = (bf16*)(ws + WS_PROJ); float* FG = (float*)(ws + WS_F);

    for (int u = tid; u < (LDS_BYTES - LDSCTL_OFF) / 4; u += NWAVES * 64) ((LAS unsigned*)(lds + LDSCTL_OFF))[u] = 0u;
    __syncthreads();
    XcdBarrier bar; bar.bar = (unsigned*)(ctl + CW_BAR); bar.x = 0; bar.st = nullptr;
    if (N_LAUNCHES == 1) bar = xcd_barrier_post((unsigned*)(ctl + CW_BAR), MISC + 8);
#define GRID_BAR() do { if (N_LAUNCHES == 1) xcd_barrier(bar); } while (0)
    const int lo = args.ph_lo, hi = args.ph_hi;
#define IN(k) (lo <= (k) && (k) < hi)
#define BOTH(k) (IN(k) && IN((k) + 1))

    if (IN(0)) {
        LAS float* scr = (LAS float*)(lds + RING_OFF + wave * 16384);
        constexpr int I_1 = (D / 64) * (DIN / 32), I_O = (D / 64) * (D / 32), I_Q = (D / 64) * (2048 / 32);
        for (int it = gw; it < I_1 + I_O + I_Q; it += NGW) {
            int r = it;
            if (r < I_1) { p0_transpose_item(w_in, D, DIN, norm_mix, W1T, scr, r, lane); continue; } r -= I_1;
            if (r < I_O) { p0_transpose_item(w_out, D, D, nullptr, WOT, scr, r, lane); continue; } r -= I_O;
            p0_transpose_item(peer_wq, D, 2048, norm_ffn, WQT, scr, r, lane);
        }
        for (int m = gw; m < T; m += NGW) {
            const GAS f32x4* xr = (const GAS f32x4*)(x + (size_t)m * D) + lane; f32x4 v[4]; float s = 0.f;
#pragma unroll
            for (int j = 0; j < 4; ++j) { v[j] = xr[64 * j]; s += (v[j].x * v[j].x + v[j].y * v[j].y) + (v[j].z * v[j].z + v[j].w * v[j].w); }
            s = wave_sum(s);
            if (lane == 0) RS1[m] = 1.0f / sqrtf(s * (1.0f / D) + EPS);
            GAS unsigned long long* o8 = (GAS unsigned long long*)(XB + (size_t)m * D) + lane;
#pragma unroll
            for (int j = 0; j < 4; ++j) o8[64 * j] = (unsigned long long)pk2(v[j].x, v[j].y) | ((unsigned long long)pk2(v[j].z, v[j].w) << 32);
        }
        for (int r = gw; r < 2 * NEXP; r += NGW) {
            const int tb = r / NEXP, e = r % NEXP;
            const GAS f32x4* src = (const GAS f32x4*)((tb ? peer_v : peer_u) + (size_t)e * D) + lane;
            GAS v2u* dst = (GAS v2u*)((tb ? V16 : U16) + (size_t)e * D) + lane;
#pragma unroll
            for (int j = 0; j < 4; ++j) { f32x4 v = src[64 * j]; if (!tb) { const f32x4 g = ((const GAS f32x4*)norm_ffn)[64 * j + lane]; v = v * g; }
                v2u o; o.x = pkh2(v.x, v.y); o.y = pkh2(v.z, v.w); dst[64 * j] = o; }
        }
        for (int i = (int)blockIdx.x * NWAVES * 64 + tid; i < T; i += G * NWAVES * 64) SS2[i] = 0.f;
        if (BOTH(0)) GRID_BAR();
    }

    if (IN(1)) {
        pg8::Gemm g{XB, W1T, T, DIN, D}; pg8::StaticOrder S; S.init(T, DIN, G, (int)blockIdx.x);
        pg8::EpiScaleBf16<0> E{PROJ, DIN, RS1};
        pg8::gemm_phase<pg8::EpiScaleBf16<0>, pg8::StaticOrder, PG8_ALIGN, PG8_SP2>(lds + RING_OFF, g, S, E);
        if (BOTH(1)) GRID_BAR();
    }

    if (IN(2)) {
        float lbv[8];
#pragma unroll
        for (int i = 0; i < 8; ++i) { const int j = 8 * lane + i; lbv[i] = 1.0f / (1.0f + __expf(hg_lb[512 + j] - hg_lb[j])); }
        for (int tok = gw; tok < T; tok += NGW) {
            const bf16* pr = PROJ + (size_t)tok * DIN;
            const v4u qv = *(const GAS v4u*)(pr + PC_Q + 8 * lane), fv = *(const GAS v4u*)(pr + PC_F + 8 * lane);
            float qf[8] = {bf_lo(qv.x), bf_hi(qv.x), bf_lo(qv.y), bf_hi(qv.y), bf_lo(qv.z), bf_hi(qv.z), bf_lo(qv.w), bf_hi(qv.w)};
            float ff[8] = {bf_lo(fv.x), bf_hi(fv.x), bf_lo(fv.y), bf_hi(fv.y), bf_lo(fv.z), bf_hi(fv.z), bf_lo(fv.w), bf_hi(fv.w)};
            float fo[8], qo[8];
#pragma unroll
            for (int i = 0; i < 8; ++i) { fo[i] = lbv[i] + (1.0f - lbv[i]) * sigmoidf_(ff[i]); qo[i] = qf[i] * sigmoidf_(qf[i]) * 0.08838834764831845f; }
            GAS f32x4* fp = (GAS f32x4*)(FG + (size_t)tok * 512) + 2 * lane; GAS f32x4* qp = (GAS f32x4*)(QS + (size_t)tok * 512) + 2 * lane;
            fp[0] = (f32x4){fo[0], fo[1], fo[2], fo[3]}; fp[1] = (f32x4){fo[4], fo[5], fo[6], fo[7]};
            qp[0] = (f32x4){qo[0], qo[1], qo[2], qo[3]}; qp[1] = (f32x4){qo[4], qo[5], qo[6], qo[7]};
        }
        for (int item = gw; item < NB * 8 * 32; item += NGW) {
            const int seg = item & 31, grp = (item >> 5) & 7, b = item >> 8, c = grp * 64 + lane, t0 = seg * 64;
            const float w0 = conv_w[c], w1 = conv_w[512 + c], w2 = conv_w[1024 + c], gn = conv_gain[c];
            float u1 = 0.f, u2 = 0.f;
            if (t0 > 0) { const bf16* p2 = PROJ + (size_t)(b * SEQ + t0 - 2) * DIN; const bf16* p1 = p2 + DIN;
                u2 = bf1(p2[PC_C + c]) * bf1(p2[PC_H + c]); u1 = bf1(p1[PC_C + c]) * bf1(p1[PC_H + c]); }
            for (int t = t0; t < t0 + 64; ++t) { const size_t tok = (size_t)b * SEQ + t; const bf16* pr = PROJ + tok * DIN;
                const float u = bf1(pr[PC_C + c]) * bf1(pr[PC_H + c]); const float y = bf1(pr[PC_B + c]) * (w0 * u2 + w1 * u1 + w2 * u);
                const float ss = wave_sum(y * y); const float r = 1.0f / sqrtf(ss * (1.0f / 64.0f) + EPS);
                MIX[tok * D + c] = (bf16)f2bf(y * r * gn); u2 = u1; u1 = u; }
        }
        if (BOTH(2)) GRID_BAR();
    }

    if (IN(3)) {
        if (wave == 0) for (int item = (int)blockIdx.x; item < NB * 4 * 2; item += G) {
            const int b = item >> 3, h = (item >> 1) & 3, vh = item & 1, vcol = h * 128 + vh * 64 + lane;
            float S[128];
#pragma unroll
            for (int k = 0; k < 128; ++k) S[k] = 0.f;
            for (int t = 0; t < SEQ; ++t) { const size_t tok = (size_t)b * SEQ + t;
                const float vt = bf1(PROJ[tok * DIN + PC_V + vcol]);
                const float* Fp = FG + tok * 512 + h * 128; const float* Qp = QS + tok * 512 + h * 128;
                float o = 0.f;
#pragma unroll
                for (int k = 0; k < 128; ++k) { S[k] = vt + Fp[k] * (S[k] - vt); o = fmaf(S[k], Qp[k], o); }
                ((GAS float*)(PROJ + tok * DIN + PC_Q))[vcol] = o; }
        }
        if (BOTH(3)) GRID_BAR();
    }

    if (IN(4)) {
        float gnv[8];
#pragma unroll
        for (int i = 0; i < 8; ++i) gnv[i] = hg_gain[(8 * lane + i) & 127];
        for (int tok = gw; tok < T; tok += NGW) {
            const bf16* pr = PROJ + (size_t)tok * DIN;
            const GAS f32x4* op = (const GAS f32x4*)(pr + PC_Q) + 2 * lane; const f32x4 o0 = op[0], o1 = op[1];
            const v4u gv = *(const GAS v4u*)(pr + PC_G + 8 * lane);
            float ss = (o0.x * o0.x + o0.y * o0.y) + (o0.z * o0.z + o0.w * o0.w) + (o1.x * o1.x + o1.y * o1.y) + (o1.z * o1.z + o1.w * o1.w);
            ss += __shfl_xor(ss, 1); ss += __shfl_xor(ss, 2); ss += __shfl_xor(ss, 4); ss += __shfl_xor(ss, 8);
            const float r = 1.0f / sqrtf(ss * (1.0f / 128.0f) + EPS);
            const float ov[8] = {o0.x, o0.y, o0.z, o0.w, o1.x, o1.y, o1.z, o1.w};
            const float gf[8] = {bf_lo(gv.x), bf_hi(gv.x), bf_lo(gv.y), bf_hi(gv.y), bf_lo(gv.z), bf_hi(gv.z), bf_lo(gv.w), bf_hi(gv.w)};
            float y[8];
#pragma unroll
            for (int i = 0; i < 8; ++i) y[i] = ov[i] * r * gnv[i] * (gf[i] * sigmoidf_(gf[i]));
            v4u w; w.x = pk2(y[0], y[1]); w.y = pk2(y[2], y[3]); w.z = pk2(y[4], y[5]); w.w = pk2(y[6], y[7]);
            *(GAS v4u*)(MIX + (size_t)tok * D + 512 + 8 * lane) = w;
        }
        if (BOTH(4)) GRID_BAR();
    }

    if (IN(5)) {
        pg8::Gemm g{MIX, WOT, T, D, D}; pg8::StaticOrder S; S.init(T, D, G, (int)blockIdx.x);
        pg8::EpiResid E{x, X1, SS2};
        pg8::gemm_phase<pg8::EpiResid, pg8::StaticOrder, PG8_ALIGN, PG8_SP2>(lds + RING_OFF, g, S, E);
        if (BOTH(5)) GRID_BAR();
    }

    if (IN(6)) {
        pg8::Gemm g{X1, WQT, T, 2048, D}; pg8::StaticOrder S; S.init(T, 2048, G, (int)blockIdx.x);
        pg8::EpiScaleBf16<1> E{QB, 2048, SS2};
        pg8::gemm_phase<pg8::EpiScaleBf16<1>, pg8::StaticOrder, PG8_ALIGN, PG8_SP2>(lds + RING_OFF, g, S, E);
        if (BOTH(6)) GRID_BAR();
    }

    if (IN(7)) {
        for (int item = gw; item < (T / 64) * 8; item += NGW) {
            const int h = item & 7, tok = (item >> 3) * 64 + lane;
            unsigned top[2][16];
#pragma unroll
            for (int p = 0; p < 2; ++p) {
                float q[128];
                const GAS v4u* qp = (const GAS v4u*)(QB + (size_t)tok * 2048 + h * 256 + p * 128);
#pragma unroll
                for (int i = 0; i < 16; ++i) { const v4u w = qp[i]; q[8 * i + 0] = bf_lo(w.x); q[8 * i + 1] = bf_hi(w.x); q[8 * i + 2] = bf_lo(w.y); q[8 * i + 3] = bf_hi(w.y);
                    q[8 * i + 4] = bf_lo(w.z); q[8 * i + 5] = bf_hi(w.z); q[8 * i + 6] = bf_lo(w.w); q[8 * i + 7] = bf_hi(w.w); }
#pragma unroll
                for (int j = 0; j < 16; ++j) top[p][j] = 0u;
                const float* kp = peer_keys + (size_t)((h * 2 + p) * 128) * 128;
                for (int n = 0; n < 128; ++n) { const float* kr = kp + n * 128;
                    float s0 = 0.f, s1 = 0.f, s2 = 0.f, s3 = 0.f;
#pragma unroll
                    for (int d = 0; d < 128; d += 4) { s0 = fmaf(q[d], kr[d], s0); s1 = fmaf(q[d + 1], kr[d + 1], s1); s2 = fmaf(q[d + 2], kr[d + 2], s2); s3 = fmaf(q[d + 3], kr[d + 3], s3); }
                    const float s = (s0 + s1) + (s2 + s3);
                    unsigned u = __builtin_bit_cast(unsigned, s); u = (u & 0x80000000u) ? ~u : (u | 0x80000000u);
                    unsigned key = (u & ~0x7Fu) | (unsigned)(127 - n);
#pragma unroll
                    for (int j = 0; j < 16; ++j) { const unsigned mx = top[p][j] > key ? top[p][j] : key; key = top[p][j] > key ? key : top[p][j]; top[p][j] = mx; }
                }
            }
            float v1[16], v2[16];
#pragma unroll
            for (int j = 0; j < 16; ++j) { unsigned a = top[0][j] & ~0x7Fu; a = (a & 0x80000000u) ? (a & 0x7FFFFFFFu) : ~a; v1[j] = __builtin_bit_cast(float, a);
                unsigned b = top[1][j] & ~0x7Fu; b = (b & 0x80000000u) ? (b & 0x7FFFFFFFu) : ~b; v2[j] = __builtin_bit_cast(float, b); }
            unsigned ct[16];
#pragma unroll
            for (int j = 0; j < 16; ++j) ct[j] = 0u;
#pragma unroll
            for (int i = 0; i < 16; ++i)
#pragma unroll
                for (int j = 0; j < 16; ++j) if ((i + 1) * (j + 1) <= 16) {
                    const float s = v1[i] + v2[j];
                    unsigned u = __builtin_bit_cast(unsigned, s); u = (u & 0x80000000u) ? ~u : (u | 0x80000000u);
                    unsigned key = (u & ~0xFFu) | (unsigned)(255 - (i * 16 + j));
#pragma unroll
                    for (int r = 0; r < 16; ++r) { const unsigned mx = ct[r] > key ? ct[r] : key; key = ct[r] > key ? key : ct[r]; ct[r] = mx; }
                }
            float cs[16]; unsigned eid[16];
#pragma unroll
            for (int r = 0; r < 16; ++r) { unsigned a = ct[r] & ~0xFFu; a = (a & 0x80000000u) ? (a & 0x7FFFFFFFu) : ~a; cs[r] = __builtin_bit_cast(float, a);
                const unsigned flat = 255u - (ct[r] & 0xFFu), ii = flat >> 4, jj = flat & 15u; unsigned k1 = 0u, k2 = 0u;
#pragma unroll
                for (int j = 0; j < 16; ++j) { k1 = (ii == (unsigned)j) ? top[0][j] : k1; k2 = (jj == (unsigned)j) ? top[1][j] : k2; }
                eid[r] = (127u - (k1 & 0x7Fu)) * 128u + (127u - (k2 & 0x7Fu)); }
            float den = 0.f, ex[16];
#pragma unroll
            for (int r = 0; r < 16; ++r) { ex[r] = __expf(cs[r] - cs[0]); den += ex[r]; }
            const float inv = 1.0f / den;
            GAS v4u* ep = (GAS v4u*)(EXPT + (size_t)tok * 128 + h * 16);
#pragma unroll
            for (int r = 0; r < 4; ++r) { v4u w;
                w.x = eid[4 * r + 0] | (pkh2(ex[4 * r + 0] * inv, 0.f) << 16); w.y = eid[4 * r + 1] | (pkh2(ex[4 * r + 1] * inv, 0.f) << 16);
                w.z = eid[4 * r + 2] | (pkh2(ex[4 * r + 2] * inv, 0.f) << 16); w.w = eid[4 * r + 3] | (pkh2(ex[4 * r + 3] * inv, 0.f) << 16); ep[r] = w; }
        }
        if (BOTH(7)) GRID_BAR();
    }

    if (IN(8)) {
        float nf[16];
#pragma unroll
        for (int i = 0; i < 8; ++i) { nf[i] = norm_f[8 * lane + i]; nf[8 + i] = norm_f[512 + 8 * lane + i]; }
        for (int tok = gw; tok < T; tok += NGW) {
            const GAS v4u* xr = (const GAS v4u*)(X1 + (size_t)tok * D);
            const v4u xa = xr[lane], xb = xr[64 + lane];
            float xf[16] = {bf_lo(xa.x), bf_hi(xa.x), bf_lo(xa.y), bf_hi(xa.y), bf_lo(xa.z), bf_hi(xa.z), bf_lo(xa.w), bf_hi(xa.w),
                            bf_lo(xb.x), bf_hi(xb.x), bf_lo(xb.y), bf_hi(xb.y), bf_lo(xb.z), bf_hi(xb.z), bf_lo(xb.w), bf_hi(xb.w)};
            h2_t hx[8];
#pragma unroll
            for (int i = 0; i < 8; ++i) hx[i] = __builtin_bit_cast(h2_t, pkh2(xf[2 * i], xf[2 * i + 1]));
            const float rstd2 = 1.0f / sqrtf(SS2[tok] * (1.0f / D) + EPS);
            float y[16];
#pragma unroll
            for (int i = 0; i < 16; ++i) y[i] = 0.f;
#pragma unroll
            for (int half = 0; half < 2; ++half) {
                const unsigned ev = EXPT[(size_t)tok * 128 + half * 64 + lane];
                float amine = 0.f;
#pragma unroll 8
                for (int i = 0; i < 64; ++i) {
                    const unsigned id = (unsigned)__builtin_amdgcn_readlane((int)ev, i) & 0xFFFFu;
                    const GAS v4u* ur = (const GAS v4u*)(U16 + (size_t)id * D);
                    const v4u ua = ur[lane], ub = ur[64 + lane];
                    float p = 0.f;
                    p = __builtin_amdgcn_fdot2(h2_of(ua.x), hx[0], p, false); p = __builtin_amdgcn_fdot2(h2_of(ua.y), hx[1], p, false);
                    p = __builtin_amdgcn_fdot2(h2_of(ua.z), hx[2], p, false); p = __builtin_amdgcn_fdot2(h2_of(ua.w), hx[3], p, false);
                    p = __builtin_amdgcn_fdot2(h2_of(ub.x), hx[4], p, false); p = __builtin_amdgcn_fdot2(h2_of(ub.y), hx[5], p, false);
                    p = __builtin_amdgcn_fdot2(h2_of(ub.z), hx[6], p, false); p = __builtin_amdgcn_fdot2(h2_of(ub.w), hx[7], p, false);
                    p = wave_sum(p);
                    amine = (lane == i) ? p : amine;
                }
                const float a = amine * rstd2;
                const float gl = 0.5f * a * (1.0f + erff(a * 0.7071067811865476f));
                const float gate = (float)__builtin_bit_cast(h2_t, ev >> 16).x;
                const float wv = gate * gl;
#pragma unroll 8
                for (int i = 0; i < 64; ++i) {
                    const unsigned id = (unsigned)__builtin_amdgcn_readlane((int)ev, i) & 0xFFFFu;
                    const float wi = __builtin_bit_cast(float, __builtin_amdgcn_readlane(__builtin_bit_cast(int, wv), i));
                    const GAS v4u* vr = (const GAS v4u*)(V16 + (size_t)id * D);
                    const v4u va = vr[lane], vb = vr[64 + lane];
                    const unsigned vw[8] = {va.x, va.y, va.z, va.w, vb.x, vb.y, vb.z, vb.w};
#pragma unroll
                    for (int j = 0; j < 8; ++j) { const h2_t hv = __builtin_bit_cast(h2_t, vw[j]); y[2 * j] = fmaf((float)hv.x, wi, y[2 * j]); y[2 * j + 1] = fmaf((float)hv.y, wi, y[2 * j + 1]); }
                }
            }
            float ss = 0.f;
#pragma unroll
            for (int i = 0; i < 16; ++i) { y[i] += xf[i]; ss += y[i] * y[i]; }
            ss = wave_sum(ss);
            const float r = 1.0f / sqrtf(ss * (1.0f / D) + EPS);
            GAS f32x4* op = (GAS f32x4*)(out + (size_t)tok * D);
            op[2 * lane] = (f32x4){y[0] * r * nf[0], y[1] * r * nf[1], y[2] * r * nf[2], y[3] * r * nf[3]};
            op[2 * lane + 1] = (f32x4){y[4] * r * nf[4], y[5] * r * nf[5], y[6] * r * nf[6], y[7] * r * nf[7]};
            op[128 + 2 * lane] = (f32x4){y[8] * r * nf[8], y[9] * r * nf[9], y[10] * r * nf[10], y[11] * r * nf[11]};
            op[128 + 2 * lane + 1] = (f32x4){y[12] * r * nf[12], y[13] * r * nf[13], y[14] * r * nf[14], y[15] * r * nf[15]};
        }
    }
#undef IN
#undef BOTH
}

extern "C" void kernel_launch(void* const* d_in, const int* in_sizes, int n_in, void* d_out, int out_size, void* d_ws, size_t ws_size, hipStream_t stream) {
    static int grid = 0;
    if (grid == 0) {
        if (n_in != 14 || in_sizes[0] != T * D || out_size != T * D || ws_size < WS_END) { fprintf(stderr, "kernel_launch: unexpected shapes (n_in %d, in0 %d, out %d, ws %zu); nothing launched\n", n_in, n_in > 0 ? in_sizes[0] : -1, out_size, ws_size); grid = -1; return; }
        int dev = 0, cus = 0, per_cu = 0;
        if (hipGetDevice(&dev) != hipSuccess || hipDeviceGetAttribute(&cus, hipDeviceAttributeMultiprocessorCount, dev) != hipSuccess) { grid = -1; return; }
        if (hipFuncSetAttribute((const void*)hymba_fwd, hipFuncAttributeMaxDynamicSharedMemorySize, LDS_BYTES) != hipSuccess) { fprintf(stderr, "kernel_launch: hipFuncSetAttribute failed\n"); grid = -1; return; }
        if (hipOccupancyMaxActiveBlocksPerMultiprocessor(&per_cu, (const void*)hymba_fwd, NWAVES * 64, LDS_BYTES) != hipSuccess || per_cu < 1) { fprintf(stderr, "kernel_launch: occupancy query says %d blocks per CU\n", per_cu); (void)hipGetLastError(); grid = -1; return; }
        grid = cus;
    }
    if (grid < 0) return;
    if (hipMemsetAsync((char*)d_ws + WS_CTL, 0, CTL_ZERO_BYTES, stream) != hipSuccess) { fprintf(stderr, "kernel_launch: hipMemsetAsync failed\n"); return; }
    Args a{};
    for (int i = 0; i < 14; ++i) a.in[i] = (const float*)d_in[i];
    a.out = (float*)d_out; a.ws = (unsigned char*)d_ws;
    if (N_LAUNCHES == 1) {
        a.ph_lo = 0; a.ph_hi = NPHASES; a.li = 0;
        void* kargs[] = {&a};
        const hipError_t e = hipLaunchCooperativeKernel((const void*)hymba_fwd, dim3(grid), dim3(NWAVES * 64), kargs, LDS_BYTES, stream);
        if (e != hipSuccess) fprintf(stderr, "kernel_launch: cooperative launch failed: %s (grid %d)\n", hipGetErrorString(e), grid);
    } else {
        for (int li = 0; li < NPHASES; ++li) {
            a.ph_lo = li; a.ph_hi = li + 1; a.li = li;
            hipLaunchKernelGGL(hymba_fwd, dim3(grid), dim3(NWAVES * 64), LDS_BYTES, stream, a);
            const hipError_t le = hipPeekAtLastError();
            if (le != hipSuccess) { fprintf(stderr, "kernel_launch: launch %d failed: %s\n", li, hipGetErrorName(le)); break; }
        }
    }
}
```

```cpp
#include <hip/hip_runtime.h>
#include <cstdio>
#include <cstdint>
namespace pg8 {
#define PG8_LAS __attribute__((address_space(3)))
typedef unsigned short bf16_t;
typedef short bf16x8 __attribute__((ext_vector_type(8)));
typedef float f32x4 __attribute__((ext_vector_type(4)));
typedef unsigned u32x4 __attribute__((ext_vector_type(4)));
constexpr int BM = 256, BK = 64, HALF = 128, HTB = HALF * BK * 2  , STAGE_BYTES = 8 * HTB, NXCD = 8, WGM = 8;

__host__ __device__ __forceinline__ int lds_byte(int r, int c) { const int st = (r >> 4) * 2 + (c >> 5), rr = r & 15, cc = c & 31, ob = rr * 64 + cc * 2; return st * 1024 + (ob ^ (((ob >> 9) & 1) << 5)); }
__host__ __device__ __forceinline__ void stage_rc(int b, int& R, int& C) { const int st = b / 1024, sb = b % 1024, swz = sb ^ (((sb >> 9) & 1) << 5); R = (st >> 1) * 16 + swz / 64; C = (st & 1) * 32 + (swz % 64) / 2; }
__host__ __device__ __forceinline__ int perm32(int rho) { const int n = rho >> 4, i = rho & 15; return 8 * (i >> 2) + 4 * n + (i & 3); }

struct Unit { int pm, pn; };
struct Gemm { const bf16_t* A; const bf16_t* Bt; int M, N, K; };

struct StaticOrder {
    int nM, nN, nwg, G, c;
    __host__ __device__ void init(int M, int N, int G_, int c_) { nM = M / BM; nN = N / BM; nwg = nM * nN; G = G_; c = c_; }
    __host__ __device__ bool next(int i, Unit& u) const {
        const long L = (long)i * G + c; if (L >= nwg) return false;
        int wgid = (int)L; { const int q = nwg / NXCD, r = nwg % NXCD, xcd = wgid % NXCD, off = wgid / NXCD; wgid = (xcd < r ? xcd * (q + 1) : r * (q + 1) + (xcd - r) * q) + off; }
        const int nig = WGM * nN, gid = wgid / nig, fm = gid * WGM, gsz = (nM - fm) < WGM ? (nM - fm) : WGM;
        u.pm = fm + ((wgid % nig) % gsz); u.pn = (wgid % nig) / gsz; return true;
    }
    __device__ __forceinline__ void a_ready(const Unit&) const {}
    __device__ __forceinline__ void done(const Unit&) const {}
};

__device__ __forceinline__ unsigned cvt_pk_bf16(float lo, float hi) { unsigned r; asm volatile("v_cvt_pk_bf16_f32 %0, %1, %2" : "=v"(r) : "v"(lo), "v"(hi)); return r; }

template <int MODE> struct EpiScaleBf16 {
    static constexpr bool PERM = true, AFTER_DRAIN = false;
    bf16_t* O; int ldc; const float* rowv;
    __device__ __forceinline__ void operator()(const f32x4 (&acc)[2][2][4][2], const Unit& u, int wr, int wc, int fr, int fq) const {
        const int row0 = u.pm * BM + wr * 64 + fr, col0 = u.pn * BM + wc * 32 + 8 * fq;
#pragma unroll
        for (int ai = 0; ai < 2; ++ai)
#pragma unroll
            for (int m = 0; m < 4; ++m) { const int row = row0 + ai * HALF + m * 16; float s = rowv[row]; if (MODE == 1) s = 1.0f / sqrtf(s * (1.0f / 1024.0f) + 1e-6f);
                bf16_t* rowp = O + (size_t)row * ldc + col0;
#pragma unroll
                for (int bj = 0; bj < 2; ++bj) { const f32x4 v0 = acc[ai][bj][m][0] * s, v1 = acc[ai][bj][m][1] * s;
                    u32x4 w; w.x = cvt_pk_bf16(v0[0], v0[1]); w.y = cvt_pk_bf16(v0[2], v0[3]); w.z = cvt_pk_bf16(v1[0], v1[1]); w.w = cvt_pk_bf16(v1[2], v1[3]);
                    *(u32x4*)(rowp + bj * HALF) = w; } }
    }
};
struct EpiResid {
    static constexpr bool PERM = true, AFTER_DRAIN = false;
    const float* X; bf16_t* O; float* ss;
    __device__ __forceinline__ void operator()(const f32x4 (&acc)[2][2][4][2], const Unit& u, int wr, int wc, int fr, int fq) const {
        const int row0 = u.pm * BM + wr * 64 + fr, col0 = u.pn * BM + wc * 32 + 8 * fq;
#pragma unroll
        for (int ai = 0; ai < 2; ++ai)
#pragma unroll
            for (int m = 0; m < 4; ++m) { const int row = row0 + ai * HALF + m * 16; float part = 0.f;
#pragma unroll
                for (int bj = 0; bj < 2; ++bj) { const float* xp = X + (size_t)row * 1024 + col0 + bj * HALF;
                    const f32x4 v0 = acc[ai][bj][m][0] + *(const f32x4*)xp, v1 = acc[ai][bj][m][1] + *(const f32x4*)(xp + 4);
                    part += (v0[0] * v0[0] + v0[1] * v0[1]) + (v0[2] * v0[2] + v0[3] * v0[3]) + (v1[0] * v1[0] + v1[1] * v1[1]) + (v1[2] * v1[2] + v1[3] * v1[3]);
                    u32x4 w; w.x = cvt_pk_bf16(v0[0], v0[1]); w.y = cvt_pk_bf16(v0[2], v0[3]); w.z = cvt_pk_bf16(v1[0], v1[1]); w.w = cvt_pk_bf16(v1[2], v1[3]);
                    *(u32x4*)(O + (size_t)row * 1024 + col0 + bj * HALF) = w; }
                part += __shfl_xor(part, 16); part += __shfl_xor(part, 32);
                if (fq == 0) (void)__builtin_amdgcn_global_atomic_fadd_f32((__attribute__((address_space(1))) float*)(ss + row), part); }
    }
};

template <class Epi, class Sched, bool ALIGN_EPI = false, bool SP2 = false>
__device__ __forceinline__ void gemm_phase(PG8_LAS unsigned char* lds, const Gemm g, const Sched& S, const Epi& E) {
    const int tid = threadIdx.x, wid = __builtin_amdgcn_readfirstlane(tid >> 6), lane = tid & 63, wr = wid >> 2, wc = wid & 3, fr = lane & 15, fq = lane >> 4;
    const int K = g.K, nt = K / BK;
    unsigned voffA[2], voffB[2];
#pragma unroll
    for (int i = 0; i < 2; ++i) { int R, C; stage_rc(tid * 16 + i * 8192, R, C); const int Rb = Epi::PERM ? ((R & ~31) + perm32(R & 31)) : R;
        voffA[i] = (unsigned)(R * K + C) * 2u; voffB[i] = (unsigned)(Rb * K + C) * 2u; }
    const size_t kstep = (size_t)(BK * 2);
    const size_t hstep = (size_t)HALF * K * 2;
    const size_t tstep = 2 * hstep;
    const unsigned ldsw = (unsigned)wid * 1024u;
    const int aoff = lds_byte(wr * 64 + fr, fq * 8), boff = lds_byte(wc * 32 + fr, fq * 8);
#define PG8_SA(b, h) (((b) * 2 + (h)) * HTB)
#define PG8_SB(b, h) ((4 + (b) * 2 + (h)) * HTB)
#define PG8_STAGE(bufoff, gbase, voff) do { _Pragma("unroll") for (int _i = 0; _i < 2; ++_i) \
        __builtin_amdgcn_global_load_lds((const unsigned*)((const char*)(gbase) + (voff)[_i]), (PG8_LAS unsigned*)(lds + (bufoff) + ldsw + _i * 8192), 16, 0, 0); } while (0)
#define PG8_LDA(dst, b, h) do { _Pragma("unroll") for (int m = 0; m < 4; ++m) _Pragma("unroll") for (int k = 0; k < 2; ++k) dst[m][k] = *(const PG8_LAS bf16x8*)(lds + PG8_SA(b, h) + aoff + m * 2048 + k * 1024); } while (0)
#define PG8_LDB(dst, b, h) do { _Pragma("unroll") for (int n = 0; n < 2; ++n) _Pragma("unroll") for (int k = 0; k < 2; ++k) dst[n][k] = *(const PG8_LAS bf16x8*)(lds + PG8_SB(b, h) + boff + n * 2048 + k * 1024); } while (0)
#define PG8_MMA(ai, bj, At, Bt) do { __builtin_amdgcn_s_setprio(1); _Pragma("unroll") for (int m = 0; m < 4; ++m) _Pragma("unroll") for (int n = 0; n < 2; ++n) _Pragma("unroll") for (int k = 0; k < 2; ++k) \
        acc[ai][bj][m][n] = __builtin_amdgcn_mfma_f32_16x16x32_bf16(Bt[n][k], At[m][k], acc[ai][bj][m][n], 0, 0, 0); __builtin_amdgcn_s_setprio(0); } while (0)
#define PG8_WAIT_V(n) asm volatile("s_waitcnt vmcnt(" #n ")" ::: "memory")
#define PG8_WAIT_L(n) asm volatile("s_waitcnt lgkmcnt(" #n ")" ::: "memory")
#define PG8_BAR __builtin_amdgcn_s_barrier()
#define PG8_SCHED __builtin_amdgcn_sched_barrier(0)
    Unit cur, nxt; int ui = 0;
    if (!S.next(0, cur)) return;
    f32x4 acc[2][2][4][2];
#pragma unroll
    for (int a = 0; a < 2; ++a)
#pragma unroll
        for (int b = 0; b < 2; ++b)
#pragma unroll
            for (int m = 0; m < 4; ++m)
#pragma unroll
                for (int n = 0; n < 2; ++n) acc[a][b][m][n] = (f32x4){0.f, 0.f, 0.f, 0.f};
    bf16x8 At[4][2], B0[2][2], B1[2][2];
    const char* cA = (const char*)g.A + (size_t)cur.pm * tstep; const char* cB = (const char*)g.Bt + (size_t)cur.pn * tstep;
    S.a_ready(cur);
    if constexpr (SP2) {
        PG8_STAGE(PG8_SB(0, 0), cB, voffB); PG8_STAGE(PG8_SB(0, 1), cB + hstep, voffB); PG8_STAGE(PG8_SA(0, 0), cA, voffA); PG8_STAGE(PG8_SA(0, 1), cA + hstep, voffA);
        if (wr == 1) PG8_BAR;
        PG8_WAIT_V(2); PG8_BAR;
        PG8_STAGE(PG8_SB(1, 0), cB + kstep, voffB); PG8_STAGE(PG8_SA(1, 0), cA + kstep, voffA); PG8_STAGE(PG8_SB(1, 1), cB + hstep + kstep, voffB);
        PG8_WAIT_V(6); PG8_BAR;
    } else {
        PG8_STAGE(PG8_SB(0, 0), cB, voffB); PG8_STAGE(PG8_SA(0, 0), cA, voffA); PG8_STAGE(PG8_SB(0, 1), cB + hstep, voffB); PG8_STAGE(PG8_SA(0, 1), cA + hstep, voffA);
        if (wr == 1) PG8_BAR;
        PG8_WAIT_V(4); PG8_BAR;
        PG8_STAGE(PG8_SB(1, 0), cB + kstep, voffB); PG8_STAGE(PG8_SA(1, 0), cA + kstep, voffA); PG8_STAGE(PG8_SB(1, 1), cB + hstep + kstep, voffB);
        PG8_WAIT_V(6); PG8_BAR;
    }
    for (;;) {
        const bool has_next = S.next(ui + 1, nxt);
        const char* nA = has_next ? (const char*)g.A + (size_t)nxt.pm * tstep : cA; const char* nB = has_next ? (const char*)g.Bt + (size_t)nxt.pn * tstep : cB;
        for (int t = 0; t < nt; t += 2) {
            const bool last = (t == nt - 2);
            const char* a1 = cA + (size_t)(t + 1) * kstep;
            const char* a2 = last ? nA : cA + (size_t)(t + 2) * kstep; const char* b2 = last ? nB : cB + (size_t)(t + 2) * kstep;
            const char* a3 = a2 + kstep; const char* b3 = b2 + kstep;
            if (last && has_next) S.a_ready(nxt);
            if constexpr (SP2) {
            PG8_LDB(B0, 0, 0); PG8_LDB(B1, 0, 1); PG8_SCHED; PG8_LDA(At, 0, 0); PG8_STAGE(PG8_SA(1, 1), a1 + hstep, voffA);
            PG8_WAIT_V(8); PG8_WAIT_L(0); PG8_BAR; PG8_MMA(0, 0, At, B0); PG8_MMA(0, 1, At, B1); PG8_BAR; PG8_SCHED;
            PG8_LDA(At, 0, 1); PG8_STAGE(PG8_SB(0, 0), b2, voffB); PG8_STAGE(PG8_SB(0, 1), b2 + hstep, voffB); PG8_STAGE(PG8_SA(0, 0), a2, voffA);
            PG8_WAIT_V(8); PG8_WAIT_L(0); PG8_BAR; PG8_MMA(1, 0, At, B0); PG8_MMA(1, 1, At, B1); PG8_BAR; PG8_SCHED;
            PG8_LDB(B0, 1, 0); PG8_LDB(B1, 1, 1); PG8_SCHED; PG8_LDA(At, 1, 0); PG8_STAGE(PG8_SA(0, 1), a2 + hstep, voffA);
            PG8_WAIT_V(8); PG8_WAIT_L(0); PG8_BAR; PG8_MMA(0, 0, At, B0); PG8_MMA(0, 1, At, B1); PG8_BAR; PG8_SCHED;
            PG8_LDA(At, 1, 1); PG8_STAGE(PG8_SB(1, 0), b3, voffB); PG8_STAGE(PG8_SB(1, 1), b3 + hstep, voffB); PG8_STAGE(PG8_SA(1, 0), a3, voffA);
            PG8_WAIT_V(8); PG8_WAIT_L(0); PG8_BAR; PG8_MMA(1, 0, At, B0); PG8_MMA(1, 1, At, B1); PG8_BAR; PG8_SCHED;
            } else {
            PG8_LDB(B0, 0, 0); PG8_SCHED; PG8_LDA(At, 0, 0); PG8_STAGE(PG8_SA(1, 1), a1 + hstep, voffA);
            PG8_WAIT_L(8); PG8_BAR; PG8_WAIT_L(0); PG8_MMA(0, 0, At, B0); PG8_BAR; PG8_SCHED;
            PG8_LDB(B1, 0, 1); PG8_STAGE(PG8_SB(0, 0), b2, voffB);
            PG8_BAR; PG8_WAIT_L(0); PG8_MMA(0, 1, At, B1); PG8_BAR;
            PG8_LDA(At, 0, 1); PG8_STAGE(PG8_SA(0, 0), a2, voffA);
            PG8_BAR; PG8_WAIT_L(0); PG8_MMA(1, 0, At, B0); PG8_BAR; PG8_SCHED;
            PG8_STAGE(PG8_SB(0, 1), b2 + hstep, voffB);
            PG8_WAIT_V(6); PG8_BAR; PG8_MMA(1, 1, At, B1); PG8_BAR;
            PG8_LDB(B0, 1, 0); PG8_SCHED; PG8_LDA(At, 1, 0); PG8_STAGE(PG8_SA(0, 1), a2 + hstep, voffA);
            PG8_WAIT_L(8); PG8_BAR; PG8_WAIT_L(0); PG8_MMA(0, 0, At, B0); PG8_BAR; PG8_SCHED;
            PG8_LDB(B1, 1, 1); PG8_STAGE(PG8_SB(1, 0), b3, voffB);
            PG8_BAR; PG8_WAIT_L(0); PG8_MMA(0, 1, At, B1); PG8_BAR;
            PG8_LDA(At, 1, 1); PG8_STAGE(PG8_SA(1, 0), a3, voffA);
            PG8_BAR; PG8_WAIT_L(0); PG8_MMA(1, 0, At, B0); PG8_BAR; PG8_SCHED;
            PG8_STAGE(PG8_SB(1, 1), b3 + hstep, voffB);
            PG8_WAIT_V(6); PG8_BAR; PG8_MMA(1, 1, At, B1); PG8_BAR;
            }
        }
        if constexpr (ALIGN_EPI) { if (wr == 0) PG8_BAR; }
        if constexpr (!Epi::AFTER_DRAIN) { E(acc, cur, wr, wc, fr, fq); S.done(cur); }
        if (!has_next) break;
#pragma unroll
        for (int a = 0; a < 2; ++a)
#pragma unroll
            for (int b = 0; b < 2; ++b)
#pragma unroll
                for (int m = 0; m < 4; ++m)
#pragma unroll
                    for (int n = 0; n < 2; ++n) acc[a][b][m][n] = (f32x4){0.f, 0.f, 0.f, 0.f};
        cur = nxt; cA = nA; cB = nB; ++ui;
        if constexpr (ALIGN_EPI) { if (wr == 1) PG8_BAR; }
    }
    PG8_WAIT_V(0);
    if constexpr (!ALIGN_EPI) { if (wr == 0) PG8_BAR; }
    PG8_BAR;
    if constexpr (Epi::AFTER_DRAIN) { E.fused(acc, cur, wr, wc, fr, fq, lds, wid, lane); S.done(cur); }
#undef PG8_SA
#undef PG8_SB
#undef PG8_STAGE
#undef PG8_LDA
#undef PG8_LDB
#undef PG8_MMA
#undef PG8_WAIT_V
#undef PG8_WAIT_L
#undef PG8_BAR
#undef PG8_SCHED
}
}

#ifndef PG8_SP2
#define PG8_SP2 true
#endif
#ifndef PG8_ALIGN
#define PG8_ALIGN true
#endif
#ifndef MK_N_LAUNCHES
#define MK_N_LAUNCHES 1
#endif
constexpr int NWAVES = 8;
constexpr int NPHASES = 9;
constexpr int N_LAUNCHES = MK_N_LAUNCHES;

constexpr int NB = 32, SEQ = 2048, T = NB * SEQ, D = 1024, DIN = 3584;
constexpr int PC_C = 0, PC_H = 512, PC_B = 1024, PC_Q = 1536, PC_F = 2048, PC_V = 2560, PC_G = 3072;
constexpr int NEXP = 16384;
constexpr float EPS = 1e-6f;

constexpr size_t MiB = 1u << 20;
constexpr size_t WS_CTL = 0, CTL_ZERO_BYTES = 1 * MiB;
constexpr size_t WS_W1T = 2 * MiB, WS_WOT = 10 * MiB, WS_WQT = 12 * MiB, WS_RS1 = 16 * MiB, WS_SS2 = 17 * MiB;
constexpr size_t WS_U16 = 32 * MiB, WS_V16 = 64 * MiB, WS_EXP = 96 * MiB;
constexpr size_t WS_XB = 128 * MiB;
constexpr size_t WS_X1 = 256 * MiB;
constexpr size_t WS_PROJ = 384 * MiB;
constexpr size_t WS_F = 832 * MiB;
constexpr size_t WS_END = 960 * MiB;
constexpr int CW_BAR = 4096;

constexpr int RING_OFF = 0, RING_BYTES = 131072;
constexpr int LDSCTL_OFF = RING_BYTES, MISC_OFF = LDSCTL_OFF + 320;
constexpr int LDS_BYTES = 147456;

#define GAS __attribute__((address_space(1)))
#define LAS __attribute__((address_space(3)))
typedef unsigned short bf16;
typedef unsigned v4u __attribute__((ext_vector_type(4)));
typedef unsigned v2u __attribute__((ext_vector_type(2)));
typedef float f32x4 __attribute__((ext_vector_type(4)));
typedef float f32x2 __attribute__((ext_vector_type(2)));
typedef _Float16 h2_t __attribute__((ext_vector_type(2)));
typedef GAS unsigned gu32;
#define RLX_AGENT __ATOMIC_RELAXED, __HIP_MEMORY_SCOPE_AGENT
#define LDS_WAIT() asm volatile("s_waitcnt lgkmcnt(0)" ::: "memory")
#define VM_WAIT() asm volatile("s_waitcnt vmcnt(0)" ::: "memory")
__device__ __forceinline__ unsigned f2bf(float f) { unsigned u = __builtin_bit_cast(unsigned, f); return (u + 0x7fffu + ((u >> 16) & 1u)) >> 16; }
__device__ __forceinline__ unsigned pk2(float lo, float hi) { return f2bf(lo) | (f2bf(hi) << 16); }
__device__ __forceinline__ float bf_lo(unsigned w) { return __builtin_bit_cast(float, w << 16); }
__device__ __forceinline__ float bf_hi(unsigned w) { return __builtin_bit_cast(float, w & 0xffff0000u); }
__device__ __forceinline__ float bf1(bf16 v) { return __builtin_bit_cast(float, (unsigned)v << 16); }
__device__ __forceinline__ unsigned pkh2(float lo, float hi) { f32x2 v = {lo, hi}; h2_t h = __builtin_convertvector(v, h2_t); return __builtin_bit_cast(unsigned, h); }
__device__ __forceinline__ h2_t h2_of(unsigned w) { return __builtin_bit_cast(h2_t, w); }
__device__ __forceinline__ float wave_sum(float v) {
#pragma unroll
    for (int o = 1; o < 64; o <<= 1) v += __shfl_xor(v, o);
    return v;
}
__device__ __forceinline__ float sigmoidf_(float x) { return 1.0f / (1.0f + __expf(-x)); }

#define XB_TMO      128
#define XB_XCNT(j)  (256  + 64 * (j))
#define XB_XSUB(j)  (1280 + 64 * (j))
#define XB_XGEN(j)  (2304 + 64 * (j))
#define XB_TOP      3328
#define XB_TOPGEN   3392
#define XCD_BAR_WORDS 3456
#define XB_SPIN_CAP (1u << 18)

__device__ __forceinline__ unsigned xb_ld(unsigned* p)              { return __hip_atomic_load(p, __ATOMIC_RELAXED, __HIP_MEMORY_SCOPE_AGENT); }
__device__ __forceinline__ unsigned xb_add(unsigned* p, unsigned v) { return __hip_atomic_fetch_add(p, v, __ATOMIC_RELAXED, __HIP_MEMORY_SCOPE_AGENT); }
__device__ __forceinline__ unsigned xb_xcc_id() { return (unsigned)__builtin_amdgcn_s_getreg((3 << 11) | 20) & 0xFu; }
#define XB_SPIN(cond, bar) do { unsigned _sp = 0; while (cond) { __builtin_amdgcn_s_sleep(1); \
    if ((++_sp & 255u) == 0u) { if (xb_ld(&(bar)[XB_TMO])) break; if (_sp > XB_SPIN_CAP) { atomicAdd(&(bar)[XB_TMO], 1u); break; } } } } while (0)

struct XcdBarrier {
    unsigned* bar; unsigned x;
    volatile LAS unsigned* st;
};

__device__ __forceinline__ XcdBarrier xcd_barrier_post(unsigned* bar, volatile LAS unsigned* st) {
    XcdBarrier b; b.bar = bar; b.x = xb_xcc_id(); b.st = st;
    if (threadIdx.x == 0) (void)xb_add(&bar[XB_XCNT(b.x)], 1u);
    return b;
}
__device__ __forceinline__ void xcd_barrier_complete(unsigned* bar, unsigned x, unsigned& nloc, unsigned& nx) {
    const unsigned G = gridDim.x * gridDim.y * gridDim.z;
    unsigned sum, cnt, mine, sp = 0u;
    for (;;) {
        sum = 0u; cnt = 0u; mine = 0u;
#pragma unroll
        for (unsigned j = 0; j < 16; ++j) { const unsigned c = xb_ld(&bar[XB_XCNT(j)]); sum += c; cnt += (c > 0u) ? 1u : 0u; mine = (j == x) ? c : mine; }
        if (sum == G) break;
        __builtin_amdgcn_s_sleep(1);
        if ((++sp & 255u) == 0u) { if (xb_ld(&bar[XB_TMO])) break; if (sp > XB_SPIN_CAP) { atomicAdd(&bar[XB_TMO], 1u); break; } }
    }
    nloc = mine > 0u ? mine : 1u; nx = cnt > 0u ? cnt : 1u;
}

__device__ __forceinline__ void xcd_barrier(const XcdBarrier& b) {
    asm volatile("s_waitcnt vmcnt(0)" ::: "memory");
    __syncthreads();
    if (threadIdx.x == 0) {
        unsigned* bar = b.bar;
        __builtin_amdgcn_s_waitcnt(0);
        unsigned nloc = b.st[0], nx = b.st[1];
        if (nloc == 0u) { xcd_barrier_complete(bar, b.x, nloc, nx); b.st[0] = nloc; b.st[1] = nx; }
        const unsigned old = xb_add(&bar[XB_XSUB(b.x)], 1u);
        const unsigned gen = old / nloc;
        if (old + 1u == (gen + 1u) * nloc) {
            __builtin_amdgcn_fence(__ATOMIC_RELEASE, "agent");
            asm volatile("s_waitcnt vmcnt(0)" ::: "memory");
            const unsigned og = xb_add(&bar[XB_TOP], 1u);
            const unsigned tg = og / nx;
            if (og + 1u == (tg + 1u) * nx) xb_add(&bar[XB_TOPGEN], 1u);
            else XB_SPIN(xb_ld(&bar[XB_TOPGEN]) == tg, bar);
            __builtin_amdgcn_fence(__ATOMIC_ACQUIRE, "agent");
            xb_add(&bar[XB_XGEN(b.x)], 1u);
            asm volatile("s_waitcnt vmcnt(0)" ::: "memory");
        } else {
            XB_SPIN(xb_ld(&bar[XB_XGEN(b.x)]) == gen, bar);
            __builtin_amdgcn_fence(__ATOMIC_ACQUIRE, "agent");
            asm volatile("s_waitcnt vmcnt(0)" ::: "memory");
        }
    }
    __syncthreads();
}


__device__ __forceinline__ void p0_transpose_item(const float* W, int K, int N, const float* gain, bf16* WT, LAS float* scr, int item, int lane) {
    const int nblk = N / 32, kb = item / nblk, nb = item % nblk, k0 = 64 * kb, n0 = 32 * nb;
#pragma unroll 8
    for (int i = 0; i < 32; ++i) { const int kk = 2 * i + (lane >> 5); const float g = gain ? gain[k0 + kk] : 1.0f; scr[kk * 33 + (lane & 31)] = W[(size_t)(k0 + kk) * N + n0 + (lane & 31)] * g; }
    LDS_WAIT(); asm volatile("" ::: "memory");
    const int c = lane & 7;
#pragma unroll
    for (int j = 0; j < 4; ++j) { const int n = (lane >> 3) + 8 * j; const LAS float* s = scr + (8 * c) * 33 + n;
        v4u o; o.x = pk2(s[0 * 33], s[1 * 33]); o.y = pk2(s[2 * 33], s[3 * 33]); o.z = pk2(s[4 * 33], s[5 * 33]); o.w = pk2(s[6 * 33], s[7 * 33]);
        *(GAS v4u*)(WT + (size_t)(n0 + n) * K + k0 + 8 * c) = o; }
    LDS_WAIT(); asm volatile("" ::: "memory");
}

struct Args { const float* in[14]; float* out; unsigned char* ws; int ph_lo, ph_hi, li, pad; };

__global__ void __launch_bounds__(NWAVES * 64, 2) hymba_fwd(Args args) {
    extern __shared__ __attribute__((aligned(16))) unsigned char lds_raw[];
    LAS unsigned char* lds = (LAS unsigned char*)lds_raw;
    volatile LAS unsigned* MISC = (volatile LAS unsigned*)(lds + MISC_OFF);
    const int tid = threadIdx.x, lane = tid & 63, wave = __builtin_amdgcn_readfirstlane(tid >> 6);
    const int G = gridDim.x;
    const int gw = (int)blockIdx.x * NWAVES + wave, NGW = G * NWAVES;
    unsigned char* ws = args.ws;
    gu32* ctl = (gu32*)(ws + WS_CTL);
    const float* x = args.in[0]; const float* norm_mix = args.in[1]; const float* w_in = args.in[2]; const float* conv_w = args.in[3]; const float* conv_gain = args.in[4];
    const float* hg_lb = args.in[5]; const float* hg_gain = args.in[6]; const float* w_out = args.in[7]; const float* norm_ffn = args.in[8]; const float* peer_wq = args.in[9];
    const float* peer_keys = args.in[10]; const float* peer_u = args.in[11]; const float* peer_v = args.in[12]; const float* norm_f = args.in[13];
    float* out = args.out;
    bf16* W1T = (bf16*)(ws + WS_W1T); bf16* WOT = (bf16*)(ws + WS_WOT); bf16* WQT = (bf16*)(ws + WS_WQT);
    float* RS1 = (float*)(ws + WS_RS1); float* SS2 = (float*)(ws + WS_SS2);
    unsigned short* U16 = (unsigned short*)(ws + WS_U16); unsigned short* V16 = (unsigned short*)(ws + WS_V16); unsigned* EXPT = (unsigned*)(ws + WS_EXP);
    bf16* XB = (bf16*)(ws + WS_XB); bf16* MIX = (bf16*)(ws + WS_XB); bf16* X1 = (bf16*)(ws + WS_X1); float* QS = (float*)(ws + WS_X1);
    bf16* PROJ = (bf16*)(ws + WS_PROJ); bf16* QB = (bf16*)(ws + WS_PROJ); float* FG = (float*)(ws + WS_F);

    for (int u = tid; u < (LDS_BYTES - LDSCTL_OFF) / 4; u += NWAVES * 64) ((LAS unsigned*)(lds + LDSCTL_OFF))[u] = 0u;
    __syncthreads();
    XcdBarrier bar; bar.bar = (unsigned*)(ctl + CW_BAR); bar.x = 0; bar.st = nullptr;
    if (N_LAUNCHES == 1) bar = xcd_barrier_post((unsigned*)(ctl + CW_BAR), MISC + 8);
#define GRID_BAR() do { if (N_LAUNCHES == 1) xcd_barrier(bar); } while (0)
    const int lo = args.ph_lo, hi = args.ph_hi;
#define IN(k) (lo <= (k) && (k) < hi)
#define BOTH(k) (IN(k) && IN((k) + 1))

    if (IN(0)) {
        LAS float* scr = (LAS float*)(lds + RING_OFF + wave * 16384);
        constexpr int I_1 = (D / 64) * (DIN / 32), I_O = (D / 64) * (D / 32), I_Q = (D / 64) * (2048 / 32);
        for (int it = gw; it < I_1 + I_O + I_Q; it += NGW) {
            int r = it;
            if (r < I_1) { p0_transpose_item(w_in, D, DIN, norm_mix, W1T, scr, r, lane); continue; } r -= I_1;
            if (r < I_O) { p0_transpose_item(w_out, D, D, nullptr, WOT, scr, r, lane); continue; } r -= I_O;
            p0_transpose_item(peer_wq, D, 2048, norm_ffn, WQT, scr, r, lane);
        }
        for (int m = gw; m < T; m += NGW) {
            const GAS f32x4* xr = (const GAS f32x4*)(x + (size_t)m * D) + lane; f32x4 v[4]; float s = 0.f;
#pragma unroll
            for (int j = 0; j < 4; ++j) { v[j] = xr[64 * j]; s += (v[j].x * v[j].x + v[j].y * v[j].y) + (v[j].z * v[j].z + v[j].w * v[j].w); }
            s = wave_sum(s);
            if (lane == 0) RS1[m] = 1.0f / sqrtf(s * (1.0f / D) + EPS);
            GAS unsigned long long* o8 = (GAS unsigned long long*)(XB + (size_t)m * D) + lane;
#pragma unroll
            for (int j = 0; j < 4; ++j) o8[64 * j] = (unsigned long long)pk2(v[j].x, v[j].y) | ((unsigned long long)pk2(v[j].z, v[j].w) << 32);
        }
        for (int r = gw; r < 2 * NEXP; r += NGW) {
            const int tb = r / NEXP, e = r % NEXP;
            const GAS f32x4* src = (const GAS f32x4*)((tb ? peer_v : peer_u) + (size_t)e * D) + lane;
            GAS v2u* dst = (GAS v2u*)((tb ? V16 : U16) + (size_t)e * D) + lane;
#pragma unroll
            for (int j = 0; j < 4; ++j) { f32x4 v = src[64 * j]; if (!tb) { const f32x4 g = ((const GAS f32x4*)norm_ffn)[64 * j + lane]; v = v * g; }
                v2u o; o.x = pkh2(v.x, v.y); o.y = pkh2(v.z, v.w); dst[64 * j] = o; }
        }
        for (int i = (int)blockIdx.x * NWAVES * 64 + tid; i < T; i += G * NWAVES * 64) SS2[i] = 0.f;
        if (BOTH(0)) GRID_BAR();
    }

    if (IN(1)) {
        pg8::Gemm g{XB, W1T, T, DIN, D}; pg8::StaticOrder S; S.init(T, DIN, G, (int)blockIdx.x);
        pg8::EpiScaleBf16<0> E{PROJ, DIN, RS1};
        pg8::gemm_phase<pg8::EpiScaleBf16<0>, pg8::StaticOrder, PG8_ALIGN, PG8_SP2>(lds + RING_OFF, g, S, E);
        if (BOTH(1)) GRID_BAR();
    }

    if (IN(2)) {
        float lbv[8];
#pragma unroll
        for (int i = 0; i < 8; ++i) { const int j = 8 * lane + i; lbv[i] = 1.0f / (1.0f + __expf(hg_lb[512 + j] - hg_lb[j])); }
        for (int tok = gw; tok < T; tok += NGW) {
            const bf16* pr = PROJ + (size_t)tok * DIN;
            const v4u qv = *(const GAS v4u*)(pr + PC_Q + 8 * lane), fv = *(const GAS v4u*)(pr + PC_F + 8 * lane);
            float qf[8] = {bf_lo(qv.x), bf_hi(qv.x), bf_lo(qv.y), bf_hi(qv.y), bf_lo(qv.z), bf_hi(qv.z), bf_lo(qv.w), bf_hi(qv.w)};
            float ff[8] = {bf_lo(fv.x), bf_hi(fv.x), bf_lo(fv.y), bf_hi(fv.y), bf_lo(fv.z), bf_hi(fv.z), bf_lo(fv.w), bf_hi(fv.w)};
            float fo[8], qo[8];
#pragma unroll
            for (int i = 0; i < 8; ++i) { fo[i] = lbv[i] + (1.0f - lbv[i]) * sigmoidf_(ff[i]); qo[i] = qf[i] * sigmoidf_(qf[i]) * 0.08838834764831845f; }
            GAS f32x4* fp = (GAS f32x4*)(FG + (size_t)tok * 512) + 2 * lane; GAS f32x4* qp = (GAS f32x4*)(QS + (size_t)tok * 512) + 2 * lane;
            fp[0] = (f32x4){fo[0], fo[1], fo[2], fo[3]}; fp[1] = (f32x4){fo[4], fo[5], fo[6], fo[7]};
            qp[0] = (f32x4){qo[0], qo[1], qo[2], qo[3]}; qp[1] = (f32x4){qo[4], qo[5], qo[6], qo[7]};
        }
        for (int item = gw; item < NB * 8 * 32; item += NGW) {
            const int seg = item & 31, grp = (item >> 5) & 7, b = item >> 8, c = grp * 64 + lane, t0 = seg * 64;
            const float w0 = conv_w[c], w1 = conv_w[512 + c], w2 = conv_w[1024 + c], gn = conv_gain[c];
            float u1 = 0.f, u2 = 0.f;
            if (t0 > 0) { const bf16* p2 = PROJ + (size_t)(b * SEQ + t0 - 2) * DIN; const bf16* p1 = p2 + DIN;
                u2 = bf1(p2[PC_C + c]) * bf1(p2[PC_H + c]); u1 = bf1(p1[PC_C + c]) * bf1(p1[PC_H + c]); }
            for (int t = t0; t < t0 + 64; ++t) { const size_t tok = (size_t)b * SEQ + t; const bf16* pr = PROJ + tok * DIN;
                const float u = bf1(pr[PC_C + c]) * bf1(pr[PC_H + c]); const float y = bf1(pr[PC_B + c]) * (w0 * u2 + w1 * u1 + w2 * u);
                const float ss = wave_sum(y * y); const float r = 1.0f / sqrtf(ss * (1.0f / 64.0f) + EPS);
                MIX[tok * D + c] = (bf16)f2bf(y * r * gn); u2 = u1; u1 = u; }
        }
        if (BOTH(2)) GRID_BAR();
    }

    if (IN(3)) {
        if (wave == 0) for (int item = (int)blockIdx.x; item < NB * 4 * 2; item += G) {
            const int b = item >> 3, h = (item >> 1) & 3, vh = item & 1, vcol = h * 128 + vh * 64 + lane;
            float S[128];
#pragma unroll
            for (int k = 0; k < 128; ++k) S[k] = 0.f;
            for (int t = 0; t < SEQ; ++t) { const size_t tok = (size_t)b * SEQ + t;
                const float vt = bf1(PROJ[tok * DIN + PC_V + vcol]);
                const float* Fp = FG + tok * 512 + h * 128; const float* Qp = QS + tok * 512 + h * 128;
                float o = 0.f;
#pragma unroll
                for (int k = 0; k < 128; ++k) { S[k] = vt + Fp[k] * (S[k] - vt); o = fmaf(S[k], Qp[k], o); }
                ((GAS float*)(PROJ + tok * DIN + PC_Q))[vcol] = o; }
        }
        if (BOTH(3)) GRID_BAR();
    }

    if (IN(4)) {
        float gnv[8];
#pragma unroll
        for (int i = 0; i < 8; ++i) gnv[i] = hg_gain[(8 * lane + i) & 127];
        for (int tok = gw; tok < T; tok += NGW) {
            const bf16* pr = PROJ + (size_t)tok * DIN;
            const GAS f32x4* op = (const GAS f32x4*)(pr + PC_Q) + 2 * lane; const f32x4 o0 = op[0], o1 = op[1];
            const v4u gv = *(const GAS v4u*)(pr + PC_G + 8 * lane);
            float ss = (o0.x * o0.x + o0.y * o0.y) + (o0.z * o0.z + o0.w * o0.w) + (o1.x * o1.x + o1.y * o1.y) + (o1.z * o1.z + o1.w * o1.w);
            ss += __shfl_xor(ss, 1); ss += __shfl_xor(ss, 2); ss += __shfl_xor(ss, 4); ss += __shfl_xor(ss, 8);
            const float r = 1.0f / sqrtf(ss * (1.0f / 128.0f) + EPS);
            const float ov[8] = {o0.x, o0.y, o0.z, o0.w, o1.x, o1.y, o1.z, o1.w};
            const float gf[8] = {bf_lo(gv.x), bf_hi(gv.x), bf_lo(gv.y), bf_hi(gv.y), bf_lo(gv.z), bf_hi(gv.z), bf_lo(gv.w), bf_hi(gv.w)};
            float y[8];
#pragma unroll
            for (int i = 0; i < 8; ++i) y[i] = ov[i] * r * gnv[i] * (gf[i] * sigmoidf_(gf[i]));
            v4u w; w.x = pk2(y[0], y[1]); w.y = pk2(y[2], y[3]); w.z = pk2(y[4], y[5]); w.w = pk2(y[6], y[7]);
            *(GAS v4u*)(MIX + (size_t)tok * D + 512 + 8 * lane) = w;
        }
        if (BOTH(4)) GRID_BAR();
    }

    if (IN(5)) {
        pg8::Gemm g{MIX, WOT, T, D, D}; pg8::StaticOrder S; S.init(T, D, G, (int)blockIdx.x);
        pg8::EpiResid E{x, X1, SS2};
        pg8::gemm_phase<pg8::EpiResid, pg8::StaticOrder, PG8_ALIGN, PG8_SP2>(lds + RING_OFF, g, S, E);
        if (BOTH(5)) GRID_BAR();
    }

    if (IN(6)) {
        pg8::Gemm g{X1, WQT, T, 2048, D}; pg8::StaticOrder S; S.init(T, 2048, G, (int)blockIdx.x);
        pg8::EpiScaleBf16<1> E{QB, 2048, SS2};
        pg8::gemm_phase<pg8::EpiScaleBf16<1>, pg8::StaticOrder, PG8_ALIGN, PG8_SP2>(lds + RING_OFF, g, S, E);
        if (BOTH(6)) GRID_BAR();
    }

    if (IN(7)) {
        for (int item = gw; item < (T / 64) * 8; item += NGW) {
            const int h = item & 7, tok = (item >> 3) * 64 + lane;
            unsigned top[2][16];
#pragma unroll
            for (int p = 0; p < 2; ++p) {
                float q[128];
                const GAS v4u* qp = (const GAS v4u*)(QB + (size_t)tok * 2048 + h * 256 + p * 128);
#pragma unroll
                for (int i = 0; i < 16; ++i) { const v4u w = qp[i]; q[8 * i + 0] = bf_lo(w.x); q[8 * i + 1] = bf_hi(w.x); q[8 * i + 2] = bf_lo(w.y); q[8 * i + 3] = bf_hi(w.y);
                    q[8 * i + 4] = bf_lo(w.z); q[8 * i + 5] = bf_hi(w.z); q[8 * i + 6] = bf_lo(w.w); q[8 * i + 7] = bf_hi(w.w); }
#pragma unroll
                for (int j = 0; j < 16; ++j) top[p][j] = 0u;
                const float* kp = peer_keys + (size_t)((h * 2 + p) * 128) * 128;
                for (int n = 0; n < 128; ++n) { const float* kr = kp + n * 128;
                    float s0 = 0.f, s1 = 0.f, s2 = 0.f, s3 = 0.f;
#pragma unroll
                    for (int d = 0; d < 128; d += 4) { s0 = fmaf(q[d], kr[d], s0); s1 = fmaf(q[d + 1], kr[d + 1], s1); s2 = fmaf(q[d + 2], kr[d + 2], s2); s3 = fmaf(q[d + 3], kr[d + 3], s3); }
                    const float s = (s0 + s1) + (s2 + s3);
                    unsigned u = __builtin_bit_cast(unsigned, s); u = (u & 0x80000000u) ? ~u : (u | 0x80000000u);
                    unsigned key = (u & ~0x7Fu) | (unsigned)(127 - n);
#pragma unroll
                    for (int j = 0; j < 16; ++j) { const unsigned mx = top[p][j] > key ? top[p][j] : key; key = top[p][j] > key ? key : top[p][j]; top[p][j] = mx; }
                }
            }
            float v1[16], v2[16];
#pragma unroll
            for (int j = 0; j < 16; ++j) { unsigned a = top[0][j] & ~0x7Fu; a = (a & 0x80000000u) ? (a & 0x7FFFFFFFu) : ~a; v1[j] = __builtin_bit_cast(float, a);
                unsigned b = top[1][j] & ~0x7Fu; b = (b & 0x80000000u) ? (b & 0x7FFFFFFFu) : ~b; v2[j] = __builtin_bit_cast(float, b); }
            unsigned ct[16];
#pragma unroll
            for (int j = 0; j < 16; ++j) ct[j] = 0u;
#pragma unroll
            for (int i = 0; i < 16; ++i)
#pragma unroll
                for (int j = 0; j < 16; ++j) if ((i + 1) * (j + 1) <= 16) {
                    const float s = v1[i] + v2[j];
                    unsigned u = __builtin_bit_cast(unsigned, s); u = (u & 0x80000000u) ? ~u : (u | 0x80000000u);
                    unsigned key = (u & ~0xFFu) | (unsigned)(255 - (i * 16 + j));
#pragma unroll
                    for (int r = 0; r < 16; ++r) { const unsigned mx = ct[r] > key ? ct[r] : key; key = ct[r] > key ? key : ct[r]; ct[r] = mx; }
                }
            float cs[16]; unsigned eid[16];
#pragma unroll
            for (int r = 0; r < 16; ++r) { unsigned a = ct[r] & ~0xFFu; a = (a & 0x80000000u) ? (a & 0x7FFFFFFFu) : ~a; cs[r] = __builtin_bit_cast(float, a);
                const unsigned flat = 255u - (ct[r] & 0xFFu), ii = flat >> 4, jj = flat & 15u; unsigned k1 = 0u, k2 = 0u;
#pragma unroll
                for (int j = 0; j < 16; ++j) { k1 = (ii == (unsigned)j) ? top[0][j] : k1; k2 = (jj == (unsigned)j) ? top[1][j] : k2; }
                eid[r] = (127u - (k1 & 0x7Fu)) * 128u + (127u - (k2 & 0x7Fu)); }
            float den = 0.f, ex[16];
#pragma unroll
            for (int r = 0; r < 16; ++r) { ex[r] = __expf(cs[r] - cs[0]); den += ex[r]; }
            const float inv = 1.0f / den;
            GAS v4u* ep = (GAS v4u*)(EXPT + (size_t)tok * 128 + h * 16);
#pragma unroll
            for (int r = 0; r < 4; ++r) { v4u w;
                w.x = eid[4 * r + 0] | (pkh2(ex[4 * r + 0] * inv, 0.f) << 16); w.y = eid[4 * r + 1] | (pkh2(ex[4 * r + 1] * inv, 0.f) << 16);
                w.z = eid[4 * r + 2] | (pkh2(ex[4 * r + 2] * inv, 0.f) << 16); w.w = eid[4 * r + 3] | (pkh2(ex[4 * r + 3] * inv, 0.f) << 16); ep[r] = w; }
        }
        if (BOTH(7)) GRID_BAR();
    }

    if (IN(8)) {
        float nf[16];
#pragma unroll
        for (int i = 0; i < 8; ++i) { nf[i] = norm_f[8 * lane + i]; nf[8 + i] = norm_f[512 + 8 * lane + i]; }
        for (int tok = gw; tok < T; tok += NGW) {
            const GAS v4u* xr = (const GAS v4u*)(X1 + (size_t)tok * D);
            const v4u xa = xr[lane], xb = xr[64 + lane];
            float xf[16] = {bf_lo(xa.x), bf_hi(xa.x), bf_lo(xa.y), bf_hi(xa.y), bf_lo(xa.z), bf_hi(xa.z), bf_lo(xa.w), bf_hi(xa.w),
                            bf_lo(xb.x), bf_hi(xb.x), bf_lo(xb.y), bf_hi(xb.y), bf_lo(xb.z), bf_hi(xb.z), bf_lo(xb.w), bf_hi(xb.w)};
            h2_t hx[8];
#pragma unroll
            for (int i = 0; i < 8; ++i) hx[i] = __builtin_bit_cast(h2_t, pkh2(xf[2 * i], xf[2 * i + 1]));
            const float rstd2 = 1.0f / sqrtf(SS2[tok] * (1.0f / D) + EPS);
            float y[16];
#pragma unroll
            for (int i = 0; i < 16; ++i) y[i] = 0.f;
#pragma unroll
            for (int half = 0; half < 2; ++half) {
                const unsigned ev = EXPT[(size_t)tok * 128 + half * 64 + lane];
                float amine = 0.f;
#pragma unroll 8
                for (int i = 0; i < 64; ++i) {
                    const unsigned id = (unsigned)__builtin_amdgcn_readlane((int)ev, i) & 0xFFFFu;
                    const GAS v4u* ur = (const GAS v4u*)(U16 + (size_t)id * D);
                    const v4u ua = ur[lane], ub = ur[64 + lane];
                    float p = 0.f;
                    p = __builtin_amdgcn_fdot2(h2_of(ua.x), hx[0], p, false); p = __builtin_amdgcn_fdot2(h2_of(ua.y), hx[1], p, false);
                    p = __builtin_amdgcn_fdot2(h2_of(ua.z), hx[2], p, false); p = __builtin_amdgcn_fdot2(h2_of(ua.w), hx[3], p, false);
                    p = __builtin_amdgcn_fdot2(h2_of(ub.x), hx[4], p, false); p = __builtin_amdgcn_fdot2(h2_of(ub.y), hx[5], p, false);
                    p = __builtin_amdgcn_fdot2(h2_of(ub.z), hx[6], p, false); p = __builtin_amdgcn_fdot2(h2_of(ub.w), hx[7], p, false);
                    p = wave_sum(p);
                    amine = (lane == i) ? p : amine;
                }
                const float a = amine * rstd2;
                const float gl = 0.5f * a * (1.0f + erff(a * 0.7071067811865476f));
                const float gate = (float)__builtin_bit_cast(h2_t, ev >> 16).x;
                const float wv = gate * gl;
#pragma unroll 8
                for (int i = 0; i < 64; ++i) {
                    const unsigned id = (unsigned)__builtin_amdgcn_readlane((int)ev, i) & 0xFFFFu;
                    const float wi = __builtin_bit_cast(float, __builtin_amdgcn_readlane(__builtin_bit_cast(int, wv), i));
                    const GAS v4u* vr = (const GAS v4u*)(V16 + (size_t)id * D);
                    const v4u va = vr[lane], vb = vr[64 + lane];
                    const unsigned vw[8] = {va.x, va.y, va.z, va.w, vb.x, vb.y, vb.z, vb.w};
#pragma unroll
                    for (int j = 0; j < 8; ++j) { const h2_t hv = __builtin_bit_cast(h2_t, vw[j]); y[2 * j] = fmaf((float)hv.x, wi, y[2 * j]); y[2 * j + 1] = fmaf((float)hv.y, wi, y[2 * j + 1]); }
                }
            }
            float ss = 0.f;
#pragma unroll
            for (int i = 0; i < 16; ++i) { y[i] += xf[i]; ss += y[i] * y[i]; }
            ss = wave_sum(ss);
            const float r = 1.0f / sqrtf(ss * (1.0f / D) + EPS);
            GAS f32x4* op = (GAS f32x4*)(out + (size_t)tok * D);
            op[2 * lane] = (f32x4){y[0] * r * nf[0], y[1] * r * nf[1], y[2] * r * nf[2], y[3] * r * nf[3]};
            op[2 * lane + 1] = (f32x4){y[4] * r * nf[4], y[5] * r * nf[5], y[6] * r * nf[6], y[7] * r * nf[7]};
            op[128 + 2 * lane] = (f32x4){y[8] * r * nf[8], y[9] * r * nf[9], y[10] * r * nf[10], y[11] * r * nf[11]};
            op[128 + 2 * lane + 1] = (f32x4){y[12] * r * nf[12], y[13] * r * nf[13], y[14] * r * nf[14], y[15] * r * nf[15]};
        }
    }
#undef IN
#undef BOTH
}

extern "C" void kernel_launch(void* const* d_in, const int* in_sizes, int n_in, void* d_out, int out_size, void* d_ws, size_t ws_size, hipStream_t stream) {
    static int grid = 0;
    if (grid == 0) {
        if (n_in != 14 || in_sizes[0] != T * D || out_size != T * D || ws_size < WS_END) { fprintf(stderr, "kernel_launch: unexpected shapes (n_in %d, in0 %d, out %d, ws %zu); nothing launched\n", n_in, n_in > 0 ? in_sizes[0] : -1, out_size, ws_size); grid = -1; return; }
        int dev = 0, cus = 0, per_cu = 0;
        if (hipGetDevice(&dev) != hipSuccess || hipDeviceGetAttribute(&cus, hipDeviceAttributeMultiprocessorCount, dev) != hipSuccess) { grid = -1; return; }
        if (hipFuncSetAttribute((const void*)hymba_fwd, hipFuncAttributeMaxDynamicSharedMemorySize, LDS_BYTES) != hipSuccess) { fprintf(stderr, "kernel_launch: hipFuncSetAttribute failed\n"); grid = -1; return; }
        if (hipOccupancyMaxActiveBlocksPerMultiprocessor(&per_cu, (const void*)hymba_fwd, NWAVES * 64, LDS_BYTES) != hipSuccess || per_cu < 1) { fprintf(stderr, "kernel_launch: occupancy query says %d blocks per CU\n", per_cu); (void)hipGetLastError(); grid = -1; return; }
        grid = cus;
    }
    if (grid < 0) return;
    if (hipMemsetAsync((char*)d_ws + WS_CTL, 0, CTL_ZERO_BYTES, stream) != hipSuccess) { fprintf(stderr, "kernel_launch: hipMemsetAsync failed\n"); return; }
    Args a{};
    for (int i = 0; i < 14; ++i) a.in[i] = (const float*)d_in[i];
    a.out = (float*)d_out; a.ws = (unsigned char*)d_ws;
    if (N_LAUNCHES == 1) {
        a.ph_lo = 0; a.ph_hi = NPHASES; a.li = 0;
        void* kargs[] = {&a};
        const hipError_t e = hipLaunchCooperativeKernel((const void*)hymba_fwd, dim3(grid), dim3(NWAVES * 64), kargs, LDS_BYTES, stream);
        if (e != hipSuccess) fprintf(stderr, "kernel_launch: cooperative launch failed: %s (grid %d)\n", hipGetErrorString(e), grid);
    } else {
        for (int li = 0; li < NPHASES; ++li) {
            a.ph_lo = li; a.ph_hi = li + 1; a.li = li;
            hipLaunchKernelGGL(hymba_fwd, dim3(grid), dim3(NWAVES * 64), LDS_BYTES, stream, a);
            const hipError_t le = hipPeekAtLastError();
            if (le != hipSuccess) { fprintf(stderr, "kernel_launch: launch %d failed: %s\n", li, hipGetErrorName(le)); break; }
        }
    }
}
```

```cpp
#include <hip/hip_runtime.h>
#include <cstdio>
#include <cstdint>
namespace pg8 {
#define PG8_LAS __attribute__((address_space(3)))
typedef unsigned short bf16_t;
typedef short bf16x8 __attribute__((ext_vector_type(8)));
typedef float f32x4 __attribute__((ext_vector_type(4)));
typedef unsigned u32x4 __attribute__((ext_vector_type(4)));
constexpr int BM = 256, BK = 64, HALF = 128, HTB = HALF * BK * 2  , STAGE_BYTES = 8 * HTB, NXCD = 8, WGM = 8;

__host__ __device__ __forceinline__ int lds_byte(int r, int c) { const int st = (r >> 4) * 2 + (c >> 5), rr = r & 15, cc = c & 31, ob = rr * 64 + cc * 2; return st * 1024 + (ob ^ (((ob >> 9) & 1) << 5)); }
__host__ __device__ __forceinline__ void stage_rc(int b, int& R, int& C) { const int st = b / 1024, sb = b % 1024, swz = sb ^ (((sb >> 9) & 1) << 5); R = (st >> 1) * 16 + swz / 64; C = (st & 1) * 32 + (swz % 64) / 2; }
__host__ __device__ __forceinline__ int perm32(int rho) { const int n = rho >> 4, i = rho & 15; return 8 * (i >> 2) + 4 * n + (i & 3); }

struct Unit { int pm, pn; };
struct Gemm { const bf16_t* A; const bf16_t* Bt; int M, N, K; };

struct StaticOrder {
    int nM, nN, nwg, G, c;
    __host__ __device__ void init(int M, int N, int G_, int c_) { nM = M / BM; nN = N / BM; nwg = nM * nN; G = G_; c = c_; }
    __host__ __device__ bool next(int i, Unit& u) const {
        const long L = (long)i * G + c; if (L >= nwg) return false;
        int wgid = (int)L; { const int q = nwg / NXCD, r = nwg % NXCD, xcd = wgid % NXCD, off = wgid / NXCD; wgid = (xcd < r ? xcd * (q + 1) : r * (q + 1) + (xcd - r) * q) + off; }
        const int nig = WGM * nN, gid = wgid / nig, fm = gid * WGM, gsz = (nM - fm) < WGM ? (nM - fm) : WGM;
        u.pm = fm + ((wgid % nig) % gsz); u.pn = (wgid % nig) / gsz; return true;
    }
    __device__ __forceinline__ void a_ready(const Unit&) const {}
    __device__ __forceinline__ void done(const Unit&) const {}
};

__device__ __forceinline__ unsigned cvt_pk_bf16(float lo, float hi) { unsigned r; asm volatile("v_cvt_pk_bf16_f32 %0, %1, %2" : "=v"(r) : "v"(lo), "v"(hi)); return r; }

template <int MODE> struct EpiScaleBf16 {
    static constexpr bool PERM = true, AFTER_DRAIN = false;
    bf16_t* O; int ldc; const float* rowv;
    __device__ __forceinline__ void operator()(const f32x4 (&acc)[2][2][4][2], const Unit& u, int wr, int wc, int fr, int fq) const {
        const int row0 = u.pm * BM + wr * 64 + fr, col0 = u.pn * BM + wc * 32 + 8 * fq;
#pragma unroll
        for (int ai = 0; ai < 2; ++ai)
#pragma unroll
            for (int m = 0; m < 4; ++m) { const int row = row0 + ai * HALF + m * 16; float s = rowv[row]; if (MODE == 1) s = 1.0f / sqrtf(s * (1.0f / 1024.0f) + 1e-6f);
                bf16_t* rowp = O + (size_t)row * ldc + col0;
#pragma unroll
                for (int bj = 0; bj < 2; ++bj) { const f32x4 v0 = acc[ai][bj][m][0] * s, v1 = acc[ai][bj][m][1] * s;
                    u32x4 w; w.x = cvt_pk_bf16(v0[0], v0[1]); w.y = cvt_pk_bf16(v0[2], v0[3]); w.z = cvt_pk_bf16(v1[0], v1[1]); w.w = cvt_pk_bf16(v1[2], v1[3]);
                    *(u32x4*)(rowp + bj * HALF) = w; } }
    }
};
struct EpiResid {
    static constexpr bool PERM = true, AFTER_DRAIN = false;
    const float* X; bf16_t* O; float* ss;
    __device__ __forceinline__ void operator()(const f32x4 (&acc)[2][2][4][2], const Unit& u, int wr, int wc, int fr, int fq) const {
        const int row0 = u.pm * BM + wr * 64 + fr, col0 = u.pn * BM + wc * 32 + 8 * fq;
#pragma unroll
        for (int ai = 0; ai < 2; ++ai)
#pragma unroll
            for (int m = 0; m < 4; ++m) { const int row = row0 + ai * HALF + m * 16; float part = 0.f;
#pragma unroll
                for (int bj = 0; bj < 2; ++bj) { const float* xp = X + (size_t)row * 1024 + col0 + bj * HALF;
                    const f32x4 v0 = acc[ai][bj][m][0] + *(const f32x4*)xp, v1 = acc[ai][bj][m][1] + *(const f32x4*)(xp + 4);
                    part += (v0[0] * v0[0] + v0[1] * v0[1]) + (v0[2] * v0[2] + v0[3] * v0[3]) + (v1[0] * v1[0] + v1[1] * v1[1]) + (v1[2] * v1[2] + v1[3] * v1[3]);
                    u32x4 w; w.x = cvt_pk_bf16(v0[0], v0[1]); w.y = cvt_pk_bf16(v0[2], v0[3]); w.z = cvt_pk_bf16(v1[0], v1[1]); w.w = cvt_pk_bf16(v1[2], v1[3]);
                    *(u32x4*)(O + (size_t)row * 1024 + col0 + bj * HALF) = w; }
                part += __shfl_xor(part, 16); part += __shfl_xor(part, 32);
                if (fq == 0) (void)__builtin_amdgcn_global_atomic_fadd_f32((__attribute__((address_space(1))) float*)(ss + row), part); }
    }
};

template <class Epi, class Sched, bool ALIGN_EPI = false, bool SP2 = false>
__device__ __forceinline__ void gemm_phase(PG8_LAS unsigned char* lds, const Gemm g, const Sched& S, const Epi& E) {
    const int tid = threadIdx.x, wid = __builtin_amdgcn_readfirstlane(tid >> 6), lane = tid & 63, wr = wid >> 2, wc = wid & 3, fr = lane & 15, fq = lane >> 4;
    const int K = g.K, nt = K / BK;
    unsigned voffA[2], voffB[2];
#pragma unroll
    for (int i = 0; i < 2; ++i) { int R, C; stage_rc(tid * 16 + i * 8192, R, C); const int Rb = Epi::PERM ? ((R & ~31) + perm32(R & 31)) : R;
        voffA[i] = (unsigned)(R * K + C) * 2u; voffB[i] = (unsigned)(Rb * K + C) * 2u; }
    const size_t kstep = (size_t)(BK * 2);
    const size_t hstep = (size_t)HALF * K * 2;
    const size_t tstep = 2 * hstep;
    const unsigned ldsw = (unsigned)wid * 1024u;
    const int aoff = lds_byte(wr * 64 + fr, fq * 8), boff = lds_byte(wc * 32 + fr, fq * 8);
#define PG8_SA(b, h) (((b) * 2 + (h)) * HTB)
#define PG8_SB(b, h) ((4 + (b) * 2 + (h)) * HTB)
#define PG8_STAGE(bufoff, gbase, voff) do { _Pragma("unroll") for (int _i = 0; _i < 2; ++_i) \
        __builtin_amdgcn_global_load_lds((const unsigned*)((const char*)(gbase) + (voff)[_i]), (PG8_LAS unsigned*)(lds + (bufoff) + ldsw + _i * 8192), 16, 0, 0); } while (0)
#define PG8_LDA(dst, b, h) do { _Pragma("unroll") for (int m = 0; m < 4; ++m) _Pragma("unroll") for (int k = 0; k < 2; ++k) dst[m][k] = *(const PG8_LAS bf16x8*)(lds + PG8_SA(b, h) + aoff + m * 2048 + k * 1024); } while (0)
#define PG8_LDB(dst, b, h) do { _Pragma("unroll") for (int n = 0; n < 2; ++n) _Pragma("unroll") for (int k = 0; k < 2; ++k) dst[n][k] = *(const PG8_LAS bf16x8*)(lds + PG8_SB(b, h) + boff + n * 2048 + k * 1024); } while (0)
#define PG8_MMA(ai, bj, At, Bt) do { __builtin_amdgcn_s_setprio(1); _Pragma("unroll") for (int m = 0; m < 4; ++m) _Pragma("unroll") for (int n = 0; n < 2; ++n) _Pragma("unroll") for (int k = 0; k < 2; ++k) \
        acc[ai][bj][m][n] = __builtin_amdgcn_mfma_f32_16x16x32_bf16(Bt[n][k], At[m][k], acc[ai][bj][m][n], 0, 0, 0); __builtin_amdgcn_s_setprio(0); } while (0)
#define PG8_WAIT_V(n) asm volatile("s_waitcnt vmcnt(" #n ")" ::: "memory")
#define PG8_WAIT_L(n) asm volatile("s_waitcnt lgkmcnt(" #n ")" ::: "memory")
#define PG8_BAR __builtin_amdgcn_s_barrier()
#define PG8_SCHED __builtin_amdgcn_sched_barrier(0)
    Unit cur, nxt; int ui = 0;
    if (!S.next(0, cur)) return;
    f32x4 acc[2][2][4][2];
#pragma unroll
    for (int a = 0; a < 2; ++a)
#pragma unroll
        for (int b = 0; b < 2; ++b)
#pragma unroll
            for (int m = 0; m < 4; ++m)
#pragma unroll
                for (int n = 0; n < 2; ++n) acc[a][b][m][n] = (f32x4){0.f, 0.f, 0.f, 0.f};
    bf16x8 At[4][2], B0[2][2], B1[2][2];
    const char* cA = (const char*)g.A + (size_t)cur.pm * tstep; const char* cB = (const char*)g.Bt + (size_t)cur.pn * tstep;
    S.a_ready(cur);
    if constexpr (SP2) {
        PG8_STAGE(PG8_SB(0, 0), cB, voffB); PG8_STAGE(PG8_SB(0, 1), cB + hstep, voffB); PG8_STAGE(PG8_SA(0, 0), cA, voffA); PG8_STAGE(PG8_SA(0, 1), cA + hstep, voffA);
        if (wr == 1) PG8_BAR;
        PG8_WAIT_V(2); PG8_BAR;
        PG8_STAGE(PG8_SB(1, 0), cB + kstep, voffB); PG8_STAGE(PG8_SA(1, 0), cA + kstep, voffA); PG8_STAGE(PG8_SB(1, 1), cB + hstep + kstep, voffB);
        PG8_WAIT_V(6); PG8_BAR;
    } else {
        PG8_STAGE(PG8_SB(0, 0), cB, voffB); PG8_STAGE(PG8_SA(0, 0), cA, voffA); PG8_STAGE(PG8_SB(0, 1), cB + hstep, voffB); PG8_STAGE(PG8_SA(0, 1), cA + hstep, voffA);
        if (wr == 1) PG8_BAR;
        PG8_WAIT_V(4); PG8_BAR;
        PG8_STAGE(PG8_SB(1, 0), cB + kstep, voffB); PG8_STAGE(PG8_SA(1, 0), cA + kstep, voffA); PG8_STAGE(PG8_SB(1, 1), cB + hstep + kstep, voffB);
        PG8_WAIT_V(6); PG8_BAR;
    }
    for (;;) {
        const bool has_next = S.next(ui + 1, nxt);
        const char* nA = has_next ? (const char*)g.A + (size_t)nxt.pm * tstep : cA; const char* nB = has_next ? (const char*)g.Bt + (size_t)nxt.pn * tstep : cB;
        for (int t = 0; t < nt; t += 2) {
            const bool last = (t == nt - 2);
            const char* a1 = cA + (size_t)(t + 1) * kstep;
            const char* a2 = last ? nA : cA + (size_t)(t + 2) * kstep; const char* b2 = last ? nB : cB + (size_t)(t + 2) * kstep;
            const char* a3 = a2 + kstep; const char* b3 = b2 + kstep;
            if (last && has_next) S.a_ready(nxt);
            if constexpr (SP2) {
            PG8_LDB(B0, 0, 0); PG8_LDB(B1, 0, 1); PG8_SCHED; PG8_LDA(At, 0, 0); PG8_STAGE(PG8_SA(1, 1), a1 + hstep, voffA);
            PG8_WAIT_V(8); PG8_WAIT_L(0); PG8_BAR; PG8_MMA(0, 0, At, B0); PG8_MMA(0, 1, At, B1); PG8_BAR; PG8_SCHED;
            PG8_LDA(At, 0, 1); PG8_STAGE(PG8_SB(0, 0), b2, voffB); PG8_STAGE(PG8_SB(0, 1), b2 + hstep, voffB); PG8_STAGE(PG8_SA(0, 0), a2, voffA);
            PG8_WAIT_V(8); PG8_WAIT_L(0); PG8_BAR; PG8_MMA(1, 0, At, B0); PG8_MMA(1, 1, At, B1); PG8_BAR; PG8_SCHED;
            PG8_LDB(B0, 1, 0); PG8_LDB(B1, 1, 1); PG8_SCHED; PG8_LDA(At, 1, 0); PG8_STAGE(PG8_SA(0, 1), a2 + hstep, voffA);
            PG8_WAIT_V(8); PG8_WAIT_L(0); PG8_BAR; PG8_MMA(0, 0, At, B0); PG8_MMA(0, 1, At, B1); PG8_BAR; PG8_SCHED;
            PG8_LDA(At, 1, 1); PG8_STAGE(PG8_SB(1, 0), b3, voffB); PG8_STAGE(PG8_SB(1, 1), b3 + hstep, voffB); PG8_STAGE(PG8_SA(1, 0), a3, voffA);
            PG8_WAIT_V(8); PG8_WAIT_L(0); PG8_BAR; PG8_MMA(1, 0, At, B0); PG8_MMA(1, 1, At, B1); PG8_BAR; PG8_SCHED;
            } else {
            PG8_LDB(B0, 0, 0); PG8_SCHED; PG8_LDA(At, 0, 0); PG8_STAGE(PG8_SA(1, 1), a1 + hstep, voffA);
            PG8_WAIT_L(8); PG8_BAR; PG8_WAIT_L(0); PG8_MMA(0, 0, At, B0); PG8_BAR; PG8_SCHED;
            PG8_LDB(B1, 0, 1); PG8_STAGE(PG8_SB(0, 0), b2, voffB);
            PG8_BAR; PG8_WAIT_L(0); PG8_MMA(0, 1, At, B1); PG8_BAR;
            PG8_LDA(At, 0, 1); PG8_STAGE(PG8_SA(0, 0), a2, voffA);
            PG8_BAR; PG8_WAIT_L(0); PG8_MMA(1, 0, At, B0); PG8_BAR; PG8_SCHED;
            PG8_STAGE(PG8_SB(0, 1), b2 + hstep, voffB);
            PG8_WAIT_V(6); PG8_BAR; PG8_MMA(1, 1, At, B1); PG8_BAR;
            PG8_LDB(B0, 1, 0); PG8_SCHED; PG8_LDA(At, 1, 0); PG8_STAGE(PG8_SA(0, 1), a2 + hstep, voffA);
            PG8_WAIT_L(8); PG8_BAR; PG8_WAIT_L(0); PG8_MMA(0, 0, At, B0); PG8_BAR; PG8_SCHED;
            PG8_LDB(B1, 1, 1); PG8_STAGE(PG8_SB(1, 0), b3, voffB);
            PG8_BAR; PG8_WAIT_L(0); PG8_MMA(0, 1, At, B1); PG8_BAR;
            PG8_LDA(At, 1, 1); PG8_STAGE(PG8_SA(1, 0), a3, voffA);
            PG8_BAR; PG8_WAIT_L(0); PG8_MMA(1, 0, At, B0); PG8_BAR; PG8_SCHED;
            PG8_STAGE(PG8_SB(1, 1), b3 + hstep, voffB);
            PG8_WAIT_V(6); PG8_BAR; PG8_MMA(1, 1, At, B1); PG8_BAR;
            }
        }
        if constexpr (ALIGN_EPI) { if (wr == 0) PG8_BAR; }
        if constexpr (!Epi::AFTER_DRAIN) { E(acc, cur, wr, wc, fr, fq); S.done(cur); }
        if (!has_next) break;
#pragma unroll
        for (int a = 0; a < 2; ++a)
#pragma unroll
            for (int b = 0; b < 2; ++b)
#pragma unroll
                for (int m = 0; m < 4; ++m)
#pragma unroll
                    for (int n = 0; n < 2; ++n) acc[a][b][m][n] = (f32x4){0.f, 0.f, 0.f, 0.f};
        cur = nxt; cA = nA; cB = nB; ++ui;
        if constexpr (ALIGN_EPI) { if (wr == 1) PG8_BAR; }
    }
    PG8_WAIT_V(0);
    if constexpr (!ALIGN_EPI) { if (wr == 0) PG8_BAR; }
    PG8_BAR;
    if constexpr (Epi::AFTER_DRAIN) { E.fused(acc, cur, wr, wc, fr, fq, lds, wid, lane); S.done(cur); }
#undef PG8_SA
#undef PG8_SB
#undef PG8_STAGE
#undef PG8_LDA
#undef PG8_LDB
#undef PG8_MMA
#undef PG8_WAIT_V
#undef PG8_WAIT_L
#undef PG8_BAR
#undef PG8_SCHED
}
}

#ifndef PG8_SP2
#define PG8_SP2 true
#endif
#ifndef PG8_ALIGN
#define PG8_ALIGN true
#endif
#ifndef MK_N_LAUNCHES
#define MK_N_LAUNCHES 1
#endif
constexpr int NWAVES = 8;
constexpr int NPHASES = 8;
constexpr int N_LAUNCHES = MK_N_LAUNCHES;

constexpr int NB = 32, SEQ = 2048, T = NB * SEQ, D = 1024, DIN = 3584;
constexpr int PC_C = 0, PC_H = 512, PC_B = 1024, PC_Q = 1536, PC_F = 2048, PC_V = 2560, PC_G = 3072;
constexpr int NEXP = 16384;
constexpr float EPS = 1e-6f;

constexpr size_t MiB = 1u << 20;
constexpr size_t WS_CTL = 0, CTL_ZERO_BYTES = 1 * MiB;
constexpr size_t WS_W1T = 2 * MiB, WS_WOT = 10 * MiB, WS_WQT = 12 * MiB, WS_RS1 = 16 * MiB, WS_SS2 = 17 * MiB;
constexpr size_t WS_U16 = 32 * MiB, WS_V16 = 64 * MiB, WS_EXP = 96 * MiB;
constexpr size_t WS_XB = 128 * MiB;
constexpr size_t WS_X1 = 256 * MiB;
constexpr size_t WS_PROJ = 384 * MiB;
constexpr size_t WS_F = 832 * MiB;
constexpr size_t WS_END = 960 * MiB;
constexpr int CW_BAR = 4096;

constexpr int RING_OFF = 0, RING_BYTES = 131072;
constexpr int LDSCTL_OFF = RING_BYTES, MISC_OFF = LDSCTL_OFF + 320;
constexpr int LDS_BYTES = 147456;

#define GAS __attribute__((address_space(1)))
#define LAS __attribute__((address_space(3)))
typedef unsigned short bf16;
typedef unsigned v4u __attribute__((ext_vector_type(4)));
typedef unsigned v2u __attribute__((ext_vector_type(2)));
typedef float f32x4 __attribute__((ext_vector_type(4)));
typedef float f32x2 __attribute__((ext_vector_type(2)));
typedef _Float16 h2_t __attribute__((ext_vector_type(2)));
typedef GAS unsigned gu32;
#define RLX_AGENT __ATOMIC_RELAXED, __HIP_MEMORY_SCOPE_AGENT
#define LDS_WAIT() asm volatile("s_waitcnt lgkmcnt(0)" ::: "memory")
#define VM_WAIT() asm volatile("s_waitcnt vmcnt(0)" ::: "memory")
__device__ __forceinline__ unsigned f2bf(float f) { unsigned u = __builtin_bit_cast(unsigned, f); return (u + 0x7fffu + ((u >> 16) & 1u)) >> 16; }
__device__ __forceinline__ unsigned pk2(float lo, float hi) { return f2bf(lo) | (f2bf(hi) << 16); }
__device__ __forceinline__ float bf_lo(unsigned w) { return __builtin_bit_cast(float, w << 16); }
__device__ __forceinline__ float bf_hi(unsigned w) { return __builtin_bit_cast(float, w & 0xffff0000u); }
__device__ __forceinline__ float bf1(bf16 v) { return __builtin_bit_cast(float, (unsigned)v << 16); }
__device__ __forceinline__ unsigned pkh2(float lo, float hi) { f32x2 v = {lo, hi}; h2_t h = __builtin_convertvector(v, h2_t); return __builtin_bit_cast(unsigned, h); }
__device__ __forceinline__ h2_t h2_of(unsigned w) { return __builtin_bit_cast(h2_t, w); }
__device__ __forceinline__ float wave_sum(float v) {
#pragma unroll
    for (int o = 1; o < 64; o <<= 1) v += __shfl_xor(v, o);
    return v;
}
typedef float f32x16 __attribute__((ext_vector_type(16)));
typedef __bf16 bf16x2_t __attribute__((ext_vector_type(2)));
__device__ __forceinline__ unsigned cvtpk(float lo, float hi) { f32x2 v = {lo, hi}; bf16x2_t b = __builtin_convertvector(v, bf16x2_t); return __builtin_bit_cast(unsigned, b); }
__device__ __forceinline__ pg8::bf16x8 pack8(const f32x16& x, int s) {
    v4u p; p.x = cvtpk(x[8 * s], x[8 * s + 1]); p.y = cvtpk(x[8 * s + 2], x[8 * s + 3]); p.z = cvtpk(x[8 * s + 4], x[8 * s + 5]); p.w = cvtpk(x[8 * s + 6], x[8 * s + 7]);
    return __builtin_bit_cast(pg8::bf16x8, p); }
__device__ __forceinline__ int swap23(int k) { return (k & ~12) | ((k & 4) << 1) | ((k & 8) >> 1); }
__device__ __forceinline__ float sigmoidf_(float x) { return 1.0f / (1.0f + __expf(-x)); }

#define XB_TMO      128
#define XB_XCNT(j)  (256  + 64 * (j))
#define XB_XSUB(j)  (1280 + 64 * (j))
#define XB_XGEN(j)  (2304 + 64 * (j))
#define XB_TOP      3328
#define XB_TOPGEN   3392
#define XCD_BAR_WORDS 3456
#define XB_SPIN_CAP (1u << 18)

__device__ __forceinline__ unsigned xb_ld(unsigned* p)              { return __hip_atomic_load(p, __ATOMIC_RELAXED, __HIP_MEMORY_SCOPE_AGENT); }
__device__ __forceinline__ unsigned xb_add(unsigned* p, unsigned v) { return __hip_atomic_fetch_add(p, v, __ATOMIC_RELAXED, __HIP_MEMORY_SCOPE_AGENT); }
__device__ __forceinline__ unsigned xb_xcc_id() { return (unsigned)__builtin_amdgcn_s_getreg((3 << 11) | 20) & 0xFu; }
#define XB_SPIN(cond, bar) do { unsigned _sp = 0; while (cond) { __builtin_amdgcn_s_sleep(1); \
    if ((++_sp & 255u) == 0u) { if (xb_ld(&(bar)[XB_TMO])) break; if (_sp > XB_SPIN_CAP) { atomicAdd(&(bar)[XB_TMO], 1u); break; } } } } while (0)

struct XcdBarrier {
    unsigned* bar; unsigned x;
    volatile LAS unsigned* st;
};

__device__ __forceinline__ XcdBarrier xcd_barrier_post(unsigned* bar, volatile LAS unsigned* st) {
    XcdBarrier b; b.bar = bar; b.x = xb_xcc_id(); b.st = st;
    if (threadIdx.x == 0) (void)xb_add(&bar[XB_XCNT(b.x)], 1u);
    return b;
}
__device__ __forceinline__ void xcd_barrier_complete(unsigned* bar, unsigned x, unsigned& nloc, unsigned& nx) {
    const unsigned G = gridDim.x * gridDim.y * gridDim.z;
    unsigned sum, cnt, mine, sp = 0u;
    for (;;) {
        sum = 0u; cnt = 0u; mine = 0u;
#pragma unroll
        for (unsigned j = 0; j < 16; ++j) { const unsigned c = xb_ld(&bar[XB_XCNT(j)]); sum += c; cnt += (c > 0u) ? 1u : 0u; mine = (j == x) ? c : mine; }
        if (sum == G) break;
        __builtin_amdgcn_s_sleep(1);
        if ((++sp & 255u) == 0u) { if (xb_ld(&bar[XB_TMO])) break; if (sp > XB_SPIN_CAP) { atomicAdd(&bar[XB_TMO], 1u); break; } }
    }
    nloc = mine > 0u ? mine : 1u; nx = cnt > 0u ? cnt : 1u;
}

__device__ __forceinline__ void xcd_barrier(const XcdBarrier& b) {
    asm volatile("s_waitcnt vmcnt(0)" ::: "memory");
    __syncthreads();
    if (threadIdx.x == 0) {
        unsigned* bar = b.bar;
        __builtin_amdgcn_s_waitcnt(0);
        unsigned nloc = b.st[0], nx = b.st[1];
        if (nloc == 0u) { xcd_barrier_complete(bar, b.x, nloc, nx); b.st[0] = nloc; b.st[1] = nx; }
        const unsigned old = xb_add(&bar[XB_XSUB(b.x)], 1u);
        const unsigned gen = old / nloc;
        if (old + 1u == (gen + 1u) * nloc) {
            __builtin_amdgcn_fence(__ATOMIC_RELEASE, "agent");
            asm volatile("s_waitcnt vmcnt(0)" ::: "memory");
            const unsigned og = xb_add(&bar[XB_TOP], 1u);
            const unsigned tg = og / nx;
            if (og + 1u == (tg + 1u) * nx) xb_add(&bar[XB_TOPGEN], 1u);
            else XB_SPIN(xb_ld(&bar[XB_TOPGEN]) == tg, bar);
            __builtin_amdgcn_fence(__ATOMIC_ACQUIRE, "agent");
            xb_add(&bar[XB_XGEN(b.x)], 1u);
            asm volatile("s_waitcnt vmcnt(0)" ::: "memory");
        } else {
            XB_SPIN(xb_ld(&bar[XB_XGEN(b.x)]) == gen, bar);
            __builtin_amdgcn_fence(__ATOMIC_ACQUIRE, "agent");
            asm volatile("s_waitcnt vmcnt(0)" ::: "memory");
        }
    }
    __syncthreads();
}


__device__ __forceinline__ void p0_transpose_item(const float* W, int K, int N, const float* gain, bf16* WT, LAS float* scr, int item, int lane) {
    const int nblk = N / 32, kb = item / nblk, nb = item % nblk, k0 = 64 * kb, n0 = 32 * nb;
#pragma unroll 8
    for (int i = 0; i < 32; ++i) { const int kk = 2 * i + (lane >> 5); const float g = gain ? gain[k0 + kk] : 1.0f; scr[kk * 33 + (lane & 31)] = W[(size_t)(k0 + kk) * N + n0 + (lane & 31)] * g; }
    LDS_WAIT(); asm volatile("" ::: "memory");
    const int c = lane & 7;
#pragma unroll
    for (int j = 0; j < 4; ++j) { const int n = (lane >> 3) + 8 * j; const LAS float* s = scr + (8 * c) * 33 + n;
        v4u o; o.x = pk2(s[0 * 33], s[1 * 33]); o.y = pk2(s[2 * 33], s[3 * 33]); o.z = pk2(s[4 * 33], s[5 * 33]); o.w = pk2(s[6 * 33], s[7 * 33]);
        *(GAS v4u*)(WT + (size_t)(n0 + n) * K + k0 + 8 * c) = o; }
    LDS_WAIT(); asm volatile("" ::: "memory");
}

struct Args { const float* in[14]; float* out; unsigned char* ws; int ph_lo, ph_hi, li, pad; };

__global__ void __launch_bounds__(NWAVES * 64, 2) hymba_fwd(Args args) {
    extern __shared__ __attribute__((aligned(16))) unsigned char lds_raw[];
    LAS unsigned char* lds = (LAS unsigned char*)lds_raw;
    volatile LAS unsigned* MISC = (volatile LAS unsigned*)(lds + MISC_OFF);
    const int tid = threadIdx.x, lane = tid & 63, wave = __builtin_amdgcn_readfirstlane(tid >> 6);
    const int G = gridDim.x;
    const int gw = (int)blockIdx.x * NWAVES + wave, NGW = G * NWAVES;
    unsigned char* ws = args.ws;
    gu32* ctl = (gu32*)(ws + WS_CTL);
    const float* x = args.in[0]; const float* norm_mix = args.in[1]; const float* w_in = args.in[2]; const float* conv_w = args.in[3]; const float* conv_gain = args.in[4];
    const float* hg_lb = args.in[5]; const float* hg_gain = args.in[6]; const float* w_out = args.in[7]; const float* norm_ffn = args.in[8]; const float* peer_wq = args.in[9];
    const float* peer_keys = args.in[10]; const float* peer_u = args.in[11]; const float* peer_v = args.in[12]; const float* norm_f = args.in[13];
    float* out = args.out;
    bf16* W1T = (bf16*)(ws + WS_W1T); bf16* WOT = (bf16*)(ws + WS_WOT); bf16* WQT = (bf16*)(ws + WS_WQT);
    float* RS1 = (float*)(ws + WS_RS1); float* SS2 = (float*)(ws + WS_SS2);
    unsigned short* U16 = (unsigned short*)(ws + WS_U16); unsigned short* V16 = (unsigned short*)(ws + WS_V16); unsigned* EXPT = (unsigned*)(ws + WS_EXP);
    bf16* XB = (bf16*)(ws + WS_XB); bf16* MIX = (bf16*)(ws + WS_XB); bf16* X1 = (bf16*)(ws + WS_X1);
    bf16* PROJ = (bf16*)(ws + WS_PROJ); bf16* QB = (bf16*)(ws + WS_PROJ); float* DEC = (float*)(ws + WS_F); bf16* KDT = (bf16*)(ws + WS_X1); bf16* VTT = (bf16*)(ws + WS_X1 + 64 * MiB);

    for (int u = tid; u < (LDS_BYTES - LDSCTL_OFF) / 4; u += NWAVES * 64) ((LAS unsigned*)(lds + LDSCTL_OFF))[u] = 0u;
    __syncthreads();
    XcdBarrier bar; bar.bar = (unsigned*)(ctl + CW_BAR); bar.x = 0; bar.st = nullptr;
    if (N_LAUNCHES == 1) bar = xcd_barrier_post((unsigned*)(ctl + CW_BAR), MISC + 8);
#define GRID_BAR() do { if (N_LAUNCHES == 1) xcd_barrier(bar); } while (0)
    const int lo = args.ph_lo, hi = args.ph_hi;
#define IN(k) (lo <= (k) && (k) < hi)
#define BOTH(k) (IN(k) && IN((k) + 1))

    if (IN(0)) {
        LAS float* scr = (LAS float*)(lds + RING_OFF + wave * 16384);
        constexpr int I_1 = (D / 64) * (DIN / 32), I_O = (D / 64) * (D / 32), I_Q = (D / 64) * (2048 / 32);
        for (int it = gw; it < I_1 + I_O + I_Q; it += NGW) {
            int r = it;
            if (r < I_1) { p0_transpose_item(w_in, D, DIN, norm_mix, W1T, scr, r, lane); continue; } r -= I_1;
            if (r < I_O) { p0_transpose_item(w_out, D, D, nullptr, WOT, scr, r, lane); continue; } r -= I_O;
            p0_transpose_item(peer_wq, D, 2048, norm_ffn, WQT, scr, r, lane);
        }
        for (int m = gw; m < T; m += NGW) {
            const GAS f32x4* xr = (const GAS f32x4*)(x + (size_t)m * D) + lane; f32x4 v[4]; float s = 0.f;
#pragma unroll
            for (int j = 0; j < 4; ++j) { v[j] = xr[64 * j]; s += (v[j].x * v[j].x + v[j].y * v[j].y) + (v[j].z * v[j].z + v[j].w * v[j].w); }
            s = wave_sum(s);
            if (lane == 0) RS1[m] = 1.0f / sqrtf(s * (1.0f / D) + EPS);
            GAS unsigned long long* o8 = (GAS unsigned long long*)(XB + (size_t)m * D) + lane;
#pragma unroll
            for (int j = 0; j < 4; ++j) o8[64 * j] = (unsigned long long)pk2(v[j].x, v[j].y) | ((unsigned long long)pk2(v[j].z, v[j].w) << 32);
        }
        for (int r = gw; r < 2 * NEXP; r += NGW) {
            const int tb = r / NEXP, e = r % NEXP;
            const GAS f32x4* src = (const GAS f32x4*)((tb ? peer_v : peer_u) + (size_t)e * D) + lane;
            GAS v2u* dst = (GAS v2u*)((tb ? V16 : U16) + (size_t)e * D) + lane;
#pragma unroll
            for (int j = 0; j < 4; ++j) { f32x4 v = src[64 * j]; if (!tb) { const f32x4 g = ((const GAS f32x4*)norm_ffn)[64 * j + lane]; v = v * g; }
                v2u o; o.x = pkh2(v.x, v.y); o.y = pkh2(v.z, v.w); dst[64 * j] = o; }
        }
        for (int i = (int)blockIdx.x * NWAVES * 64 + tid; i < T; i += G * NWAVES * 64) SS2[i] = 0.f;
        if (BOTH(0)) GRID_BAR();
    }

    if (IN(1)) {
        pg8::Gemm g{XB, W1T, T, DIN, D}; pg8::StaticOrder S; S.init(T, DIN, G, (int)blockIdx.x);
        pg8::EpiScaleBf16<0> E{PROJ, DIN, RS1};
        pg8::gemm_phase<pg8::EpiScaleBf16<0>, pg8::StaticOrder, PG8_ALIGN, PG8_SP2>(lds + RING_OFF, g, S, E);
        if (BOTH(1)) GRID_BAR();
    }

    if (IN(2)) {
        for (int item = gw; item < NB * 64 * 4; item += NGW) {
            const int h = item & 3, n = (item >> 2) & 63, b = item >> 8;
            const size_t tok0 = (size_t)b * SEQ + n * 32;
            const int c0 = h * 128 + 2 * lane, cs = h * 128 + swap23(2 * lane);
            const float lb0 = 1.0f / (1.0f + __expf(hg_lb[512 + c0] - hg_lb[c0])), lb1 = 1.0f / (1.0f + __expf(hg_lb[512 + c0 + 1] - hg_lb[c0 + 1]));
            unsigned qw[32], fw[32], vw[32];
#pragma unroll
            for (int c = 0; c < 32; ++c) { const bf16* pr = PROJ + (tok0 + c) * DIN;
                qw[c] = *(const GAS unsigned*)(pr + PC_Q + c0); fw[c] = *(const GAS unsigned*)(pr + PC_F + c0); vw[c] = *(const GAS unsigned*)(pr + PC_V + c0); }
            float eG0 = 1.f, eG1 = 1.f;
            unsigned kd0[16], kd1[16], vv0[16], vv1[16];
#pragma unroll
            for (int i = 0; i < 16; ++i) { kd0[i] = 0u; kd1[i] = 0u; vv0[i] = 0u; vv1[i] = 0u; }
#pragma unroll
            for (int c = 0; c < 32; ++c) { bf16* pr = PROJ + (tok0 + c) * DIN;
                const float f0 = lb0 + (1.0f - lb0) * sigmoidf_(bf_lo(fw[c])), f1 = lb1 + (1.0f - lb1) * sigmoidf_(bf_hi(fw[c]));
                eG0 *= f0; eG1 *= f1;
                const float q0 = bf_lo(qw[c]), q1 = bf_hi(qw[c]);
                const float qd0 = q0 * sigmoidf_(q0) * 0.08838834764831845f * eG0, qd1 = q1 * sigmoidf_(q1) * 0.08838834764831845f * eG1;
                const float kv0 = (1.0f - f0) / eG0, kv1 = (1.0f - f1) / eG1;
                *(GAS unsigned*)(pr + PC_Q + cs) = pk2(qd0, qd1);
                const unsigned kp = pk2(kv0, kv1);
                *(GAS unsigned*)(pr + PC_F + cs) = kp;
                const int pp = swap23(c), sh = 16 * (pp & 1);
                kd0[pp >> 1] |= (kp & 0xffffu) << sh; kd1[pp >> 1] |= (kp >> 16) << sh;
                vv0[pp >> 1] |= (vw[c] & 0xffffu) << sh; vv1[pp >> 1] |= (vw[c] >> 16) << sh; }
            GAS v4u* kt = (GAS v4u*)(KDT + ((size_t)item * 128 + 2 * lane) * 32);
            GAS v4u* vt = (GAS v4u*)(VTT + ((size_t)item * 128 + 2 * lane) * 32);
#pragma unroll
            for (int i = 0; i < 4; ++i) { kt[i] = (v4u){kd0[4 * i], kd0[4 * i + 1], kd0[4 * i + 2], kd0[4 * i + 3]}; kt[4 + i] = (v4u){kd1[4 * i], kd1[4 * i + 1], kd1[4 * i + 2], kd1[4 * i + 3]};
                vt[i] = (v4u){vv0[4 * i], vv0[4 * i + 1], vv0[4 * i + 2], vv0[4 * i + 3]}; vt[4 + i] = (v4u){vv1[4 * i], vv1[4 * i + 1], vv1[4 * i + 2], vv1[4 * i + 3]}; }
            *(GAS f32x2*)(DEC + (size_t)item * 128 + 2 * lane) = (f32x2){eG0, eG1};
        }
        for (int item = gw; item < NB * 8 * 32; item += NGW) {
            const int seg = item & 31, grp = (item >> 5) & 7, b = item >> 8, c = grp * 64 + lane, t0 = seg * 64;
            const float w0 = conv_w[c], w1 = conv_w[512 + c], w2 = conv_w[1024 + c], gn = conv_gain[c];
            float u1 = 0.f, u2 = 0.f;
            if (t0 > 0) { const bf16* p2 = PROJ + (size_t)(b * SEQ + t0 - 2) * DIN; const bf16* p1 = p2 + DIN;
                u2 = bf1(p2[PC_C + c]) * bf1(p2[PC_H + c]); u1 = bf1(p1[PC_C + c]) * bf1(p1[PC_H + c]); }
            for (int t = t0; t < t0 + 64; ++t) { const size_t tok = (size_t)b * SEQ + t; const bf16* pr = PROJ + tok * DIN;
                const float u = bf1(pr[PC_C + c]) * bf1(pr[PC_H + c]); const float y = bf1(pr[PC_B + c]) * (w0 * u2 + w1 * u1 + w2 * u);
                const float ss = wave_sum(y * y); const float r = 1.0f / sqrtf(ss * (1.0f / 64.0f) + EPS);
                MIX[tok * D + c] = (bf16)f2bf(y * r * gn); u2 = u1; u1 = u; }
        }
        if (BOTH(2)) GRID_BAR();
    }

    if (IN(3)) {
        constexpr int BUFB = 33792, OB0 = 2 * BUFB;
        for (int it = (int)blockIdx.x; it < NB * 4; it += G) {
            const int b = it >> 2, h = it & 3;
            const int lt = tid & 255, r = lane & 31, hh = lane >> 5, sl = wave;
            v4u st[9];
#define SCAN_LOAD(n_) do { const size_t tk0 = (size_t)b * SEQ + (n_) * 32; const size_t itm = (size_t)((b * 64 + (n_)) * 4 + h); \
                _Pragma("unroll") for (int i = 0; i < 2; ++i) { const int q = lt + 256 * i, row = q >> 4, cc = q & 15; const bf16* pr = PROJ + (tk0 + row) * DIN + h * 128 + cc * 8; \
                    st[i] = *(const GAS v4u*)(pr + PC_Q); st[2 + i] = *(const GAS v4u*)(pr + PC_F); \
                    st[4 + i] = ((const GAS v4u*)(KDT + itm * 4096))[q]; st[6 + i] = ((const GAS v4u*)(VTT + itm * 4096))[q]; } \
                if (lt < 32) st[8] = ((const GAS v4u*)(DEC + itm * 128))[lt]; } while (0)
#define SCAN_COMMIT(n_) do { LAS unsigned char* Bf = lds + RING_OFF + ((n_) & 1) * BUFB; \
                _Pragma("unroll") for (int i = 0; i < 2; ++i) { const int q = lt + 256 * i, row = q >> 4, cc = q & 15, k = q >> 2, c4 = q & 3; \
                    *(LAS v4u*)(Bf + row * 256 + ((cc ^ (row & 15)) * 16)) = st[i]; *(LAS v4u*)(Bf + 8192 + row * 256 + ((cc ^ (row & 15)) * 16)) = st[2 + i]; \
                    *(LAS v4u*)(Bf + 16384 + k * 64 + ((c4 ^ ((k >> 2) & 3)) * 16)) = st[4 + i]; *(LAS v4u*)(Bf + 24576 + k * 64 + ((c4 ^ ((k >> 2) & 3)) * 16)) = st[6 + i]; } \
                if (lt < 32) *(LAS v4u*)(Bf + 32768 + lt * 16) = st[8]; } while (0)
#define SCAN_POST(n_) do { const int pos = lt >> 3, vg = lt & 7; const LAS f32x4* ob = (const LAS f32x4*)(lds + RING_OFF + OB0 + ((n_) & 1) * 16384 + (pos * 128 + vg * 16) * 4); \
                const f32x4 o0 = ob[0], o1 = ob[1], o2 = ob[2], o3 = ob[3]; \
                float ss = (o0.x * o0.x + o0.y * o0.y) + (o0.z * o0.z + o0.w * o0.w) + (o1.x * o1.x + o1.y * o1.y) + (o1.z * o1.z + o1.w * o1.w) \
                         + (o2.x * o2.x + o2.y * o2.y) + (o2.z * o2.z + o2.w * o2.w) + (o3.x * o3.x + o3.y * o3.y) + (o3.z * o3.z + o3.w * o3.w); \
                ss += __shfl_xor(ss, 1); ss += __shfl_xor(ss, 2); ss += __shfl_xor(ss, 4); \
                const float rr = 1.0f / sqrtf(ss * (1.0f / 128.0f) + EPS); \
                const size_t tk = (size_t)b * SEQ + (n_) * 32 + pos; const GAS v4u* gp = (const GAS v4u*)(PROJ + tk * DIN + PC_G + h * 128 + vg * 16); const v4u g0 = gp[0], g1 = gp[1]; \
                const float ov[16] = {o0.x, o0.y, o0.z, o0.w, o1.x, o1.y, o1.z, o1.w, o2.x, o2.y, o2.z, o2.w, o3.x, o3.y, o3.z, o3.w}; \
                const float gf[16] = {bf_lo(g0.x), bf_hi(g0.x), bf_lo(g0.y), bf_hi(g0.y), bf_lo(g0.z), bf_hi(g0.z), bf_lo(g0.w), bf_hi(g0.w), bf_lo(g1.x), bf_hi(g1.x), bf_lo(g1.y), bf_hi(g1.y), bf_lo(g1.z), bf_hi(g1.z), bf_lo(g1.w), bf_hi(g1.w)}; \
                float yv[16]; _Pragma("unroll") for (int i = 0; i < 16; ++i) yv[i] = ov[i] * rr * hg_gain[vg * 16 + i] * (gf[i] * sigmoidf_(gf[i])); \
                GAS v4u* mp = (GAS v4u*)(MIX + tk * D + 512 + h * 128 + vg * 16); \
                mp[0] = (v4u){pk2(yv[0], yv[1]), pk2(yv[2], yv[3]), pk2(yv[4], yv[5]), pk2(yv[6], yv[7])}; mp[1] = (v4u){pk2(yv[8], yv[9]), pk2(yv[10], yv[11]), pk2(yv[12], yv[13]), pk2(yv[14], yv[15])}; } while (0)
#define SCAN_BAR() do { asm volatile("s_waitcnt lgkmcnt(0)" ::: "memory"); __builtin_amdgcn_s_barrier(); asm volatile("" ::: "memory"); } while (0)
            if (wave >= 4) {
                SCAN_LOAD(0); SCAN_COMMIT(0);
                SCAN_BAR();
                for (int n = 0; n < 64; ++n) {
                    if (n + 1 < 64) SCAN_LOAD(n + 1);
                    if (n >= 1) SCAN_POST(n - 1);
                    if (n + 1 < 64) SCAN_COMMIT(n + 1);
                    SCAN_BAR();
                }
                SCAN_POST(63);
                SCAN_BAR();
            } else {
                f32x16 S0, S1, S2, S3;
#pragma unroll
                for (int i = 0; i < 16; ++i) { S0[i] = 0.f; S1[i] = 0.f; S2[i] = 0.f; S3[i] = 0.f; }
                SCAN_BAR();
                for (int n = 0; n < 64; ++n) {
                    const LAS unsigned char* Bf = lds + RING_OFF + (n & 1) * BUFB;
                    pg8::bf16x8 qd[8], kd[8], vt[2];
#pragma unroll
                    for (int ks = 0; ks < 8; ++ks) { const int off = r * 256 + (((2 * ks + hh) ^ (r & 15)) * 16); qd[ks] = *(const LAS pg8::bf16x8*)(Bf + off); kd[ks] = *(const LAS pg8::bf16x8*)(Bf + 8192 + off); }
#pragma unroll
                    for (int sp = 0; sp < 2; ++sp) { const int row = 32 * sl + r; vt[sp] = *(const LAS pg8::bf16x8*)(Bf + 24576 + row * 64 + (((2 * sp + hh) ^ ((row >> 2) & 3)) * 16)); }
                    f32x16 X, O;
#pragma unroll
                    for (int i = 0; i < 16; ++i) { X[i] = 0.f; O[i] = 0.f; }
#pragma unroll
                    for (int ks = 0; ks < 8; ++ks) X = __builtin_amdgcn_mfma_f32_32x32x16_bf16(kd[ks], qd[ks], X, 0, 0, 0);
                    O = __builtin_amdgcn_mfma_f32_32x32x16_bf16(qd[0], pack8(S0, 0), O, 0, 0, 0); O = __builtin_amdgcn_mfma_f32_32x32x16_bf16(qd[1], pack8(S0, 1), O, 0, 0, 0);
                    O = __builtin_amdgcn_mfma_f32_32x32x16_bf16(qd[2], pack8(S1, 0), O, 0, 0, 0); O = __builtin_amdgcn_mfma_f32_32x32x16_bf16(qd[3], pack8(S1, 1), O, 0, 0, 0);
                    O = __builtin_amdgcn_mfma_f32_32x32x16_bf16(qd[4], pack8(S2, 0), O, 0, 0, 0); O = __builtin_amdgcn_mfma_f32_32x32x16_bf16(qd[5], pack8(S2, 1), O, 0, 0, 0);
                    O = __builtin_amdgcn_mfma_f32_32x32x16_bf16(qd[6], pack8(S3, 0), O, 0, 0, 0); O = __builtin_amdgcn_mfma_f32_32x32x16_bf16(qd[7], pack8(S3, 1), O, 0, 0, 0);
#pragma unroll
                    for (int i = 0; i < 16; ++i) { const int s_ = (i & 3) + 8 * (i >> 2) + 4 * hh; X[i] = (s_ <= r) ? X[i] : 0.f; }
                    O = __builtin_amdgcn_mfma_f32_32x32x16_bf16(pack8(X, 0), vt[0], O, 0, 0, 0); O = __builtin_amdgcn_mfma_f32_32x32x16_bf16(pack8(X, 1), vt[1], O, 0, 0, 0);
#define SCAN_SUPD(Sx, rt_) do { _Pragma("unroll") for (int sp = 0; sp < 2; ++sp) { const int row = 32 * (rt_) + r; \
                            const pg8::bf16x8 kt = *(const LAS pg8::bf16x8*)(Bf + 16384 + row * 64 + (((2 * sp + hh) ^ ((row >> 2) & 3)) * 16)); \
                            Sx = __builtin_amdgcn_mfma_f32_32x32x16_bf16(kt, vt[sp], Sx, 0, 0, 0); } \
                        _Pragma("unroll") for (int g = 0; g < 4; ++g) { const f32x4 dv = *(const LAS f32x4*)(Bf + 32768 + (32 * (rt_) + 8 * g + 4 * hh) * 4); \
                            Sx[4 * g] *= dv.x; Sx[4 * g + 1] *= dv.y; Sx[4 * g + 2] *= dv.z; Sx[4 * g + 3] *= dv.w; } } while (0)
                    SCAN_SUPD(S0, 0); SCAN_SUPD(S1, 1); SCAN_SUPD(S2, 2); SCAN_SUPD(S3, 3);
                    LAS float* ob = (LAS float*)(lds + RING_OFF + OB0 + (n & 1) * 16384);
#pragma unroll
                    for (int i = 0; i < 16; ++i) ob[((i & 3) + 8 * (i >> 2) + 4 * hh) * 128 + 32 * sl + r] = O[i];
                    SCAN_BAR();
                }
                SCAN_BAR();
            }
        }
        if (BOTH(3)) GRID_BAR();
    }


    if (IN(4)) {
        pg8::Gemm g{MIX, WOT, T, D, D}; pg8::StaticOrder S; S.init(T, D, G, (int)blockIdx.x);
        pg8::EpiResid E{x, X1, SS2};
        pg8::gemm_phase<pg8::EpiResid, pg8::StaticOrder, PG8_ALIGN, PG8_SP2>(lds + RING_OFF, g, S, E);
        if (BOTH(4)) GRID_BAR();
    }

    if (IN(5)) {
        pg8::Gemm g{X1, WQT, T, 2048, D}; pg8::StaticOrder S; S.init(T, 2048, G, (int)blockIdx.x);
        pg8::EpiScaleBf16<1> E{QB, 2048, SS2};
        pg8::gemm_phase<pg8::EpiScaleBf16<1>, pg8::StaticOrder, PG8_ALIGN, PG8_SP2>(lds + RING_OFF, g, S, E);
        if (BOTH(5)) GRID_BAR();
    }

    if (IN(6)) {
        for (int item = gw; item < (T / 64) * 8; item += NGW) {
            const int h = item & 7, tok = (item >> 3) * 64 + lane;
            unsigned top[2][16];
#pragma unroll
            for (int p = 0; p < 2; ++p) {
                float q[128];
                const GAS v4u* qp = (const GAS v4u*)(QB + (size_t)tok * 2048 + h * 256 + p * 128);
#pragma unroll
                for (int i = 0; i < 16; ++i) { const v4u w = qp[i]; q[8 * i + 0] = bf_lo(w.x); q[8 * i + 1] = bf_hi(w.x); q[8 * i + 2] = bf_lo(w.y); q[8 * i + 3] = bf_hi(w.y);
                    q[8 * i + 4] = bf_lo(w.z); q[8 * i + 5] = bf_hi(w.z); q[8 * i + 6] = bf_lo(w.w); q[8 * i + 7] = bf_hi(w.w); }
#pragma unroll
                for (int j = 0; j < 16; ++j) top[p][j] = 0u;
                const float* kp = peer_keys + (size_t)((h * 2 + p) * 128) * 128;
                for (int n = 0; n < 128; ++n) { const float* kr = kp + n * 128;
                    float s0 = 0.f, s1 = 0.f, s2 = 0.f, s3 = 0.f;
#pragma unroll
                    for (int d = 0; d < 128; d += 4) { s0 = fmaf(q[d], kr[d], s0); s1 = fmaf(q[d + 1], kr[d + 1], s1); s2 = fmaf(q[d + 2], kr[d + 2], s2); s3 = fmaf(q[d + 3], kr[d + 3], s3); }
                    const float s = (s0 + s1) + (s2 + s3);
                    unsigned u = __builtin_bit_cast(unsigned, s); u = (u & 0x80000000u) ? ~u : (u | 0x80000000u);
                    unsigned key = (u & ~0x7Fu) | (unsigned)(127 - n);
#pragma unroll
                    for (int j = 0; j < 16; ++j) { const unsigned mx = top[p][j] > key ? top[p][j] : key; key = top[p][j] > key ? key : top[p][j]; top[p][j] = mx; }
                }
            }
            float v1[16], v2[16];
#pragma unroll
            for (int j = 0; j < 16; ++j) { unsigned a = top[0][j] & ~0x7Fu; a = (a & 0x80000000u) ? (a & 0x7FFFFFFFu) : ~a; v1[j] = __builtin_bit_cast(float, a);
                unsigned b = top[1][j] & ~0x7Fu; b = (b & 0x80000000u) ? (b & 0x7FFFFFFFu) : ~b; v2[j] = __builtin_bit_cast(float, b); }
            unsigned ct[16];
#pragma unroll
            for (int j = 0; j < 16; ++j) ct[j] = 0u;
#pragma unroll
            for (int i = 0; i < 16; ++i)
#pragma unroll
                for (int j = 0; j < 16; ++j) if ((i + 1) * (j + 1) <= 16) {
                    const float s = v1[i] + v2[j];
                    unsigned u = __builtin_bit_cast(unsigned, s); u = (u & 0x80000000u) ? ~u : (u | 0x80000000u);
                    unsigned key = (u & ~0xFFu) | (unsigned)(255 - (i * 16 + j));
#pragma unroll
                    for (int r = 0; r < 16; ++r) { const unsigned mx = ct[r] > key ? ct[r] : key; key = ct[r] > key ? key : ct[r]; ct[r] = mx; }
                }
            float cs[16]; unsigned eid[16];
#pragma unroll
            for (int r = 0; r < 16; ++r) { unsigned a = ct[r] & ~0xFFu; a = (a & 0x80000000u) ? (a & 0x7FFFFFFFu) : ~a; cs[r] = __builtin_bit_cast(float, a);
                const unsigned flat = 255u - (ct[r] & 0xFFu), ii = flat >> 4, jj = flat & 15u; unsigned k1 = 0u, k2 = 0u;
#pragma unroll
                for (int j = 0; j < 16; ++j) { k1 = (ii == (unsigned)j) ? top[0][j] : k1; k2 = (jj == (unsigned)j) ? top[1][j] : k2; }
                eid[r] = (127u - (k1 & 0x7Fu)) * 128u + (127u - (k2 & 0x7Fu)); }
            float den = 0.f, ex[16];
#pragma unroll
            for (int r = 0; r < 16; ++r) { ex[r] = __expf(cs[r] - cs[0]); den += ex[r]; }
            const float inv = 1.0f / den;
            GAS v4u* ep = (GAS v4u*)(EXPT + (size_t)tok * 128 + h * 16);
#pragma unroll
            for (int r = 0; r < 4; ++r) { v4u w;
                w.x = eid[4 * r + 0] | (pkh2(ex[4 * r + 0] * inv, 0.f) << 16); w.y = eid[4 * r + 1] | (pkh2(ex[4 * r + 1] * inv, 0.f) << 16);
                w.z = eid[4 * r + 2] | (pkh2(ex[4 * r + 2] * inv, 0.f) << 16); w.w = eid[4 * r + 3] | (pkh2(ex[4 * r + 3] * inv, 0.f) << 16); ep[r] = w; }
        }
        if (BOTH(6)) GRID_BAR();
    }

    if (IN(7)) {
        float nf[16];
#pragma unroll
        for (int i = 0; i < 8; ++i) { nf[i] = norm_f[8 * lane + i]; nf[8 + i] = norm_f[512 + 8 * lane + i]; }
        for (int tok = gw; tok < T; tok += NGW) {
            const GAS v4u* xr = (const GAS v4u*)(X1 + (size_t)tok * D);
            const v4u xa = xr[lane], xb = xr[64 + lane];
            float xf[16] = {bf_lo(xa.x), bf_hi(xa.x), bf_lo(xa.y), bf_hi(xa.y), bf_lo(xa.z), bf_hi(xa.z), bf_lo(xa.w), bf_hi(xa.w),
                            bf_lo(xb.x), bf_hi(xb.x), bf_lo(xb.y), bf_hi(xb.y), bf_lo(xb.z), bf_hi(xb.z), bf_lo(xb.w), bf_hi(xb.w)};
            h2_t hx[8];
#pragma unroll
            for (int i = 0; i < 8; ++i) hx[i] = __builtin_bit_cast(h2_t, pkh2(xf[2 * i], xf[2 * i + 1]));
            const float rstd2 = 1.0f / sqrtf(SS2[tok] * (1.0f / D) + EPS);
            float y[16];
#pragma unroll
            for (int i = 0; i < 16; ++i) y[i] = 0.f;
#pragma unroll
            for (int half = 0; half < 2; ++half) {
                const unsigned ev = EXPT[(size_t)tok * 128 + half * 64 + lane];
                float amine = 0.f;
#pragma unroll 8
                for (int i = 0; i < 64; ++i) {
                    const unsigned id = (unsigned)__builtin_amdgcn_readlane((int)ev, i) & 0xFFFFu;
                    const GAS v4u* ur = (const GAS v4u*)(U16 + (size_t)id * D);
                    const v4u ua = ur[lane], ub = ur[64 + lane];
                    float p = 0.f;
                    p = __builtin_amdgcn_fdot2(h2_of(ua.x), hx[0], p, false); p = __builtin_amdgcn_fdot2(h2_of(ua.y), hx[1], p, false);
                    p = __builtin_amdgcn_fdot2(h2_of(ua.z), hx[2], p, false); p = __builtin_amdgcn_fdot2(h2_of(ua.w), hx[3], p, false);
                    p = __builtin_amdgcn_fdot2(h2_of(ub.x), hx[4], p, false); p = __builtin_amdgcn_fdot2(h2_of(ub.y), hx[5], p, false);
                    p = __builtin_amdgcn_fdot2(h2_of(ub.z), hx[6], p, false); p = __builtin_amdgcn_fdot2(h2_of(ub.w), hx[7], p, false);
                    p = wave_sum(p);
                    amine = (lane == i) ? p : amine;
                }
                const float a = amine * rstd2;
                const float gl = 0.5f * a * (1.0f + erff(a * 0.7071067811865476f));
                const float gate = (float)__builtin_bit_cast(h2_t, ev >> 16).x;
                const float wv = gate * gl;
#pragma unroll 8
                for (int i = 0; i < 64; ++i) {
                    const unsigned id = (unsigned)__builtin_amdgcn_readlane((int)ev, i) & 0xFFFFu;
                    const float wi = __builtin_bit_cast(float, __builtin_amdgcn_readlane(__builtin_bit_cast(int, wv), i));
                    const GAS v4u* vr = (const GAS v4u*)(V16 + (size_t)id * D);
                    const v4u va = vr[lane], vb = vr[64 + lane];
                    const unsigned vw[8] = {va.x, va.y, va.z, va.w, vb.x, vb.y, vb.z, vb.w};
#pragma unroll
                    for (int j = 0; j < 8; ++j) { const h2_t hv = __builtin_bit_cast(h2_t, vw[j]); y[2 * j] = fmaf((float)hv.x, wi, y[2 * j]); y[2 * j + 1] = fmaf((float)hv.y, wi, y[2 * j + 1]); }
                }
            }
            float ss = 0.f;
#pragma unroll
            for (int i = 0; i < 16; ++i) { y[i] += xf[i]; ss += y[i] * y[i]; }
            ss = wave_sum(ss);
            const float r = 1.0f / sqrtf(ss * (1.0f / D) + EPS);
            GAS f32x4* op = (GAS f32x4*)(out + (size_t)tok * D);
            op[2 * lane] = (f32x4){y[0] * r * nf[0], y[1] * r * nf[1], y[2] * r * nf[2], y[3] * r * nf[3]};
            op[2 * lane + 1] = (f32x4){y[4] * r * nf[4], y[5] * r * nf[5], y[6] * r * nf[6], y[7] * r * nf[7]};
            op[128 + 2 * lane] = (f32x4){y[8] * r * nf[8], y[9] * r * nf[9], y[10] * r * nf[10], y[11] * r * nf[11]};
            op[128 + 2 * lane + 1] = (f32x4){y[12] * r * nf[12], y[13] * r * nf[13], y[14] * r * nf[14], y[15] * r * nf[15]};
        }
    }
#undef IN
#undef BOTH
}

extern "C" void kernel_launch(void* const* d_in, const int* in_sizes, int n_in, void* d_out, int out_size, void* d_ws, size_t ws_size, hipStream_t stream) {
    static int grid = 0;
    if (grid == 0) {
        if (n_in != 14 || in_sizes[0] != T * D || out_size != T * D || ws_size < WS_END) { fprintf(stderr, "kernel_launch: unexpected shapes (n_in %d, in0 %d, out %d, ws %zu); nothing launched\n", n_in, n_in > 0 ? in_sizes[0] : -1, out_size, ws_size); grid = -1; return; }
        int dev = 0, cus = 0, per_cu = 0;
        if (hipGetDevice(&dev) != hipSuccess || hipDeviceGetAttribute(&cus, hipDeviceAttributeMultiprocessorCount, dev) != hipSuccess) { grid = -1; return; }
        if (hipFuncSetAttribute((const void*)hymba_fwd, hipFuncAttributeMaxDynamicSharedMemorySize, LDS_BYTES) != hipSuccess) { fprintf(stderr, "kernel_launch: hipFuncSetAttribute failed\n"); grid = -1; return; }
        if (hipOccupancyMaxActiveBlocksPerMultiprocessor(&per_cu, (const void*)hymba_fwd, NWAVES * 64, LDS_BYTES) != hipSuccess || per_cu < 1) { fprintf(stderr, "kernel_launch: occupancy query says %d blocks per CU\n", per_cu); (void)hipGetLastError(); grid = -1; return; }
        grid = cus;
    }
    if (grid < 0) return;
    if (hipMemsetAsync((char*)d_ws + WS_CTL, 0, CTL_ZERO_BYTES, stream) != hipSuccess) { fprintf(stderr, "kernel_launch: hipMemsetAsync failed\n"); return; }
    Args a{};
    for (int i = 0; i < 14; ++i) a.in[i] = (const float*)d_in[i];
    a.out = (float*)d_out; a.ws = (unsigned char*)d_ws;
    if (N_LAUNCHES == 1) {
        a.ph_lo = 0; a.ph_hi = NPHASES; a.li = 0;
        void* kargs[] = {&a};
        const hipError_t e = hipLaunchCooperativeKernel((const void*)hymba_fwd, dim3(grid), dim3(NWAVES * 64), kargs, LDS_BYTES, stream);
        if (e != hipSuccess) fprintf(stderr, "kernel_launch: cooperative launch failed: %s (grid %d)\n", hipGetErrorString(e), grid);
    } else {
        for (int li = 0; li < NPHASES; ++li) {
            a.ph_lo = li; a.ph_hi = li + 1; a.li = li;
            hipLaunchKernelGGL(hymba_fwd, dim3(grid), dim3(NWAVES * 64), LDS_BYTES, stream, a);
            const hipError_t le = hipPeekAtLastError();
            if (le != hipSuccess) { fprintf(stderr, "kernel_launch: launch %d failed: %s\n", li, hipGetErrorName(le)); break; }
        }
    }
}
```

```cpp
#include <hip/hip_runtime.h>
#include <cstdio>
#include <cstdint>
namespace pg8 {
#define PG8_LAS __attribute__((address_space(3)))
typedef unsigned short bf16_t;
typedef short bf16x8 __attribute__((ext_vector_type(8)));
typedef float f32x4 __attribute__((ext_vector_type(4)));
typedef unsigned u32x4 __attribute__((ext_vector_type(4)));
constexpr int BM = 256, BK = 64, HALF = 128, HTB = HALF * BK * 2  , STAGE_BYTES = 8 * HTB, NXCD = 8, WGM = 8;

__host__ __device__ __forceinline__ int lds_byte(int r, int c) { const int st = (r >> 4) * 2 + (c >> 5), rr = r & 15, cc = c & 31, ob = rr * 64 + cc * 2; return st * 1024 + (ob ^ (((ob >> 9) & 1) << 5)); }
__host__ __device__ __forceinline__ void stage_rc(int b, int& R, int& C) { const int st = b / 1024, sb = b % 1024, swz = sb ^ (((sb >> 9) & 1) << 5); R = (st >> 1) * 16 + swz / 64; C = (st & 1) * 32 + (swz % 64) / 2; }
__host__ __device__ __forceinline__ int perm32(int rho) { const int n = rho >> 4, i = rho & 15; return 8 * (i >> 2) + 4 * n + (i & 3); }

struct Unit { int pm, pn; };
struct Gemm { const bf16_t* A; const bf16_t* Bt; int M, N, K; };

struct StaticOrder {
    int nM, nN, nwg, G, c;
    __host__ __device__ void init(int M, int N, int G_, int c_) { nM = M / BM; nN = N / BM; nwg = nM * nN; G = G_; c = c_; }
    __host__ __device__ bool next(int i, Unit& u) const {
        const long L = (long)i * G + c; if (L >= nwg) return false;
        int wgid = (int)L; { const int q = nwg / NXCD, r = nwg % NXCD, xcd = wgid % NXCD, off = wgid / NXCD; wgid = (xcd < r ? xcd * (q + 1) : r * (q + 1) + (xcd - r) * q) + off; }
        const int nig = WGM * nN, gid = wgid / nig, fm = gid * WGM, gsz = (nM - fm) < WGM ? (nM - fm) : WGM;
        u.pm = fm + ((wgid % nig) % gsz); u.pn = (wgid % nig) / gsz; return true;
    }
    __device__ __forceinline__ void a_ready(const Unit&) const {}
    __device__ __forceinline__ void done(const Unit&) const {}
};

__device__ __forceinline__ unsigned cvt_pk_bf16(float lo, float hi) { unsigned r; asm volatile("v_cvt_pk_bf16_f32 %0, %1, %2" : "=v"(r) : "v"(lo), "v"(hi)); return r; }

template <int MODE> struct EpiScaleBf16 {
    static constexpr bool PERM = true, AFTER_DRAIN = false;
    bf16_t* O; int ldc; const float* rowv;
    __device__ __forceinline__ void operator()(const f32x4 (&acc)[2][2][4][2], const Unit& u, int wr, int wc, int fr, int fq) const {
        const int row0 = u.pm * BM + wr * 64 + fr, col0 = u.pn * BM + wc * 32 + 8 * fq;
#pragma unroll
        for (int ai = 0; ai < 2; ++ai)
#pragma unroll
            for (int m = 0; m < 4; ++m) { const int row = row0 + ai * HALF + m * 16; float s = rowv[row]; if (MODE == 1) s = 1.0f / sqrtf(s * (1.0f / 1024.0f) + 1e-6f);
                bf16_t* rowp = O + (size_t)row * ldc + col0;
#pragma unroll
                for (int bj = 0; bj < 2; ++bj) { const f32x4 v0 = acc[ai][bj][m][0] * s, v1 = acc[ai][bj][m][1] * s;
                    u32x4 w; w.x = cvt_pk_bf16(v0[0], v0[1]); w.y = cvt_pk_bf16(v0[2], v0[3]); w.z = cvt_pk_bf16(v1[0], v1[1]); w.w = cvt_pk_bf16(v1[2], v1[3]);
                    *(u32x4*)(rowp + bj * HALF) = w; } }
    }
};
struct EpiResid {
    static constexpr bool PERM = true, AFTER_DRAIN = false;
    const float* X; bf16_t* O; float* ss;
    __device__ __forceinline__ void operator()(const f32x4 (&acc)[2][2][4][2], const Unit& u, int wr, int wc, int fr, int fq) const {
        const int row0 = u.pm * BM + wr * 64 + fr, col0 = u.pn * BM + wc * 32 + 8 * fq;
#pragma unroll
        for (int ai = 0; ai < 2; ++ai)
#pragma unroll
            for (int m = 0; m < 4; ++m) { const int row = row0 + ai * HALF + m * 16; float part = 0.f;
#pragma unroll
                for (int bj = 0; bj < 2; ++bj) { const float* xp = X + (size_t)row * 1024 + col0 + bj * HALF;
                    const f32x4 v0 = acc[ai][bj][m][0] + *(const f32x4*)xp, v1 = acc[ai][bj][m][1] + *(const f32x4*)(xp + 4);
                    part += (v0[0] * v0[0] + v0[1] * v0[1]) + (v0[2] * v0[2] + v0[3] * v0[3]) + (v1[0] * v1[0] + v1[1] * v1[1]) + (v1[2] * v1[2] + v1[3] * v1[3]);
                    u32x4 w; w.x = cvt_pk_bf16(v0[0], v0[1]); w.y = cvt_pk_bf16(v0[2], v0[3]); w.z = cvt_pk_bf16(v1[0], v1[1]); w.w = cvt_pk_bf16(v1[2], v1[3]);
                    *(u32x4*)(O + (size_t)row * 1024 + col0 + bj * HALF) = w; }
                part += __shfl_xor(part, 16); part += __shfl_xor(part, 32);
                if (fq == 0) (void)__builtin_amdgcn_global_atomic_fadd_f32((__attribute__((address_space(1))) float*)(ss + row), part); }
    }
};

template <class Epi, class Sched, bool ALIGN_EPI = false, bool SP2 = false>
__device__ __forceinline__ void gemm_phase(PG8_LAS unsigned char* lds, const Gemm g, const Sched& S, const Epi& E) {
    const int tid = threadIdx.x, wid = __builtin_amdgcn_readfirstlane(tid >> 6), lane = tid & 63, wr = wid >> 2, wc = wid & 3, fr = lane & 15, fq = lane >> 4;
    const int K = g.K, nt = K / BK;
    unsigned voffA[2], voffB[2];
#pragma unroll
    for (int i = 0; i < 2; ++i) { int R, C; stage_rc(tid * 16 + i * 8192, R, C); const int Rb = Epi::PERM ? ((R & ~31) + perm32(R & 31)) : R;
        voffA[i] = (unsigned)(R * K + C) * 2u; voffB[i] = (unsigned)(Rb * K + C) * 2u; }
    const size_t kstep = (size_t)(BK * 2);
    const size_t hstep = (size_t)HALF * K * 2;
    const size_t tstep = 2 * hstep;
    const unsigned ldsw = (unsigned)wid * 1024u;
    const int aoff = lds_byte(wr * 64 + fr, fq * 8), boff = lds_byte(wc * 32 + fr, fq * 8);
#define PG8_SA(b, h) (((b) * 2 + (h)) * HTB)
#define PG8_SB(b, h) ((4 + (b) * 2 + (h)) * HTB)
#define PG8_STAGE(bufoff, gbase, voff) do { _Pragma("unroll") for (int _i = 0; _i < 2; ++_i) \
        __builtin_amdgcn_global_load_lds((const unsigned*)((const char*)(gbase) + (voff)[_i]), (PG8_LAS unsigned*)(lds + (bufoff) + ldsw + _i * 8192), 16, 0, 0); } while (0)
#define PG8_LDA(dst, b, h) do { _Pragma("unroll") for (int m = 0; m < 4; ++m) _Pragma("unroll") for (int k = 0; k < 2; ++k) dst[m][k] = *(const PG8_LAS bf16x8*)(lds + PG8_SA(b, h) + aoff + m * 2048 + k * 1024); } while (0)
#define PG8_LDB(dst, b, h) do { _Pragma("unroll") for (int n = 0; n < 2; ++n) _Pragma("unroll") for (int k = 0; k < 2; ++k) dst[n][k] = *(const PG8_LAS bf16x8*)(lds + PG8_SB(b, h) + boff + n * 2048 + k * 1024); } while (0)
#define PG8_MMA(ai, bj, At, Bt) do { __builtin_amdgcn_s_setprio(1); _Pragma("unroll") for (int m = 0; m < 4; ++m) _Pragma("unroll") for (int n = 0; n < 2; ++n) _Pragma("unroll") for (int k = 0; k < 2; ++k) \
        acc[ai][bj][m][n] = __builtin_amdgcn_mfma_f32_16x16x32_bf16(Bt[n][k], At[m][k], acc[ai][bj][m][n], 0, 0, 0); __builtin_amdgcn_s_setprio(0); } while (0)
#define PG8_WAIT_V(n) asm volatile("s_waitcnt vmcnt(" #n ")" ::: "memory")
#define PG8_WAIT_L(n) asm volatile("s_waitcnt lgkmcnt(" #n ")" ::: "memory")
#define PG8_BAR __builtin_amdgcn_s_barrier()
#define PG8_SCHED __builtin_amdgcn_sched_barrier(0)
    Unit cur, nxt; int ui = 0;
    if (!S.next(0, cur)) return;
    f32x4 acc[2][2][4][2];
#pragma unroll
    for (int a = 0; a < 2; ++a)
#pragma unroll
        for (int b = 0; b < 2; ++b)
#pragma unroll
            for (int m = 0; m < 4; ++m)
#pragma unroll
                for (int n = 0; n < 2; ++n) acc[a][b][m][n] = (f32x4){0.f, 0.f, 0.f, 0.f};
    bf16x8 At[4][2], B0[2][2], B1[2][2];
    const char* cA = (const char*)g.A + (size_t)cur.pm * tstep; const char* cB = (const char*)g.Bt + (size_t)cur.pn * tstep;
    S.a_ready(cur);
    if constexpr (SP2) {
        PG8_STAGE(PG8_SB(0, 0), cB, voffB); PG8_STAGE(PG8_SB(0, 1), cB + hstep, voffB); PG8_STAGE(PG8_SA(0, 0), cA, voffA); PG8_STAGE(PG8_SA(0, 1), cA + hstep, voffA);
        if (wr == 1) PG8_BAR;
        PG8_WAIT_V(2); PG8_BAR;
        PG8_STAGE(PG8_SB(1, 0), cB + kstep, voffB); PG8_STAGE(PG8_SA(1, 0), cA + kstep, voffA); PG8_STAGE(PG8_SB(1, 1), cB + hstep + kstep, voffB);
        PG8_WAIT_V(6); PG8_BAR;
    } else {
        PG8_STAGE(PG8_SB(0, 0), cB, voffB); PG8_STAGE(PG8_SA(0, 0), cA, voffA); PG8_STAGE(PG8_SB(0, 1), cB + hstep, voffB); PG8_STAGE(PG8_SA(0, 1), cA + hstep, voffA);
        if (wr == 1) PG8_BAR;
        PG8_WAIT_V(4); PG8_BAR;
        PG8_STAGE(PG8_SB(1, 0), cB + kstep, voffB); PG8_STAGE(PG8_SA(1, 0), cA + kstep, voffA); PG8_STAGE(PG8_SB(1, 1), cB + hstep + kstep, voffB);
        PG8_WAIT_V(6); PG8_BAR;
    }
    for (;;) {
        const bool has_next = S.next(ui + 1, nxt);
        const char* nA = has_next ? (const char*)g.A + (size_t)nxt.pm * tstep : cA; const char* nB = has_next ? (const char*)g.Bt + (size_t)nxt.pn * tstep : cB;
        for (int t = 0; t < nt; t += 2) {
            const bool last = (t == nt - 2);
            const char* a1 = cA + (size_t)(t + 1) * kstep;
            const char* a2 = last ? nA : cA + (size_t)(t + 2) * kstep; const char* b2 = last ? nB : cB + (size_t)(t + 2) * kstep;
            const char* a3 = a2 + kstep; const char* b3 = b2 + kstep;
            if (last && has_next) S.a_ready(nxt);
            if constexpr (SP2) {
            PG8_LDB(B0, 0, 0); PG8_LDB(B1, 0, 1); PG8_SCHED; PG8_LDA(At, 0, 0); PG8_STAGE(PG8_SA(1, 1), a1 + hstep, voffA);
            PG8_WAIT_V(8); PG8_WAIT_L(0); PG8_BAR; PG8_MMA(0, 0, At, B0); PG8_MMA(0, 1, At, B1); PG8_BAR; PG8_SCHED;
            PG8_LDA(At, 0, 1); PG8_STAGE(PG8_SB(0, 0), b2, voffB); PG8_STAGE(PG8_SB(0, 1), b2 + hstep, voffB); PG8_STAGE(PG8_SA(0, 0), a2, voffA);
            PG8_WAIT_V(8); PG8_WAIT_L(0); PG8_BAR; PG8_MMA(1, 0, At, B0); PG8_MMA(1, 1, At, B1); PG8_BAR; PG8_SCHED;
            PG8_LDB(B0, 1, 0); PG8_LDB(B1, 1, 1); PG8_SCHED; PG8_LDA(At, 1, 0); PG8_STAGE(PG8_SA(0, 1), a2 + hstep, voffA);
            PG8_WAIT_V(8); PG8_WAIT_L(0); PG8_BAR; PG8_MMA(0, 0, At, B0); PG8_MMA(0, 1, At, B1); PG8_BAR; PG8_SCHED;
            PG8_LDA(At, 1, 1); PG8_STAGE(PG8_SB(1, 0), b3, voffB); PG8_STAGE(PG8_SB(1, 1), b3 + hstep, voffB); PG8_STAGE(PG8_SA(1, 0), a3, voffA);
            PG8_WAIT_V(8); PG8_WAIT_L(0); PG8_BAR; PG8_MMA(1, 0, At, B0); PG8_MMA(1, 1, At, B1); PG8_BAR; PG8_SCHED;
            } else {
            PG8_LDB(B0, 0, 0); PG8_SCHED; PG8_LDA(At, 0, 0); PG8_STAGE(PG8_SA(1, 1), a1 + hstep, voffA);
            PG8_WAIT_L(8); PG8_BAR; PG8_WAIT_L(0); PG8_MMA(0, 0, At, B0); PG8_BAR; PG8_SCHED;
            PG8_LDB(B1, 0, 1); PG8_STAGE(PG8_SB(0, 0), b2, voffB);
            PG8_BAR; PG8_WAIT_L(0); PG8_MMA(0, 1, At, B1); PG8_BAR;
            PG8_LDA(At, 0, 1); PG8_STAGE(PG8_SA(0, 0), a2, voffA);
            PG8_BAR; PG8_WAIT_L(0); PG8_MMA(1, 0, At, B0); PG8_BAR; PG8_SCHED;
            PG8_STAGE(PG8_SB(0, 1), b2 + hstep, voffB);
            PG8_WAIT_V(6); PG8_BAR; PG8_MMA(1, 1, At, B1); PG8_BAR;
            PG8_LDB(B0, 1, 0); PG8_SCHED; PG8_LDA(At, 1, 0); PG8_STAGE(PG8_SA(0, 1), a2 + hstep, voffA);
            PG8_WAIT_L(8); PG8_BAR; PG8_WAIT_L(0); PG8_MMA(0, 0, At, B0); PG8_BAR; PG8_SCHED;
            PG8_LDB(B1, 1, 1); PG8_STAGE(PG8_SB(1, 0), b3, voffB);
            PG8_BAR; PG8_WAIT_L(0); PG8_MMA(0, 1, At, B1); PG8_BAR;
            PG8_LDA(At, 1, 1); PG8_STAGE(PG8_SA(1, 0), a3, voffA);
            PG8_BAR; PG8_WAIT_L(0); PG8_MMA(1, 0, At, B0); PG8_BAR; PG8_SCHED;
            PG8_STAGE(PG8_SB(1, 1), b3 + hstep, voffB);
            PG8_WAIT_V(6); PG8_BAR; PG8_MMA(1, 1, At, B1); PG8_BAR;
            }
        }
        if constexpr (ALIGN_EPI) { if (wr == 0) PG8_BAR; }
        if constexpr (!Epi::AFTER_DRAIN) { E(acc, cur, wr, wc, fr, fq); S.done(cur); }
        if (!has_next) break;
#pragma unroll
        for (int a = 0; a < 2; ++a)
#pragma unroll
            for (int b = 0; b < 2; ++b)
#pragma unroll
                for (int m = 0; m < 4; ++m)
#pragma unroll
                    for (int n = 0; n < 2; ++n) acc[a][b][m][n] = (f32x4){0.f, 0.f, 0.f, 0.f};
        cur = nxt; cA = nA; cB = nB; ++ui;
        if constexpr (ALIGN_EPI) { if (wr == 1) PG8_BAR; }
    }
    PG8_WAIT_V(0);
    if constexpr (!ALIGN_EPI) { if (wr == 0) PG8_BAR; }
    PG8_BAR;
    if constexpr (Epi::AFTER_DRAIN) { E.fused(acc, cur, wr, wc, fr, fq, lds, wid, lane); S.done(cur); }
#undef PG8_SA
#undef PG8_SB
#undef PG8_STAGE
#undef PG8_LDA
#undef PG8_LDB
#undef PG8_MMA
#undef PG8_WAIT_V
#undef PG8_WAIT_L
#undef PG8_BAR
#undef PG8_SCHED
}
}

#ifndef PG8_SP2
#define PG8_SP2 true
#endif
#ifndef PG8_ALIGN
#define PG8_ALIGN true
#endif
#ifndef MK_N_LAUNCHES
#define MK_N_LAUNCHES 1
#endif
constexpr int NWAVES = 8;
constexpr int NPHASES = 8;
constexpr int N_LAUNCHES = MK_N_LAUNCHES;

constexpr int NB = 32, SEQ = 2048, T = NB * SEQ, D = 1024, DIN = 3584;
constexpr int PC_C = 0, PC_H = 512, PC_B = 1024, PC_Q = 1536, PC_F = 2048, PC_V = 2560, PC_G = 3072;
constexpr int NEXP = 16384;
constexpr float EPS = 1e-6f;

constexpr size_t MiB = 1u << 20;
constexpr size_t WS_CTL = 0, CTL_ZERO_BYTES = 1 * MiB;
constexpr size_t WS_W1T = 2 * MiB, WS_WOT = 10 * MiB, WS_WQT = 12 * MiB, WS_RS1 = 16 * MiB, WS_SS2 = 17 * MiB;
constexpr size_t WS_KEYB = 18 * MiB;
constexpr size_t WS_U16 = 32 * MiB, WS_V16 = 64 * MiB, WS_EXP = 96 * MiB;
constexpr size_t WS_XB = 128 * MiB;
constexpr size_t WS_X1 = 256 * MiB;
constexpr size_t WS_PROJ = 384 * MiB;
constexpr size_t WS_F = 832 * MiB;
constexpr size_t WS_END = 960 * MiB;
constexpr int CW_BAR = 4096;

constexpr int RING_OFF = 0, RING_BYTES = 131072;
constexpr int LDSCTL_OFF = RING_BYTES, MISC_OFF = LDSCTL_OFF + 320;
constexpr int LDS_BYTES = 147456;

#define GAS __attribute__((address_space(1)))
#define LAS __attribute__((address_space(3)))
typedef unsigned short bf16;
typedef unsigned v4u __attribute__((ext_vector_type(4)));
typedef unsigned v2u __attribute__((ext_vector_type(2)));
typedef float f32x4 __attribute__((ext_vector_type(4)));
typedef float f32x2 __attribute__((ext_vector_type(2)));
typedef _Float16 h2_t __attribute__((ext_vector_type(2)));
typedef GAS unsigned gu32;
#define RLX_AGENT __ATOMIC_RELAXED, __HIP_MEMORY_SCOPE_AGENT
#define LDS_WAIT() asm volatile("s_waitcnt lgkmcnt(0)" ::: "memory")
#define VM_WAIT() asm volatile("s_waitcnt vmcnt(0)" ::: "memory")
__device__ __forceinline__ unsigned f2bf(float f) { unsigned u = __builtin_bit_cast(unsigned, f); return (u + 0x7fffu + ((u >> 16) & 1u)) >> 16; }
__device__ __forceinline__ unsigned pk2(float lo, float hi) { return f2bf(lo) | (f2bf(hi) << 16); }
__device__ __forceinline__ float bf_lo(unsigned w) { return __builtin_bit_cast(float, w << 16); }
__device__ __forceinline__ float bf_hi(unsigned w) { return __builtin_bit_cast(float, w & 0xffff0000u); }
__device__ __forceinline__ float bf1(bf16 v) { return __builtin_bit_cast(float, (unsigned)v << 16); }
__device__ __forceinline__ unsigned pkh2(float lo, float hi) { f32x2 v = {lo, hi}; h2_t h = __builtin_convertvector(v, h2_t); return __builtin_bit_cast(unsigned, h); }
__device__ __forceinline__ h2_t h2_of(unsigned w) { return __builtin_bit_cast(h2_t, w); }
__device__ __forceinline__ float wave_sum(float v) {
#pragma unroll
    for (int o = 1; o < 64; o <<= 1) v += __shfl_xor(v, o);
    return v;
}
typedef float f32x16 __attribute__((ext_vector_type(16)));
typedef __bf16 bf16x2_t __attribute__((ext_vector_type(2)));
__device__ __forceinline__ unsigned cvtpk(float lo, float hi) { f32x2 v = {lo, hi}; bf16x2_t b = __builtin_convertvector(v, bf16x2_t); return __builtin_bit_cast(unsigned, b); }
__device__ __forceinline__ pg8::bf16x8 pack8(const f32x16& x, int s) {
    v4u p; p.x = cvtpk(x[8 * s], x[8 * s + 1]); p.y = cvtpk(x[8 * s + 2], x[8 * s + 3]); p.z = cvtpk(x[8 * s + 4], x[8 * s + 5]); p.w = cvtpk(x[8 * s + 6], x[8 * s + 7]);
    return __builtin_bit_cast(pg8::bf16x8, p); }
__device__ __forceinline__ void ce_desc(unsigned& a, unsigned& b) { const unsigned mx = a > b ? a : b, mn = a > b ? b : a; a = mx; b = mn; }
__device__ __forceinline__ void sort16_desc(unsigned (&a)[16]) {
#pragma unroll
    for (int k = 2; k <= 16; k <<= 1)
#pragma unroll
        for (int j = k >> 1; j > 0; j >>= 1)
#pragma unroll
            for (int i = 0; i < 16; ++i) { const int l = i ^ j; if (l > i) { if ((i & k) == 0) ce_desc(a[i], a[l]); else ce_desc(a[l], a[i]); } }
}
__device__ __forceinline__ void merge16_desc(unsigned (&a)[16], const unsigned (&b)[16]) {
#pragma unroll
    for (int i = 0; i < 16; ++i) a[i] = a[i] > b[15 - i] ? a[i] : b[15 - i];
#pragma unroll
    for (int j = 8; j > 0; j >>= 1)
#pragma unroll
        for (int i = 0; i < 16; ++i) { const int l = i ^ j; if (l > i) ce_desc(a[i], a[l]); }
}
__device__ __forceinline__ float unkey(unsigned a) { a = (a & 0x80000000u) ? (a & 0x7FFFFFFFu) : ~a; return __builtin_bit_cast(float, a); }
__device__ __forceinline__ unsigned ckey(float s, int flat) { unsigned u = __builtin_bit_cast(unsigned, s); u ^= (unsigned)((int)u >> 31) | 0x80000000u; return (u & ~0xFFu) | (unsigned)(255 - flat); }
__device__ __forceinline__ int swap23(int k) { return (k & ~12) | ((k & 4) << 1) | ((k & 8) >> 1); }
__device__ __forceinline__ float sigmoidf_(float x) { return 1.0f / (1.0f + __expf(-x)); }

#define XB_TMO      128
#define XB_XCNT(j)  (256  + 64 * (j))
#define XB_XSUB(j)  (1280 + 64 * (j))
#define XB_XGEN(j)  (2304 + 64 * (j))
#define XB_TOP      3328
#define XB_TOPGEN   3392
#define XCD_BAR_WORDS 3456
#define XB_SPIN_CAP (1u << 18)

__device__ __forceinline__ unsigned xb_ld(unsigned* p)              { return __hip_atomic_load(p, __ATOMIC_RELAXED, __HIP_MEMORY_SCOPE_AGENT); }
__device__ __forceinline__ unsigned xb_add(unsigned* p, unsigned v) { return __hip_atomic_fetch_add(p, v, __ATOMIC_RELAXED, __HIP_MEMORY_SCOPE_AGENT); }
__device__ __forceinline__ unsigned xb_xcc_id() { return (unsigned)__builtin_amdgcn_s_getreg((3 << 11) | 20) & 0xFu; }
#define XB_SPIN(cond, bar) do { unsigned _sp = 0; while (cond) { __builtin_amdgcn_s_sleep(1); \
    if ((++_sp & 255u) == 0u) { if (xb_ld(&(bar)[XB_TMO])) break; if (_sp > XB_SPIN_CAP) { atomicAdd(&(bar)[XB_TMO], 1u); break; } } } } while (0)

struct XcdBarrier {
    unsigned* bar; unsigned x;
    volatile LAS unsigned* st;
};

__device__ __forceinline__ XcdBarrier xcd_barrier_post(unsigned* bar, volatile LAS unsigned* st) {
    XcdBarrier b; b.bar = bar; b.x = xb_xcc_id(); b.st = st;
    if (threadIdx.x == 0) (void)xb_add(&bar[XB_XCNT(b.x)], 1u);
    return b;
}
__device__ __forceinline__ void xcd_barrier_complete(unsigned* bar, unsigned x, unsigned& nloc, unsigned& nx) {
    const unsigned G = gridDim.x * gridDim.y * gridDim.z;
    unsigned sum, cnt, mine, sp = 0u;
    for (;;) {
        sum = 0u; cnt = 0u; mine = 0u;
#pragma unroll
        for (unsigned j = 0; j < 16; ++j) { const unsigned c = xb_ld(&bar[XB_XCNT(j)]); sum += c; cnt += (c > 0u) ? 1u : 0u; mine = (j == x) ? c : mine; }
        if (sum == G) break;
        __builtin_amdgcn_s_sleep(1);
        if ((++sp & 255u) == 0u) { if (xb_ld(&bar[XB_TMO])) break; if (sp > XB_SPIN_CAP) { atomicAdd(&bar[XB_TMO], 1u); break; } }
    }
    nloc = mine > 0u ? mine : 1u; nx = cnt > 0u ? cnt : 1u;
}

__device__ __forceinline__ void xcd_barrier(const XcdBarrier& b) {
    asm volatile("s_waitcnt vmcnt(0)" ::: "memory");
    __syncthreads();
    if (threadIdx.x == 0) {
        unsigned* bar = b.bar;
        __builtin_amdgcn_s_waitcnt(0);
        unsigned nloc = b.st[0], nx = b.st[1];
        if (nloc == 0u) { xcd_barrier_complete(bar, b.x, nloc, nx); b.st[0] = nloc; b.st[1] = nx; }
        const unsigned old = xb_add(&bar[XB_XSUB(b.x)], 1u);
        const unsigned gen = old / nloc;
        if (old + 1u == (gen + 1u) * nloc) {
            __builtin_amdgcn_fence(__ATOMIC_RELEASE, "agent");
            asm volatile("s_waitcnt vmcnt(0)" ::: "memory");
            const unsigned og = xb_add(&bar[XB_TOP], 1u);
            const unsigned tg = og / nx;
            if (og + 1u == (tg + 1u) * nx) xb_add(&bar[XB_TOPGEN], 1u);
            else XB_SPIN(xb_ld(&bar[XB_TOPGEN]) == tg, bar);
            __builtin_amdgcn_fence(__ATOMIC_ACQUIRE, "agent");
            xb_add(&bar[XB_XGEN(b.x)], 1u);
            asm volatile("s_waitcnt vmcnt(0)" ::: "memory");
        } else {
            XB_SPIN(xb_ld(&bar[XB_XGEN(b.x)]) == gen, bar);
            __builtin_amdgcn_fence(__ATOMIC_ACQUIRE, "agent");
            asm volatile("s_waitcnt vmcnt(0)" ::: "memory");
        }
    }
    __syncthreads();
}


__device__ __forceinline__ void p0_transpose_item(const float* W, int K, int N, const float* gain, bf16* WT, LAS float* scr, int item, int lane) {
    const int nblk = N / 32, kb = item / nblk, nb = item % nblk, k0 = 64 * kb, n0 = 32 * nb;
#pragma unroll 8
    for (int i = 0; i < 32; ++i) { const int kk = 2 * i + (lane >> 5); const float g = gain ? gain[k0 + kk] : 1.0f; scr[kk * 33 + (lane & 31)] = W[(size_t)(k0 + kk) * N + n0 + (lane & 31)] * g; }
    LDS_WAIT(); asm volatile("" ::: "memory");
    const int c = lane & 7;
#pragma unroll
    for (int j = 0; j < 4; ++j) { const int n = (lane >> 3) + 8 * j; const LAS float* s = scr + (8 * c) * 33 + n;
        v4u o; o.x = pk2(s[0 * 33], s[1 * 33]); o.y = pk2(s[2 * 33], s[3 * 33]); o.z = pk2(s[4 * 33], s[5 * 33]); o.w = pk2(s[6 * 33], s[7 * 33]);
        *(GAS v4u*)(WT + (size_t)(n0 + n) * K + k0 + 8 * c) = o; }
    LDS_WAIT(); asm volatile("" ::: "memory");
}

struct Args { const float* in[14]; float* out; unsigned char* ws; int ph_lo, ph_hi, li, pad; };

__global__ void __launch_bounds__(NWAVES * 64, 2) hymba_fwd(Args args) {
    extern __shared__ __attribute__((aligned(16))) unsigned char lds_raw[];
    LAS unsigned char* lds = (LAS unsigned char*)lds_raw;
    volatile LAS unsigned* MISC = (volatile LAS unsigned*)(lds + MISC_OFF);
    const int tid = threadIdx.x, lane = tid & 63, wave = __builtin_amdgcn_readfirstlane(tid >> 6);
    const int G = gridDim.x;
    const int gw = (int)blockIdx.x * NWAVES + wave, NGW = G * NWAVES;
    unsigned char* ws = args.ws;
    gu32* ctl = (gu32*)(ws + WS_CTL);
    const float* x = args.in[0]; const float* norm_mix = args.in[1]; const float* w_in = args.in[2]; const float* conv_w = args.in[3]; const float* conv_gain = args.in[4];
    const float* hg_lb = args.in[5]; const float* hg_gain = args.in[6]; const float* w_out = args.in[7]; const float* norm_ffn = args.in[8]; const float* peer_wq = args.in[9];
    const float* peer_keys = args.in[10]; const float* peer_u = args.in[11]; const float* peer_v = args.in[12]; const float* norm_f = args.in[13];
    float* out = args.out;
    bf16* W1T = (bf16*)(ws + WS_W1T); bf16* WOT = (bf16*)(ws + WS_WOT); bf16* WQT = (bf16*)(ws + WS_WQT);
    float* RS1 = (float*)(ws + WS_RS1); float* SS2 = (float*)(ws + WS_SS2);
    unsigned short* U16 = (unsigned short*)(ws + WS_U16); unsigned short* V16 = (unsigned short*)(ws + WS_V16); unsigned* EXPT = (unsigned*)(ws + WS_EXP); bf16* KEYB = (bf16*)(ws + WS_KEYB);
    bf16* XB = (bf16*)(ws + WS_XB); bf16* MIX = (bf16*)(ws + WS_XB); bf16* X1 = (bf16*)(ws + WS_X1);
    bf16* PROJ = (bf16*)(ws + WS_PROJ); bf16* QB = (bf16*)(ws + WS_PROJ); float* DEC = (float*)(ws + WS_F); bf16* KDT = (bf16*)(ws + WS_X1); bf16* VTT = (bf16*)(ws + WS_X1 + 64 * MiB);

    for (int u = tid; u < (LDS_BYTES - LDSCTL_OFF) / 4; u += NWAVES * 64) ((LAS unsigned*)(lds + LDSCTL_OFF))[u] = 0u;
    __syncthreads();
    XcdBarrier bar; bar.bar = (unsigned*)(ctl + CW_BAR); bar.x = 0; bar.st = nullptr;
    if (N_LAUNCHES == 1) bar = xcd_barrier_post((unsigned*)(ctl + CW_BAR), MISC + 8);
#define GRID_BAR() do { if (N_LAUNCHES == 1) xcd_barrier(bar); } while (0)
    const int lo = args.ph_lo, hi = args.ph_hi;
#define IN(k) (lo <= (k) && (k) < hi)
#define BOTH(k) (IN(k) && IN((k) + 1))

    if (IN(0)) {
        LAS float* scr = (LAS float*)(lds + RING_OFF + wave * 16384);
        constexpr int I_1 = (D / 64) * (DIN / 32), I_O = (D / 64) * (D / 32), I_Q = (D / 64) * (2048 / 32);
        for (int it = gw; it < I_1 + I_O + I_Q; it += NGW) {
            int r = it;
            if (r < I_1) { p0_transpose_item(w_in, D, DIN, norm_mix, W1T, scr, r, lane); continue; } r -= I_1;
            if (r < I_O) { p0_transpose_item(w_out, D, D, nullptr, WOT, scr, r, lane); continue; } r -= I_O;
            p0_transpose_item(peer_wq, D, 2048, norm_ffn, WQT, scr, r, lane);
        }
        for (int m = gw; m < T; m += NGW) {
            const GAS f32x4* xr = (const GAS f32x4*)(x + (size_t)m * D) + lane; f32x4 v[4]; float s = 0.f;
#pragma unroll
            for (int j = 0; j < 4; ++j) { v[j] = xr[64 * j]; s += (v[j].x * v[j].x + v[j].y * v[j].y) + (v[j].z * v[j].z + v[j].w * v[j].w); }
            s = wave_sum(s);
            if (lane == 0) RS1[m] = 1.0f / sqrtf(s * (1.0f / D) + EPS);
            GAS unsigned long long* o8 = (GAS unsigned long long*)(XB + (size_t)m * D) + lane;
#pragma unroll
            for (int j = 0; j < 4; ++j) o8[64 * j] = (unsigned long long)pk2(v[j].x, v[j].y) | ((unsigned long long)pk2(v[j].z, v[j].w) << 32);
        }
        for (int r = gw; r < 2 * NEXP; r += NGW) {
            const int tb = r / NEXP, e = r % NEXP;
            const GAS f32x4* src = (const GAS f32x4*)((tb ? peer_v : peer_u) + (size_t)e * D) + lane;
            GAS v2u* dst = (GAS v2u*)((tb ? V16 : U16) + (size_t)e * D) + lane;
#pragma unroll
            for (int j = 0; j < 4; ++j) { f32x4 v = src[64 * j]; if (!tb) { const f32x4 g = ((const GAS f32x4*)norm_ffn)[64 * j + lane]; v = v * g; }
                v2u o; o.x = pkh2(v.x, v.y); o.y = pkh2(v.z, v.w); dst[64 * j] = o; }
        }
        for (int i = (int)blockIdx.x * NWAVES * 64 + tid; i < T; i += G * NWAVES * 64) SS2[i] = 0.f;
        for (int i = (int)blockIdx.x * NWAVES * 64 + tid; i < 8 * 2 * 128 * 128 / 2; i += G * NWAVES * 64) ((GAS unsigned*)KEYB)[i] = pk2(peer_keys[2 * i], peer_keys[2 * i + 1]);
        if (BOTH(0)) GRID_BAR();
    }

    if (IN(1)) {
        pg8::Gemm g{XB, W1T, T, DIN, D}; pg8::StaticOrder S; S.init(T, DIN, G, (int)blockIdx.x);
        pg8::EpiScaleBf16<0> E{PROJ, DIN, RS1};
        pg8::gemm_phase<pg8::EpiScaleBf16<0>, pg8::StaticOrder, PG8_ALIGN, PG8_SP2>(lds + RING_OFF, g, S, E);
        if (BOTH(1)) GRID_BAR();
    }

    if (IN(2)) {
        for (int item = gw; item < NB * 64 * 4; item += NGW) {
            const int h = item & 3, n = (item >> 2) & 63, b = item >> 8;
            const size_t tok0 = (size_t)b * SEQ + n * 32;
            const int c0 = h * 128 + 2 * lane, cs = h * 128 + swap23(2 * lane);
            const float lb0 = 1.0f / (1.0f + __expf(hg_lb[512 + c0] - hg_lb[c0])), lb1 = 1.0f / (1.0f + __expf(hg_lb[512 + c0 + 1] - hg_lb[c0 + 1]));
            unsigned qw[32], fw[32], vw[32];
#pragma unroll
            for (int c = 0; c < 32; ++c) { const bf16* pr = PROJ + (tok0 + c) * DIN;
                qw[c] = *(const GAS unsigned*)(pr + PC_Q + c0); fw[c] = *(const GAS unsigned*)(pr + PC_F + c0); vw[c] = *(const GAS unsigned*)(pr + PC_V + c0); }
            float eG0 = 1.f, eG1 = 1.f;
            unsigned kd0[16], kd1[16], vv0[16], vv1[16];
#pragma unroll
            for (int i = 0; i < 16; ++i) { kd0[i] = 0u; kd1[i] = 0u; vv0[i] = 0u; vv1[i] = 0u; }
#pragma unroll
            for (int c = 0; c < 32; ++c) { bf16* pr = PROJ + (tok0 + c) * DIN;
                const float f0 = lb0 + (1.0f - lb0) * sigmoidf_(bf_lo(fw[c])), f1 = lb1 + (1.0f - lb1) * sigmoidf_(bf_hi(fw[c]));
                eG0 *= f0; eG1 *= f1;
                const float q0 = bf_lo(qw[c]), q1 = bf_hi(qw[c]);
                const float qd0 = q0 * sigmoidf_(q0) * 0.08838834764831845f * eG0, qd1 = q1 * sigmoidf_(q1) * 0.08838834764831845f * eG1;
                const float kv0 = (1.0f - f0) / eG0, kv1 = (1.0f - f1) / eG1;
                *(GAS unsigned*)(pr + PC_Q + cs) = pk2(qd0, qd1);
                const unsigned kp = pk2(kv0, kv1);
                *(GAS unsigned*)(pr + PC_F + cs) = kp;
                const int pp = swap23(c), sh = 16 * (pp & 1);
                kd0[pp >> 1] |= (kp & 0xffffu) << sh; kd1[pp >> 1] |= (kp >> 16) << sh;
                vv0[pp >> 1] |= (vw[c] & 0xffffu) << sh; vv1[pp >> 1] |= (vw[c] >> 16) << sh; }
            GAS v4u* kt = (GAS v4u*)(KDT + ((size_t)item * 128 + 2 * lane) * 32);
            GAS v4u* vt = (GAS v4u*)(VTT + ((size_t)item * 128 + 2 * lane) * 32);
#pragma unroll
            for (int i = 0; i < 4; ++i) { kt[i] = (v4u){kd0[4 * i], kd0[4 * i + 1], kd0[4 * i + 2], kd0[4 * i + 3]}; kt[4 + i] = (v4u){kd1[4 * i], kd1[4 * i + 1], kd1[4 * i + 2], kd1[4 * i + 3]};
                vt[i] = (v4u){vv0[4 * i], vv0[4 * i + 1], vv0[4 * i + 2], vv0[4 * i + 3]}; vt[4 + i] = (v4u){vv1[4 * i], vv1[4 * i + 1], vv1[4 * i + 2], vv1[4 * i + 3]}; }
            *(GAS f32x2*)(DEC + (size_t)item * 128 + 2 * lane) = (f32x2){eG0, eG1};
        }
        for (int item = gw; item < NB * 8 * 32; item += NGW) {
            const int seg = item & 31, grp = (item >> 5) & 7, b = item >> 8, c = grp * 64 + lane, t0 = seg * 64;
            const float w0 = conv_w[c], w1 = conv_w[512 + c], w2 = conv_w[1024 + c], gn = conv_gain[c];
            float u1 = 0.f, u2 = 0.f;
            if (t0 > 0) { const bf16* p2 = PROJ + (size_t)(b * SEQ + t0 - 2) * DIN; const bf16* p1 = p2 + DIN;
                u2 = bf1(p2[PC_C + c]) * bf1(p2[PC_H + c]); u1 = bf1(p1[PC_C + c]) * bf1(p1[PC_H + c]); }
            for (int t = t0; t < t0 + 64; ++t) { const size_t tok = (size_t)b * SEQ + t; const bf16* pr = PROJ + tok * DIN;
                const float u = bf1(pr[PC_C + c]) * bf1(pr[PC_H + c]); const float y = bf1(pr[PC_B + c]) * (w0 * u2 + w1 * u1 + w2 * u);
                const float ss = wave_sum(y * y); const float r = 1.0f / sqrtf(ss * (1.0f / 64.0f) + EPS);
                MIX[tok * D + c] = (bf16)f2bf(y * r * gn); u2 = u1; u1 = u; }
        }
        if (BOTH(2)) GRID_BAR();
    }

    if (IN(3)) {
        constexpr int BUFB = 33792, OB0 = 2 * BUFB;
        for (int it = (int)blockIdx.x; it < NB * 4; it += G) {
            const int b = it >> 2, h = it & 3;
            const int lt = tid & 255, r = lane & 31, hh = lane >> 5, sl = wave;
            v4u st[9];
#define SCAN_LOAD(n_) do { const size_t tk0 = (size_t)b * SEQ + (n_) * 32; const size_t itm = (size_t)((b * 64 + (n_)) * 4 + h); \
                _Pragma("unroll") for (int i = 0; i < 2; ++i) { const int q = lt + 256 * i, row = q >> 4, cc = q & 15; const bf16* pr = PROJ + (tk0 + row) * DIN + h * 128 + cc * 8; \
                    st[i] = *(const GAS v4u*)(pr + PC_Q); st[2 + i] = *(const GAS v4u*)(pr + PC_F); \
                    st[4 + i] = ((const GAS v4u*)(KDT + itm * 4096))[q]; st[6 + i] = ((const GAS v4u*)(VTT + itm * 4096))[q]; } \
                if (lt < 32) st[8] = ((const GAS v4u*)(DEC + itm * 128))[lt]; } while (0)
#define SCAN_COMMIT(n_) do { LAS unsigned char* Bf = lds + RING_OFF + ((n_) & 1) * BUFB; \
                _Pragma("unroll") for (int i = 0; i < 2; ++i) { const int q = lt + 256 * i, row = q >> 4, cc = q & 15, k = q >> 2, c4 = q & 3; \
                    *(LAS v4u*)(Bf + row * 256 + ((cc ^ (row & 15)) * 16)) = st[i]; *(LAS v4u*)(Bf + 8192 + row * 256 + ((cc ^ (row & 15)) * 16)) = st[2 + i]; \
                    *(LAS v4u*)(Bf + 16384 + k * 64 + ((c4 ^ ((k >> 2) & 3)) * 16)) = st[4 + i]; *(LAS v4u*)(Bf + 24576 + k * 64 + ((c4 ^ ((k >> 2) & 3)) * 16)) = st[6 + i]; } \
                if (lt < 32) *(LAS v4u*)(Bf + 32768 + lt * 16) = st[8]; } while (0)
#define SCAN_POST(n_) do { const int pos = lt >> 3, vg = lt & 7; const LAS f32x4* ob = (const LAS f32x4*)(lds + RING_OFF + OB0 + ((n_) & 1) * 16384 + (pos * 128 + vg * 16) * 4); \
                const f32x4 o0 = ob[0], o1 = ob[1], o2 = ob[2], o3 = ob[3]; \
                float ss = (o0.x * o0.x + o0.y * o0.y) + (o0.z * o0.z + o0.w * o0.w) + (o1.x * o1.x + o1.y * o1.y) + (o1.z * o1.z + o1.w * o1.w) \
                         + (o2.x * o2.x + o2.y * o2.y) + (o2.z * o2.z + o2.w * o2.w) + (o3.x * o3.x + o3.y * o3.y) + (o3.z * o3.z + o3.w * o3.w); \
                ss += __shfl_xor(ss, 1); ss += __shfl_xor(ss, 2); ss += __shfl_xor(ss, 4); \
                const float rr = 1.0f / sqrtf(ss * (1.0f / 128.0f) + EPS); \
                const size_t tk = (size_t)b * SEQ + (n_) * 32 + pos; const GAS v4u* gp = (const GAS v4u*)(PROJ + tk * DIN + PC_G + h * 128 + vg * 16); const v4u g0 = gp[0], g1 = gp[1]; \
                const float ov[16] = {o0.x, o0.y, o0.z, o0.w, o1.x, o1.y, o1.z, o1.w, o2.x, o2.y, o2.z, o2.w, o3.x, o3.y, o3.z, o3.w}; \
                const float gf[16] = {bf_lo(g0.x), bf_hi(g0.x), bf_lo(g0.y), bf_hi(g0.y), bf_lo(g0.z), bf_hi(g0.z), bf_lo(g0.w), bf_hi(g0.w), bf_lo(g1.x), bf_hi(g1.x), bf_lo(g1.y), bf_hi(g1.y), bf_lo(g1.z), bf_hi(g1.z), bf_lo(g1.w), bf_hi(g1.w)}; \
                float yv[16]; _Pragma("unroll") for (int i = 0; i < 16; ++i) yv[i] = ov[i] * rr * hg_gain[vg * 16 + i] * (gf[i] * sigmoidf_(gf[i])); \
                GAS v4u* mp = (GAS v4u*)(MIX + tk * D + 512 + h * 128 + vg * 16); \
                mp[0] = (v4u){pk2(yv[0], yv[1]), pk2(yv[2], yv[3]), pk2(yv[4], yv[5]), pk2(yv[6], yv[7])}; mp[1] = (v4u){pk2(yv[8], yv[9]), pk2(yv[10], yv[11]), pk2(yv[12], yv[13]), pk2(yv[14], yv[15])}; } while (0)
#define SCAN_BAR() do { asm volatile("s_waitcnt lgkmcnt(0)" ::: "memory"); __builtin_amdgcn_s_barrier(); asm volatile("" ::: "memory"); } while (0)
            if (wave >= 4) {
                SCAN_LOAD(0); SCAN_COMMIT(0);
                SCAN_BAR();
                for (int n = 0; n < 64; ++n) {
                    if (n + 1 < 64) SCAN_LOAD(n + 1);
                    if (n >= 1) SCAN_POST(n - 1);
                    if (n + 1 < 64) SCAN_COMMIT(n + 1);
                    SCAN_BAR();
                }
                SCAN_POST(63);
                SCAN_BAR();
            } else {
                f32x16 S0, S1, S2, S3;
#pragma unroll
                for (int i = 0; i < 16; ++i) { S0[i] = 0.f; S1[i] = 0.f; S2[i] = 0.f; S3[i] = 0.f; }
                SCAN_BAR();
                for (int n = 0; n < 64; ++n) {
                    const LAS unsigned char* Bf = lds + RING_OFF + (n & 1) * BUFB;
                    pg8::bf16x8 qd[8], kd[8], vt[2];
#pragma unroll
                    for (int ks = 0; ks < 8; ++ks) { const int off = r * 256 + (((2 * ks + hh) ^ (r & 15)) * 16); qd[ks] = *(const LAS pg8::bf16x8*)(Bf + off); kd[ks] = *(const LAS pg8::bf16x8*)(Bf + 8192 + off); }
#pragma unroll
                    for (int sp = 0; sp < 2; ++sp) { const int row = 32 * sl + r; vt[sp] = *(const LAS pg8::bf16x8*)(Bf + 24576 + row * 64 + (((2 * sp + hh) ^ ((row >> 2) & 3)) * 16)); }
                    f32x16 X, O;
#pragma unroll
                    for (int i = 0; i < 16; ++i) { X[i] = 0.f; O[i] = 0.f; }
#pragma unroll
                    for (int ks = 0; ks < 8; ++ks) X = __builtin_amdgcn_mfma_f32_32x32x16_bf16(kd[ks], qd[ks], X, 0, 0, 0);
                    O = __builtin_amdgcn_mfma_f32_32x32x16_bf16(qd[0], pack8(S0, 0), O, 0, 0, 0); O = __builtin_amdgcn_mfma_f32_32x32x16_bf16(qd[1], pack8(S0, 1), O, 0, 0, 0);
                    O = __builtin_amdgcn_mfma_f32_32x32x16_bf16(qd[2], pack8(S1, 0), O, 0, 0, 0); O = __builtin_amdgcn_mfma_f32_32x32x16_bf16(qd[3], pack8(S1, 1), O, 0, 0, 0);
                    O = __builtin_amdgcn_mfma_f32_32x32x16_bf16(qd[4], pack8(S2, 0), O, 0, 0, 0); O = __builtin_amdgcn_mfma_f32_32x32x16_bf16(qd[5], pack8(S2, 1), O, 0, 0, 0);
                    O = __builtin_amdgcn_mfma_f32_32x32x16_bf16(qd[6], pack8(S3, 0), O, 0, 0, 0); O = __builtin_amdgcn_mfma_f32_32x32x16_bf16(qd[7], pack8(S3, 1), O, 0, 0, 0);
#pragma unroll
                    for (int i = 0; i < 16; ++i) { const int s_ = (i & 3) + 8 * (i >> 2) + 4 * hh; X[i] = (s_ <= r) ? X[i] : 0.f; }
                    O = __builtin_amdgcn_mfma_f32_32x32x16_bf16(pack8(X, 0), vt[0], O, 0, 0, 0); O = __builtin_amdgcn_mfma_f32_32x32x16_bf16(pack8(X, 1), vt[1], O, 0, 0, 0);
#define SCAN_SUPD(Sx, rt_) do { _Pragma("unroll") for (int sp = 0; sp < 2; ++sp) { const int row = 32 * (rt_) + r; \
                            const pg8::bf16x8 kt = *(const LAS pg8::bf16x8*)(Bf + 16384 + row * 64 + (((2 * sp + hh) ^ ((row >> 2) & 3)) * 16)); \
                            Sx = __builtin_amdgcn_mfma_f32_32x32x16_bf16(kt, vt[sp], Sx, 0, 0, 0); } \
                        _Pragma("unroll") for (int g = 0; g < 4; ++g) { const f32x4 dv = *(const LAS f32x4*)(Bf + 32768 + (32 * (rt_) + 8 * g + 4 * hh) * 4); \
                            Sx[4 * g] *= dv.x; Sx[4 * g + 1] *= dv.y; Sx[4 * g + 2] *= dv.z; Sx[4 * g + 3] *= dv.w; } } while (0)
                    SCAN_SUPD(S0, 0); SCAN_SUPD(S1, 1); SCAN_SUPD(S2, 2); SCAN_SUPD(S3, 3);
                    LAS float* ob = (LAS float*)(lds + RING_OFF + OB0 + (n & 1) * 16384);
#pragma unroll
                    for (int i = 0; i < 16; ++i) ob[((i & 3) + 8 * (i >> 2) + 4 * hh) * 128 + 32 * sl + r] = O[i];
                    SCAN_BAR();
                }
                SCAN_BAR();
            }
        }
        if (BOTH(3)) GRID_BAR();
    }


    if (IN(4)) {
        pg8::Gemm g{MIX, WOT, T, D, D}; pg8::StaticOrder S; S.init(T, D, G, (int)blockIdx.x);
        pg8::EpiResid E{x, X1, SS2};
        pg8::gemm_phase<pg8::EpiResid, pg8::StaticOrder, PG8_ALIGN, PG8_SP2>(lds + RING_OFF, g, S, E);
        if (BOTH(4)) GRID_BAR();
    }

    if (IN(5)) {
        pg8::Gemm g{X1, WQT, T, 2048, D}; pg8::StaticOrder S; S.init(T, 2048, G, (int)blockIdx.x);
        pg8::EpiScaleBf16<1> E{QB, 2048, SS2};
        pg8::gemm_phase<pg8::EpiScaleBf16<1>, pg8::StaticOrder, PG8_ALIGN, PG8_SP2>(lds + RING_OFF, g, S, E);
        if (BOTH(5)) GRID_BAR();
    }

    if (IN(6)) {
        const int r = lane & 31, hh = lane >> 5;
        for (int item = gw; item < (T / 32) * 8; item += NGW) {
            const int h = item & 7, tok = (item >> 3) * 32 + r;
            unsigned L[2][16];
#pragma unroll
            for (int p = 0; p < 2; ++p) {
                pg8::bf16x8 qf[8];
                const GAS pg8::bf16x8* qp = (const GAS pg8::bf16x8*)(QB + (size_t)tok * 2048 + h * 256 + p * 128 + 8 * hh);
#pragma unroll
                for (int ks = 0; ks < 8; ++ks) qf[ks] = qp[2 * ks];
                const GAS pg8::bf16x8* kp = (const GAS pg8::bf16x8*)(KEYB + (size_t)((h * 2 + p) * 128 + r) * 128 + 8 * hh);
                unsigned best[16];
#pragma unroll
                for (int nt = 0; nt < 4; ++nt) {
                    f32x16 acc;
#pragma unroll
                    for (int i = 0; i < 16; ++i) acc[i] = 0.f;
                    const GAS pg8::bf16x8* kb = kp + nt * 512; asm volatile("" : "+v"(kb));
#pragma unroll
                    for (int ks = 0; ks < 8; ++ks) acc = __builtin_amdgcn_mfma_f32_32x32x16_bf16(kb[2 * ks], qf[ks], acc, 0, 0, 0);
                    unsigned cur[16];
#pragma unroll
                    for (int i = 0; i < 16; ++i) { const int n = 32 * nt + (i & 3) + 8 * (i >> 2) + 4 * hh;
                        const float av = acc[i]; unsigned u = __builtin_bit_cast(unsigned, av); u ^= (unsigned)((int)u >> 31) | 0x80000000u;
                        cur[i] = (u & ~0x7Fu) | (unsigned)(127 - n); }
                    sort16_desc(cur);
                    if (nt == 0) {
#pragma unroll
                        for (int i = 0; i < 16; ++i) best[i] = cur[i];
                    } else merge16_desc(best, cur);
                }
                unsigned o[16];
#pragma unroll
                for (int i = 0; i < 16; ++i) o[i] = (unsigned)__shfl_xor((int)best[i], 32);
                merge16_desc(best, o);
#pragma unroll
                for (int i = 0; i < 16; ++i) L[p][i] = best[i];
            }
            float v1[16], v2[16];
#pragma unroll
            for (int j = 0; j < 16; ++j) { v1[j] = unkey(L[0][j] & ~0x7Fu); v2[j] = unkey(L[1][j] & ~0x7Fu); }
            unsigned ct[16];
#pragma unroll
            for (int j = 0; j < 16; ++j) ct[j] = ckey(v1[0] + v2[j], j);
#pragma unroll
            for (int i = 1; i < 16; ++i)
#pragma unroll
                for (int j = 0; j < 16; ++j) if ((i + 1) * (j + 1) <= 16) {
                    unsigned key = ckey(v1[i] + v2[j], i * 16 + j);
#pragma unroll
                    for (int t = 0; t < 16; ++t) { const unsigned mx = ct[t] > key ? ct[t] : key; key = ct[t] > key ? key : ct[t]; ct[t] = mx; }
                }
            float den = 0.f, ex[16]; const float cmax = unkey(ct[0] & ~0xFFu);
#pragma unroll
            for (int t = 0; t < 16; ++t) { ex[t] = __expf(unkey(ct[t] & ~0xFFu) - cmax); den += ex[t]; }
            const float inv = 1.0f / den;
            unsigned b1[4], b2[4];
#pragma unroll
            for (int w = 0; w < 4; ++w) { b1[w] = (L[0][4 * w] & 0x7Fu) | ((L[0][4 * w + 1] & 0x7Fu) << 8) | ((L[0][4 * w + 2] & 0x7Fu) << 16) | ((L[0][4 * w + 3] & 0x7Fu) << 24);
                b2[w] = (L[1][4 * w] & 0x7Fu) | ((L[1][4 * w + 1] & 0x7Fu) << 8) | ((L[1][4 * w + 2] & 0x7Fu) << 16) | ((L[1][4 * w + 3] & 0x7Fu) << 24); }
            unsigned ent[8];
#pragma unroll
            for (int t = 0; t < 8; ++t) { const unsigned hm = 0u - (unsigned)hh;
                const unsigned ck = ct[t] ^ ((ct[t] ^ ct[8 + t]) & hm); const unsigned e0 = __builtin_bit_cast(unsigned, ex[t]), e1 = __builtin_bit_cast(unsigned, ex[8 + t]);
                const float gt = __builtin_bit_cast(float, e0 ^ ((e0 ^ e1) & hm)) * inv;
                const unsigned flat = 255u - (ck & 0xFFu), ii = flat >> 4, jj = flat & 15u;
                const unsigned w1 = (ii & 8u) ? ((ii & 4u) ? b1[3] : b1[2]) : ((ii & 4u) ? b1[1] : b1[0]), w2 = (jj & 8u) ? ((jj & 4u) ? b2[3] : b2[2]) : ((jj & 4u) ? b2[1] : b2[0]);
                const unsigned n1 = 127u - ((w1 >> (8u * (ii & 3u))) & 0x7Fu), n2 = 127u - ((w2 >> (8u * (jj & 3u))) & 0x7Fu);
                ent[t] = (n1 * 128u + n2) | (pkh2(gt, 0.f) << 16); }
            GAS v4u* ep = (GAS v4u*)(EXPT + (size_t)tok * 128 + h * 16 + 8 * hh);
            ep[0] = (v4u){ent[0], ent[1], ent[2], ent[3]}; ep[1] = (v4u){ent[4], ent[5], ent[6], ent[7]};
        }
        if (BOTH(6)) GRID_BAR();
    }


    if (IN(7)) {
        float nf[16];
#pragma unroll
        for (int i = 0; i < 8; ++i) { nf[i] = norm_f[8 * lane + i]; nf[8 + i] = norm_f[512 + 8 * lane + i]; }
        for (int tok = gw; tok < T; tok += NGW) {
            const GAS v4u* xr = (const GAS v4u*)(X1 + (size_t)tok * D);
            const v4u xa = xr[lane], xb = xr[64 + lane];
            float xf[16] = {bf_lo(xa.x), bf_hi(xa.x), bf_lo(xa.y), bf_hi(xa.y), bf_lo(xa.z), bf_hi(xa.z), bf_lo(xa.w), bf_hi(xa.w),
                            bf_lo(xb.x), bf_hi(xb.x), bf_lo(xb.y), bf_hi(xb.y), bf_lo(xb.z), bf_hi(xb.z), bf_lo(xb.w), bf_hi(xb.w)};
            h2_t hx[8];
#pragma unroll
            for (int i = 0; i < 8; ++i) hx[i] = __builtin_bit_cast(h2_t, pkh2(xf[2 * i], xf[2 * i + 1]));
            const float rstd2 = 1.0f / sqrtf(SS2[tok] * (1.0f / D) + EPS);
            float y[16];
#pragma unroll
            for (int i = 0; i < 16; ++i) y[i] = 0.f;
#pragma unroll
            for (int half = 0; half < 2; ++half) {
                const unsigned ev = EXPT[(size_t)tok * 128 + half * 64 + lane];
                float amine = 0.f;
#pragma unroll 8
                for (int i = 0; i < 64; ++i) {
                    const unsigned id = (unsigned)__builtin_amdgcn_readlane((int)ev, i) & 0xFFFFu;
                    const GAS v4u* ur = (const GAS v4u*)(U16 + (size_t)id * D);
                    const v4u ua = ur[lane], ub = ur[64 + lane];
                    float p = 0.f;
                    p = __builtin_amdgcn_fdot2(h2_of(ua.x), hx[0], p, false); p = __builtin_amdgcn_fdot2(h2_of(ua.y), hx[1], p, false);
                    p = __builtin_amdgcn_fdot2(h2_of(ua.z), hx[2], p, false); p = __builtin_amdgcn_fdot2(h2_of(ua.w), hx[3], p, false);
                    p = __builtin_amdgcn_fdot2(h2_of(ub.x), hx[4], p, false); p = __builtin_amdgcn_fdot2(h2_of(ub.y), hx[5], p, false);
                    p = __builtin_amdgcn_fdot2(h2_of(ub.z), hx[6], p, false); p = __builtin_amdgcn_fdot2(h2_of(ub.w), hx[7], p, false);
                    p = wave_sum(p);
                    amine = (lane == i) ? p : amine;
                }
                const float a = amine * rstd2;
                const float gl = 0.5f * a * (1.0f + erff(a * 0.7071067811865476f));
                const float gate = (float)__builtin_bit_cast(h2_t, ev >> 16).x;
                const float wv = gate * gl;
#pragma unroll 8
                for (int i = 0; i < 64; ++i) {
                    const unsigned id = (unsigned)__builtin_amdgcn_readlane((int)ev, i) & 0xFFFFu;
                    const float wi = __builtin_bit_cast(float, __builtin_amdgcn_readlane(__builtin_bit_cast(int, wv), i));
                    const GAS v4u* vr = (const GAS v4u*)(V16 + (size_t)id * D);
                    const v4u va = vr[lane], vb = vr[64 + lane];
                    const unsigned vw[8] = {va.x, va.y, va.z, va.w, vb.x, vb.y, vb.z, vb.w};
#pragma unroll
                    for (int j = 0; j < 8; ++j) { const h2_t hv = __builtin_bit_cast(h2_t, vw[j]); y[2 * j] = fmaf((float)hv.x, wi, y[2 * j]); y[2 * j + 1] = fmaf((float)hv.y, wi, y[2 * j + 1]); }
                }
            }
            float ss = 0.f;
#pragma unroll
            for (int i = 0; i < 16; ++i) { y[i] += xf[i]; ss += y[i] * y[i]; }
            ss = wave_sum(ss);
            const float r = 1.0f / sqrtf(ss * (1.0f / D) + EPS);
            GAS f32x4* op = (GAS f32x4*)(out + (size_t)tok * D);
            op[2 * lane] = (f32x4){y[0] * r * nf[0], y[1] * r * nf[1], y[2] * r * nf[2], y[3] * r * nf[3]};
            op[2 * lane + 1] = (f32x4){y[4] * r * nf[4], y[5] * r * nf[5], y[6] * r * nf[6], y[7] * r * nf[7]};
            op[128 + 2 * lane] = (f32x4){y[8] * r * nf[8], y[9] * r * nf[9], y[10] * r * nf[10], y[11] * r * nf[11]};
            op[128 + 2 * lane + 1] = (f32x4){y[12] * r * nf[12], y[13] * r * nf[13], y[14] * r * nf[14], y[15] * r * nf[15]};
        }
    }
#undef IN
#undef BOTH
}

extern "C" void kernel_launch(void* const* d_in, const int* in_sizes, int n_in, void* d_out, int out_size, void* d_ws, size_t ws_size, hipStream_t stream) {
    static int grid = 0;
    if (grid == 0) {
        if (n_in != 14 || in_sizes[0] != T * D || out_size != T * D || ws_size < WS_END) { fprintf(stderr, "kernel_launch: unexpected shapes (n_in %d, in0 %d, out %d, ws %zu); nothing launched\n", n_in, n_in > 0 ? in_sizes[0] : -1, out_size, ws_size); grid = -1; return; }
        int dev = 0, cus = 0, per_cu = 0;
        if (hipGetDevice(&dev) != hipSuccess || hipDeviceGetAttribute(&cus, hipDeviceAttributeMultiprocessorCount, dev) != hipSuccess) { grid = -1; return; }
        if (hipFuncSetAttribute((const void*)hymba_fwd, hipFuncAttributeMaxDynamicSharedMemorySize, LDS_BYTES) != hipSuccess) { fprintf(stderr, "kernel_launch: hipFuncSetAttribute failed\n"); grid = -1; return; }
        if (hipOccupancyMaxActiveBlocksPerMultiprocessor(&per_cu, (const void*)hymba_fwd, NWAVES * 64, LDS_BYTES) != hipSuccess || per_cu < 1) { fprintf(stderr, "kernel_launch: occupancy query says %d blocks per CU\n", per_cu); (void)hipGetLastError(); grid = -1; return; }
        grid = cus;
    }
    if (grid < 0) return;
    if (hipMemsetAsync((char*)d_ws + WS_CTL, 0, CTL_ZERO_BYTES, stream) != hipSuccess) { fprintf(stderr, "kernel_launch: hipMemsetAsync failed\n"); return; }
    Args a{};
    for (int i = 0; i < 14; ++i) a.in[i] = (const float*)d_in[i];
    a.out = (float*)d_out; a.ws = (unsigned char*)d_ws;
    if (N_LAUNCHES == 1) {
        a.ph_lo = 0; a.ph_hi = NPHASES; a.li = 0;
        void* kargs[] = {&a};
        const hipError_t e = hipLaunchCooperativeKernel((const void*)hymba_fwd, dim3(grid), dim3(NWAVES * 64), kargs, LDS_BYTES, stream);
        if (e != hipSuccess) fprintf(stderr, "kernel_launch: cooperative launch failed: %s (grid %d)\n", hipGetErrorString(e), grid);
    } else {
        for (int li = 0; li < NPHASES; ++li) {
            a.ph_lo = li; a.ph_hi = li + 1; a.li = li;
            hipLaunchKernelGGL(hymba_fwd, dim3(grid), dim3(NWAVES * 64), LDS_BYTES, stream, a);
            const hipError_t le = hipPeekAtLastError();
            if (le != hipSuccess) { fprintf(stderr, "kernel_launch: launch %d failed: %s\n", li, hipGetErrorName(le)); break; }
        }
    }
}
```

```cpp
#include <hip/hip_runtime.h>
#include <cstdio>
#include <cstdint>
namespace pg8 {
#define PG8_LAS __attribute__((address_space(3)))
typedef unsigned short bf16_t;
typedef short bf16x8 __attribute__((ext_vector_type(8)));
typedef float f32x4 __attribute__((ext_vector_type(4)));
typedef unsigned u32x4 __attribute__((ext_vector_type(4)));
constexpr int BM = 256, BK = 64, HALF = 128, HTB = HALF * BK * 2  , STAGE_BYTES = 8 * HTB, NXCD = 8, WGM = 8;

__host__ __device__ __forceinline__ int lds_byte(int r, int c) { const int st = (r >> 4) * 2 + (c >> 5), rr = r & 15, cc = c & 31, ob = rr * 64 + cc * 2; return st * 1024 + (ob ^ (((ob >> 9) & 1) << 5)); }
__host__ __device__ __forceinline__ void stage_rc(int b, int& R, int& C) { const int st = b / 1024, sb = b % 1024, swz = sb ^ (((sb >> 9) & 1) << 5); R = (st >> 1) * 16 + swz / 64; C = (st & 1) * 32 + (swz % 64) / 2; }
__host__ __device__ __forceinline__ int perm32(int rho) { const int n = rho >> 4, i = rho & 15; return 8 * (i >> 2) + 4 * n + (i & 3); }

struct Unit { int pm, pn; };
struct Gemm { const bf16_t* A; const bf16_t* Bt; int M, N, K; };

struct StaticOrder {
    int nM, nN, nwg, G, c;
    __host__ __device__ void init(int M, int N, int G_, int c_) { nM = M / BM; nN = N / BM; nwg = nM * nN; G = G_; c = c_; }
    __host__ __device__ bool next(int i, Unit& u) const {
        const long L = (long)i * G + c; if (L >= nwg) return false;
        int wgid = (int)L; { const int q = nwg / NXCD, r = nwg % NXCD, xcd = wgid % NXCD, off = wgid / NXCD; wgid = (xcd < r ? xcd * (q + 1) : r * (q + 1) + (xcd - r) * q) + off; }
        const int nig = WGM * nN, gid = wgid / nig, fm = gid * WGM, gsz = (nM - fm) < WGM ? (nM - fm) : WGM;
        u.pm = fm + ((wgid % nig) % gsz); u.pn = (wgid % nig) / gsz; return true;
    }
    __device__ __forceinline__ void a_ready(const Unit&) const {}
    __device__ __forceinline__ void done(const Unit&) const {}
};

__device__ __forceinline__ unsigned cvt_pk_bf16(float lo, float hi) { unsigned r; asm volatile("v_cvt_pk_bf16_f32 %0, %1, %2" : "=v"(r) : "v"(lo), "v"(hi)); return r; }

template <int MODE> struct EpiScaleBf16 {
    static constexpr bool PERM = true, AFTER_DRAIN = false;
    bf16_t* O; int ldc; const float* rowv;
    __device__ __forceinline__ void operator()(const f32x4 (&acc)[2][2][4][2], const Unit& u, int wr, int wc, int fr, int fq) const {
        const int row0 = u.pm * BM + wr * 64 + fr, col0 = u.pn * BM + wc * 32 + 8 * fq;
#pragma unroll
        for (int ai = 0; ai < 2; ++ai)
#pragma unroll
            for (int m = 0; m < 4; ++m) { const int row = row0 + ai * HALF + m * 16; float s = rowv[row]; if (MODE == 1) s = 1.0f / sqrtf(s * (1.0f / 1024.0f) + 1e-6f);
                bf16_t* rowp = O + (size_t)row * ldc + col0;
#pragma unroll
                for (int bj = 0; bj < 2; ++bj) { const f32x4 v0 = acc[ai][bj][m][0] * s, v1 = acc[ai][bj][m][1] * s;
                    u32x4 w; w.x = cvt_pk_bf16(v0[0], v0[1]); w.y = cvt_pk_bf16(v0[2], v0[3]); w.z = cvt_pk_bf16(v1[0], v1[1]); w.w = cvt_pk_bf16(v1[2], v1[3]);
                    *(u32x4*)(rowp + bj * HALF) = w; } }
    }
};
struct EpiResid {
    static constexpr bool PERM = true, AFTER_DRAIN = false;
    const float* X; bf16_t* O; float* ss;
    __device__ __forceinline__ void operator()(const f32x4 (&acc)[2][2][4][2], const Unit& u, int wr, int wc, int fr, int fq) const {
        const int row0 = u.pm * BM + wr * 64 + fr, col0 = u.pn * BM + wc * 32 + 8 * fq;
#pragma unroll
        for (int ai = 0; ai < 2; ++ai)
#pragma unroll
            for (int m = 0; m < 4; ++m) { const int row = row0 + ai * HALF + m * 16; float part = 0.f;
#pragma unroll
                for (int bj = 0; bj < 2; ++bj) { const float* xp = X + (size_t)row * 1024 + col0 + bj * HALF;
                    const f32x4 v0 = acc[ai][bj][m][0] + *(const f32x4*)xp, v1 = acc[ai][bj][m][1] + *(const f32x4*)(xp + 4);
                    part += (v0[0] * v0[0] + v0[1] * v0[1]) + (v0[2] * v0[2] + v0[3] * v0[3]) + (v1[0] * v1[0] + v1[1] * v1[1]) + (v1[2] * v1[2] + v1[3] * v1[3]);
                    u32x4 w; w.x = cvt_pk_bf16(v0[0], v0[1]); w.y = cvt_pk_bf16(v0[2], v0[3]); w.z = cvt_pk_bf16(v1[0], v1[1]); w.w = cvt_pk_bf16(v1[2], v1[3]);
                    *(u32x4*)(O + (size_t)row * 1024 + col0 + bj * HALF) = w; }
                part += __shfl_xor(part, 16); part += __shfl_xor(part, 32);
                if (fq == 0) (void)__builtin_amdgcn_global_atomic_fadd_f32((__attribute__((address_space(1))) float*)(ss + row), part); }
    }
};

template <class Epi, class Sched, bool ALIGN_EPI = false, bool SP2 = false>
__device__ __forceinline__ void gemm_phase(PG8_LAS unsigned char* lds, const Gemm g, const Sched& S, const Epi& E) {
    const int tid = threadIdx.x, wid = __builtin_amdgcn_readfirstlane(tid >> 6), lane = tid & 63, wr = wid >> 2, wc = wid & 3, fr = lane & 15, fq = lane >> 4;
    const int K = g.K, nt = K / BK;
    unsigned voffA[2], voffB[2];
#pragma unroll
    for (int i = 0; i < 2; ++i) { int R, C; stage_rc(tid * 16 + i * 8192, R, C); const int Rb = Epi::PERM ? ((R & ~31) + perm32(R & 31)) : R;
        voffA[i] = (unsigned)(R * K + C) * 2u; voffB[i] = (unsigned)(Rb * K + C) * 2u; }
    const size_t kstep = (size_t)(BK * 2);
    const size_t hstep = (size_t)HALF * K * 2;
    const size_t tstep = 2 * hstep;
    const unsigned ldsw = (unsigned)wid * 1024u;
    const int aoff = lds_byte(wr * 64 + fr, fq * 8), boff = lds_byte(wc * 32 + fr, fq * 8);
#define PG8_SA(b, h) (((b) * 2 + (h)) * HTB)
#define PG8_SB(b, h) ((4 + (b) * 2 + (h)) * HTB)
#define PG8_STAGE(bufoff, gbase, voff) do { _Pragma("unroll") for (int _i = 0; _i < 2; ++_i) \
        __builtin_amdgcn_global_load_lds((const unsigned*)((const char*)(gbase) + (voff)[_i]), (PG8_LAS unsigned*)(lds + (bufoff) + ldsw + _i * 8192), 16, 0, 0); } while (0)
#define PG8_LDA(dst, b, h) do { _Pragma("unroll") for (int m = 0; m < 4; ++m) _Pragma("unroll") for (int k = 0; k < 2; ++k) dst[m][k] = *(const PG8_LAS bf16x8*)(lds + PG8_SA(b, h) + aoff + m * 2048 + k * 1024); } while (0)
#define PG8_LDB(dst, b, h) do { _Pragma("unroll") for (int n = 0; n < 2; ++n) _Pragma("unroll") for (int k = 0; k < 2; ++k) dst[n][k] = *(const PG8_LAS bf16x8*)(lds + PG8_SB(b, h) + boff + n * 2048 + k * 1024); } while (0)
#define PG8_MMA(ai, bj, At, Bt) do { __builtin_amdgcn_s_setprio(1); _Pragma("unroll") for (int m = 0; m < 4; ++m) _Pragma("unroll") for (int n = 0; n < 2; ++n) _Pragma("unroll") for (int k = 0; k < 2; ++k) \
        acc[ai][bj][m][n] = __builtin_amdgcn_mfma_f32_16x16x32_bf16(Bt[n][k], At[m][k], acc[ai][bj][m][n], 0, 0, 0); __builtin_amdgcn_s_setprio(0); } while (0)
#define PG8_WAIT_V(n) asm volatile("s_waitcnt vmcnt(" #n ")" ::: "memory")
#define PG8_WAIT_L(n) asm volatile("s_waitcnt lgkmcnt(" #n ")" ::: "memory")
#define PG8_BAR __builtin_amdgcn_s_barrier()
#define PG8_SCHED __builtin_amdgcn_sched_barrier(0)
    Unit cur, nxt; int ui = 0;
    if (!S.next(0, cur)) return;
    f32x4 acc[2][2][4][2];
#pragma unroll
    for (int a = 0; a < 2; ++a)
#pragma unroll
        for (int b = 0; b < 2; ++b)
#pragma unroll
            for (int m = 0; m < 4; ++m)
#pragma unroll
                for (int n = 0; n < 2; ++n) acc[a][b][m][n] = (f32x4){0.f, 0.f, 0.f, 0.f};
    bf16x8 At[4][2], B0[2][2], B1[2][2];
    const char* cA = (const char*)g.A + (size_t)cur.pm * tstep; const char* cB = (const char*)g.Bt + (size_t)cur.pn * tstep;
    S.a_ready(cur);
    if constexpr (SP2) {
        PG8_STAGE(PG8_SB(0, 0), cB, voffB); PG8_STAGE(PG8_SB(0, 1), cB + hstep, voffB); PG8_STAGE(PG8_SA(0, 0), cA, voffA); PG8_STAGE(PG8_SA(0, 1), cA + hstep, voffA);
        if (wr == 1) PG8_BAR;
        PG8_WAIT_V(2); PG8_BAR;
        PG8_STAGE(PG8_SB(1, 0), cB + kstep, voffB); PG8_STAGE(PG8_SA(1, 0), cA + kstep, voffA); PG8_STAGE(PG8_SB(1, 1), cB + hstep + kstep, voffB);
        PG8_WAIT_V(6); PG8_BAR;
    } else {
        PG8_STAGE(PG8_SB(0, 0), cB, voffB); PG8_STAGE(PG8_SA(0, 0), cA, voffA); PG8_STAGE(PG8_SB(0, 1), cB + hstep, voffB); PG8_STAGE(PG8_SA(0, 1), cA + hstep, voffA);
        if (wr == 1) PG8_BAR;
        PG8_WAIT_V(4); PG8_BAR;
        PG8_STAGE(PG8_SB(1, 0), cB + kstep, voffB); PG8_STAGE(PG8_SA(1, 0), cA + kstep, voffA); PG8_STAGE(PG8_SB(1, 1), cB + hstep + kstep, voffB);
        PG8_WAIT_V(6); PG8_BAR;
    }
    for (;;) {
        const bool has_next = S.next(ui + 1, nxt);
        const char* nA = has_next ? (const char*)g.A + (size_t)nxt.pm * tstep : cA; const char* nB = has_next ? (const char*)g.Bt + (size_t)nxt.pn * tstep : cB;
        for (int t = 0; t < nt; t += 2) {
            const bool last = (t == nt - 2);
            const char* a1 = cA + (size_t)(t + 1) * kstep;
            const char* a2 = last ? nA : cA + (size_t)(t + 2) * kstep; const char* b2 = last ? nB : cB + (size_t)(t + 2) * kstep;
            const char* a3 = a2 + kstep; const char* b3 = b2 + kstep;
            if (last && has_next) S.a_ready(nxt);
            if constexpr (SP2) {
            PG8_LDB(B0, 0, 0); PG8_LDB(B1, 0, 1); PG8_SCHED; PG8_LDA(At, 0, 0); PG8_STAGE(PG8_SA(1, 1), a1 + hstep, voffA);
            PG8_WAIT_V(8); PG8_WAIT_L(0); PG8_BAR; PG8_MMA(0, 0, At, B0); PG8_MMA(0, 1, At, B1); PG8_BAR; PG8_SCHED;
            PG8_LDA(At, 0, 1); PG8_STAGE(PG8_SB(0, 0), b2, voffB); PG8_STAGE(PG8_SB(0, 1), b2 + hstep, voffB); PG8_STAGE(PG8_SA(0, 0), a2, voffA);
            PG8_WAIT_V(8); PG8_WAIT_L(0); PG8_BAR; PG8_MMA(1, 0, At, B0); PG8_MMA(1, 1, At, B1); PG8_BAR; PG8_SCHED;
            PG8_LDB(B0, 1, 0); PG8_LDB(B1, 1, 1); PG8_SCHED; PG8_LDA(At, 1, 0); PG8_STAGE(PG8_SA(0, 1), a2 + hstep, voffA);
            PG8_WAIT_V(8); PG8_WAIT_L(0); PG8_BAR; PG8_MMA(0, 0, At, B0); PG8_MMA(0, 1, At, B1); PG8_BAR; PG8_SCHED;
            PG8_LDA(At, 1, 1); PG8_STAGE(PG8_SB(1, 0), b3, voffB); PG8_STAGE(PG8_SB(1, 1), b3 + hstep, voffB); PG8_STAGE(PG8_SA(1, 0), a3, voffA);
            PG8_WAIT_V(8); PG8_WAIT_L(0); PG8_BAR; PG8_MMA(1, 0, At, B0); PG8_MMA(1, 1, At, B1); PG8_BAR; PG8_SCHED;
            } else {
            PG8_LDB(B0, 0, 0); PG8_SCHED; PG8_LDA(At, 0, 0); PG8_STAGE(PG8_SA(1, 1), a1 + hstep, voffA);
            PG8_WAIT_L(8); PG8_BAR; PG8_WAIT_L(0); PG8_MMA(0, 0, At, B0); PG8_BAR; PG8_SCHED;
            PG8_LDB(B1, 0, 1); PG8_STAGE(PG8_SB(0, 0), b2, voffB);
            PG8_BAR; PG8_WAIT_L(0); PG8_MMA(0, 1, At, B1); PG8_BAR;
            PG8_LDA(At, 0, 1); PG8_STAGE(PG8_SA(0, 0), a2, voffA);
            PG8_BAR; PG8_WAIT_L(0); PG8_MMA(1, 0, At, B0); PG8_BAR; PG8_SCHED;
            PG8_STAGE(PG8_SB(0, 1), b2 + hstep, voffB);
            PG8_WAIT_V(6); PG8_BAR; PG8_MMA(1, 1, At, B1); PG8_BAR;
            PG8_LDB(B0, 1, 0); PG8_SCHED; PG8_LDA(At, 1, 0); PG8_STAGE(PG8_SA(0, 1), a2 + hstep, voffA);
            PG8_WAIT_L(8); PG8_BAR; PG8_WAIT_L(0); PG8_MMA(0, 0, At, B0); PG8_BAR; PG8_SCHED;
            PG8_LDB(B1, 1, 1); PG8_STAGE(PG8_SB(1, 0), b3, voffB);
            PG8_BAR; PG8_WAIT_L(0); PG8_MMA(0, 1, At, B1); PG8_BAR;
            PG8_LDA(At, 1, 1); PG8_STAGE(PG8_SA(1, 0), a3, voffA);
            PG8_BAR; PG8_WAIT_L(0); PG8_MMA(1, 0, At, B0); PG8_BAR; PG8_SCHED;
            PG8_STAGE(PG8_SB(1, 1), b3 + hstep, voffB);
            PG8_WAIT_V(6); PG8_BAR; PG8_MMA(1, 1, At, B1); PG8_BAR;
            }
        }
        if constexpr (ALIGN_EPI) { if (wr == 0) PG8_BAR; }
        if constexpr (!Epi::AFTER_DRAIN) { E(acc, cur, wr, wc, fr, fq); S.done(cur); }
        if (!has_next) break;
#pragma unroll
        for (int a = 0; a < 2; ++a)
#pragma unroll
            for (int b = 0; b < 2; ++b)
#pragma unroll
                for (int m = 0; m < 4; ++m)
#pragma unroll
                    for (int n = 0; n < 2; ++n) acc[a][b][m][n] = (f32x4){0.f, 0.f, 0.f, 0.f};
        cur = nxt; cA = nA; cB = nB; ++ui;
        if constexpr (ALIGN_EPI) { if (wr == 1) PG8_BAR; }
    }
    PG8_WAIT_V(0);
    if constexpr (!ALIGN_EPI) { if (wr == 0) PG8_BAR; }
    PG8_BAR;
    if constexpr (Epi::AFTER_DRAIN) { E.fused(acc, cur, wr, wc, fr, fq, lds, wid, lane); S.done(cur); }
#undef PG8_SA
#undef PG8_SB
#undef PG8_STAGE
#undef PG8_LDA
#undef PG8_LDB
#undef PG8_MMA
#undef PG8_WAIT_V
#undef PG8_WAIT_L
#undef PG8_BAR
#undef PG8_SCHED
}
}

#ifndef PG8_SP2
#define PG8_SP2 true
#endif
#ifndef PG8_ALIGN
#define PG8_ALIGN true
#endif
#ifndef MK_N_LAUNCHES
#define MK_N_LAUNCHES 1
#endif
constexpr int NWAVES = 8;
constexpr int NPHASES = 8;
constexpr int N_LAUNCHES = MK_N_LAUNCHES;

constexpr int NB = 32, SEQ = 2048, T = NB * SEQ, D = 1024, DIN = 3584;
constexpr int PC_C = 0, PC_H = 512, PC_B = 1024, PC_Q = 1536, PC_F = 2048, PC_V = 2560, PC_G = 3072;
constexpr int NEXP = 16384;
constexpr float EPS = 1e-6f;

constexpr size_t MiB = 1u << 20;
constexpr size_t WS_CTL = 0, CTL_ZERO_BYTES = 1 * MiB;
constexpr size_t WS_W1T = 2 * MiB, WS_WOT = 10 * MiB, WS_WQT = 12 * MiB, WS_RS1 = 16 * MiB, WS_SS2 = 17 * MiB;
constexpr size_t WS_KEYB = 18 * MiB;
constexpr size_t WS_U16 = 32 * MiB, WS_V16 = 64 * MiB, WS_EXP = 96 * MiB;
constexpr size_t WS_XB = 128 * MiB;
constexpr size_t WS_X1 = 256 * MiB;
constexpr size_t WS_PROJ = 384 * MiB;
constexpr size_t WS_F = 832 * MiB;
constexpr size_t WS_END = 960 * MiB;
constexpr int CW_BAR = 4096;

constexpr int RING_OFF = 0, RING_BYTES = 131072;
constexpr int LDSCTL_OFF = RING_BYTES, MISC_OFF = LDSCTL_OFF + 320;
constexpr int LDS_BYTES = 147456;

#define GAS __attribute__((address_space(1)))
#define LAS __attribute__((address_space(3)))
typedef unsigned short bf16;
typedef unsigned v4u __attribute__((ext_vector_type(4)));
typedef unsigned v2u __attribute__((ext_vector_type(2)));
typedef float f32x4 __attribute__((ext_vector_type(4)));
typedef float f32x2 __attribute__((ext_vector_type(2)));
typedef _Float16 h2_t __attribute__((ext_vector_type(2)));
typedef GAS unsigned gu32;
#define RLX_AGENT __ATOMIC_RELAXED, __HIP_MEMORY_SCOPE_AGENT
#define LDS_WAIT() asm volatile("s_waitcnt lgkmcnt(0)" ::: "memory")
#define VM_WAIT() asm volatile("s_waitcnt vmcnt(0)" ::: "memory")
__device__ __forceinline__ unsigned f2bf(float f) { unsigned u = __builtin_bit_cast(unsigned, f); return (u + 0x7fffu + ((u >> 16) & 1u)) >> 16; }
__device__ __forceinline__ unsigned pk2(float lo, float hi) { return f2bf(lo) | (f2bf(hi) << 16); }
__device__ __forceinline__ float bf_lo(unsigned w) { return __builtin_bit_cast(float, w << 16); }
__device__ __forceinline__ float bf_hi(unsigned w) { return __builtin_bit_cast(float, w & 0xffff0000u); }
__device__ __forceinline__ float bf1(bf16 v) { return __builtin_bit_cast(float, (unsigned)v << 16); }
__device__ __forceinline__ unsigned pkh2(float lo, float hi) { f32x2 v = {lo, hi}; h2_t h = __builtin_convertvector(v, h2_t); return __builtin_bit_cast(unsigned, h); }
__device__ __forceinline__ h2_t h2_of(unsigned w) { return __builtin_bit_cast(h2_t, w); }
__device__ __forceinline__ float wave_sum(float v) {
#pragma unroll
    for (int o = 1; o < 64; o <<= 1) v += __shfl_xor(v, o);
    return v;
}
typedef float f32x16 __attribute__((ext_vector_type(16)));
typedef __bf16 bf16x2_t __attribute__((ext_vector_type(2)));
__device__ __forceinline__ unsigned cvtpk(float lo, float hi) { f32x2 v = {lo, hi}; bf16x2_t b = __builtin_convertvector(v, bf16x2_t); return __builtin_bit_cast(unsigned, b); }
__device__ __forceinline__ pg8::bf16x8 pack8(const f32x16& x, int s) {
    v4u p; p.x = cvtpk(x[8 * s], x[8 * s + 1]); p.y = cvtpk(x[8 * s + 2], x[8 * s + 3]); p.z = cvtpk(x[8 * s + 4], x[8 * s + 5]); p.w = cvtpk(x[8 * s + 6], x[8 * s + 7]);
    return __builtin_bit_cast(pg8::bf16x8, p); }
__device__ __forceinline__ void ce_desc(unsigned& a, unsigned& b) { const unsigned mx = a > b ? a : b, mn = a > b ? b : a; a = mx; b = mn; }
__device__ __forceinline__ void sort16_desc(unsigned (&a)[16]) {
#pragma unroll
    for (int k = 2; k <= 16; k <<= 1)
#pragma unroll
        for (int j = k >> 1; j > 0; j >>= 1)
#pragma unroll
            for (int i = 0; i < 16; ++i) { const int l = i ^ j; if (l > i) { if ((i & k) == 0) ce_desc(a[i], a[l]); else ce_desc(a[l], a[i]); } }
}
__device__ __forceinline__ void merge16_desc(unsigned (&a)[16], const unsigned (&b)[16]) {
#pragma unroll
    for (int i = 0; i < 16; ++i) a[i] = a[i] > b[15 - i] ? a[i] : b[15 - i];
#pragma unroll
    for (int j = 8; j > 0; j >>= 1)
#pragma unroll
        for (int i = 0; i < 16; ++i) { const int l = i ^ j; if (l > i) ce_desc(a[i], a[l]); }
}
__device__ __forceinline__ float unkey(unsigned a) { a = (a & 0x80000000u) ? (a & 0x7FFFFFFFu) : ~a; return __builtin_bit_cast(float, a); }
__device__ __forceinline__ unsigned ckey(float s, int flat) { unsigned u = __builtin_bit_cast(unsigned, s); u ^= (unsigned)((int)u >> 31) | 0x80000000u; return (u & ~0xFFu) | (unsigned)(255 - flat); }
__device__ __forceinline__ void sort128_asc(unsigned& k0, unsigned& k1, int lane) {
#pragma unroll
    for (int k = 2; k <= 128; k <<= 1)
#pragma unroll
        for (int j = k >> 1; j > 0; j >>= 1) {
            if (j == 64) { const unsigned mn = k0 < k1 ? k0 : k1, mx = k0 < k1 ? k1 : k0; k0 = mn; k1 = mx; }
            else {
                const unsigned p0 = (unsigned)__shfl_xor((int)k0, j), p1 = (unsigned)__shfl_xor((int)k1, j);
                const bool lower = (lane & j) == 0;
                const bool up0 = (k == 128) ? true : (k == 64 ? true : ((lane & k) == 0));
                const bool up1 = (k == 128) ? true : (k == 64 ? false : ((lane & k) == 0));
                const unsigned mn0 = k0 < p0 ? k0 : p0, mx0 = k0 < p0 ? p0 : k0, mn1 = k1 < p1 ? k1 : p1, mx1 = k1 < p1 ? p1 : k1;
                k0 = (lower == up0) ? mn0 : mx0; k1 = (lower == up1) ? mn1 : mx1;
            }
        }
}
__device__ __forceinline__ float reduce16(const float (&p)[16], int lane) {
    float q[8], r[4], u[2];
    const bool b5 = (lane & 32) != 0, b4 = (lane & 16) != 0, b3 = (lane & 8) != 0, b2 = (lane & 4) != 0;
#pragma unroll
    for (int i = 0; i < 8; ++i) { const float keep = b5 ? p[2 * i + 1] : p[2 * i], send = b5 ? p[2 * i] : p[2 * i + 1]; q[i] = keep + __shfl_xor(send, 32); }
#pragma unroll
    for (int i = 0; i < 4; ++i) { const float keep = b4 ? q[2 * i + 1] : q[2 * i], send = b4 ? q[2 * i] : q[2 * i + 1]; r[i] = keep + __shfl_xor(send, 16); }
#pragma unroll
    for (int i = 0; i < 2; ++i) { const float keep = b3 ? r[2 * i + 1] : r[2 * i], send = b3 ? r[2 * i] : r[2 * i + 1]; u[i] = keep + __shfl_xor(send, 8); }
    const float keep = b2 ? u[1] : u[0], send = b2 ? u[0] : u[1];
    float v = keep + __shfl_xor(send, 4);
    v += __shfl_xor(v, 2); v += __shfl_xor(v, 1);
    return v;
}
__device__ __forceinline__ int swap23(int k) { return (k & ~12) | ((k & 4) << 1) | ((k & 8) >> 1); }
__device__ __forceinline__ float sigmoidf_(float x) { return 1.0f / (1.0f + __expf(-x)); }

#define XB_TMO      128
#define XB_XCNT(j)  (256  + 64 * (j))
#define XB_XSUB(j)  (1280 + 64 * (j))
#define XB_XGEN(j)  (2304 + 64 * (j))
#define XB_TOP      3328
#define XB_TOPGEN   3392
#define XCD_BAR_WORDS 3456
#define XB_SPIN_CAP (1u << 18)

__device__ __forceinline__ unsigned xb_ld(unsigned* p)              { return __hip_atomic_load(p, __ATOMIC_RELAXED, __HIP_MEMORY_SCOPE_AGENT); }
__device__ __forceinline__ unsigned xb_add(unsigned* p, unsigned v) { return __hip_atomic_fetch_add(p, v, __ATOMIC_RELAXED, __HIP_MEMORY_SCOPE_AGENT); }
__device__ __forceinline__ unsigned xb_xcc_id() { return (unsigned)__builtin_amdgcn_s_getreg((3 << 11) | 20) & 0xFu; }
#define XB_SPIN(cond, bar) do { unsigned _sp = 0; while (cond) { __builtin_amdgcn_s_sleep(1); \
    if ((++_sp & 255u) == 0u) { if (xb_ld(&(bar)[XB_TMO])) break; if (_sp > XB_SPIN_CAP) { atomicAdd(&(bar)[XB_TMO], 1u); break; } } } } while (0)

struct XcdBarrier {
    unsigned* bar; unsigned x;
    volatile LAS unsigned* st;
};

__device__ __forceinline__ XcdBarrier xcd_barrier_post(unsigned* bar, volatile LAS unsigned* st) {
    XcdBarrier b; b.bar = bar; b.x = xb_xcc_id(); b.st = st;
    if (threadIdx.x == 0) (void)xb_add(&bar[XB_XCNT(b.x)], 1u);
    return b;
}
__device__ __forceinline__ void xcd_barrier_complete(unsigned* bar, unsigned x, unsigned& nloc, unsigned& nx) {
    const unsigned G = gridDim.x * gridDim.y * gridDim.z;
    unsigned sum, cnt, mine, sp = 0u;
    for (;;) {
        sum = 0u; cnt = 0u; mine = 0u;
#pragma unroll
        for (unsigned j = 0; j < 16; ++j) { const unsigned c = xb_ld(&bar[XB_XCNT(j)]); sum += c; cnt += (c > 0u) ? 1u : 0u; mine = (j == x) ? c : mine; }
        if (sum == G) break;
        __builtin_amdgcn_s_sleep(1);
        if ((++sp & 255u) == 0u) { if (xb_ld(&bar[XB_TMO])) break; if (sp > XB_SPIN_CAP) { atomicAdd(&bar[XB_TMO], 1u); break; } }
    }
    nloc = mine > 0u ? mine : 1u; nx = cnt > 0u ? cnt : 1u;
}

__device__ __forceinline__ void xcd_barrier(const XcdBarrier& b) {
    asm volatile("s_waitcnt vmcnt(0)" ::: "memory");
    __syncthreads();
    if (threadIdx.x == 0) {
        unsigned* bar = b.bar;
        __builtin_amdgcn_s_waitcnt(0);
        unsigned nloc = b.st[0], nx = b.st[1];
        if (nloc == 0u) { xcd_barrier_complete(bar, b.x, nloc, nx); b.st[0] = nloc; b.st[1] = nx; }
        const unsigned old = xb_add(&bar[XB_XSUB(b.x)], 1u);
        const unsigned gen = old / nloc;
        if (old + 1u == (gen + 1u) * nloc) {
            __builtin_amdgcn_fence(__ATOMIC_RELEASE, "agent");
            asm volatile("s_waitcnt vmcnt(0)" ::: "memory");
            const unsigned og = xb_add(&bar[XB_TOP], 1u);
            const unsigned tg = og / nx;
            if (og + 1u == (tg + 1u) * nx) xb_add(&bar[XB_TOPGEN], 1u);
            else XB_SPIN(xb_ld(&bar[XB_TOPGEN]) == tg, bar);
            __builtin_amdgcn_fence(__ATOMIC_ACQUIRE, "agent");
            xb_add(&bar[XB_XGEN(b.x)], 1u);
            asm volatile("s_waitcnt vmcnt(0)" ::: "memory");
        } else {
            XB_SPIN(xb_ld(&bar[XB_XGEN(b.x)]) == gen, bar);
            __builtin_amdgcn_fence(__ATOMIC_ACQUIRE, "agent");
            asm volatile("s_waitcnt vmcnt(0)" ::: "memory");
        }
    }
    __syncthreads();
}


__device__ __forceinline__ void p0_transpose_item(const float* W, int K, int N, const float* gain, bf16* WT, LAS float* scr, int item, int lane) {
    const int nblk = N / 32, kb = item / nblk, nb = item % nblk, k0 = 64 * kb, n0 = 32 * nb;
#pragma unroll 8
    for (int i = 0; i < 32; ++i) { const int kk = 2 * i + (lane >> 5); const float g = gain ? gain[k0 + kk] : 1.0f; scr[kk * 33 + (lane & 31)] = W[(size_t)(k0 + kk) * N + n0 + (lane & 31)] * g; }
    LDS_WAIT(); asm volatile("" ::: "memory");
    const int c = lane & 7;
#pragma unroll
    for (int j = 0; j < 4; ++j) { const int n = (lane >> 3) + 8 * j; const LAS float* s = scr + (8 * c) * 33 + n;
        v4u o; o.x = pk2(s[0 * 33], s[1 * 33]); o.y = pk2(s[2 * 33], s[3 * 33]); o.z = pk2(s[4 * 33], s[5 * 33]); o.w = pk2(s[6 * 33], s[7 * 33]);
        *(GAS v4u*)(WT + (size_t)(n0 + n) * K + k0 + 8 * c) = o; }
    LDS_WAIT(); asm volatile("" ::: "memory");
}

struct Args { const float* in[14]; float* out; unsigned char* ws; int ph_lo, ph_hi, li, pad; };

__global__ void __launch_bounds__(NWAVES * 64, 2) hymba_fwd(Args args) {
    extern __shared__ __attribute__((aligned(16))) unsigned char lds_raw[];
    LAS unsigned char* lds = (LAS unsigned char*)lds_raw;
    volatile LAS unsigned* MISC = (volatile LAS unsigned*)(lds + MISC_OFF);
    const int tid = threadIdx.x, lane = tid & 63, wave = __builtin_amdgcn_readfirstlane(tid >> 6);
    const int G = gridDim.x;
    const int gw = (int)blockIdx.x * NWAVES + wave, NGW = G * NWAVES;
    unsigned char* ws = args.ws;
    gu32* ctl = (gu32*)(ws + WS_CTL);
    const float* x = args.in[0]; const float* norm_mix = args.in[1]; const float* w_in = args.in[2]; const float* conv_w = args.in[3]; const float* conv_gain = args.in[4];
    const float* hg_lb = args.in[5]; const float* hg_gain = args.in[6]; const float* w_out = args.in[7]; const float* norm_ffn = args.in[8]; const float* peer_wq = args.in[9];
    const float* peer_keys = args.in[10]; const float* peer_u = args.in[11]; const float* peer_v = args.in[12]; const float* norm_f = args.in[13];
    float* out = args.out;
    bf16* W1T = (bf16*)(ws + WS_W1T); bf16* WOT = (bf16*)(ws + WS_WOT); bf16* WQT = (bf16*)(ws + WS_WQT);
    float* RS1 = (float*)(ws + WS_RS1); float* SS2 = (float*)(ws + WS_SS2);
    unsigned short* U16 = (unsigned short*)(ws + WS_U16); unsigned short* V16 = (unsigned short*)(ws + WS_V16); unsigned* EXPT = (unsigned*)(ws + WS_EXP); bf16* KEYB = (bf16*)(ws + WS_KEYB);
    bf16* XB = (bf16*)(ws + WS_XB); bf16* MIX = (bf16*)(ws + WS_XB); bf16* X1 = (bf16*)(ws + WS_X1);
    bf16* PROJ = (bf16*)(ws + WS_PROJ); bf16* QB = (bf16*)(ws + WS_PROJ); float* DEC = (float*)(ws + WS_F); bf16* KDT = (bf16*)(ws + WS_X1); bf16* VTT = (bf16*)(ws + WS_X1 + 64 * MiB);

    for (int u = tid; u < (LDS_BYTES - LDSCTL_OFF) / 4; u += NWAVES * 64) ((LAS unsigned*)(lds + LDSCTL_OFF))[u] = 0u;
    __syncthreads();
    XcdBarrier bar; bar.bar = (unsigned*)(ctl + CW_BAR); bar.x = 0; bar.st = nullptr;
    if (N_LAUNCHES == 1) bar = xcd_barrier_post((unsigned*)(ctl + CW_BAR), MISC + 8);
#define GRID_BAR() do { if (N_LAUNCHES == 1) xcd_barrier(bar); } while (0)
    const int lo = args.ph_lo, hi = args.ph_hi;
#define IN(k) (lo <= (k) && (k) < hi)
#define BOTH(k) (IN(k) && IN((k) + 1))

    if (IN(0)) {
        LAS float* scr = (LAS float*)(lds + RING_OFF + wave * 16384);
        constexpr int I_1 = (D / 64) * (DIN / 32), I_O = (D / 64) * (D / 32), I_Q = (D / 64) * (2048 / 32);
        for (int it = gw; it < I_1 + I_O + I_Q; it += NGW) {
            int r = it;
            if (r < I_1) { p0_transpose_item(w_in, D, DIN, norm_mix, W1T, scr, r, lane); continue; } r -= I_1;
            if (r < I_O) { p0_transpose_item(w_out, D, D, nullptr, WOT, scr, r, lane); continue; } r -= I_O;
            p0_transpose_item(peer_wq, D, 2048, norm_ffn, WQT, scr, r, lane);
        }
        for (int m = gw; m < T; m += NGW) {
            const GAS f32x4* xr = (const GAS f32x4*)(x + (size_t)m * D) + lane; f32x4 v[4]; float s = 0.f;
#pragma unroll
            for (int j = 0; j < 4; ++j) { v[j] = xr[64 * j]; s += (v[j].x * v[j].x + v[j].y * v[j].y) + (v[j].z * v[j].z + v[j].w * v[j].w); }
            s = wave_sum(s);
            if (lane == 0) RS1[m] = 1.0f / sqrtf(s * (1.0f / D) + EPS);
            GAS unsigned long long* o8 = (GAS unsigned long long*)(XB + (size_t)m * D) + lane;
#pragma unroll
            for (int j = 0; j < 4; ++j) o8[64 * j] = (unsigned long long)pk2(v[j].x, v[j].y) | ((unsigned long long)pk2(v[j].z, v[j].w) << 32);
        }
        for (int r = gw; r < 2 * NEXP; r += NGW) {
            const int tb = r / NEXP, e = r % NEXP;
            const GAS f32x4* src = (const GAS f32x4*)((tb ? peer_v : peer_u) + (size_t)e * D) + lane;
            GAS v2u* dst = (GAS v2u*)((tb ? V16 : U16) + (size_t)e * D) + lane;
#pragma unroll
            for (int j = 0; j < 4; ++j) { f32x4 v = src[64 * j]; if (!tb) { const f32x4 g = ((const GAS f32x4*)norm_ffn)[64 * j + lane]; v = v * g; }
                v2u o; o.x = pkh2(v.x, v.y); o.y = pkh2(v.z, v.w); dst[64 * j] = o; }
        }
        for (int i = (int)blockIdx.x * NWAVES * 64 + tid; i < T; i += G * NWAVES * 64) SS2[i] = 0.f;
        for (int i = (int)blockIdx.x * NWAVES * 64 + tid; i < 8 * 2 * 128 * 128 / 2; i += G * NWAVES * 64) ((GAS unsigned*)KEYB)[i] = pk2(peer_keys[2 * i], peer_keys[2 * i + 1]);
        if (BOTH(0)) GRID_BAR();
    }

    if (IN(1)) {
        pg8::Gemm g{XB, W1T, T, DIN, D}; pg8::StaticOrder S; S.init(T, DIN, G, (int)blockIdx.x);
        pg8::EpiScaleBf16<0> E{PROJ, DIN, RS1};
        pg8::gemm_phase<pg8::EpiScaleBf16<0>, pg8::StaticOrder, PG8_ALIGN, PG8_SP2>(lds + RING_OFF, g, S, E);
        if (BOTH(1)) GRID_BAR();
    }

    if (IN(2)) {
        for (int item = gw; item < NB * 64 * 4; item += NGW) {
            const int h = item & 3, n = (item >> 2) & 63, b = item >> 8;
            const size_t tok0 = (size_t)b * SEQ + n * 32;
            const int c0 = h * 128 + 2 * lane, cs = h * 128 + swap23(2 * lane);
            const float lb0 = 1.0f / (1.0f + __expf(hg_lb[512 + c0] - hg_lb[c0])), lb1 = 1.0f / (1.0f + __expf(hg_lb[512 + c0 + 1] - hg_lb[c0 + 1]));
            unsigned qw[32], fw[32], vw[32];
#pragma unroll
            for (int c = 0; c < 32; ++c) { const bf16* pr = PROJ + (tok0 + c) * DIN;
                qw[c] = *(const GAS unsigned*)(pr + PC_Q + c0); fw[c] = *(const GAS unsigned*)(pr + PC_F + c0); vw[c] = *(const GAS unsigned*)(pr + PC_V + c0); }
            float eG0 = 1.f, eG1 = 1.f;
            unsigned kd0[16], kd1[16], vv0[16], vv1[16];
#pragma unroll
            for (int i = 0; i < 16; ++i) { kd0[i] = 0u; kd1[i] = 0u; vv0[i] = 0u; vv1[i] = 0u; }
#pragma unroll
            for (int c = 0; c < 32; ++c) { bf16* pr = PROJ + (tok0 + c) * DIN;
                const float f0 = lb0 + (1.0f - lb0) * sigmoidf_(bf_lo(fw[c])), f1 = lb1 + (1.0f - lb1) * sigmoidf_(bf_hi(fw[c]));
                eG0 *= f0; eG1 *= f1;
                const float q0 = bf_lo(qw[c]), q1 = bf_hi(qw[c]);
                const float qd0 = q0 * sigmoidf_(q0) * 0.08838834764831845f * eG0, qd1 = q1 * sigmoidf_(q1) * 0.08838834764831845f * eG1;
                const float kv0 = (1.0f - f0) / eG0, kv1 = (1.0f - f1) / eG1;
                *(GAS unsigned*)(pr + PC_Q + cs) = pk2(qd0, qd1);
                const unsigned kp = pk2(kv0, kv1);
                *(GAS unsigned*)(pr + PC_F + cs) = kp;
                const int pp = swap23(c), sh = 16 * (pp & 1);
                kd0[pp >> 1] |= (kp & 0xffffu) << sh; kd1[pp >> 1] |= (kp >> 16) << sh;
                vv0[pp >> 1] |= (vw[c] & 0xffffu) << sh; vv1[pp >> 1] |= (vw[c] >> 16) << sh; }
            GAS v4u* kt = (GAS v4u*)(KDT + ((size_t)item * 128 + 2 * lane) * 32);
            GAS v4u* vt = (GAS v4u*)(VTT + ((size_t)item * 128 + 2 * lane) * 32);
#pragma unroll
            for (int i = 0; i < 4; ++i) { kt[i] = (v4u){kd0[4 * i], kd0[4 * i + 1], kd0[4 * i + 2], kd0[4 * i + 3]}; kt[4 + i] = (v4u){kd1[4 * i], kd1[4 * i + 1], kd1[4 * i + 2], kd1[4 * i + 3]};
                vt[i] = (v4u){vv0[4 * i], vv0[4 * i + 1], vv0[4 * i + 2], vv0[4 * i + 3]}; vt[4 + i] = (v4u){vv1[4 * i], vv1[4 * i + 1], vv1[4 * i + 2], vv1[4 * i + 3]}; }
            *(GAS f32x2*)(DEC + (size_t)item * 128 + 2 * lane) = (f32x2){eG0, eG1};
        }
        for (int item = gw; item < NB * 8 * 32; item += NGW) {
            const int seg = item & 31, grp = (item >> 5) & 7, b = item >> 8, c = grp * 64 + lane, t0 = seg * 64;
            const float w0 = conv_w[c], w1 = conv_w[512 + c], w2 = conv_w[1024 + c], gn = conv_gain[c];
            float u1 = 0.f, u2 = 0.f;
            if (t0 > 0) { const bf16* p2 = PROJ + (size_t)(b * SEQ + t0 - 2) * DIN; const bf16* p1 = p2 + DIN;
                u2 = bf1(p2[PC_C + c]) * bf1(p2[PC_H + c]); u1 = bf1(p1[PC_C + c]) * bf1(p1[PC_H + c]); }
            for (int t = t0; t < t0 + 64; ++t) { const size_t tok = (size_t)b * SEQ + t; const bf16* pr = PROJ + tok * DIN;
                const float u = bf1(pr[PC_C + c]) * bf1(pr[PC_H + c]); const float y = bf1(pr[PC_B + c]) * (w0 * u2 + w1 * u1 + w2 * u);
                const float ss = wave_sum(y * y); const float r = 1.0f / sqrtf(ss * (1.0f / 64.0f) + EPS);
                MIX[tok * D + c] = (bf16)f2bf(y * r * gn); u2 = u1; u1 = u; }
        }
        if (BOTH(2)) GRID_BAR();
    }

    if (IN(3)) {
        constexpr int BUFB = 33792, OB0 = 2 * BUFB;
        for (int it = (int)blockIdx.x; it < NB * 4; it += G) {
            const int b = it >> 2, h = it & 3;
            const int lt = tid & 255, r = lane & 31, hh = lane >> 5, sl = wave;
            v4u st[9];
#define SCAN_LOAD(n_) do { const size_t tk0 = (size_t)b * SEQ + (n_) * 32; const size_t itm = (size_t)((b * 64 + (n_)) * 4 + h); \
                _Pragma("unroll") for (int i = 0; i < 2; ++i) { const int q = lt + 256 * i, row = q >> 4, cc = q & 15; const bf16* pr = PROJ + (tk0 + row) * DIN + h * 128 + cc * 8; \
                    st[i] = *(const GAS v4u*)(pr + PC_Q); st[2 + i] = *(const GAS v4u*)(pr + PC_F); \
                    st[4 + i] = ((const GAS v4u*)(KDT + itm * 4096))[q]; st[6 + i] = ((const GAS v4u*)(VTT + itm * 4096))[q]; } \
                if (lt < 32) st[8] = ((const GAS v4u*)(DEC + itm * 128))[lt]; } while (0)
#define SCAN_COMMIT(n_) do { LAS unsigned char* Bf = lds + RING_OFF + ((n_) & 1) * BUFB; \
                _Pragma("unroll") for (int i = 0; i < 2; ++i) { const int q = lt + 256 * i, row = q >> 4, cc = q & 15, k = q >> 2, c4 = q & 3; \
                    *(LAS v4u*)(Bf + row * 256 + ((cc ^ (row & 15)) * 16)) = st[i]; *(LAS v4u*)(Bf + 8192 + row * 256 + ((cc ^ (row & 15)) * 16)) = st[2 + i]; \
                    *(LAS v4u*)(Bf + 16384 + k * 64 + ((c4 ^ ((k >> 2) & 3)) * 16)) = st[4 + i]; *(LAS v4u*)(Bf + 24576 + k * 64 + ((c4 ^ ((k >> 2) & 3)) * 16)) = st[6 + i]; } \
                if (lt < 32) *(LAS v4u*)(Bf + 32768 + lt * 16) = st[8]; } while (0)
#define SCAN_POST(n_) do { const int pos = lt >> 3, vg = lt & 7; const LAS f32x4* ob = (const LAS f32x4*)(lds + RING_OFF + OB0 + ((n_) & 1) * 16384 + (pos * 128 + vg * 16) * 4); \
                const f32x4 o0 = ob[0], o1 = ob[1], o2 = ob[2], o3 = ob[3]; \
                float ss = (o0.x * o0.x + o0.y * o0.y) + (o0.z * o0.z + o0.w * o0.w) + (o1.x * o1.x + o1.y * o1.y) + (o1.z * o1.z + o1.w * o1.w) \
                         + (o2.x * o2.x + o2.y * o2.y) + (o2.z * o2.z + o2.w * o2.w) + (o3.x * o3.x + o3.y * o3.y) + (o3.z * o3.z + o3.w * o3.w); \
                ss += __shfl_xor(ss, 1); ss += __shfl_xor(ss, 2); ss += __shfl_xor(ss, 4); \
                const float rr = 1.0f / sqrtf(ss * (1.0f / 128.0f) + EPS); \
                const size_t tk = (size_t)b * SEQ + (n_) * 32 + pos; const GAS v4u* gp = (const GAS v4u*)(PROJ + tk * DIN + PC_G + h * 128 + vg * 16); const v4u g0 = gp[0], g1 = gp[1]; \
                const float ov[16] = {o0.x, o0.y, o0.z, o0.w, o1.x, o1.y, o1.z, o1.w, o2.x, o2.y, o2.z, o2.w, o3.x, o3.y, o3.z, o3.w}; \
                const float gf[16] = {bf_lo(g0.x), bf_hi(g0.x), bf_lo(g0.y), bf_hi(g0.y), bf_lo(g0.z), bf_hi(g0.z), bf_lo(g0.w), bf_hi(g0.w), bf_lo(g1.x), bf_hi(g1.x), bf_lo(g1.y), bf_hi(g1.y), bf_lo(g1.z), bf_hi(g1.z), bf_lo(g1.w), bf_hi(g1.w)}; \
                float yv[16]; _Pragma("unroll") for (int i = 0; i < 16; ++i) yv[i] = ov[i] * rr * hg_gain[vg * 16 + i] * (gf[i] * sigmoidf_(gf[i])); \
                GAS v4u* mp = (GAS v4u*)(MIX + tk * D + 512 + h * 128 + vg * 16); \
                mp[0] = (v4u){pk2(yv[0], yv[1]), pk2(yv[2], yv[3]), pk2(yv[4], yv[5]), pk2(yv[6], yv[7])}; mp[1] = (v4u){pk2(yv[8], yv[9]), pk2(yv[10], yv[11]), pk2(yv[12], yv[13]), pk2(yv[14], yv[15])}; } while (0)
#define SCAN_BAR() do { asm volatile("s_waitcnt lgkmcnt(0)" ::: "memory"); __builtin_amdgcn_s_barrier(); asm volatile("" ::: "memory"); } while (0)
            if (wave >= 4) {
                SCAN_LOAD(0); SCAN_COMMIT(0);
                SCAN_BAR();
                for (int n = 0; n < 64; ++n) {
                    if (n + 1 < 64) SCAN_LOAD(n + 1);
                    if (n >= 1) SCAN_POST(n - 1);
                    if (n + 1 < 64) SCAN_COMMIT(n + 1);
                    SCAN_BAR();
                }
                SCAN_POST(63);
                SCAN_BAR();
            } else {
                f32x16 S0, S1, S2, S3;
#pragma unroll
                for (int i = 0; i < 16; ++i) { S0[i] = 0.f; S1[i] = 0.f; S2[i] = 0.f; S3[i] = 0.f; }
                SCAN_BAR();
                for (int n = 0; n < 64; ++n) {
                    const LAS unsigned char* Bf = lds + RING_OFF + (n & 1) * BUFB;
                    pg8::bf16x8 qd[8], kd[8], vt[2];
#pragma unroll
                    for (int ks = 0; ks < 8; ++ks) { const int off = r * 256 + (((2 * ks + hh) ^ (r & 15)) * 16); qd[ks] = *(const LAS pg8::bf16x8*)(Bf + off); kd[ks] = *(const LAS pg8::bf16x8*)(Bf + 8192 + off); }
#pragma unroll
                    for (int sp = 0; sp < 2; ++sp) { const int row = 32 * sl + r; vt[sp] = *(const LAS pg8::bf16x8*)(Bf + 24576 + row * 64 + (((2 * sp + hh) ^ ((row >> 2) & 3)) * 16)); }
                    f32x16 X, O;
#pragma unroll
                    for (int i = 0; i < 16; ++i) { X[i] = 0.f; O[i] = 0.f; }
#pragma unroll
                    for (int ks = 0; ks < 8; ++ks) X = __builtin_amdgcn_mfma_f32_32x32x16_bf16(kd[ks], qd[ks], X, 0, 0, 0);
                    O = __builtin_amdgcn_mfma_f32_32x32x16_bf16(qd[0], pack8(S0, 0), O, 0, 0, 0); O = __builtin_amdgcn_mfma_f32_32x32x16_bf16(qd[1], pack8(S0, 1), O, 0, 0, 0);
                    O = __builtin_amdgcn_mfma_f32_32x32x16_bf16(qd[2], pack8(S1, 0), O, 0, 0, 0); O = __builtin_amdgcn_mfma_f32_32x32x16_bf16(qd[3], pack8(S1, 1), O, 0, 0, 0);
                    O = __builtin_amdgcn_mfma_f32_32x32x16_bf16(qd[4], pack8(S2, 0), O, 0, 0, 0); O = __builtin_amdgcn_mfma_f32_32x32x16_bf16(qd[5], pack8(S2, 1), O, 0, 0, 0);
                    O = __builtin_amdgcn_mfma_f32_32x32x16_bf16(qd[6], pack8(S3, 0), O, 0, 0, 0); O = __builtin_amdgcn_mfma_f32_32x32x16_bf16(qd[7], pack8(S3, 1), O, 0, 0, 0);
#pragma unroll
                    for (int i = 0; i < 16; ++i) { const int s_ = (i & 3) + 8 * (i >> 2) + 4 * hh; X[i] = (s_ <= r) ? X[i] : 0.f; }
                    O = __builtin_amdgcn_mfma_f32_32x32x16_bf16(pack8(X, 0), vt[0], O, 0, 0, 0); O = __builtin_amdgcn_mfma_f32_32x32x16_bf16(pack8(X, 1), vt[1], O, 0, 0, 0);
#define SCAN_SUPD(Sx, rt_) do { _Pragma("unroll") for (int sp = 0; sp < 2; ++sp) { const int row = 32 * (rt_) + r; \
                            const pg8::bf16x8 kt = *(const LAS pg8::bf16x8*)(Bf + 16384 + row * 64 + (((2 * sp + hh) ^ ((row >> 2) & 3)) * 16)); \
                            Sx = __builtin_amdgcn_mfma_f32_32x32x16_bf16(kt, vt[sp], Sx, 0, 0, 0); } \
                        _Pragma("unroll") for (int g = 0; g < 4; ++g) { const f32x4 dv = *(const LAS f32x4*)(Bf + 32768 + (32 * (rt_) + 8 * g + 4 * hh) * 4); \
                            Sx[4 * g] *= dv.x; Sx[4 * g + 1] *= dv.y; Sx[4 * g + 2] *= dv.z; Sx[4 * g + 3] *= dv.w; } } while (0)
                    SCAN_SUPD(S0, 0); SCAN_SUPD(S1, 1); SCAN_SUPD(S2, 2); SCAN_SUPD(S3, 3);
                    LAS float* ob = (LAS float*)(lds + RING_OFF + OB0 + (n & 1) * 16384);
#pragma unroll
                    for (int i = 0; i < 16; ++i) ob[((i & 3) + 8 * (i >> 2) + 4 * hh) * 128 + 32 * sl + r] = O[i];
                    SCAN_BAR();
                }
                SCAN_BAR();
            }
        }
        if (BOTH(3)) GRID_BAR();
    }


    if (IN(4)) {
        pg8::Gemm g{MIX, WOT, T, D, D}; pg8::StaticOrder S; S.init(T, D, G, (int)blockIdx.x);
        pg8::EpiResid E{x, X1, SS2};
        pg8::gemm_phase<pg8::EpiResid, pg8::StaticOrder, PG8_ALIGN, PG8_SP2>(lds + RING_OFF, g, S, E);
        if (BOTH(4)) GRID_BAR();
    }

    if (IN(5)) {
        pg8::Gemm g{X1, WQT, T, 2048, D}; pg8::StaticOrder S; S.init(T, 2048, G, (int)blockIdx.x);
        pg8::EpiScaleBf16<1> E{QB, 2048, SS2};
        pg8::gemm_phase<pg8::EpiScaleBf16<1>, pg8::StaticOrder, PG8_ALIGN, PG8_SP2>(lds + RING_OFF, g, S, E);
        if (BOTH(5)) GRID_BAR();
    }

    if (IN(6)) {
        const int r = lane & 31, hh = lane >> 5;
        for (int item = gw; item < (T / 32) * 8; item += NGW) {
            const int h = item & 7, tok = (item >> 3) * 32 + r;
            unsigned L[2][16];
#pragma unroll
            for (int p = 0; p < 2; ++p) {
                pg8::bf16x8 qf[8];
                const GAS pg8::bf16x8* qp = (const GAS pg8::bf16x8*)(QB + (size_t)tok * 2048 + h * 256 + p * 128 + 8 * hh);
#pragma unroll
                for (int ks = 0; ks < 8; ++ks) qf[ks] = qp[2 * ks];
                const GAS pg8::bf16x8* kp = (const GAS pg8::bf16x8*)(KEYB + (size_t)((h * 2 + p) * 128 + r) * 128 + 8 * hh);
                unsigned best[16];
#pragma unroll
                for (int nt = 0; nt < 4; ++nt) {
                    f32x16 acc;
#pragma unroll
                    for (int i = 0; i < 16; ++i) acc[i] = 0.f;
                    const GAS pg8::bf16x8* kb = kp + nt * 512; asm volatile("" : "+v"(kb));
#pragma unroll
                    for (int ks = 0; ks < 8; ++ks) acc = __builtin_amdgcn_mfma_f32_32x32x16_bf16(kb[2 * ks], qf[ks], acc, 0, 0, 0);
                    unsigned cur[16];
#pragma unroll
                    for (int i = 0; i < 16; ++i) { const int n = 32 * nt + (i & 3) + 8 * (i >> 2) + 4 * hh;
                        const float av = acc[i]; unsigned u = __builtin_bit_cast(unsigned, av); u ^= (unsigned)((int)u >> 31) | 0x80000000u;
                        cur[i] = (u & ~0x7Fu) | (unsigned)(127 - n); }
                    sort16_desc(cur);
                    if (nt == 0) {
#pragma unroll
                        for (int i = 0; i < 16; ++i) best[i] = cur[i];
                    } else merge16_desc(best, cur);
                }
                unsigned o[16];
#pragma unroll
                for (int i = 0; i < 16; ++i) o[i] = (unsigned)__shfl_xor((int)best[i], 32);
                merge16_desc(best, o);
#pragma unroll
                for (int i = 0; i < 16; ++i) L[p][i] = best[i];
            }
            float v1[16], v2[16];
#pragma unroll
            for (int j = 0; j < 16; ++j) { v1[j] = unkey(L[0][j] & ~0x7Fu); v2[j] = unkey(L[1][j] & ~0x7Fu); }
            unsigned ct[16];
#pragma unroll
            for (int j = 0; j < 16; ++j) ct[j] = ckey(v1[0] + v2[j], j);
#pragma unroll
            for (int i = 1; i < 16; ++i)
#pragma unroll
                for (int j = 0; j < 16; ++j) if ((i + 1) * (j + 1) <= 16) {
                    unsigned key = ckey(v1[i] + v2[j], i * 16 + j);
#pragma unroll
                    for (int t = 0; t < 16; ++t) { const unsigned mx = ct[t] > key ? ct[t] : key; key = ct[t] > key ? key : ct[t]; ct[t] = mx; }
                }
            float den = 0.f, ex[16]; const float cmax = unkey(ct[0] & ~0xFFu);
#pragma unroll
            for (int t = 0; t < 16; ++t) { ex[t] = __expf(unkey(ct[t] & ~0xFFu) - cmax); den += ex[t]; }
            const float inv = 1.0f / den;
            unsigned b1[4], b2[4];
#pragma unroll
            for (int w = 0; w < 4; ++w) { b1[w] = (L[0][4 * w] & 0x7Fu) | ((L[0][4 * w + 1] & 0x7Fu) << 8) | ((L[0][4 * w + 2] & 0x7Fu) << 16) | ((L[0][4 * w + 3] & 0x7Fu) << 24);
                b2[w] = (L[1][4 * w] & 0x7Fu) | ((L[1][4 * w + 1] & 0x7Fu) << 8) | ((L[1][4 * w + 2] & 0x7Fu) << 16) | ((L[1][4 * w + 3] & 0x7Fu) << 24); }
            unsigned ent[8];
#pragma unroll
            for (int t = 0; t < 8; ++t) { const unsigned hm = 0u - (unsigned)hh;
                const unsigned ck = ct[t] ^ ((ct[t] ^ ct[8 + t]) & hm); const unsigned e0 = __builtin_bit_cast(unsigned, ex[t]), e1 = __builtin_bit_cast(unsigned, ex[8 + t]);
                const float gt = __builtin_bit_cast(float, e0 ^ ((e0 ^ e1) & hm)) * inv;
                const unsigned flat = 255u - (ck & 0xFFu), ii = flat >> 4, jj = flat & 15u;
                const unsigned w1 = (ii & 8u) ? ((ii & 4u) ? b1[3] : b1[2]) : ((ii & 4u) ? b1[1] : b1[0]), w2 = (jj & 8u) ? ((jj & 4u) ? b2[3] : b2[2]) : ((jj & 4u) ? b2[1] : b2[0]);
                const unsigned n1 = 127u - ((w1 >> (8u * (ii & 3u))) & 0x7Fu), n2 = 127u - ((w2 >> (8u * (jj & 3u))) & 0x7Fu);
                ent[t] = (n1 * 128u + n2) | (pkh2(gt, 0.f) << 16); }
            GAS v4u* ep = (GAS v4u*)(EXPT + (size_t)tok * 128 + h * 16 + 8 * hh);
            ep[0] = (v4u){ent[0], ent[1], ent[2], ent[3]}; ep[1] = (v4u){ent[4], ent[5], ent[6], ent[7]};
        }
        if (BOTH(6)) GRID_BAR();
    }


    if (IN(7)) {
        constexpr int NT = 4;
        const unsigned srcl = (unsigned)(32 * (lane & 1) + 16 * ((lane >> 1) & 1)) << 2;
        for (int bt = gw; bt < T / NT; bt += NGW) {
            const int tok0 = bt * NT;
            unsigned e[NT][2]; float rs2[NT];
#pragma unroll
            for (int t = 0; t < NT; ++t) { const unsigned r0 = EXPT[(size_t)(tok0 + t) * 128 + lane], r1 = EXPT[(size_t)(tok0 + t) * 128 + 64 + lane];
                e[t][0] = (r0 << 16) | (r0 >> 16); e[t][1] = (r1 << 16) | (r1 >> 16); sort128_asc(e[t][0], e[t][1], lane);
                rs2[t] = 1.0f / sqrtf(SS2[tok0 + t] * (1.0f / D) + EPS); }
            float ah[2][NT][2];
#pragma unroll
            for (int hf = 0; hf < 2; ++hf) {
                h2_t hx[NT][4];
#pragma unroll
                for (int t = 0; t < NT; ++t) { const v4u xa = __builtin_nontemporal_load((const GAS v4u*)(X1 + (size_t)(tok0 + t) * D + hf * 512) + lane);
                    hx[t][0] = h2_of(pkh2(bf_lo(xa.x), bf_hi(xa.x))); hx[t][1] = h2_of(pkh2(bf_lo(xa.y), bf_hi(xa.y))); hx[t][2] = h2_of(pkh2(bf_lo(xa.z), bf_hi(xa.z))); hx[t][3] = h2_of(pkh2(bf_lo(xa.w), bf_hi(xa.w)));
                    ah[hf][t][0] = 0.f; ah[hf][t][1] = 0.f; }
#pragma unroll
                for (int sh = 0; sh < 2; ++sh)
                    for (int s = 0; s < 16; ++s) {
                        v4u ub[NT][4];
#pragma unroll
                        for (int t = 0; t < NT; ++t)
#pragma unroll
                            for (int q = 0; q < 4; ++q) { const unsigned id = (unsigned)__builtin_amdgcn_readlane((int)e[t][sh], 4 * s + q) >> 16;
                                ub[t][q] = ((const GAS v4u*)(U16 + (size_t)id * D + hf * 512))[lane]; }
                        float p[16];
#pragma unroll
                        for (int t = 0; t < NT; ++t)
#pragma unroll
                            for (int q = 0; q < 4; ++q) { float d = __builtin_amdgcn_fdot2(h2_of(ub[t][q].x), hx[t][0], 0.f, false); d = __builtin_amdgcn_fdot2(h2_of(ub[t][q].y), hx[t][1], d, false);
                                d = __builtin_amdgcn_fdot2(h2_of(ub[t][q].z), hx[t][2], d, false); p[4 * t + q] = __builtin_amdgcn_fdot2(h2_of(ub[t][q].w), hx[t][3], d, false); }
                        const float red = reduce16(p, lane);
#pragma unroll
                        for (int t = 0; t < NT; ++t) { const float got = __builtin_bit_cast(float, __builtin_amdgcn_ds_bpermute((int)(srcl + (unsigned)((8 * (t & 1) + 4 * (t >> 1)) << 2)), __builtin_bit_cast(int, red)));
                            ah[hf][t][sh] = ((lane >> 2) == s) ? got : ah[hf][t][sh]; }
                    }
            }
            float wv[NT][2];
#pragma unroll
            for (int t = 0; t < NT; ++t)
#pragma unroll
                for (int g = 0; g < 2; ++g) { const float a = (ah[0][t][g] + ah[1][t][g]) * rs2[t]; const float gate = (float)h2_of(e[t][g] & 0xFFFFu).x;
                    wv[t][g] = gate * 0.5f * a * (1.0f + erff(a * 0.7071067811865476f)); }
            float y[NT][16];
#pragma unroll
            for (int t = 0; t < NT; ++t)
#pragma unroll
                for (int i = 0; i < 16; ++i) y[t][i] = 0.f;
#pragma unroll
            for (int hf = 0; hf < 2; ++hf)
#pragma unroll
                for (int sh = 0; sh < 2; ++sh)
                    for (int s = 0; s < 16; ++s) {
                        v4u vb[NT][4];
#pragma unroll
                        for (int t = 0; t < NT; ++t)
#pragma unroll
                            for (int q = 0; q < 4; ++q) { const unsigned id = (unsigned)__builtin_amdgcn_readlane((int)e[t][sh], 4 * s + q) >> 16;
                                vb[t][q] = ((const GAS v4u*)(V16 + (size_t)id * D + hf * 512))[lane]; }
#pragma unroll
                        for (int t = 0; t < NT; ++t)
#pragma unroll
                            for (int q = 0; q < 4; ++q) { const float wi = __builtin_bit_cast(float, __builtin_amdgcn_readlane(__builtin_bit_cast(int, wv[t][sh]), 4 * s + q));
                                const unsigned vw[4] = {vb[t][q].x, vb[t][q].y, vb[t][q].z, vb[t][q].w};
#pragma unroll
                                for (int j = 0; j < 4; ++j) { const h2_t hv = h2_of(vw[j]); y[t][hf * 8 + 2 * j] = fmaf((float)hv.x, wi, y[t][hf * 8 + 2 * j]); y[t][hf * 8 + 2 * j + 1] = fmaf((float)hv.y, wi, y[t][hf * 8 + 2 * j + 1]); } }
                    }
#pragma unroll
            for (int t = 0; t < NT; ++t) { const size_t tok = (size_t)(tok0 + t);
                const GAS v4u* xr = (const GAS v4u*)(X1 + tok * D); const v4u xa = __builtin_nontemporal_load(xr + lane), xb = __builtin_nontemporal_load(xr + 64 + lane);
                const float xf[16] = {bf_lo(xa.x), bf_hi(xa.x), bf_lo(xa.y), bf_hi(xa.y), bf_lo(xa.z), bf_hi(xa.z), bf_lo(xa.w), bf_hi(xa.w),
                                      bf_lo(xb.x), bf_hi(xb.x), bf_lo(xb.y), bf_hi(xb.y), bf_lo(xb.z), bf_hi(xb.z), bf_lo(xb.w), bf_hi(xb.w)};
                float ss = 0.f;
#pragma unroll
                for (int i = 0; i < 16; ++i) { y[t][i] += xf[i]; ss += y[t][i] * y[t][i]; }
                ss = wave_sum(ss);
                const float r = 1.0f / sqrtf(ss * (1.0f / D) + EPS);
                const GAS f32x4* nfp = (const GAS f32x4*)norm_f; const f32x4 n0 = nfp[2 * lane], n1 = nfp[2 * lane + 1], n2 = nfp[128 + 2 * lane], n3 = nfp[128 + 2 * lane + 1];
                GAS f32x4* op = (GAS f32x4*)(out + tok * D);
                __builtin_nontemporal_store((f32x4){y[t][0] * r * n0.x, y[t][1] * r * n0.y, y[t][2] * r * n0.z, y[t][3] * r * n0.w}, op + 2 * lane);
                __builtin_nontemporal_store((f32x4){y[t][4] * r * n1.x, y[t][5] * r * n1.y, y[t][6] * r * n1.z, y[t][7] * r * n1.w}, op + 2 * lane + 1);
                __builtin_nontemporal_store((f32x4){y[t][8] * r * n2.x, y[t][9] * r * n2.y, y[t][10] * r * n2.z, y[t][11] * r * n2.w}, op + 128 + 2 * lane);
                __builtin_nontemporal_store((f32x4){y[t][12] * r * n3.x, y[t][13] * r * n3.y, y[t][14] * r * n3.z, y[t][15] * r * n3.w}, op + 128 + 2 * lane + 1); }
        }
    }

#undef IN
#undef BOTH
}

extern "C" void kernel_launch(void* const* d_in, const int* in_sizes, int n_in, void* d_out, int out_size, void* d_ws, size_t ws_size, hipStream_t stream) {
    static int grid = 0;
    if (grid == 0) {
        if (n_in != 14 || in_sizes[0] != T * D || out_size != T * D || ws_size < WS_END) { fprintf(stderr, "kernel_launch: unexpected shapes (n_in %d, in0 %d, out %d, ws %zu); nothing launched\n", n_in, n_in > 0 ? in_sizes[0] : -1, out_size, ws_size); grid = -1; return; }
        int dev = 0, cus = 0, per_cu = 0;
        if (hipGetDevice(&dev) != hipSuccess || hipDeviceGetAttribute(&cus, hipDeviceAttributeMultiprocessorCount, dev) != hipSuccess) { grid = -1; return; }
        if (hipFuncSetAttribute((const void*)hymba_fwd, hipFuncAttributeMaxDynamicSharedMemorySize, LDS_BYTES) != hipSuccess) { fprintf(stderr, "kernel_launch: hipFuncSetAttribute failed\n"); grid = -1; return; }
        if (hipOccupancyMaxActiveBlocksPerMultiprocessor(&per_cu, (const void*)hymba_fwd, NWAVES * 64, LDS_BYTES) != hipSuccess || per_cu < 1) { fprintf(stderr, "kernel_launch: occupancy query says %d blocks per CU\n", per_cu); (void)hipGetLastError(); grid = -1; return; }
        grid = cus;
    }
    if (grid < 0) return;
    if (hipMemsetAsync((char*)d_ws + WS_CTL, 0, CTL_ZERO_BYTES, stream) != hipSuccess) { fprintf(stderr, "kernel_launch: hipMemsetAsync failed\n"); return; }
    Args a{};
    for (int i = 0; i < 14; ++i) a.in[i] = (const float*)d_in[i];
    a.out = (float*)d_out; a.ws = (unsigned char*)d_ws;
    if (N_LAUNCHES == 1) {
        a.ph_lo = 0; a.ph_hi = NPHASES; a.li = 0;
        void* kargs[] = {&a};
        const hipError_t e = hipLaunchCooperativeKernel((const void*)hymba_fwd, dim3(grid), dim3(NWAVES * 64), kargs, LDS_BYTES, stream);
        if (e != hipSuccess) fprintf(stderr, "kernel_launch: cooperative launch failed: %s (grid %d)\n", hipGetErrorString(e), grid);
    } else {
        for (int li = 0; li < NPHASES; ++li) {
            a.ph_lo = li; a.ph_hi = li + 1; a.li = li;
            hipLaunchKernelGGL(hymba_fwd, dim3(grid), dim3(NWAVES * 64), LDS_BYTES, stream, a);
            const hipError_t le = hipPeekAtLastError();
            if (le != hipSuccess) { fprintf(stderr, "kernel_launch: launch %d failed: %s\n", li, hipGetErrorName(le)); break; }
        }
    }
}
```

```cpp
#include <hip/hip_runtime.h>
#include <cstdio>
#include <cstdint>
namespace pg8 {
#define PG8_LAS __attribute__((address_space(3)))
typedef unsigned short bf16_t;
typedef short bf16x8 __attribute__((ext_vector_type(8)));
typedef float f32x4 __attribute__((ext_vector_type(4)));
typedef unsigned u32x4 __attribute__((ext_vector_type(4)));
constexpr int BM = 256, BK = 64, HALF = 128, HTB = HALF * BK * 2  , STAGE_BYTES = 8 * HTB, NXCD = 8, WGM = 8;

__host__ __device__ __forceinline__ int lds_byte(int r, int c) { const int st = (r >> 4) * 2 + (c >> 5), rr = r & 15, cc = c & 31, ob = rr * 64 + cc * 2; return st * 1024 + (ob ^ (((ob >> 9) & 1) << 5)); }
__host__ __device__ __forceinline__ void stage_rc(int b, int& R, int& C) { const int st = b / 1024, sb = b % 1024, swz = sb ^ (((sb >> 9) & 1) << 5); R = (st >> 1) * 16 + swz / 64; C = (st & 1) * 32 + (swz % 64) / 2; }
__host__ __device__ __forceinline__ int perm32(int rho) { const int n = rho >> 4, i = rho & 15; return 8 * (i >> 2) + 4 * n + (i & 3); }

struct Unit { int pm, pn; };
struct Gemm { const bf16_t* A; const bf16_t* Bt; int M, N, K; };

struct StaticOrder {
    int nM, nN, nwg, G, c;
    __host__ __device__ void init(int M, int N, int G_, int c_) { nM = M / BM; nN = N / BM; nwg = nM * nN; G = G_; c = c_; }
    __host__ __device__ bool next(int i, Unit& u) const {
        const long L = (long)i * G + c; if (L >= nwg) return false;
        int wgid = (int)L; { const int q = nwg / NXCD, r = nwg % NXCD, xcd = wgid % NXCD, off = wgid / NXCD; wgid = (xcd < r ? xcd * (q + 1) : r * (q + 1) + (xcd - r) * q) + off; }
        const int nig = WGM * nN, gid = wgid / nig, fm = gid * WGM, gsz = (nM - fm) < WGM ? (nM - fm) : WGM;
        u.pm = fm + ((wgid % nig) % gsz); u.pn = (wgid % nig) / gsz; return true;
    }
    __device__ __forceinline__ void a_ready(const Unit&) const {}
    __device__ __forceinline__ void done(const Unit&) const {}
};

__device__ __forceinline__ unsigned cvt_pk_bf16(float lo, float hi) { unsigned r; asm volatile("v_cvt_pk_bf16_f32 %0, %1, %2" : "=v"(r) : "v"(lo), "v"(hi)); return r; }

template <int MODE> struct EpiScaleBf16 {
    static constexpr bool PERM = true, AFTER_DRAIN = false;
    bf16_t* O; int ldc; const float* rowv;
    __device__ __forceinline__ void operator()(const f32x4 (&acc)[2][2][4][2], const Unit& u, int wr, int wc, int fr, int fq) const {
        const int row0 = u.pm * BM + wr * 64 + fr, col0 = u.pn * BM + wc * 32 + 8 * fq;
#pragma unroll
        for (int ai = 0; ai < 2; ++ai)
#pragma unroll
            for (int m = 0; m < 4; ++m) { const int row = row0 + ai * HALF + m * 16; float s = rowv[row]; if (MODE == 1) s = 1.0f / sqrtf(s * (1.0f / 1024.0f) + 1e-6f);
                bf16_t* rowp = O + (size_t)row * ldc + col0;
#pragma unroll
                for (int bj = 0; bj < 2; ++bj) { const f32x4 v0 = acc[ai][bj][m][0] * s, v1 = acc[ai][bj][m][1] * s;
                    u32x4 w; w.x = cvt_pk_bf16(v0[0], v0[1]); w.y = cvt_pk_bf16(v0[2], v0[3]); w.z = cvt_pk_bf16(v1[0], v1[1]); w.w = cvt_pk_bf16(v1[2], v1[3]);
                    *(u32x4*)(rowp + bj * HALF) = w; } }
    }
};
struct EpiResid {
    static constexpr bool PERM = true, AFTER_DRAIN = false;
    const float* X; bf16_t* O; float* ss;
    __device__ __forceinline__ void operator()(const f32x4 (&acc)[2][2][4][2], const Unit& u, int wr, int wc, int fr, int fq) const {
        const int row0 = u.pm * BM + wr * 64 + fr, col0 = u.pn * BM + wc * 32 + 8 * fq;
#pragma unroll
        for (int ai = 0; ai < 2; ++ai)
#pragma unroll
            for (int m = 0; m < 4; ++m) { const int row = row0 + ai * HALF + m * 16; float part = 0.f;
#pragma unroll
                for (int bj = 0; bj < 2; ++bj) { const float* xp = X + (size_t)row * 1024 + col0 + bj * HALF;
                    const f32x4 v0 = acc[ai][bj][m][0] + *(const f32x4*)xp, v1 = acc[ai][bj][m][1] + *(const f32x4*)(xp + 4);
                    part += (v0[0] * v0[0] + v0[1] * v0[1]) + (v0[2] * v0[2] + v0[3] * v0[3]) + (v1[0] * v1[0] + v1[1] * v1[1]) + (v1[2] * v1[2] + v1[3] * v1[3]);
                    u32x4 w; w.x = cvt_pk_bf16(v0[0], v0[1]); w.y = cvt_pk_bf16(v0[2], v0[3]); w.z = cvt_pk_bf16(v1[0], v1[1]); w.w = cvt_pk_bf16(v1[2], v1[3]);
                    *(u32x4*)(O + (size_t)row * 1024 + col0 + bj * HALF) = w; }
                part += __shfl_xor(part, 16); part += __shfl_xor(part, 32);
                if (fq == 0) (void)__builtin_amdgcn_global_atomic_fadd_f32((__attribute__((address_space(1))) float*)(ss + row), part); }
    }
};

template <class Epi, class Sched, bool ALIGN_EPI = false, bool SP2 = false>
__device__ __forceinline__ void gemm_phase(PG8_LAS unsigned char* lds, const Gemm g, const Sched& S, const Epi& E) {
    const int tid = threadIdx.x, wid = __builtin_amdgcn_readfirstlane(tid >> 6), lane = tid & 63, wr = wid >> 2, wc = wid & 3, fr = lane & 15, fq = lane >> 4;
    const int K = g.K, nt = K / BK;
    unsigned voffA[2], voffB[2];
#pragma unroll
    for (int i = 0; i < 2; ++i) { int R, C; stage_rc(tid * 16 + i * 8192, R, C); const int Rb = Epi::PERM ? ((R & ~31) + perm32(R & 31)) : R;
        voffA[i] = (unsigned)(R * K + C) * 2u; voffB[i] = (unsigned)(Rb * K + C) * 2u; }
    const size_t kstep = (size_t)(BK * 2);
    const size_t hstep = (size_t)HALF * K * 2;
    const size_t tstep = 2 * hstep;
    const unsigned ldsw = (unsigned)wid * 1024u;
    const int aoff = lds_byte(wr * 64 + fr, fq * 8), boff = lds_byte(wc * 32 + fr, fq * 8);
#define PG8_SA(b, h) (((b) * 2 + (h)) * HTB)
#define PG8_SB(b, h) ((4 + (b) * 2 + (h)) * HTB)
#define PG8_STAGE(bufoff, gbase, voff) do { _Pragma("unroll") for (int _i = 0; _i < 2; ++_i) \
        __builtin_amdgcn_global_load_lds((const unsigned*)((const char*)(gbase) + (voff)[_i]), (PG8_LAS unsigned*)(lds + (bufoff) + ldsw + _i * 8192), 16, 0, 0); } while (0)
#define PG8_LDA(dst, b, h) do { _Pragma("unroll") for (int m = 0; m < 4; ++m) _Pragma("unroll") for (int k = 0; k < 2; ++k) dst[m][k] = *(const PG8_LAS bf16x8*)(lds + PG8_SA(b, h) + aoff + m * 2048 + k * 1024); } while (0)
#define PG8_LDB(dst, b, h) do { _Pragma("unroll") for (int n = 0; n < 2; ++n) _Pragma("unroll") for (int k = 0; k < 2; ++k) dst[n][k] = *(const PG8_LAS bf16x8*)(lds + PG8_SB(b, h) + boff + n * 2048 + k * 1024); } while (0)
#define PG8_MMA(ai, bj, At, Bt) do { __builtin_amdgcn_s_setprio(1); _Pragma("unroll") for (int m = 0; m < 4; ++m) _Pragma("unroll") for (int n = 0; n < 2; ++n) _Pragma("unroll") for (int k = 0; k < 2; ++k) \
        acc[ai][bj][m][n] = __builtin_amdgcn_mfma_f32_16x16x32_bf16(Bt[n][k], At[m][k], acc[ai][bj][m][n], 0, 0, 0); __builtin_amdgcn_s_setprio(0); } while (0)
#define PG8_WAIT_V(n) asm volatile("s_waitcnt vmcnt(" #n ")" ::: "memory")
#define PG8_WAIT_L(n) asm volatile("s_waitcnt lgkmcnt(" #n ")" ::: "memory")
#define PG8_BAR __builtin_amdgcn_s_barrier()
#define PG8_SCHED __builtin_amdgcn_sched_barrier(0)
    Unit cur, nxt; int ui = 0;
    if (!S.next(0, cur)) return;
    f32x4 acc[2][2][4][2];
#pragma unroll
    for (int a = 0; a < 2; ++a)
#pragma unroll
        for (int b = 0; b < 2; ++b)
#pragma unroll
            for (int m = 0; m < 4; ++m)
#pragma unroll
                for (int n = 0; n < 2; ++n) acc[a][b][m][n] = (f32x4){0.f, 0.f, 0.f, 0.f};
    bf16x8 At[4][2], B0[2][2], B1[2][2];
    const char* cA = (const char*)g.A + (size_t)cur.pm * tstep; const char* cB = (const char*)g.Bt + (size_t)cur.pn * tstep;
    S.a_ready(cur);
    if constexpr (SP2) {
        PG8_STAGE(PG8_SB(0, 0), cB, voffB); PG8_STAGE(PG8_SB(0, 1), cB + hstep, voffB); PG8_STAGE(PG8_SA(0, 0), cA, voffA); PG8_STAGE(PG8_SA(0, 1), cA + hstep, voffA);
        if (wr == 1) PG8_BAR;
        PG8_WAIT_V(2); PG8_BAR;
        PG8_STAGE(PG8_SB(1, 0), cB + kstep, voffB); PG8_STAGE(PG8_SA(1, 0), cA + kstep, voffA); PG8_STAGE(PG8_SB(1, 1), cB + hstep + kstep, voffB);
        PG8_WAIT_V(6); PG8_BAR;
    } else {
        PG8_STAGE(PG8_SB(0, 0), cB, voffB); PG8_STAGE(PG8_SA(0, 0), cA, voffA); PG8_STAGE(PG8_SB(0, 1), cB + hstep, voffB); PG8_STAGE(PG8_SA(0, 1), cA + hstep, voffA);
        if (wr == 1) PG8_BAR;
        PG8_WAIT_V(4); PG8_BAR;
        PG8_STAGE(PG8_SB(1, 0), cB + kstep, voffB); PG8_STAGE(PG8_SA(1, 0), cA + kstep, voffA); PG8_STAGE(PG8_SB(1, 1), cB + hstep + kstep, voffB);
        PG8_WAIT_V(6); PG8_BAR;
    }
    for (;;) {
        const bool has_next = S.next(ui + 1, nxt);
        const char* nA = has_next ? (const char*)g.A + (size_t)nxt.pm * tstep : cA; const char* nB = has_next ? (const char*)g.Bt + (size_t)nxt.pn * tstep : cB;
        for (int t = 0; t < nt; t += 2) {
            const bool last = (t == nt - 2);
            const char* a1 = cA + (size_t)(t + 1) * kstep;
            const char* a2 = last ? nA : cA + (size_t)(t + 2) * kstep; const char* b2 = last ? nB : cB + (size_t)(t + 2) * kstep;
            const char* a3 = a2 + kstep; const char* b3 = b2 + kstep;
            if (last && has_next) S.a_ready(nxt);
            if constexpr (SP2) {
            PG8_LDB(B0, 0, 0); PG8_LDB(B1, 0, 1); PG8_SCHED; PG8_LDA(At, 0, 0); PG8_STAGE(PG8_SA(1, 1), a1 + hstep, voffA);
            PG8_WAIT_V(8); PG8_WAIT_L(0); PG8_BAR; PG8_MMA(0, 0, At, B0); PG8_MMA(0, 1, At, B1); PG8_BAR; PG8_SCHED;
            PG8_LDA(At, 0, 1); PG8_STAGE(PG8_SB(0, 0), b2, voffB); PG8_STAGE(PG8_SB(0, 1), b2 + hstep, voffB); PG8_STAGE(PG8_SA(0, 0), a2, voffA);
            PG8_WAIT_V(8); PG8_WAIT_L(0); PG8_BAR; PG8_MMA(1, 0, At, B0); PG8_MMA(1, 1, At, B1); PG8_BAR; PG8_SCHED;
            PG8_LDB(B0, 1, 0); PG8_LDB(B1, 1, 1); PG8_SCHED; PG8_LDA(At, 1, 0); PG8_STAGE(PG8_SA(0, 1), a2 + hstep, voffA);
            PG8_WAIT_V(8); PG8_WAIT_L(0); PG8_BAR; PG8_MMA(0, 0, At, B0); PG8_MMA(0, 1, At, B1); PG8_BAR; PG8_SCHED;
            PG8_LDA(At, 1, 1); PG8_STAGE(PG8_SB(1, 0), b3, voffB); PG8_STAGE(PG8_SB(1, 1), b3 + hstep, voffB); PG8_STAGE(PG8_SA(1, 0), a3, voffA);
            PG8_WAIT_V(8); PG8_WAIT_L(0); PG8_BAR; PG8_MMA(1, 0, At, B0); PG8_MMA(1, 1, At, B1); PG8_BAR; PG8_SCHED;
            } else {
            PG8_LDB(B0, 0, 0); PG8_SCHED; PG8_LDA(At, 0, 0); PG8_STAGE(PG8_SA(1, 1), a1 + hstep, voffA);
            PG8_WAIT_L(8); PG8_BAR; PG8_WAIT_L(0); PG8_MMA(0, 0, At, B0); PG8_BAR; PG8_SCHED;
            PG8_LDB(B1, 0, 1); PG8_STAGE(PG8_SB(0, 0), b2, voffB);
            PG8_BAR; PG8_WAIT_L(0); PG8_MMA(0, 1, At, B1); PG8_BAR;
            PG8_LDA(At, 0, 1); PG8_STAGE(PG8_SA(0, 0), a2, voffA);
            PG8_BAR; PG8_WAIT_L(0); PG8_MMA(1, 0, At, B0); PG8_BAR; PG8_SCHED;
            PG8_STAGE(PG8_SB(0, 1), b2 + hstep, voffB);
            PG8_WAIT_V(6); PG8_BAR; PG8_MMA(1, 1, At, B1); PG8_BAR;
            PG8_LDB(B0, 1, 0); PG8_SCHED; PG8_LDA(At, 1, 0); PG8_STAGE(PG8_SA(0, 1), a2 + hstep, voffA);
            PG8_WAIT_L(8); PG8_BAR; PG8_WAIT_L(0); PG8_MMA(0, 0, At, B0); PG8_BAR; PG8_SCHED;
            PG8_LDB(B1, 1, 1); PG8_STAGE(PG8_SB(1, 0), b3, voffB);
            PG8_BAR; PG8_WAIT_L(0); PG8_MMA(0, 1, At, B1); PG8_BAR;
            PG8_LDA(At, 1, 1); PG8_STAGE(PG8_SA(1, 0), a3, voffA);
            PG8_BAR; PG8_WAIT_L(0); PG8_MMA(1, 0, At, B0); PG8_BAR; PG8_SCHED;
            PG8_STAGE(PG8_SB(1, 1), b3 + hstep, voffB);
            PG8_WAIT_V(6); PG8_BAR; PG8_MMA(1, 1, At, B1); PG8_BAR;
            }
        }
        if constexpr (ALIGN_EPI) { if (wr == 0) PG8_BAR; }
        if constexpr (!Epi::AFTER_DRAIN) { E(acc, cur, wr, wc, fr, fq); S.done(cur); }
        if (!has_next) break;
#pragma unroll
        for (int a = 0; a < 2; ++a)
#pragma unroll
            for (int b = 0; b < 2; ++b)
#pragma unroll
                for (int m = 0; m < 4; ++m)
#pragma unroll
                    for (int n = 0; n < 2; ++n) acc[a][b][m][n] = (f32x4){0.f, 0.f, 0.f, 0.f};
        cur = nxt; cA = nA; cB = nB; ++ui;
        if constexpr (ALIGN_EPI) { if (wr == 1) PG8_BAR; }
    }
    PG8_WAIT_V(0);
    if constexpr (!ALIGN_EPI) { if (wr == 0) PG8_BAR; }
    PG8_BAR;
    if constexpr (Epi::AFTER_DRAIN) { E.fused(acc, cur, wr, wc, fr, fq, lds, wid, lane); S.done(cur); }
#undef PG8_SA
#undef PG8_SB
#undef PG8_STAGE
#undef PG8_LDA
#undef PG8_LDB
#undef PG8_MMA
#undef PG8_WAIT_V
#undef PG8_WAIT_L
#undef PG8_BAR
#undef PG8_SCHED
}
}

#ifndef PG8_SP2
#define PG8_SP2 true
#endif
#ifndef PG8_ALIGN
#define PG8_ALIGN true
#endif
#ifndef MK_N_LAUNCHES
#define MK_N_LAUNCHES 1
#endif
constexpr int NWAVES = 8;
constexpr int NPHASES = 8;
constexpr int N_LAUNCHES = MK_N_LAUNCHES;

constexpr int NB = 32, SEQ = 2048, T = NB * SEQ, D = 1024, DIN = 3584;
constexpr int PC_C = 0, PC_H = 512, PC_B = 1024, PC_Q = 1536, PC_F = 2048, PC_V = 2560, PC_G = 3072;
constexpr int NEXP = 16384;
constexpr float EPS = 1e-6f;
constexpr float PEER_SU = 1024.0f, PEER_SV = 64.0f;

constexpr size_t MiB = 1u << 20;
constexpr size_t WS_CTL = 0, CTL_ZERO_BYTES = 1 * MiB;
constexpr size_t WS_W1T = 2 * MiB, WS_WOT = 10 * MiB, WS_WQT = 12 * MiB, WS_RS1 = 16 * MiB, WS_SS2 = 17 * MiB;
constexpr size_t WS_KEYB = 18 * MiB;
constexpr size_t WS_U16 = 32 * MiB, WS_V16 = 64 * MiB, WS_EXP = 96 * MiB;
constexpr size_t WS_XB = 128 * MiB;
constexpr size_t WS_X1 = 256 * MiB;
constexpr size_t WS_PROJ = 384 * MiB;
constexpr size_t WS_F = 832 * MiB;
constexpr size_t WS_END = 960 * MiB;
constexpr int CW_BAR = 4096;

constexpr int RING_OFF = 0, RING_BYTES = 131072;
constexpr int LDSCTL_OFF = RING_BYTES, MISC_OFF = LDSCTL_OFF + 320;
constexpr int LDS_BYTES = 147456;

#define GAS __attribute__((address_space(1)))
#define LAS __attribute__((address_space(3)))
typedef unsigned short bf16;
typedef unsigned v4u __attribute__((ext_vector_type(4)));
typedef unsigned v2u __attribute__((ext_vector_type(2)));
typedef float f32x4 __attribute__((ext_vector_type(4)));
typedef float f32x2 __attribute__((ext_vector_type(2)));
typedef _Float16 h2_t __attribute__((ext_vector_type(2)));
typedef GAS unsigned gu32;
#define RLX_AGENT __ATOMIC_RELAXED, __HIP_MEMORY_SCOPE_AGENT
#define LDS_WAIT() asm volatile("s_waitcnt lgkmcnt(0)" ::: "memory")
#define VM_WAIT() asm volatile("s_waitcnt vmcnt(0)" ::: "memory")
__device__ __forceinline__ unsigned f2bf(float f) { unsigned u = __builtin_bit_cast(unsigned, f); return (u + 0x7fffu + ((u >> 16) & 1u)) >> 16; }
__device__ __forceinline__ unsigned pk2(float lo, float hi) { return f2bf(lo) | (f2bf(hi) << 16); }
__device__ __forceinline__ float bf_lo(unsigned w) { return __builtin_bit_cast(float, w << 16); }
__device__ __forceinline__ float bf_hi(unsigned w) { return __builtin_bit_cast(float, w & 0xffff0000u); }
__device__ __forceinline__ float bf1(bf16 v) { return __builtin_bit_cast(float, (unsigned)v << 16); }
__device__ __forceinline__ unsigned pkh2(float lo, float hi) { f32x2 v = {lo, hi}; h2_t h = __builtin_convertvector(v, h2_t); return __builtin_bit_cast(unsigned, h); }
__device__ __forceinline__ h2_t h2_of(unsigned w) { return __builtin_bit_cast(h2_t, w); }
__device__ __forceinline__ float wave_sum(float v) {
#pragma unroll
    for (int o = 1; o < 64; o <<= 1) v += __shfl_xor(v, o);
    return v;
}
typedef float f32x16 __attribute__((ext_vector_type(16)));
typedef __bf16 bf16x2_t __attribute__((ext_vector_type(2)));
__device__ __forceinline__ unsigned cvtpk(float lo, float hi) { f32x2 v = {lo, hi}; bf16x2_t b = __builtin_convertvector(v, bf16x2_t); return __builtin_bit_cast(unsigned, b); }
__device__ __forceinline__ pg8::bf16x8 pack8(const f32x16& x, int s) {
    v4u p; p.x = cvtpk(x[8 * s], x[8 * s + 1]); p.y = cvtpk(x[8 * s + 2], x[8 * s + 3]); p.z = cvtpk(x[8 * s + 4], x[8 * s + 5]); p.w = cvtpk(x[8 * s + 6], x[8 * s + 7]);
    return __builtin_bit_cast(pg8::bf16x8, p); }
__device__ __forceinline__ void ce_desc(unsigned& a, unsigned& b) { const unsigned mx = a > b ? a : b, mn = a > b ? b : a; a = mx; b = mn; }
__device__ __forceinline__ void sort16_desc(unsigned (&a)[16]) {
#pragma unroll
    for (int k = 2; k <= 16; k <<= 1)
#pragma unroll
        for (int j = k >> 1; j > 0; j >>= 1)
#pragma unroll
            for (int i = 0; i < 16; ++i) { const int l = i ^ j; if (l > i) { if ((i & k) == 0) ce_desc(a[i], a[l]); else ce_desc(a[l], a[i]); } }
}
__device__ __forceinline__ void merge16_desc(unsigned (&a)[16], const unsigned (&b)[16]) {
#pragma unroll
    for (int i = 0; i < 16; ++i) a[i] = a[i] > b[15 - i] ? a[i] : b[15 - i];
#pragma unroll
    for (int j = 8; j > 0; j >>= 1)
#pragma unroll
        for (int i = 0; i < 16; ++i) { const int l = i ^ j; if (l > i) ce_desc(a[i], a[l]); }
}
__device__ __forceinline__ float unkey(unsigned a) { a = (a & 0x80000000u) ? (a & 0x7FFFFFFFu) : ~a; return __builtin_bit_cast(float, a); }
__device__ __forceinline__ unsigned ckey(float s, int flat) { unsigned u = __builtin_bit_cast(unsigned, s); u ^= (unsigned)((int)u >> 31) | 0x80000000u; return (u & ~0xFFu) | (unsigned)(255 - flat); }
__device__ __forceinline__ void sort128_asc(unsigned& k0, unsigned& k1, int lane) {
#pragma unroll
    for (int k = 2; k <= 128; k <<= 1)
#pragma unroll
        for (int j = k >> 1; j > 0; j >>= 1) {
            if (j == 64) { const unsigned mn = k0 < k1 ? k0 : k1, mx = k0 < k1 ? k1 : k0; k0 = mn; k1 = mx; }
            else {
                const unsigned p0 = (unsigned)__shfl_xor((int)k0, j), p1 = (unsigned)__shfl_xor((int)k1, j);
                const bool lower = (lane & j) == 0;
                const bool up0 = (k == 128) ? true : (k == 64 ? true : ((lane & k) == 0));
                const bool up1 = (k == 128) ? true : (k == 64 ? false : ((lane & k) == 0));
                const unsigned mn0 = k0 < p0 ? k0 : p0, mx0 = k0 < p0 ? p0 : k0, mn1 = k1 < p1 ? k1 : p1, mx1 = k1 < p1 ? p1 : k1;
                k0 = (lower == up0) ? mn0 : mx0; k1 = (lower == up1) ? mn1 : mx1;
            }
        }
}
__device__ __forceinline__ float reduce16(const float (&p)[16], int lane) {
    float q[8], r[4], u[2];
    const bool b5 = (lane & 32) != 0, b4 = (lane & 16) != 0, b3 = (lane & 8) != 0, b2 = (lane & 4) != 0;
#pragma unroll
    for (int i = 0; i < 8; ++i) { const float keep = b5 ? p[2 * i + 1] : p[2 * i], send = b5 ? p[2 * i] : p[2 * i + 1]; q[i] = keep + __shfl_xor(send, 32); }
#pragma unroll
    for (int i = 0; i < 4; ++i) { const float keep = b4 ? q[2 * i + 1] : q[2 * i], send = b4 ? q[2 * i] : q[2 * i + 1]; r[i] = keep + __shfl_xor(send, 16); }
#pragma unroll
    for (int i = 0; i < 2; ++i) { const float keep = b3 ? r[2 * i + 1] : r[2 * i], send = b3 ? r[2 * i] : r[2 * i + 1]; u[i] = keep + __shfl_xor(send, 8); }
    const float keep = b2 ? u[1] : u[0], send = b2 ? u[0] : u[1];
    float v = keep + __shfl_xor(send, 4);
    v += __shfl_xor(v, 2); v += __shfl_xor(v, 1);
    return v;
}
__device__ __forceinline__ int swap23(int k) { return (k & ~12) | ((k & 4) << 1) | ((k & 8) >> 1); }
__device__ __forceinline__ float sigmoidf_(float x) { return 1.0f / (1.0f + __expf(-x)); }

#define XB_TMO      128
#define XB_XCNT(j)  (256  + 64 * (j))
#define XB_XSUB(j)  (1280 + 64 * (j))
#define XB_XGEN(j)  (2304 + 64 * (j))
#define XB_TOP      3328
#define XB_TOPGEN   3392
#define XCD_BAR_WORDS 3456
#define XB_SPIN_CAP (1u << 18)

__device__ __forceinline__ unsigned xb_ld(unsigned* p)              { return __hip_atomic_load(p, __ATOMIC_RELAXED, __HIP_MEMORY_SCOPE_AGENT); }
__device__ __forceinline__ unsigned xb_add(unsigned* p, unsigned v) { return __hip_atomic_fetch_add(p, v, __ATOMIC_RELAXED, __HIP_MEMORY_SCOPE_AGENT); }
__device__ __forceinline__ unsigned xb_xcc_id() { return (unsigned)__builtin_amdgcn_s_getreg((3 << 11) | 20) & 0xFu; }
#define XB_SPIN(cond, bar) do { unsigned _sp = 0; while (cond) { __builtin_amdgcn_s_sleep(1); \
    if ((++_sp & 255u) == 0u) { if (xb_ld(&(bar)[XB_TMO])) break; if (_sp > XB_SPIN_CAP) { atomicAdd(&(bar)[XB_TMO], 1u); break; } } } } while (0)

struct XcdBarrier {
    unsigned* bar; unsigned x;
    volatile LAS unsigned* st;
};

__device__ __forceinline__ XcdBarrier xcd_barrier_post(unsigned* bar, volatile LAS unsigned* st) {
    XcdBarrier b; b.bar = bar; b.x = xb_xcc_id(); b.st = st;
    if (threadIdx.x == 0) (void)xb_add(&bar[XB_XCNT(b.x)], 1u);
    return b;
}
__device__ __forceinline__ void xcd_barrier_complete(unsigned* bar, unsigned x, unsigned& nloc, unsigned& nx) {
    const unsigned G = gridDim.x * gridDim.y * gridDim.z;
    unsigned sum, cnt, mine, sp = 0u;
    for (;;) {
        sum = 0u; cnt = 0u; mine = 0u;
#pragma unroll
        for (unsigned j = 0; j < 16; ++j) { const unsigned c = xb_ld(&bar[XB_XCNT(j)]); sum += c; cnt += (c > 0u) ? 1u : 0u; mine = (j == x) ? c : mine; }
        if (sum == G) break;
        __builtin_amdgcn_s_sleep(1);
        if ((++sp & 255u) == 0u) { if (xb_ld(&bar[XB_TMO])) break; if (sp > XB_SPIN_CAP) { atomicAdd(&bar[XB_TMO], 1u); break; } }
    }
    nloc = mine > 0u ? mine : 1u; nx = cnt > 0u ? cnt : 1u;
}

__device__ __forceinline__ void xcd_barrier(const XcdBarrier& b) {
    asm volatile("s_waitcnt vmcnt(0)" ::: "memory");
    __syncthreads();
    if (threadIdx.x == 0) {
        unsigned* bar = b.bar;
        __builtin_amdgcn_s_waitcnt(0);
        unsigned nloc = b.st[0], nx = b.st[1];
        if (nloc == 0u) { xcd_barrier_complete(bar, b.x, nloc, nx); b.st[0] = nloc; b.st[1] = nx; }
        const unsigned old = xb_add(&bar[XB_XSUB(b.x)], 1u);
        const unsigned gen = old / nloc;
        if (old + 1u == (gen + 1u) * nloc) {
            __builtin_amdgcn_fence(__ATOMIC_RELEASE, "agent");
            asm volatile("s_waitcnt vmcnt(0)" ::: "memory");
            const unsigned og = xb_add(&bar[XB_TOP], 1u);
            const unsigned tg = og / nx;
            if (og + 1u == (tg + 1u) * nx) xb_add(&bar[XB_TOPGEN], 1u);
            else XB_SPIN(xb_ld(&bar[XB_TOPGEN]) == tg, bar);
            __builtin_amdgcn_fence(__ATOMIC_ACQUIRE, "agent");
            xb_add(&bar[XB_XGEN(b.x)], 1u);
            asm volatile("s_waitcnt vmcnt(0)" ::: "memory");
        } else {
            XB_SPIN(xb_ld(&bar[XB_XGEN(b.x)]) == gen, bar);
            __builtin_amdgcn_fence(__ATOMIC_ACQUIRE, "agent");
            asm volatile("s_waitcnt vmcnt(0)" ::: "memory");
        }
    }
    __syncthreads();
}


__device__ __forceinline__ void p0_transpose_item(const float* W, int K, int N, const float* gain, bf16* WT, LAS float* scr, int item, int lane) {
    const int nblk = N / 32, kb = item / nblk, nb = item % nblk, k0 = 64 * kb, n0 = 32 * nb;
#pragma unroll 8
    for (int i = 0; i < 32; ++i) { const int kk = 2 * i + (lane >> 5); const float g = gain ? gain[k0 + kk] : 1.0f; scr[kk * 33 + (lane & 31)] = W[(size_t)(k0 + kk) * N + n0 + (lane & 31)] * g; }
    LDS_WAIT(); asm volatile("" ::: "memory");
    const int c = lane & 7;
#pragma unroll
    for (int j = 0; j < 4; ++j) { const int n = (lane >> 3) + 8 * j; const LAS float* s = scr + (8 * c) * 33 + n;
        v4u o; o.x = pk2(s[0 * 33], s[1 * 33]); o.y = pk2(s[2 * 33], s[3 * 33]); o.z = pk2(s[4 * 33], s[5 * 33]); o.w = pk2(s[6 * 33], s[7 * 33]);
        *(GAS v4u*)(WT + (size_t)(n0 + n) * K + k0 + 8 * c) = o; }
    LDS_WAIT(); asm volatile("" ::: "memory");
}

struct Args { const float* in[14]; float* out; unsigned char* ws; int ph_lo, ph_hi, li, pad; };

__global__ void __launch_bounds__(NWAVES * 64, 2) hymba_fwd(Args args) {
    extern __shared__ __attribute__((aligned(16))) unsigned char lds_raw[];
    LAS unsigned char* lds = (LAS unsigned char*)lds_raw;
    volatile LAS unsigned* MISC = (volatile LAS unsigned*)(lds + MISC_OFF);
    const int tid = threadIdx.x, lane = tid & 63, wave = __builtin_amdgcn_readfirstlane(tid >> 6);
    const int G = gridDim.x;
    const int gw = (int)blockIdx.x * NWAVES + wave, NGW = G * NWAVES;
    unsigned char* ws = args.ws;
    gu32* ctl = (gu32*)(ws + WS_CTL);
    const float* x = args.in[0]; const float* norm_mix = args.in[1]; const float* w_in = args.in[2]; const float* conv_w = args.in[3]; const float* conv_gain = args.in[4];
    const float* hg_lb = args.in[5]; const float* hg_gain = args.in[6]; const float* w_out = args.in[7]; const float* norm_ffn = args.in[8]; const float* peer_wq = args.in[9];
    const float* peer_keys = args.in[10]; const float* peer_u = args.in[11]; const float* peer_v = args.in[12]; const float* norm_f = args.in[13];
    float* out = args.out;
    bf16* W1T = (bf16*)(ws + WS_W1T); bf16* WOT = (bf16*)(ws + WS_WOT); bf16* WQT = (bf16*)(ws + WS_WQT);
    float* RS1 = (float*)(ws + WS_RS1); float* SS2 = (float*)(ws + WS_SS2);
    unsigned char* U8 = ws + WS_U16; unsigned char* V8 = ws + WS_V16; unsigned* EXPT = (unsigned*)(ws + WS_EXP); bf16* KEYB = (bf16*)(ws + WS_KEYB);
    bf16* XB = (bf16*)(ws + WS_XB); bf16* MIX = (bf16*)(ws + WS_XB); bf16* X1 = (bf16*)(ws + WS_X1);
    bf16* PROJ = (bf16*)(ws + WS_PROJ); bf16* QB = (bf16*)(ws + WS_PROJ); float* DEC = (float*)(ws + WS_F); bf16* KDT = (bf16*)(ws + WS_X1); bf16* VTT = (bf16*)(ws + WS_X1 + 64 * MiB);

    for (int u = tid; u < (LDS_BYTES - LDSCTL_OFF) / 4; u += NWAVES * 64) ((LAS unsigned*)(lds + LDSCTL_OFF))[u] = 0u;
    __syncthreads();
    XcdBarrier bar; bar.bar = (unsigned*)(ctl + CW_BAR); bar.x = 0; bar.st = nullptr;
    if (N_LAUNCHES == 1) bar = xcd_barrier_post((unsigned*)(ctl + CW_BAR), MISC + 8);
#define GRID_BAR() do { if (N_LAUNCHES == 1) xcd_barrier(bar); } while (0)
    const int lo = args.ph_lo, hi = args.ph_hi;
#define IN(k) (lo <= (k) && (k) < hi)
#define BOTH(k) (IN(k) && IN((k) + 1))

    if (IN(0)) {
        LAS float* scr = (LAS float*)(lds + RING_OFF + wave * 16384);
        constexpr int I_1 = (D / 64) * (DIN / 32), I_O = (D / 64) * (D / 32), I_Q = (D / 64) * (2048 / 32);
        for (int it = gw; it < I_1 + I_O + I_Q; it += NGW) {
            int r = it;
            if (r < I_1) { p0_transpose_item(w_in, D, DIN, norm_mix, W1T, scr, r, lane); continue; } r -= I_1;
            if (r < I_O) { p0_transpose_item(w_out, D, D, nullptr, WOT, scr, r, lane); continue; } r -= I_O;
            p0_transpose_item(peer_wq, D, 2048, norm_ffn, WQT, scr, r, lane);
        }
        for (int m = gw; m < T; m += NGW) {
            const GAS f32x4* xr = (const GAS f32x4*)(x + (size_t)m * D) + lane; f32x4 v[4]; float s = 0.f;
#pragma unroll
            for (int j = 0; j < 4; ++j) { v[j] = xr[64 * j]; s += (v[j].x * v[j].x + v[j].y * v[j].y) + (v[j].z * v[j].z + v[j].w * v[j].w); }
            s = wave_sum(s);
            if (lane == 0) RS1[m] = 1.0f / sqrtf(s * (1.0f / D) + EPS);
            GAS unsigned long long* o8 = (GAS unsigned long long*)(XB + (size_t)m * D) + lane;
#pragma unroll
            for (int j = 0; j < 4; ++j) o8[64 * j] = (unsigned long long)pk2(v[j].x, v[j].y) | ((unsigned long long)pk2(v[j].z, v[j].w) << 32);
        }
        for (int r = gw; r < 2 * NEXP; r += NGW) {
            const int tb = r / NEXP, e = r % NEXP; const float sc = tb ? PEER_SV : PEER_SU;
            const GAS f32x4* src = (const GAS f32x4*)((tb ? peer_v : peer_u) + (size_t)e * D) + lane;
            GAS unsigned* dst = (GAS unsigned*)((tb ? V8 : U8) + (size_t)e * D) + lane;
#pragma unroll
            for (int j = 0; j < 4; ++j) { f32x4 v = src[64 * j]; if (!tb) { const f32x4 g = ((const GAS f32x4*)norm_ffn)[64 * j + lane]; v = v * g; }
                v = v * sc; v.x = fminf(fmaxf(v.x, -240.f), 240.f); v.y = fminf(fmaxf(v.y, -240.f), 240.f); v.z = fminf(fmaxf(v.z, -240.f), 240.f); v.w = fminf(fmaxf(v.w, -240.f), 240.f);
                int pk = 0; pk = __builtin_amdgcn_cvt_pk_fp8_f32(v.x, v.y, pk, false); pk = __builtin_amdgcn_cvt_pk_fp8_f32(v.z, v.w, pk, true); dst[64 * j] = (unsigned)pk; }
        }
        for (int i = (int)blockIdx.x * NWAVES * 64 + tid; i < T; i += G * NWAVES * 64) SS2[i] = 0.f;
        for (int i = (int)blockIdx.x * NWAVES * 64 + tid; i < 8 * 2 * 128 * 128 / 2; i += G * NWAVES * 64) ((GAS unsigned*)KEYB)[i] = pk2(peer_keys[2 * i], peer_keys[2 * i + 1]);
        if (BOTH(0)) GRID_BAR();
    }

    if (IN(1)) {
        pg8::Gemm g{XB, W1T, T, DIN, D}; pg8::StaticOrder S; S.init(T, DIN, G, (int)blockIdx.x);
        pg8::EpiScaleBf16<0> E{PROJ, DIN, RS1};
        pg8::gemm_phase<pg8::EpiScaleBf16<0>, pg8::StaticOrder, PG8_ALIGN, PG8_SP2>(lds + RING_OFF, g, S, E);
        if (BOTH(1)) GRID_BAR();
    }

    if (IN(2)) {
        for (int item = gw; item < NB * 64 * 4; item += NGW) {
            const int h = item & 3, n = (item >> 2) & 63, b = item >> 8;
            const size_t tok0 = (size_t)b * SEQ + n * 32;
            const int c0 = h * 128 + 2 * lane, cs = h * 128 + swap23(2 * lane);
            const float lb0 = 1.0f / (1.0f + __expf(hg_lb[512 + c0] - hg_lb[c0])), lb1 = 1.0f / (1.0f + __expf(hg_lb[512 + c0 + 1] - hg_lb[c0 + 1]));
            unsigned qw[32], fw[32], vw[32];
#pragma unroll
            for (int c = 0; c < 32; ++c) { const bf16* pr = PROJ + (tok0 + c) * DIN;
                qw[c] = *(const GAS unsigned*)(pr + PC_Q + c0); fw[c] = *(const GAS unsigned*)(pr + PC_F + c0); vw[c] = *(const GAS unsigned*)(pr + PC_V + c0); }
            float eG0 = 1.f, eG1 = 1.f;
            unsigned kd0[16], kd1[16], vv0[16], vv1[16];
#pragma unroll
            for (int i = 0; i < 16; ++i) { kd0[i] = 0u; kd1[i] = 0u; vv0[i] = 0u; vv1[i] = 0u; }
#pragma unroll
            for (int c = 0; c < 32; ++c) { bf16* pr = PROJ + (tok0 + c) * DIN;
                const float f0 = lb0 + (1.0f - lb0) * sigmoidf_(bf_lo(fw[c])), f1 = lb1 + (1.0f - lb1) * sigmoidf_(bf_hi(fw[c]));
                eG0 *= f0; eG1 *= f1;
                const float q0 = bf_lo(qw[c]), q1 = bf_hi(qw[c]);
                const float qd0 = q0 * sigmoidf_(q0) * 0.08838834764831845f * eG0, qd1 = q1 * sigmoidf_(q1) * 0.08838834764831845f * eG1;
                const float kv0 = (1.0f - f0) / eG0, kv1 = (1.0f - f1) / eG1;
                *(GAS unsigned*)(pr + PC_Q + cs) = pk2(qd0, qd1);
                const unsigned kp = pk2(kv0, kv1);
                *(GAS unsigned*)(pr + PC_F + cs) = kp;
                const int pp = swap23(c), sh = 16 * (pp & 1);
                kd0[pp >> 1] |= (kp & 0xffffu) << sh; kd1[pp >> 1] |= (kp >> 16) << sh;
                vv0[pp >> 1] |= (vw[c] & 0xffffu) << sh; vv1[pp >> 1] |= (vw[c] >> 16) << sh; }
            GAS v4u* kt = (GAS v4u*)(KDT + ((size_t)item * 128 + 2 * lane) * 32);
            GAS v4u* vt = (GAS v4u*)(VTT + ((size_t)item * 128 + 2 * lane) * 32);
#pragma unroll
            for (int i = 0; i < 4; ++i) { kt[i] = (v4u){kd0[4 * i], kd0[4 * i + 1], kd0[4 * i + 2], kd0[4 * i + 3]}; kt[4 + i] = (v4u){kd1[4 * i], kd1[4 * i + 1], kd1[4 * i + 2], kd1[4 * i + 3]};
                vt[i] = (v4u){vv0[4 * i], vv0[4 * i + 1], vv0[4 * i + 2], vv0[4 * i + 3]}; vt[4 + i] = (v4u){vv1[4 * i], vv1[4 * i + 1], vv1[4 * i + 2], vv1[4 * i + 3]}; }
            *(GAS f32x2*)(DEC + (size_t)item * 128 + 2 * lane) = (f32x2){eG0, eG1};
        }
        for (int item = gw; item < NB * 8 * 32; item += NGW) {
            const int seg = item & 31, grp = (item >> 5) & 7, b = item >> 8, c = grp * 64 + lane, t0 = seg * 64;
            const float w0 = conv_w[c], w1 = conv_w[512 + c], w2 = conv_w[1024 + c], gn = conv_gain[c];
            float u1 = 0.f, u2 = 0.f;
            if (t0 > 0) { const bf16* p2 = PROJ + (size_t)(b * SEQ + t0 - 2) * DIN; const bf16* p1 = p2 + DIN;
                u2 = bf1(p2[PC_C + c]) * bf1(p2[PC_H + c]); u1 = bf1(p1[PC_C + c]) * bf1(p1[PC_H + c]); }
            for (int t = t0; t < t0 + 64; ++t) { const size_t tok = (size_t)b * SEQ + t; const bf16* pr = PROJ + tok * DIN;
                const float u = bf1(pr[PC_C + c]) * bf1(pr[PC_H + c]); const float y = bf1(pr[PC_B + c]) * (w0 * u2 + w1 * u1 + w2 * u);
                const float ss = wave_sum(y * y); const float r = 1.0f / sqrtf(ss * (1.0f / 64.0f) + EPS);
                MIX[tok * D + c] = (bf16)f2bf(y * r * gn); u2 = u1; u1 = u; }
        }
        if (BOTH(2)) GRID_BAR();
    }

    if (IN(3)) {
        constexpr int BUFB = 33792, OB0 = 2 * BUFB;
        for (int it = (int)blockIdx.x; it < NB * 4; it += G) {
            const int b = it >> 2, h = it & 3;
            const int lt = tid & 255, r = lane & 31, hh = lane >> 5, sl = wave;
            v4u st[9];
#define SCAN_LOAD(n_) do { const size_t tk0 = (size_t)b * SEQ + (n_) * 32; const size_t itm = (size_t)((b * 64 + (n_)) * 4 + h); \
                _Pragma("unroll") for (int i = 0; i < 2; ++i) { const int q = lt + 256 * i, row = q >> 4, cc = q & 15; const bf16* pr = PROJ + (tk0 + row) * DIN + h * 128 + cc * 8; \
                    st[i] = *(const GAS v4u*)(pr + PC_Q); st[2 + i] = *(const GAS v4u*)(pr + PC_F); \
                    st[4 + i] = ((const GAS v4u*)(KDT + itm * 4096))[q]; st[6 + i] = ((const GAS v4u*)(VTT + itm * 4096))[q]; } \
                if (lt < 32) st[8] = ((const GAS v4u*)(DEC + itm * 128))[lt]; } while (0)
#define SCAN_COMMIT(n_) do { LAS unsigned char* Bf = lds + RING_OFF + ((n_) & 1) * BUFB; \
                _Pragma("unroll") for (int i = 0; i < 2; ++i) { const int q = lt + 256 * i, row = q >> 4, cc = q & 15, k = q >> 2, c4 = q & 3; \
                    *(LAS v4u*)(Bf + row * 256 + ((cc ^ (row & 15)) * 16)) = st[i]; *(LAS v4u*)(Bf + 8192 + row * 256 + ((cc ^ (row & 15)) * 16)) = st[2 + i]; \
                    *(LAS v4u*)(Bf + 16384 + k * 64 + ((c4 ^ ((k >> 2) & 3)) * 16)) = st[4 + i]; *(LAS v4u*)(Bf + 24576 + k * 64 + ((c4 ^ ((k >> 2) & 3)) * 16)) = st[6 + i]; } \
                if (lt < 32) *(LAS v4u*)(Bf + 32768 + lt * 16) = st[8]; } while (0)
#define SCAN_POST(n_) do { const int pos = lt >> 3, vg = lt & 7; const LAS f32x4* ob = (const LAS f32x4*)(lds + RING_OFF + OB0 + ((n_) & 1) * 16384 + (pos * 128 + vg * 16) * 4); \
                const f32x4 o0 = ob[0], o1 = ob[1], o2 = ob[2], o3 = ob[3]; \
                float ss = (o0.x * o0.x + o0.y * o0.y) + (o0.z * o0.z + o0.w * o0.w) + (o1.x * o1.x + o1.y * o1.y) + (o1.z * o1.z + o1.w * o1.w) \
                         + (o2.x * o2.x + o2.y * o2.y) + (o2.z * o2.z + o2.w * o2.w) + (o3.x * o3.x + o3.y * o3.y) + (o3.z * o3.z + o3.w * o3.w); \
                ss += __shfl_xor(ss, 1); ss += __shfl_xor(ss, 2); ss += __shfl_xor(ss, 4); \
                const float rr = 1.0f / sqrtf(ss * (1.0f / 128.0f) + EPS); \
                const size_t tk = (size_t)b * SEQ + (n_) * 32 + pos; const GAS v4u* gp = (const GAS v4u*)(PROJ + tk * DIN + PC_G + h * 128 + vg * 16); const v4u g0 = gp[0], g1 = gp[1]; \
                const float ov[16] = {o0.x, o0.y, o0.z, o0.w, o1.x, o1.y, o1.z, o1.w, o2.x, o2.y, o2.z, o2.w, o3.x, o3.y, o3.z, o3.w}; \
                const float gf[16] = {bf_lo(g0.x), bf_hi(g0.x), bf_lo(g0.y), bf_hi(g0.y), bf_lo(g0.z), bf_hi(g0.z), bf_lo(g0.w), bf_hi(g0.w), bf_lo(g1.x), bf_hi(g1.x), bf_lo(g1.y), bf_hi(g1.y), bf_lo(g1.z), bf_hi(g1.z), bf_lo(g1.w), bf_hi(g1.w)}; \
                float yv[16]; _Pragma("unroll") for (int i = 0; i < 16; ++i) yv[i] = ov[i] * rr * hg_gain[vg * 16 + i] * (gf[i] * sigmoidf_(gf[i])); \
                GAS v4u* mp = (GAS v4u*)(MIX + tk * D + 512 + h * 128 + vg * 16); \
                mp[0] = (v4u){pk2(yv[0], yv[1]), pk2(yv[2], yv[3]), pk2(yv[4], yv[5]), pk2(yv[6], yv[7])}; mp[1] = (v4u){pk2(yv[8], yv[9]), pk2(yv[10], yv[11]), pk2(yv[12], yv[13]), pk2(yv[14], yv[15])}; } while (0)
#define SCAN_BAR() do { asm volatile("s_waitcnt lgkmcnt(0)" ::: "memory"); __builtin_amdgcn_s_barrier(); asm volatile("" ::: "memory"); } while (0)
            if (wave >= 4) {
                SCAN_LOAD(0); SCAN_COMMIT(0);
                SCAN_BAR();
                for (int n = 0; n < 64; ++n) {
                    if (n + 1 < 64) SCAN_LOAD(n + 1);
                    if (n >= 1) SCAN_POST(n - 1);
                    if (n + 1 < 64) SCAN_COMMIT(n + 1);
                    SCAN_BAR();
                }
                SCAN_POST(63);
                SCAN_BAR();
            } else {
                f32x16 S0, S1, S2, S3;
#pragma unroll
                for (int i = 0; i < 16; ++i) { S0[i] = 0.f; S1[i] = 0.f; S2[i] = 0.f; S3[i] = 0.f; }
                SCAN_BAR();
                for (int n = 0; n < 64; ++n) {
                    const LAS unsigned char* Bf = lds + RING_OFF + (n & 1) * BUFB;
                    pg8::bf16x8 qd[8], kd[8], vt[2];
#pragma unroll
                    for (int ks = 0; ks < 8; ++ks) { const int off = r * 256 + (((2 * ks + hh) ^ (r & 15)) * 16); qd[ks] = *(const LAS pg8::bf16x8*)(Bf + off); kd[ks] = *(const LAS pg8::bf16x8*)(Bf + 8192 + off); }
#pragma unroll
                    for (int sp = 0; sp < 2; ++sp) { const int row = 32 * sl + r; vt[sp] = *(const LAS pg8::bf16x8*)(Bf + 24576 + row * 64 + (((2 * sp + hh) ^ ((row >> 2) & 3)) * 16)); }
                    f32x16 X, O;
#pragma unroll
                    for (int i = 0; i < 16; ++i) { X[i] = 0.f; O[i] = 0.f; }
#pragma unroll
                    for (int ks = 0; ks < 8; ++ks) X = __builtin_amdgcn_mfma_f32_32x32x16_bf16(kd[ks], qd[ks], X, 0, 0, 0);
                    O = __builtin_amdgcn_mfma_f32_32x32x16_bf16(qd[0], pack8(S0, 0), O, 0, 0, 0); O = __builtin_amdgcn_mfma_f32_32x32x16_bf16(qd[1], pack8(S0, 1), O, 0, 0, 0);
                    O = __builtin_amdgcn_mfma_f32_32x32x16_bf16(qd[2], pack8(S1, 0), O, 0, 0, 0); O = __builtin_amdgcn_mfma_f32_32x32x16_bf16(qd[3], pack8(S1, 1), O, 0, 0, 0);
                    O = __builtin_amdgcn_mfma_f32_32x32x16_bf16(qd[4], pack8(S2, 0), O, 0, 0, 0); O = __builtin_amdgcn_mfma_f32_32x32x16_bf16(qd[5], pack8(S2, 1), O, 0, 0, 0);
                    O = __builtin_amdgcn_mfma_f32_32x32x16_bf16(qd[6], pack8(S3, 0), O, 0, 0, 0); O = __builtin_amdgcn_mfma_f32_32x32x16_bf16(qd[7], pack8(S3, 1), O, 0, 0, 0);
#pragma unroll
                    for (int i = 0; i < 16; ++i) { const int s_ = (i & 3) + 8 * (i >> 2) + 4 * hh; X[i] = (s_ <= r) ? X[i] : 0.f; }
                    O = __builtin_amdgcn_mfma_f32_32x32x16_bf16(pack8(X, 0), vt[0], O, 0, 0, 0); O = __builtin_amdgcn_mfma_f32_32x32x16_bf16(pack8(X, 1), vt[1], O, 0, 0, 0);
#define SCAN_SUPD(Sx, rt_) do { _Pragma("unroll") for (int sp = 0; sp < 2; ++sp) { const int row = 32 * (rt_) + r; \
                            const pg8::bf16x8 kt = *(const LAS pg8::bf16x8*)(Bf + 16384 + row * 64 + (((2 * sp + hh) ^ ((row >> 2) & 3)) * 16)); \
                            Sx = __builtin_amdgcn_mfma_f32_32x32x16_bf16(kt, vt[sp], Sx, 0, 0, 0); } \
                        _Pragma("unroll") for (int g = 0; g < 4; ++g) { const f32x4 dv = *(const LAS f32x4*)(Bf + 32768 + (32 * (rt_) + 8 * g + 4 * hh) * 4); \
                            Sx[4 * g] *= dv.x; Sx[4 * g + 1] *= dv.y; Sx[4 * g + 2] *= dv.z; Sx[4 * g + 3] *= dv.w; } } while (0)
                    SCAN_SUPD(S0, 0); SCAN_SUPD(S1, 1); SCAN_SUPD(S2, 2); SCAN_SUPD(S3, 3);
                    LAS float* ob = (LAS float*)(lds + RING_OFF + OB0 + (n & 1) * 16384);
#pragma unroll
                    for (int i = 0; i < 16; ++i) ob[((i & 3) + 8 * (i >> 2) + 4 * hh) * 128 + 32 * sl + r] = O[i];
                    SCAN_BAR();
                }
                SCAN_BAR();
            }
        }
        if (BOTH(3)) GRID_BAR();
    }


    if (IN(4)) {
        pg8::Gemm g{MIX, WOT, T, D, D}; pg8::StaticOrder S; S.init(T, D, G, (int)blockIdx.x);
        pg8::EpiResid E{x, X1, SS2};
        pg8::gemm_phase<pg8::EpiResid, pg8::StaticOrder, PG8_ALIGN, PG8_SP2>(lds + RING_OFF, g, S, E);
        if (BOTH(4)) GRID_BAR();
    }

    if (IN(5)) {
        pg8::Gemm g{X1, WQT, T, 2048, D}; pg8::StaticOrder S; S.init(T, 2048, G, (int)blockIdx.x);
        pg8::EpiScaleBf16<1> E{QB, 2048, SS2};
        pg8::gemm_phase<pg8::EpiScaleBf16<1>, pg8::StaticOrder, PG8_ALIGN, PG8_SP2>(lds + RING_OFF, g, S, E);
        if (BOTH(5)) GRID_BAR();
    }

    if (IN(6)) {
        const int r = lane & 31, hh = lane >> 5;
        for (int item = gw; item < (T / 32) * 8; item += NGW) {
            const int h = item & 7, tok = (item >> 3) * 32 + r;
            unsigned L[2][16];
#pragma unroll
            for (int p = 0; p < 2; ++p) {
                pg8::bf16x8 qf[8];
                const GAS pg8::bf16x8* qp = (const GAS pg8::bf16x8*)(QB + (size_t)tok * 2048 + h * 256 + p * 128 + 8 * hh);
#pragma unroll
                for (int ks = 0; ks < 8; ++ks) qf[ks] = qp[2 * ks];
                const GAS pg8::bf16x8* kp = (const GAS pg8::bf16x8*)(KEYB + (size_t)((h * 2 + p) * 128 + r) * 128 + 8 * hh);
                unsigned best[16];
#pragma unroll
                for (int nt = 0; nt < 4; ++nt) {
                    f32x16 acc;
#pragma unroll
                    for (int i = 0; i < 16; ++i) acc[i] = 0.f;
                    const GAS pg8::bf16x8* kb = kp + nt * 512; asm volatile("" : "+v"(kb));
#pragma unroll
                    for (int ks = 0; ks < 8; ++ks) acc = __builtin_amdgcn_mfma_f32_32x32x16_bf16(kb[2 * ks], qf[ks], acc, 0, 0, 0);
                    unsigned cur[16];
#pragma unroll
                    for (int i = 0; i < 16; ++i) { const int n = 32 * nt + (i & 3) + 8 * (i >> 2) + 4 * hh;
                        const float av = acc[i]; unsigned u = __builtin_bit_cast(unsigned, av); u ^= (unsigned)((int)u >> 31) | 0x80000000u;
                        cur[i] = (u & ~0x7Fu) | (unsigned)(127 - n); }
                    sort16_desc(cur);
                    if (nt == 0) {
#pragma unroll
                        for (int i = 0; i < 16; ++i) best[i] = cur[i];
                    } else merge16_desc(best, cur);
                }
                unsigned o[16];
#pragma unroll
                for (int i = 0; i < 16; ++i) o[i] = (unsigned)__shfl_xor((int)best[i], 32);
                merge16_desc(best, o);
#pragma unroll
                for (int i = 0; i < 16; ++i) L[p][i] = best[i];
            }
            float v1[16], v2[16];
#pragma unroll
            for (int j = 0; j < 16; ++j) { v1[j] = unkey(L[0][j] & ~0x7Fu); v2[j] = unkey(L[1][j] & ~0x7Fu); }
            unsigned ct[16];
#pragma unroll
            for (int j = 0; j < 16; ++j) ct[j] = ckey(v1[0] + v2[j], j);
#pragma unroll
            for (int i = 1; i < 16; ++i)
#pragma unroll
                for (int j = 0; j < 16; ++j) if ((i + 1) * (j + 1) <= 16) {
                    unsigned key = ckey(v1[i] + v2[j], i * 16 + j);
#pragma unroll
                    for (int t = 0; t < 16; ++t) { const unsigned mx = ct[t] > key ? ct[t] : key; key = ct[t] > key ? key : ct[t]; ct[t] = mx; }
                }
            float den = 0.f, ex[16]; const float cmax = unkey(ct[0] & ~0xFFu);
#pragma unroll
            for (int t = 0; t < 16; ++t) { ex[t] = __expf(unkey(ct[t] & ~0xFFu) - cmax); den += ex[t]; }
            const float inv = 1.0f / den;
            unsigned b1[4], b2[4];
#pragma unroll
            for (int w = 0; w < 4; ++w) { b1[w] = (L[0][4 * w] & 0x7Fu) | ((L[0][4 * w + 1] & 0x7Fu) << 8) | ((L[0][4 * w + 2] & 0x7Fu) << 16) | ((L[0][4 * w + 3] & 0x7Fu) << 24);
                b2[w] = (L[1][4 * w] & 0x7Fu) | ((L[1][4 * w + 1] & 0x7Fu) << 8) | ((L[1][4 * w + 2] & 0x7Fu) << 16) | ((L[1][4 * w + 3] & 0x7Fu) << 24); }
            unsigned ent[8];
#pragma unroll
            for (int t = 0; t < 8; ++t) { const unsigned hm = 0u - (unsigned)hh;
                const unsigned ck = ct[t] ^ ((ct[t] ^ ct[8 + t]) & hm); const unsigned e0 = __builtin_bit_cast(unsigned, ex[t]), e1 = __builtin_bit_cast(unsigned, ex[8 + t]);
                const float gt = __builtin_bit_cast(float, e0 ^ ((e0 ^ e1) & hm)) * inv;
                const unsigned flat = 255u - (ck & 0xFFu), ii = flat >> 4, jj = flat & 15u;
                const unsigned w1 = (ii & 8u) ? ((ii & 4u) ? b1[3] : b1[2]) : ((ii & 4u) ? b1[1] : b1[0]), w2 = (jj & 8u) ? ((jj & 4u) ? b2[3] : b2[2]) : ((jj & 4u) ? b2[1] : b2[0]);
                const unsigned n1 = 127u - ((w1 >> (8u * (ii & 3u))) & 0x7Fu), n2 = 127u - ((w2 >> (8u * (jj & 3u))) & 0x7Fu);
                ent[t] = (n1 * 128u + n2) | (pkh2(gt, 0.f) << 16); }
            GAS v4u* ep = (GAS v4u*)(EXPT + (size_t)tok * 128 + h * 16 + 8 * hh);
            ep[0] = (v4u){ent[0], ent[1], ent[2], ent[3]}; ep[1] = (v4u){ent[4], ent[5], ent[6], ent[7]};
        }
        if (BOTH(6)) GRID_BAR();
    }


    if (IN(7)) {
        constexpr int NT = 4;
        const unsigned srcl = (unsigned)(32 * (lane & 1) + 16 * ((lane >> 1) & 1)) << 2;
        for (int bt = gw; bt < T / NT; bt += NGW) {
            const int tok0 = bt * NT;
            unsigned e[NT][2]; float rs2[NT];
#pragma unroll
            for (int t = 0; t < NT; ++t) { const unsigned r0 = EXPT[(size_t)(tok0 + t) * 128 + lane], r1 = EXPT[(size_t)(tok0 + t) * 128 + 64 + lane];
                e[t][0] = (r0 << 16) | (r0 >> 16); e[t][1] = (r1 << 16) | (r1 >> 16); sort128_asc(e[t][0], e[t][1], lane);
                rs2[t] = 1.0f / sqrtf(SS2[tok0 + t] * (1.0f / D) + EPS); }
            float ah[2][NT][2];
#define PEER_LOAD(buf, TAB, st_) do { _Pragma("unroll") for (int t = 0; t < NT; ++t) { const unsigned em_ = ((st_) & 16) ? 0xFFFFFFFFu : 0u; const unsigned esel = e[t][0] ^ ((e[t][0] ^ e[t][1]) & em_); \
                _Pragma("unroll") for (int q = 0; q < 4; ++q) { const unsigned id = (unsigned)__builtin_amdgcn_readlane((int)esel, 4 * ((st_) & 15) + q) >> 16; \
                    buf[t][q] = ((const GAS v2u*)(TAB + (size_t)id * D + hf * 512))[lane]; } } } while (0)
#define PEER_DOTS(buf, st_) do { float p[16]; \
                _Pragma("unroll") for (int t = 0; t < NT; ++t) _Pragma("unroll") for (int q = 0; q < 4; ++q) { \
                    const unsigned w0_ = buf[t][q].x, w1_ = buf[t][q].y; const f32x2 c0 = __builtin_amdgcn_cvt_pk_f32_fp8((int)w0_, false), c1 = __builtin_amdgcn_cvt_pk_f32_fp8((int)w0_, true), c2 = __builtin_amdgcn_cvt_pk_f32_fp8((int)w1_, false), c3 = __builtin_amdgcn_cvt_pk_f32_fp8((int)w1_, true); \
                    p[4 * t + q] = (c0.x * hx[t][0] + c0.y * hx[t][1]) + (c1.x * hx[t][2] + c1.y * hx[t][3]) + (c2.x * hx[t][4] + c2.y * hx[t][5]) + (c3.x * hx[t][6] + c3.y * hx[t][7]); } \
                const float red = reduce16(p, lane); const bool hit = (lane >> 2) == ((st_) & 15), hi = ((st_) & 16) != 0; \
                _Pragma("unroll") for (int t = 0; t < NT; ++t) { const float got = __builtin_bit_cast(float, __builtin_amdgcn_ds_bpermute((int)(srcl + (unsigned)((8 * (t & 1) + 4 * (t >> 1)) << 2)), __builtin_bit_cast(int, red))); \
                    ah[hf][t][0] = (hit && !hi) ? got : ah[hf][t][0]; ah[hf][t][1] = (hit && hi) ? got : ah[hf][t][1]; } } while (0)
#pragma unroll
            for (int hf = 0; hf < 2; ++hf) {
                float hx[NT][8];
#pragma unroll
                for (int t = 0; t < NT; ++t) { const v4u xa = __builtin_nontemporal_load((const GAS v4u*)(X1 + (size_t)(tok0 + t) * D + hf * 512) + lane);
                    hx[t][0] = bf_lo(xa.x); hx[t][1] = bf_hi(xa.x); hx[t][2] = bf_lo(xa.y); hx[t][3] = bf_hi(xa.y); hx[t][4] = bf_lo(xa.z); hx[t][5] = bf_hi(xa.z); hx[t][6] = bf_lo(xa.w); hx[t][7] = bf_hi(xa.w);
                    ah[hf][t][0] = 0.f; ah[hf][t][1] = 0.f; }
                v2u ua[NT][4], ubb[NT][4];
                PEER_LOAD(ua, U8, 0);
                for (int st = 0; st < 32; st += 2) {
                    PEER_LOAD(ubb, U8, st + 1);
                    PEER_DOTS(ua, st);
                    if (st + 2 < 32) PEER_LOAD(ua, U8, st + 2);
                    PEER_DOTS(ubb, st + 1);
                }
            }
            float wv[NT][2];
#pragma unroll
            for (int t = 0; t < NT; ++t)
#pragma unroll
                for (int g = 0; g < 2; ++g) { const float a = (ah[0][t][g] + ah[1][t][g]) * (rs2[t] * (1.0f / PEER_SU)); const float gate = (float)h2_of(e[t][g] & 0xFFFFu).x;
                    wv[t][g] = gate * (0.5f / PEER_SV) * a * (1.0f + erff(a * 0.7071067811865476f)); }
            float y[NT][16];
#pragma unroll
            for (int t = 0; t < NT; ++t)
#pragma unroll
                for (int i = 0; i < 16; ++i) y[t][i] = 0.f;
#define PEER_LOADB(buf, st_) do { _Pragma("unroll") for (int t = 0; t < NT; ++t) { const unsigned em_ = ((st_) & 32) ? 0xFFFFFFFFu : 0u; const unsigned esel = e[t][0] ^ ((e[t][0] ^ e[t][1]) & em_); \
                _Pragma("unroll") for (int q = 0; q < 2; ++q) { const unsigned id = (unsigned)__builtin_amdgcn_readlane((int)esel, 2 * ((st_) & 31) + q) >> 16; \
                    buf[t][q] = ((const GAS v2u*)(V8 + (size_t)id * D + hf * 512))[lane]; } } } while (0)
#define PEER_AXPY(buf, st_) do { _Pragma("unroll") for (int t = 0; t < NT; ++t) { const unsigned wm_ = ((st_) & 32) ? 0xFFFFFFFFu : 0u; const unsigned w0_ = __builtin_bit_cast(unsigned, wv[t][0]), w1_ = __builtin_bit_cast(unsigned, wv[t][1]); const unsigned wsel = w0_ ^ ((w0_ ^ w1_) & wm_); \
                _Pragma("unroll") for (int q = 0; q < 2; ++q) { const float wi = __builtin_bit_cast(float, __builtin_amdgcn_readlane((int)wsel, 2 * ((st_) & 31) + q)); \
                    const unsigned w0_ = buf[t][q].x, w1_ = buf[t][q].y; const f32x2 c0 = __builtin_amdgcn_cvt_pk_f32_fp8((int)w0_, false), c1 = __builtin_amdgcn_cvt_pk_f32_fp8((int)w0_, true), c2 = __builtin_amdgcn_cvt_pk_f32_fp8((int)w1_, false), c3 = __builtin_amdgcn_cvt_pk_f32_fp8((int)w1_, true); \
                    y[t][hf * 8 + 0] = fmaf(c0.x, wi, y[t][hf * 8 + 0]); y[t][hf * 8 + 1] = fmaf(c0.y, wi, y[t][hf * 8 + 1]); y[t][hf * 8 + 2] = fmaf(c1.x, wi, y[t][hf * 8 + 2]); y[t][hf * 8 + 3] = fmaf(c1.y, wi, y[t][hf * 8 + 3]); \
                    y[t][hf * 8 + 4] = fmaf(c2.x, wi, y[t][hf * 8 + 4]); y[t][hf * 8 + 5] = fmaf(c2.y, wi, y[t][hf * 8 + 5]); y[t][hf * 8 + 6] = fmaf(c3.x, wi, y[t][hf * 8 + 6]); y[t][hf * 8 + 7] = fmaf(c3.y, wi, y[t][hf * 8 + 7]); } } } while (0)
#pragma unroll
            for (int hf = 0; hf < 2; ++hf) {
                v2u va[NT][2], vbb[NT][2];
                PEER_LOADB(va, 0);
                for (int st = 0; st < 64; st += 2) {
                    PEER_LOADB(vbb, st + 1);
                    PEER_AXPY(va, st);
                    if (st + 2 < 64) PEER_LOADB(va, st + 2);
                    PEER_AXPY(vbb, st + 1);
                }
            }
#pragma unroll
            for (int t = 0; t < NT; ++t) { const size_t tok = (size_t)(tok0 + t);
                const GAS v4u* xr = (const GAS v4u*)(X1 + tok * D); const v4u xa = __builtin_nontemporal_load(xr + lane), xb = __builtin_nontemporal_load(xr + 64 + lane);
                const float xf[16] = {bf_lo(xa.x), bf_hi(xa.x), bf_lo(xa.y), bf_hi(xa.y), bf_lo(xa.z), bf_hi(xa.z), bf_lo(xa.w), bf_hi(xa.w),
                                      bf_lo(xb.x), bf_hi(xb.x), bf_lo(xb.y), bf_hi(xb.y), bf_lo(xb.z), bf_hi(xb.z), bf_lo(xb.w), bf_hi(xb.w)};
                float ss = 0.f;
#pragma unroll
                for (int i = 0; i < 16; ++i) { y[t][i] += xf[i]; ss += y[t][i] * y[t][i]; }
                ss = wave_sum(ss);
                const float r = 1.0f / sqrtf(ss * (1.0f / D) + EPS);
                const GAS f32x4* nfp = (const GAS f32x4*)norm_f; const f32x4 n0 = nfp[2 * lane], n1 = nfp[2 * lane + 1], n2 = nfp[128 + 2 * lane], n3 = nfp[128 + 2 * lane + 1];
                GAS f32x4* op = (GAS f32x4*)(out + tok * D);
                __builtin_nontemporal_store((f32x4){y[t][0] * r * n0.x, y[t][1] * r * n0.y, y[t][2] * r * n0.z, y[t][3] * r * n0.w}, op + 2 * lane);
                __builtin_nontemporal_store((f32x4){y[t][4] * r * n1.x, y[t][5] * r * n1.y, y[t][6] * r * n1.z, y[t][7] * r * n1.w}, op + 2 * lane + 1);
                __builtin_nontemporal_store((f32x4){y[t][8] * r * n2.x, y[t][9] * r * n2.y, y[t][10] * r * n2.z, y[t][11] * r * n2.w}, op + 128 + 2 * lane);
                __builtin_nontemporal_store((f32x4){y[t][12] * r * n3.x, y[t][13] * r * n3.y, y[t][14] * r * n3.z, y[t][15] * r * n3.w}, op + 128 + 2 * lane + 1); }
        }
    }

#undef IN
#undef BOTH
}

extern "C" void kernel_launch(void* const* d_in, const int* in_sizes, int n_in, void* d_out, int out_size, void* d_ws, size_t ws_size, hipStream_t stream) {
    static int grid = 0;
    if (grid == 0) {
        if (n_in != 14 || in_sizes[0] != T * D || out_size != T * D || ws_size < WS_END) { fprintf(stderr, "kernel_launch: unexpected shapes (n_in %d, in0 %d, out %d, ws %zu); nothing launched\n", n_in, n_in > 0 ? in_sizes[0] : -1, out_size, ws_size); grid = -1; return; }
        int dev = 0, cus = 0, per_cu = 0;
        if (hipGetDevice(&dev) != hipSuccess || hipDeviceGetAttribute(&cus, hipDeviceAttributeMultiprocessorCount, dev) != hipSuccess) { grid = -1; return; }
        if (hipFuncSetAttribute((const void*)hymba_fwd, hipFuncAttributeMaxDynamicSharedMemorySize, LDS_BYTES) != hipSuccess) { fprintf(stderr, "kernel_launch: hipFuncSetAttribute failed\n"); grid = -1; return; }
        if (hipOccupancyMaxActiveBlocksPerMultiprocessor(&per_cu, (const void*)hymba_fwd, NWAVES * 64, LDS_BYTES) != hipSuccess || per_cu < 1) { fprintf(stderr, "kernel_launch: occupancy query says %d blocks per CU\n", per_cu); (void)hipGetLastError(); grid = -1; return; }
        grid = cus;
    }
    if (grid < 0) return;
    if (hipMemsetAsync((char*)d_ws + WS_CTL, 0, CTL_ZERO_BYTES, stream) != hipSuccess) { fprintf(stderr, "kernel_launch: hipMemsetAsync failed\n"); return; }
    Args a{};
    for (int i = 0; i < 14; ++i) a.in[i] = (const float*)d_in[i];
    a.out = (float*)d_out; a.ws = (unsigned char*)d_ws;
    if (N_LAUNCHES == 1) {
        a.ph_lo = 0; a.ph_hi = NPHASES; a.li = 0;
        void* kargs[] = {&a};
        const hipError_t e = hipLaunchCooperativeKernel((const void*)hymba_fwd, dim3(grid), dim3(NWAVES * 64), kargs, LDS_BYTES, stream);
        if (e != hipSuccess) fprintf(stderr, "kernel_launch: cooperative launch failed: %s (grid %d)\n", hipGetErrorString(e), grid);
    } else {
        for (int li = 0; li < NPHASES; ++li) {
            a.ph_lo = li; a.ph_hi = li + 1; a.li = li;
            hipLaunchKernelGGL(hymba_fwd, dim3(grid), dim3(NWAVES * 64), LDS_BYTES, stream, a);
            const hipError_t le = hipPeekAtLastError();
            if (le != hipSuccess) { fprintf(stderr, "kernel_launch: launch %d failed: %s\n", li, hipGetErrorName(le)); break; }
        }
    }
}
```

```cpp
#include <hip/hip_runtime.h>
#include <cstdio>
#include <cstdint>
namespace pg8 {
#define PG8_LAS __attribute__((address_space(3)))
typedef unsigned short bf16_t;
typedef short bf16x8 __attribute__((ext_vector_type(8)));
typedef float f32x4 __attribute__((ext_vector_type(4)));
typedef unsigned u32x4 __attribute__((ext_vector_type(4)));
constexpr int BM = 256, BK = 64, HALF = 128, HTB = HALF * BK * 2  , STAGE_BYTES = 8 * HTB, NXCD = 8, WGM = 8;

__host__ __device__ __forceinline__ int lds_byte(int r, int c) { const int st = (r >> 4) * 2 + (c >> 5), rr = r & 15, cc = c & 31, ob = rr * 64 + cc * 2; return st * 1024 + (ob ^ (((ob >> 9) & 1) << 5)); }
__host__ __device__ __forceinline__ void stage_rc(int b, int& R, int& C) { const int st = b / 1024, sb = b % 1024, swz = sb ^ (((sb >> 9) & 1) << 5); R = (st >> 1) * 16 + swz / 64; C = (st & 1) * 32 + (swz % 64) / 2; }
__host__ __device__ __forceinline__ int perm32(int rho) { const int n = rho >> 4, i = rho & 15; return 8 * (i >> 2) + 4 * n + (i & 3); }

struct Unit { int pm, pn; };
struct Gemm { const bf16_t* A; const bf16_t* Bt; int M, N, K; };

struct StaticOrder {
    int nM, nN, nwg, G, c;
    __host__ __device__ void init(int M, int N, int G_, int c_) { nM = M / BM; nN = N / BM; nwg = nM * nN; G = G_; c = c_; }
    __host__ __device__ bool next(int i, Unit& u) const {
        const long L = (long)i * G + c; if (L >= nwg) return false;
        int wgid = (int)L; { const int q = nwg / NXCD, r = nwg % NXCD, xcd = wgid % NXCD, off = wgid / NXCD; wgid = (xcd < r ? xcd * (q + 1) : r * (q + 1) + (xcd - r) * q) + off; }
        const int nig = WGM * nN, gid = wgid / nig, fm = gid * WGM, gsz = (nM - fm) < WGM ? (nM - fm) : WGM;
        u.pm = fm + ((wgid % nig) % gsz); u.pn = (wgid % nig) / gsz; return true;
    }
    __device__ __forceinline__ void a_ready(const Unit&) const {}
    __device__ __forceinline__ void done(const Unit&) const {}
};

__device__ __forceinline__ unsigned cvt_pk_bf16(float lo, float hi) { unsigned r; asm volatile("v_cvt_pk_bf16_f32 %0, %1, %2" : "=v"(r) : "v"(lo), "v"(hi)); return r; }

template <int MODE> struct EpiScaleBf16 {
    static constexpr bool PERM = true, AFTER_DRAIN = false;
    bf16_t* O; int ldc; const float* rowv;
    __device__ __forceinline__ void operator()(const f32x4 (&acc)[2][2][4][2], const Unit& u, int wr, int wc, int fr, int fq) const {
        const int row0 = u.pm * BM + wr * 64 + fr, col0 = u.pn * BM + wc * 32 + 8 * fq;
#pragma unroll
        for (int ai = 0; ai < 2; ++ai)
#pragma unroll
            for (int m = 0; m < 4; ++m) { const int row = row0 + ai * HALF + m * 16; float s = rowv[row]; if (MODE == 1) s = 1.0f / sqrtf(s * (1.0f / 1024.0f) + 1e-6f);
                bf16_t* rowp = O + (size_t)row * ldc + col0;
#pragma unroll
                for (int bj = 0; bj < 2; ++bj) { const f32x4 v0 = acc[ai][bj][m][0] * s, v1 = acc[ai][bj][m][1] * s;
                    u32x4 w; w.x = cvt_pk_bf16(v0[0], v0[1]); w.y = cvt_pk_bf16(v0[2], v0[3]); w.z = cvt_pk_bf16(v1[0], v1[1]); w.w = cvt_pk_bf16(v1[2], v1[3]);
                    *(u32x4*)(rowp + bj * HALF) = w; } }
    }
};
struct EpiResid {
    static constexpr bool PERM = true, AFTER_DRAIN = false;
    const float* X; bf16_t* O; float* ss;
    __device__ __forceinline__ void operator()(const f32x4 (&acc)[2][2][4][2], const Unit& u, int wr, int wc, int fr, int fq) const {
        const int row0 = u.pm * BM + wr * 64 + fr, col0 = u.pn * BM + wc * 32 + 8 * fq;
#pragma unroll
        for (int ai = 0; ai < 2; ++ai)
#pragma unroll
            for (int m = 0; m < 4; ++m) { const int row = row0 + ai * HALF + m * 16; float part = 0.f;
#pragma unroll
                for (int bj = 0; bj < 2; ++bj) { const float* xp = X + (size_t)row * 1024 + col0 + bj * HALF;
                    const f32x4 v0 = acc[ai][bj][m][0] + *(const f32x4*)xp, v1 = acc[ai][bj][m][1] + *(const f32x4*)(xp + 4);
                    part += (v0[0] * v0[0] + v0[1] * v0[1]) + (v0[2] * v0[2] + v0[3] * v0[3]) + (v1[0] * v1[0] + v1[1] * v1[1]) + (v1[2] * v1[2] + v1[3] * v1[3]);
                    u32x4 w; w.x = cvt_pk_bf16(v0[0], v0[1]); w.y = cvt_pk_bf16(v0[2], v0[3]); w.z = cvt_pk_bf16(v1[0], v1[1]); w.w = cvt_pk_bf16(v1[2], v1[3]);
                    *(u32x4*)(O + (size_t)row * 1024 + col0 + bj * HALF) = w; }
                part += __shfl_xor(part, 16); part += __shfl_xor(part, 32);
                if (fq == 0) (void)__builtin_amdgcn_global_atomic_fadd_f32((__attribute__((address_space(1))) float*)(ss + row), part); }
    }
};

template <class Epi, class Sched, bool ALIGN_EPI = false, bool SP2 = false>
__device__ __forceinline__ void gemm_phase(PG8_LAS unsigned char* lds, const Gemm g, const Sched& S, const Epi& E) {
    const int tid = threadIdx.x, wid = __builtin_amdgcn_readfirstlane(tid >> 6), lane = tid & 63, wr = wid >> 2, wc = wid & 3, fr = lane & 15, fq = lane >> 4;
    const int K = g.K, nt = K / BK;
    unsigned voffA[2], voffB[2];
#pragma unroll
    for (int i = 0; i < 2; ++i) { int R, C; stage_rc(tid * 16 + i * 8192, R, C); const int Rb = Epi::PERM ? ((R & ~31) + perm32(R & 31)) : R;
        voffA[i] = (unsigned)(R * K + C) * 2u; voffB[i] = (unsigned)(Rb * K + C) * 2u; }
    const size_t kstep = (size_t)(BK * 2);
    const size_t hstep = (size_t)HALF * K * 2;
    const size_t tstep = 2 * hstep;
    const unsigned ldsw = (unsigned)wid * 1024u;
    const int aoff = lds_byte(wr * 64 + fr, fq * 8), boff = lds_byte(wc * 32 + fr, fq * 8);
#define PG8_SA(b, h) (((b) * 2 + (h)) * HTB)
#define PG8_SB(b, h) ((4 + (b) * 2 + (h)) * HTB)
#define PG8_STAGE(bufoff, gbase, voff) do { _Pragma("unroll") for (int _i = 0; _i < 2; ++_i) \
        __builtin_amdgcn_global_load_lds((const unsigned*)((const char*)(gbase) + (voff)[_i]), (PG8_LAS unsigned*)(lds + (bufoff) + ldsw + _i * 8192), 16, 0, 0); } while (0)
#define PG8_LDA(dst, b, h) do { _Pragma("unroll") for (int m = 0; m < 4; ++m) _Pragma("unroll") for (int k = 0; k < 2; ++k) dst[m][k] = *(const PG8_LAS bf16x8*)(lds + PG8_SA(b, h) + aoff + m * 2048 + k * 1024); } while (0)
#define PG8_LDB(dst, b, h) do { _Pragma("unroll") for (int n = 0; n < 2; ++n) _Pragma("unroll") for (int k = 0; k < 2; ++k) dst[n][k] = *(const PG8_LAS bf16x8*)(lds + PG8_SB(b, h) + boff + n * 2048 + k * 1024); } while (0)
#define PG8_MMA(ai, bj, At, Bt) do { __builtin_amdgcn_s_setprio(1); _Pragma("unroll") for (int m = 0; m < 4; ++m) _Pragma("unroll") for (int n = 0; n < 2; ++n) _Pragma("unroll") for (int k = 0; k < 2; ++k) \
        acc[ai][bj][m][n] = __builtin_amdgcn_mfma_f32_16x16x32_bf16(Bt[n][k], At[m][k], acc[ai][bj][m][n], 0, 0, 0); __builtin_amdgcn_s_setprio(0); } while (0)
#define PG8_WAIT_V(n) asm volatile("s_waitcnt vmcnt(" #n ")" ::: "memory")
#define PG8_WAIT_L(n) asm volatile("s_waitcnt lgkmcnt(" #n ")" ::: "memory")
#define PG8_BAR __builtin_amdgcn_s_barrier()
#define PG8_SCHED __builtin_amdgcn_sched_barrier(0)
    Unit cur, nxt; int ui = 0;
    if (!S.next(0, cur)) return;
    f32x4 acc[2][2][4][2];
#pragma unroll
    for (int a = 0; a < 2; ++a)
#pragma unroll
        for (int b = 0; b < 2; ++b)
#pragma unroll
            for (int m = 0; m < 4; ++m)
#pragma unroll
                for (int n = 0; n < 2; ++n) acc[a][b][m][n] = (f32x4){0.f, 0.f, 0.f, 0.f};
    bf16x8 At[4][2], B0[2][2], B1[2][2];
    const char* cA = (const char*)g.A + (size_t)cur.pm * tstep; const char* cB = (const char*)g.Bt + (size_t)cur.pn * tstep;
    S.a_ready(cur);
    if constexpr (SP2) {
        PG8_STAGE(PG8_SB(0, 0), cB, voffB); PG8_STAGE(PG8_SB(0, 1), cB + hstep, voffB); PG8_STAGE(PG8_SA(0, 0), cA, voffA); PG8_STAGE(PG8_SA(0, 1), cA + hstep, voffA);
        if (wr == 1) PG8_BAR;
        PG8_WAIT_V(2); PG8_BAR;
        PG8_STAGE(PG8_SB(1, 0), cB + kstep, voffB); PG8_STAGE(PG8_SA(1, 0), cA + kstep, voffA); PG8_STAGE(PG8_SB(1, 1), cB + hstep + kstep, voffB);
        PG8_WAIT_V(6); PG8_BAR;
    } else {
        PG8_STAGE(PG8_SB(0, 0), cB, voffB); PG8_STAGE(PG8_SA(0, 0), cA, voffA); PG8_STAGE(PG8_SB(0, 1), cB + hstep, voffB); PG8_STAGE(PG8_SA(0, 1), cA + hstep, voffA);
        if (wr == 1) PG8_BAR;
        PG8_WAIT_V(4); PG8_BAR;
        PG8_STAGE(PG8_SB(1, 0), cB + kstep, voffB); PG8_STAGE(PG8_SA(1, 0), cA + kstep, voffA); PG8_STAGE(PG8_SB(1, 1), cB + hstep + kstep, voffB);
        PG8_WAIT_V(6); PG8_BAR;
    }
    for (;;) {
        const bool has_next = S.next(ui + 1, nxt);
        const char* nA = has_next ? (const char*)g.A + (size_t)nxt.pm * tstep : cA; const char* nB = has_next ? (const char*)g.Bt + (size_t)nxt.pn * tstep : cB;
        for (int t = 0; t < nt; t += 2) {
            const bool last = (t == nt - 2);
            const char* a1 = cA + (size_t)(t + 1) * kstep;
            const char* a2 = last ? nA : cA + (size_t)(t + 2) * kstep; const char* b2 = last ? nB : cB + (size_t)(t + 2) * kstep;
            const char* a3 = a2 + kstep; const char* b3 = b2 + kstep;
            if (last && has_next) S.a_ready(nxt);
            if constexpr (SP2) {
            PG8_LDB(B0, 0, 0); PG8_LDB(B1, 0, 1); PG8_SCHED; PG8_LDA(At, 0, 0); PG8_STAGE(PG8_SA(1, 1), a1 + hstep, voffA);
            PG8_WAIT_V(8); PG8_WAIT_L(0); PG8_BAR; PG8_MMA(0, 0, At, B0); PG8_MMA(0, 1, At, B1); PG8_BAR; PG8_SCHED;
            PG8_LDA(At, 0, 1); PG8_STAGE(PG8_SB(0, 0), b2, voffB); PG8_STAGE(PG8_SB(0, 1), b2 + hstep, voffB); PG8_STAGE(PG8_SA(0, 0), a2, voffA);
            PG8_WAIT_V(8); PG8_WAIT_L(0); PG8_BAR; PG8_MMA(1, 0, At, B0); PG8_MMA(1, 1, At, B1); PG8_BAR; PG8_SCHED;
            PG8_LDB(B0, 1, 0); PG8_LDB(B1, 1, 1); PG8_SCHED; PG8_LDA(At, 1, 0); PG8_STAGE(PG8_SA(0, 1), a2 + hstep, voffA);
            PG8_WAIT_V(8); PG8_WAIT_L(0); PG8_BAR; PG8_MMA(0, 0, At, B0); PG8_MMA(0, 1, At, B1); PG8_BAR; PG8_SCHED;
            PG8_LDA(At, 1, 1); PG8_STAGE(PG8_SB(1, 0), b3, voffB); PG8_STAGE(PG8_SB(1, 1), b3 + hstep, voffB); PG8_STAGE(PG8_SA(1, 0), a3, voffA);
            PG8_WAIT_V(8); PG8_WAIT_L(0); PG8_BAR; PG8_MMA(1, 0, At, B0); PG8_MMA(1, 1, At, B1); PG8_BAR; PG8_SCHED;
            } else {
            PG8_LDB(B0, 0, 0); PG8_SCHED; PG8_LDA(At, 0, 0); PG8_STAGE(PG8_SA(1, 1), a1 + hstep, voffA);
            PG8_WAIT_L(8); PG8_BAR; PG8_WAIT_L(0); PG8_MMA(0, 0, At, B0); PG8_BAR; PG8_SCHED;
            PG8_LDB(B1, 0, 1); PG8_STAGE(PG8_SB(0, 0), b2, voffB);
            PG8_BAR; PG8_WAIT_L(0); PG8_MMA(0, 1, At, B1); PG8_BAR;
            PG8_LDA(At, 0, 1); PG8_STAGE(PG8_SA(0, 0), a2, voffA);
            PG8_BAR; PG8_WAIT_L(0); PG8_MMA(1, 0, At, B0); PG8_BAR; PG8_SCHED;
            PG8_STAGE(PG8_SB(0, 1), b2 + hstep, voffB);
            PG8_WAIT_V(6); PG8_BAR; PG8_MMA(1, 1, At, B1); PG8_BAR;
            PG8_LDB(B0, 1, 0); PG8_SCHED; PG8_LDA(At, 1, 0); PG8_STAGE(PG8_SA(0, 1), a2 + hstep, voffA);
            PG8_WAIT_L(8); PG8_BAR; PG8_WAIT_L(0); PG8_MMA(0, 0, At, B0); PG8_BAR; PG8_SCHED;
            PG8_LDB(B1, 1, 1); PG8_STAGE(PG8_SB(1, 0), b3, voffB);
            PG8_BAR; PG8_WAIT_L(0); PG8_MMA(0, 1, At, B1); PG8_BAR;
            PG8_LDA(At, 1, 1); PG8_STAGE(PG8_SA(1, 0), a3, voffA);
            PG8_BAR; PG8_WAIT_L(0); PG8_MMA(1, 0, At, B0); PG8_BAR; PG8_SCHED;
            PG8_STAGE(PG8_SB(1, 1), b3 + hstep, voffB);
            PG8_WAIT_V(6); PG8_BAR; PG8_MMA(1, 1, At, B1); PG8_BAR;
            }
        }
        if constexpr (ALIGN_EPI) { if (wr == 0) PG8_BAR; }
        if constexpr (!Epi::AFTER_DRAIN) { E(acc, cur, wr, wc, fr, fq); S.done(cur); }
        if (!has_next) break;
#pragma unroll
        for (int a = 0; a < 2; ++a)
#pragma unroll
            for (int b = 0; b < 2; ++b)
#pragma unroll
                for (int m = 0; m < 4; ++m)
#pragma unroll
                    for (int n = 0; n < 2; ++n) acc[a][b][m][n] = (f32x4){0.f, 0.f, 0.f, 0.f};
        cur = nxt; cA = nA; cB = nB; ++ui;
        if constexpr (ALIGN_EPI) { if (wr == 1) PG8_BAR; }
    }
    PG8_WAIT_V(0);
    if constexpr (!ALIGN_EPI) { if (wr == 0) PG8_BAR; }
    PG8_BAR;
    if constexpr (Epi::AFTER_DRAIN) { E.fused(acc, cur, wr, wc, fr, fq, lds, wid, lane); S.done(cur); }
#undef PG8_SA
#undef PG8_SB
#undef PG8_STAGE
#undef PG8_LDA
#undef PG8_LDB
#undef PG8_MMA
#undef PG8_WAIT_V
#undef PG8_WAIT_L
#undef PG8_BAR
#undef PG8_SCHED
}
}

#ifndef PG8_SP2
#define PG8_SP2 true
#endif
#ifndef PG8_ALIGN
#define PG8_ALIGN true
#endif
#ifndef MK_N_LAUNCHES
#define MK_N_LAUNCHES 1
#endif
constexpr int NWAVES = 8;
constexpr int NPHASES = 8;
constexpr int N_LAUNCHES = MK_N_LAUNCHES;

constexpr int NB = 32, SEQ = 2048, T = NB * SEQ, D = 1024, DIN = 3584;
constexpr int PC_C = 0, PC_H = 512, PC_B = 1024, PC_Q = 1536, PC_F = 2048, PC_V = 2560, PC_G = 3072;
constexpr int NEXP = 16384;
constexpr float EPS = 1e-6f;
constexpr float PEER_SU = 1024.0f, PEER_SV = 64.0f;

constexpr size_t MiB = 1u << 20;
constexpr size_t WS_CTL = 0, CTL_ZERO_BYTES = 1 * MiB;
constexpr size_t WS_W1T = 2 * MiB, WS_WOT = 10 * MiB, WS_WQT = 12 * MiB, WS_RS1 = 16 * MiB, WS_SS2 = 17 * MiB;
constexpr size_t WS_KEYB = 18 * MiB;
constexpr size_t WS_U16 = 32 * MiB, WS_V16 = 64 * MiB, WS_EXP = 96 * MiB;
constexpr size_t WS_XB = 128 * MiB;
constexpr size_t WS_X1 = 256 * MiB;
constexpr size_t WS_PROJ = 384 * MiB;
constexpr size_t WS_F = 832 * MiB;
constexpr size_t WS_END = 960 * MiB;
constexpr int CW_BAR = 4096;

constexpr int RING_OFF = 0, RING_BYTES = 131072;
constexpr int LDSCTL_OFF = RING_BYTES, MISC_OFF = LDSCTL_OFF + 320;
constexpr int LDS_BYTES = 147456;

#define GAS __attribute__((address_space(1)))
#define LAS __attribute__((address_space(3)))
typedef unsigned short bf16;
typedef unsigned v4u __attribute__((ext_vector_type(4)));
typedef unsigned v2u __attribute__((ext_vector_type(2)));
typedef float f32x4 __attribute__((ext_vector_type(4)));
typedef float f32x2 __attribute__((ext_vector_type(2)));
typedef _Float16 h2_t __attribute__((ext_vector_type(2)));
typedef GAS unsigned gu32;
#define RLX_AGENT __ATOMIC_RELAXED, __HIP_MEMORY_SCOPE_AGENT
#define LDS_WAIT() asm volatile("s_waitcnt lgkmcnt(0)" ::: "memory")
#define VM_WAIT() asm volatile("s_waitcnt vmcnt(0)" ::: "memory")
__device__ __forceinline__ unsigned f2bf(float f) { unsigned u = __builtin_bit_cast(unsigned, f); return (u + 0x7fffu + ((u >> 16) & 1u)) >> 16; }
__device__ __forceinline__ unsigned pk2(float lo, float hi) { return f2bf(lo) | (f2bf(hi) << 16); }
__device__ __forceinline__ float bf_lo(unsigned w) { return __builtin_bit_cast(float, w << 16); }
__device__ __forceinline__ float bf_hi(unsigned w) { return __builtin_bit_cast(float, w & 0xffff0000u); }
__device__ __forceinline__ float bf1(bf16 v) { return __builtin_bit_cast(float, (unsigned)v << 16); }
__device__ __forceinline__ unsigned pkh2(float lo, float hi) { f32x2 v = {lo, hi}; h2_t h = __builtin_convertvector(v, h2_t); return __builtin_bit_cast(unsigned, h); }
__device__ __forceinline__ h2_t h2_of(unsigned w) { return __builtin_bit_cast(h2_t, w); }
__device__ __forceinline__ float wave_sum(float v) {
#pragma unroll
    for (int o = 1; o < 64; o <<= 1) v += __shfl_xor(v, o);
    return v;
}
typedef float f32x16 __attribute__((ext_vector_type(16)));
typedef __bf16 bf16x2_t __attribute__((ext_vector_type(2)));
__device__ __forceinline__ unsigned cvtpk(float lo, float hi) { f32x2 v = {lo, hi}; bf16x2_t b = __builtin_convertvector(v, bf16x2_t); return __builtin_bit_cast(unsigned, b); }
__device__ __forceinline__ pg8::bf16x8 pack8(const f32x16& x, int s) {
    v4u p; p.x = cvtpk(x[8 * s], x[8 * s + 1]); p.y = cvtpk(x[8 * s + 2], x[8 * s + 3]); p.z = cvtpk(x[8 * s + 4], x[8 * s + 5]); p.w = cvtpk(x[8 * s + 6], x[8 * s + 7]);
    return __builtin_bit_cast(pg8::bf16x8, p); }
__device__ __forceinline__ void ce_desc(unsigned& a, unsigned& b) { const unsigned mx = a > b ? a : b, mn = a > b ? b : a; a = mx; b = mn; }
__device__ __forceinline__ void sort16_desc(unsigned (&a)[16]) {
#pragma unroll
    for (int k = 2; k <= 16; k <<= 1)
#pragma unroll
        for (int j = k >> 1; j > 0; j >>= 1)
#pragma unroll
            for (int i = 0; i < 16; ++i) { const int l = i ^ j; if (l > i) { if ((i & k) == 0) ce_desc(a[i], a[l]); else ce_desc(a[l], a[i]); } }
}
__device__ __forceinline__ void merge16_desc(unsigned (&a)[16], const unsigned (&b)[16]) {
#pragma unroll
    for (int i = 0; i < 16; ++i) a[i] = a[i] > b[15 - i] ? a[i] : b[15 - i];
#pragma unroll
    for (int j = 8; j > 0; j >>= 1)
#pragma unroll
        for (int i = 0; i < 16; ++i) { const int l = i ^ j; if (l > i) ce_desc(a[i], a[l]); }
}
__device__ __forceinline__ float unkey(unsigned a) { a = (a & 0x80000000u) ? (a & 0x7FFFFFFFu) : ~a; return __builtin_bit_cast(float, a); }
__device__ __forceinline__ unsigned ckey(float s, int flat) { unsigned u = __builtin_bit_cast(unsigned, s); u ^= (unsigned)((int)u >> 31) | 0x80000000u; return (u & ~0xFFu) | (unsigned)(255 - flat); }
__device__ __forceinline__ void sort128_asc(unsigned& k0, unsigned& k1, int lane) {
#pragma unroll
    for (int k = 2; k <= 128; k <<= 1)
#pragma unroll
        for (int j = k >> 1; j > 0; j >>= 1) {
            if (j == 64) { const unsigned mn = k0 < k1 ? k0 : k1, mx = k0 < k1 ? k1 : k0; k0 = mn; k1 = mx; }
            else {
                const unsigned p0 = (unsigned)__shfl_xor((int)k0, j), p1 = (unsigned)__shfl_xor((int)k1, j);
                const bool lower = (lane & j) == 0;
                const bool up0 = (k == 128) ? true : (k == 64 ? true : ((lane & k) == 0));
                const bool up1 = (k == 128) ? true : (k == 64 ? false : ((lane & k) == 0));
                const unsigned mn0 = k0 < p0 ? k0 : p0, mx0 = k0 < p0 ? p0 : k0, mn1 = k1 < p1 ? k1 : p1, mx1 = k1 < p1 ? p1 : k1;
                k0 = (lower == up0) ? mn0 : mx0; k1 = (lower == up1) ? mn1 : mx1;
            }
        }
}
__device__ __forceinline__ float swap32_add(float a, float b) { const v2u r = __builtin_amdgcn_permlane32_swap(__builtin_bit_cast(unsigned, a), __builtin_bit_cast(unsigned, b), false, false);
    const unsigned rx = r.x, ry = r.y; return __builtin_bit_cast(float, rx) + __builtin_bit_cast(float, ry); }
__device__ __forceinline__ float swap16_add(float a, float b) { const v2u r = __builtin_amdgcn_permlane16_swap(__builtin_bit_cast(unsigned, a), __builtin_bit_cast(unsigned, b), false, false);
    const unsigned rx = r.x, ry = r.y; return __builtin_bit_cast(float, rx) + __builtin_bit_cast(float, ry); }
template <int CTRL> __device__ __forceinline__ float dpp_f(float v) { return __builtin_bit_cast(float, __builtin_amdgcn_update_dpp(0, __builtin_bit_cast(int, v), CTRL, 0xF, 0xF, false)); }
__device__ __forceinline__ float reduce16(const float (&p)[16], int lane) {
    float q[8], r[4], u[2];
    const bool b3 = (lane & 8) != 0, b2 = (lane & 4) != 0;
#pragma unroll
    for (int i = 0; i < 8; ++i) q[i] = swap32_add(p[2 * i], p[2 * i + 1]);
#pragma unroll
    for (int i = 0; i < 4; ++i) r[i] = swap16_add(q[2 * i], q[2 * i + 1]);
#pragma unroll
    for (int i = 0; i < 2; ++i) { const float keep = b3 ? r[2 * i + 1] : r[2 * i], send = b3 ? r[2 * i] : r[2 * i + 1]; u[i] = keep + dpp_f<0x128>(send); }
    const float keep = b2 ? u[1] : u[0], send = b2 ? u[0] : u[1];
    float v = keep + __shfl_xor(send, 4);
    v += dpp_f<0x4E>(v);
    v += dpp_f<0xB1>(v);
    return v;
}
__device__ __forceinline__ int swap23(int k) { return (k & ~12) | ((k & 4) << 1) | ((k & 8) >> 1); }
__device__ __forceinline__ float sigmoidf_(float x) { return 1.0f / (1.0f + __expf(-x)); }

#define XB_TMO      128
#define XB_XCNT(j)  (256  + 64 * (j))
#define XB_XSUB(j)  (1280 + 64 * (j))
#define XB_XGEN(j)  (2304 + 64 * (j))
#define XB_TOP      3328
#define XB_TOPGEN   3392
#define XCD_BAR_WORDS 3456
#define XB_SPIN_CAP (1u << 18)

__device__ __forceinline__ unsigned xb_ld(unsigned* p)              { return __hip_atomic_load(p, __ATOMIC_RELAXED, __HIP_MEMORY_SCOPE_AGENT); }
__device__ __forceinline__ unsigned xb_add(unsigned* p, unsigned v) { return __hip_atomic_fetch_add(p, v, __ATOMIC_RELAXED, __HIP_MEMORY_SCOPE_AGENT); }
__device__ __forceinline__ unsigned xb_xcc_id() { return (unsigned)__builtin_amdgcn_s_getreg((3 << 11) | 20) & 0xFu; }
#define XB_SPIN(cond, bar) do { unsigned _sp = 0; while (cond) { __builtin_amdgcn_s_sleep(1); \
    if ((++_sp & 255u) == 0u) { if (xb_ld(&(bar)[XB_TMO])) break; if (_sp > XB_SPIN_CAP) { atomicAdd(&(bar)[XB_TMO], 1u); break; } } } } while (0)

struct XcdBarrier {
    unsigned* bar; unsigned x;
    volatile LAS unsigned* st;
};

__device__ __forceinline__ XcdBarrier xcd_barrier_post(unsigned* bar, volatile LAS unsigned* st) {
    XcdBarrier b; b.bar = bar; b.x = xb_xcc_id(); b.st = st;
    if (threadIdx.x == 0) (void)xb_add(&bar[XB_XCNT(b.x)], 1u);
    return b;
}
__device__ __forceinline__ void xcd_barrier_complete(unsigned* bar, unsigned x, unsigned& nloc, unsigned& nx) {
    const unsigned G = gridDim.x * gridDim.y * gridDim.z;
    unsigned sum, cnt, mine, sp = 0u;
    for (;;) {
        sum = 0u; cnt = 0u; mine = 0u;
#pragma unroll
        for (unsigned j = 0; j < 16; ++j) { const unsigned c = xb_ld(&bar[XB_XCNT(j)]); sum += c; cnt += (c > 0u) ? 1u : 0u; mine = (j == x) ? c : mine; }
        if (sum == G) break;
        __builtin_amdgcn_s_sleep(1);
        if ((++sp & 255u) == 0u) { if (xb_ld(&bar[XB_TMO])) break; if (sp > XB_SPIN_CAP) { atomicAdd(&bar[XB_TMO], 1u); break; } }
    }
    nloc = mine > 0u ? mine : 1u; nx = cnt > 0u ? cnt : 1u;
}

__device__ __forceinline__ void xcd_barrier(const XcdBarrier& b) {
    asm volatile("s_waitcnt vmcnt(0)" ::: "memory");
    __syncthreads();
    if (threadIdx.x == 0) {
        unsigned* bar = b.bar;
        __builtin_amdgcn_s_waitcnt(0);
        unsigned nloc = b.st[0], nx = b.st[1];
        if (nloc == 0u) { xcd_barrier_complete(bar, b.x, nloc, nx); b.st[0] = nloc; b.st[1] = nx; }
        const unsigned old = xb_add(&bar[XB_XSUB(b.x)], 1u);
        const unsigned gen = old / nloc;
        if (old + 1u == (gen + 1u) * nloc) {
            __builtin_amdgcn_fence(__ATOMIC_RELEASE, "agent");
            asm volatile("s_waitcnt vmcnt(0)" ::: "memory");
            const unsigned og = xb_add(&bar[XB_TOP], 1u);
            const unsigned tg = og / nx;
            if (og + 1u == (tg + 1u) * nx) xb_add(&bar[XB_TOPGEN], 1u);
            else XB_SPIN(xb_ld(&bar[XB_TOPGEN]) == tg, bar);
            __builtin_amdgcn_fence(__ATOMIC_ACQUIRE, "agent");
            xb_add(&bar[XB_XGEN(b.x)], 1u);
            asm volatile("s_waitcnt vmcnt(0)" ::: "memory");
        } else {
            XB_SPIN(xb_ld(&bar[XB_XGEN(b.x)]) == gen, bar);
            __builtin_amdgcn_fence(__ATOMIC_ACQUIRE, "agent");
            asm volatile("s_waitcnt vmcnt(0)" ::: "memory");
        }
    }
    __syncthreads();
}


__device__ __forceinline__ void p0_transpose_item(const float* W, int K, int N, const float* gain, bf16* WT, LAS float* scr, int item, int lane) {
    const int nblk = N / 32, kb = item / nblk, nb = item % nblk, k0 = 64 * kb, n0 = 32 * nb;
#pragma unroll 8
    for (int i = 0; i < 32; ++i) { const int kk = 2 * i + (lane >> 5); const float g = gain ? gain[k0 + kk] : 1.0f; scr[kk * 33 + (lane & 31)] = W[(size_t)(k0 + kk) * N + n0 + (lane & 31)] * g; }
    LDS_WAIT(); asm volatile("" ::: "memory");
    const int c = lane & 7;
#pragma unroll
    for (int j = 0; j < 4; ++j) { const int n = (lane >> 3) + 8 * j; const LAS float* s = scr + (8 * c) * 33 + n;
        v4u o; o.x = pk2(s[0 * 33], s[1 * 33]); o.y = pk2(s[2 * 33], s[3 * 33]); o.z = pk2(s[4 * 33], s[5 * 33]); o.w = pk2(s[6 * 33], s[7 * 33]);
        *(GAS v4u*)(WT + (size_t)(n0 + n) * K + k0 + 8 * c) = o; }
    LDS_WAIT(); asm volatile("" ::: "memory");
}

struct Args { const float* in[14]; float* out; unsigned char* ws; int ph_lo, ph_hi, li, pad; };

__global__ void __launch_bounds__(NWAVES * 64, 2) hymba_fwd(Args args) {
    extern __shared__ __attribute__((aligned(16))) unsigned char lds_raw[];
    LAS unsigned char* lds = (LAS unsigned char*)lds_raw;
    volatile LAS unsigned* MISC = (volatile LAS unsigned*)(lds + MISC_OFF);
    const int tid = threadIdx.x, lane = tid & 63, wave = __builtin_amdgcn_readfirstlane(tid >> 6);
    const int G = gridDim.x;
    const int gw = (int)blockIdx.x * NWAVES + wave, NGW = G * NWAVES;
    unsigned char* ws = args.ws;
    gu32* ctl = (gu32*)(ws + WS_CTL);
    const float* x = args.in[0]; const float* norm_mix = args.in[1]; const float* w_in = args.in[2]; const float* conv_w = args.in[3]; const float* conv_gain = args.in[4];
    const float* hg_lb = args.in[5]; const float* hg_gain = args.in[6]; const float* w_out = args.in[7]; const float* norm_ffn = args.in[8]; const float* peer_wq = args.in[9];
    const float* peer_keys = args.in[10]; const float* peer_u = args.in[11]; const float* peer_v = args.in[12]; const float* norm_f = args.in[13];
    float* out = args.out;
    bf16* W1T = (bf16*)(ws + WS_W1T); bf16* WOT = (bf16*)(ws + WS_WOT); bf16* WQT = (bf16*)(ws + WS_WQT);
    float* RS1 = (float*)(ws + WS_RS1); float* SS2 = (float*)(ws + WS_SS2);
    unsigned char* U8 = ws + WS_U16; unsigned char* V8 = ws + WS_V16; unsigned* EXPT = (unsigned*)(ws + WS_EXP); bf16* KEYB = (bf16*)(ws + WS_KEYB);
    bf16* XB = (bf16*)(ws + WS_XB); bf16* MIX = (bf16*)(ws + WS_XB); bf16* X1 = (bf16*)(ws + WS_X1);
    bf16* PROJ = (bf16*)(ws + WS_PROJ); bf16* QB = (bf16*)(ws + WS_PROJ); float* DEC = (float*)(ws + WS_F); bf16* KDT = (bf16*)(ws + WS_X1); bf16* VTT = (bf16*)(ws + WS_X1 + 64 * MiB);

    for (int u = tid; u < (LDS_BYTES - LDSCTL_OFF) / 4; u += NWAVES * 64) ((LAS unsigned*)(lds + LDSCTL_OFF))[u] = 0u;
    __syncthreads();
    XcdBarrier bar; bar.bar = (unsigned*)(ctl + CW_BAR); bar.x = 0; bar.st = nullptr;
    if (N_LAUNCHES == 1) bar = xcd_barrier_post((unsigned*)(ctl + CW_BAR), MISC + 8);
#define GRID_BAR() do { if (N_LAUNCHES == 1) xcd_barrier(bar); } while (0)
    const int lo = args.ph_lo, hi = args.ph_hi;
#define IN(k) (lo <= (k) && (k) < hi)
#define BOTH(k) (IN(k) && IN((k) + 1))

    if (IN(0)) {
        LAS float* scr = (LAS float*)(lds + RING_OFF + wave * 16384);
        constexpr int I_1 = (D / 64) * (DIN / 32), I_O = (D / 64) * (D / 32), I_Q = (D / 64) * (2048 / 32);
        for (int it = gw; it < I_1 + I_O + I_Q; it += NGW) {
            int r = it;
            if (r < I_1) { p0_transpose_item(w_in, D, DIN, norm_mix, W1T, scr, r, lane); continue; } r -= I_1;
            if (r < I_O) { p0_transpose_item(w_out, D, D, nullptr, WOT, scr, r, lane); continue; } r -= I_O;
            p0_transpose_item(peer_wq, D, 2048, norm_ffn, WQT, scr, r, lane);
        }
        for (int m = gw; m < T; m += NGW) {
            const GAS f32x4* xr = (const GAS f32x4*)(x + (size_t)m * D) + lane; f32x4 v[4]; float s = 0.f;
#pragma unroll
            for (int j = 0; j < 4; ++j) { v[j] = xr[64 * j]; s += (v[j].x * v[j].x + v[j].y * v[j].y) + (v[j].z * v[j].z + v[j].w * v[j].w); }
            s = wave_sum(s);
            if (lane == 0) RS1[m] = 1.0f / sqrtf(s * (1.0f / D) + EPS);
            GAS unsigned long long* o8 = (GAS unsigned long long*)(XB + (size_t)m * D) + lane;
#pragma unroll
            for (int j = 0; j < 4; ++j) o8[64 * j] = (unsigned long long)pk2(v[j].x, v[j].y) | ((unsigned long long)pk2(v[j].z, v[j].w) << 32);
        }
        for (int r = gw; r < 2 * NEXP; r += NGW) {
            const int tb = r / NEXP, e = r % NEXP; const float sc = tb ? PEER_SV : PEER_SU;
            const GAS f32x4* src = (const GAS f32x4*)((tb ? peer_v : peer_u) + (size_t)e * D);
            f32x4 v[4] = {src[2 * lane], src[2 * lane + 1], src[128 + 2 * lane], src[128 + 2 * lane + 1]};
            if (!tb) { const GAS f32x4* gp = (const GAS f32x4*)norm_ffn; v[0] = v[0] * gp[2 * lane]; v[1] = v[1] * gp[2 * lane + 1]; v[2] = v[2] * gp[128 + 2 * lane]; v[3] = v[3] * gp[128 + 2 * lane + 1]; }
            unsigned o[4];
#pragma unroll
            for (int j = 0; j < 4; ++j) { f32x4 w = v[j] * sc; w.x = fminf(fmaxf(w.x, -240.f), 240.f); w.y = fminf(fmaxf(w.y, -240.f), 240.f); w.z = fminf(fmaxf(w.z, -240.f), 240.f); w.w = fminf(fmaxf(w.w, -240.f), 240.f);
                int pk = 0; pk = __builtin_amdgcn_cvt_pk_fp8_f32(w.x, w.y, pk, false); pk = __builtin_amdgcn_cvt_pk_fp8_f32(w.z, w.w, pk, true); o[j] = (unsigned)pk; }
            ((GAS v4u*)((tb ? V8 : U8) + (size_t)e * D))[lane] = (v4u){o[0], o[1], o[2], o[3]};
        }
        for (int i = (int)blockIdx.x * NWAVES * 64 + tid; i < T; i += G * NWAVES * 64) SS2[i] = 0.f;
        for (int i = (int)blockIdx.x * NWAVES * 64 + tid; i < 8 * 2 * 128 * 128 / 2; i += G * NWAVES * 64) ((GAS unsigned*)KEYB)[i] = pk2(peer_keys[2 * i], peer_keys[2 * i + 1]);
        if (BOTH(0)) GRID_BAR();
    }

    if (IN(1)) {
        pg8::Gemm g{XB, W1T, T, DIN, D}; pg8::StaticOrder S; S.init(T, DIN, G, (int)blockIdx.x);
        pg8::EpiScaleBf16<0> E{PROJ, DIN, RS1};
        pg8::gemm_phase<pg8::EpiScaleBf16<0>, pg8::StaticOrder, PG8_ALIGN, PG8_SP2>(lds + RING_OFF, g, S, E);
        if (BOTH(1)) GRID_BAR();
    }

    if (IN(2)) {
        for (int item = gw; item < NB * 64 * 4; item += NGW) {
            const int h = item & 3, n = (item >> 2) & 63, b = item >> 8;
            const size_t tok0 = (size_t)b * SEQ + n * 32;
            const int c0 = h * 128 + 2 * lane, cs = h * 128 + swap23(2 * lane);
            const float lb0 = 1.0f / (1.0f + __expf(hg_lb[512 + c0] - hg_lb[c0])), lb1 = 1.0f / (1.0f + __expf(hg_lb[512 + c0 + 1] - hg_lb[c0 + 1]));
            unsigned qw[32], fw[32], vw[32];
#pragma unroll
            for (int c = 0; c < 32; ++c) { const bf16* pr = PROJ + (tok0 + c) * DIN;
                qw[c] = *(const GAS unsigned*)(pr + PC_Q + c0); fw[c] = *(const GAS unsigned*)(pr + PC_F + c0); vw[c] = *(const GAS unsigned*)(pr + PC_V + c0); }
            float eG0 = 1.f, eG1 = 1.f;
            unsigned kd0[16], kd1[16], vv0[16], vv1[16];
#pragma unroll
            for (int i = 0; i < 16; ++i) { kd0[i] = 0u; kd1[i] = 0u; vv0[i] = 0u; vv1[i] = 0u; }
#pragma unroll
            for (int c = 0; c < 32; ++c) { bf16* pr = PROJ + (tok0 + c) * DIN;
                const float f0 = lb0 + (1.0f - lb0) * sigmoidf_(bf_lo(fw[c])), f1 = lb1 + (1.0f - lb1) * sigmoidf_(bf_hi(fw[c]));
                eG0 *= f0; eG1 *= f1;
                const float q0 = bf_lo(qw[c]), q1 = bf_hi(qw[c]);
                const float qd0 = q0 * sigmoidf_(q0) * 0.08838834764831845f * eG0, qd1 = q1 * sigmoidf_(q1) * 0.08838834764831845f * eG1;
                const float kv0 = (1.0f - f0) / eG0, kv1 = (1.0f - f1) / eG1;
                *(GAS unsigned*)(pr + PC_Q + cs) = pk2(qd0, qd1);
                const unsigned kp = pk2(kv0, kv1);
                *(GAS unsigned*)(pr + PC_F + cs) = kp;
                const int pp = swap23(c), sh = 16 * (pp & 1);
                kd0[pp >> 1] |= (kp & 0xffffu) << sh; kd1[pp >> 1] |= (kp >> 16) << sh;
                vv0[pp >> 1] |= (vw[c] & 0xffffu) << sh; vv1[pp >> 1] |= (vw[c] >> 16) << sh; }
            GAS v4u* kt = (GAS v4u*)(KDT + ((size_t)item * 128 + 2 * lane) * 32);
            GAS v4u* vt = (GAS v4u*)(VTT + ((size_t)item * 128 + 2 * lane) * 32);
#pragma unroll
            for (int i = 0; i < 4; ++i) { kt[i] = (v4u){kd0[4 * i], kd0[4 * i + 1], kd0[4 * i + 2], kd0[4 * i + 3]}; kt[4 + i] = (v4u){kd1[4 * i], kd1[4 * i + 1], kd1[4 * i + 2], kd1[4 * i + 3]};
                vt[i] = (v4u){vv0[4 * i], vv0[4 * i + 1], vv0[4 * i + 2], vv0[4 * i + 3]}; vt[4 + i] = (v4u){vv1[4 * i], vv1[4 * i + 1], vv1[4 * i + 2], vv1[4 * i + 3]}; }
            *(GAS f32x2*)(DEC + (size_t)item * 128 + 2 * lane) = (f32x2){eG0, eG1};
        }
        for (int item = gw; item < NB * 8 * 32; item += NGW) {
            const int seg = item & 31, grp = (item >> 5) & 7, b = item >> 8, c = grp * 64 + lane, t0 = seg * 64;
            const float w0 = conv_w[c], w1 = conv_w[512 + c], w2 = conv_w[1024 + c], gn = conv_gain[c];
            float u1 = 0.f, u2 = 0.f;
            if (t0 > 0) { const bf16* p2 = PROJ + (size_t)(b * SEQ + t0 - 2) * DIN; const bf16* p1 = p2 + DIN;
                u2 = bf1(p2[PC_C + c]) * bf1(p2[PC_H + c]); u1 = bf1(p1[PC_C + c]) * bf1(p1[PC_H + c]); }
            for (int t = t0; t < t0 + 64; ++t) { const size_t tok = (size_t)b * SEQ + t; const bf16* pr = PROJ + tok * DIN;
                const float u = bf1(pr[PC_C + c]) * bf1(pr[PC_H + c]); const float y = bf1(pr[PC_B + c]) * (w0 * u2 + w1 * u1 + w2 * u);
                const float ss = wave_sum(y * y); const float r = 1.0f / sqrtf(ss * (1.0f / 64.0f) + EPS);
                MIX[tok * D + c] = (bf16)f2bf(y * r * gn); u2 = u1; u1 = u; }
        }
        if (BOTH(2)) GRID_BAR();
    }

    if (IN(3)) {
        constexpr int BUFB = 33792, OB0 = 2 * BUFB;
        for (int it = (int)blockIdx.x; it < NB * 4; it += G) {
            const int b = it >> 2, h = it & 3;
            const int lt = tid & 255, r = lane & 31, hh = lane >> 5, sl = wave;
            v4u st[9];
#define SCAN_LOAD(n_) do { const size_t tk0 = (size_t)b * SEQ + (n_) * 32; const size_t itm = (size_t)((b * 64 + (n_)) * 4 + h); \
                _Pragma("unroll") for (int i = 0; i < 2; ++i) { const int q = lt + 256 * i, row = q >> 4, cc = q & 15; const bf16* pr = PROJ + (tk0 + row) * DIN + h * 128 + cc * 8; \
                    st[i] = *(const GAS v4u*)(pr + PC_Q); st[2 + i] = *(const GAS v4u*)(pr + PC_F); \
                    st[4 + i] = ((const GAS v4u*)(KDT + itm * 4096))[q]; st[6 + i] = ((const GAS v4u*)(VTT + itm * 4096))[q]; } \
                if (lt < 32) st[8] = ((const GAS v4u*)(DEC + itm * 128))[lt]; } while (0)
#define SCAN_COMMIT(n_) do { LAS unsigned char* Bf = lds + RING_OFF + ((n_) & 1) * BUFB; \
                _Pragma("unroll") for (int i = 0; i < 2; ++i) { const int q = lt + 256 * i, row = q >> 4, cc = q & 15, k = q >> 2, c4 = q & 3; \
                    *(LAS v4u*)(Bf + row * 256 + ((cc ^ (row & 15)) * 16)) = st[i]; *(LAS v4u*)(Bf + 8192 + row * 256 + ((cc ^ (row & 15)) * 16)) = st[2 + i]; \
                    *(LAS v4u*)(Bf + 16384 + k * 64 + ((c4 ^ ((k >> 2) & 3)) * 16)) = st[4 + i]; *(LAS v4u*)(Bf + 24576 + k * 64 + ((c4 ^ ((k >> 2) & 3)) * 16)) = st[6 + i]; } \
                if (lt < 32) *(LAS v4u*)(Bf + 32768 + lt * 16) = st[8]; } while (0)
#define SCAN_POST(n_) do { const int pos = lt >> 3, vg = lt & 7; const LAS f32x4* ob = (const LAS f32x4*)(lds + RING_OFF + OB0 + ((n_) & 1) * 16384 + (pos * 128 + vg * 16) * 4); \
                const f32x4 o0 = ob[0], o1 = ob[1], o2 = ob[2], o3 = ob[3]; \
                float ss = (o0.x * o0.x + o0.y * o0.y) + (o0.z * o0.z + o0.w * o0.w) + (o1.x * o1.x + o1.y * o1.y) + (o1.z * o1.z + o1.w * o1.w) \
                         + (o2.x * o2.x + o2.y * o2.y) + (o2.z * o2.z + o2.w * o2.w) + (o3.x * o3.x + o3.y * o3.y) + (o3.z * o3.z + o3.w * o3.w); \
                ss += __shfl_xor(ss, 1); ss += __shfl_xor(ss, 2); ss += __shfl_xor(ss, 4); \
                const float rr = 1.0f / sqrtf(ss * (1.0f / 128.0f) + EPS); \
                const size_t tk = (size_t)b * SEQ + (n_) * 32 + pos; const GAS v4u* gp = (const GAS v4u*)(PROJ + tk * DIN + PC_G + h * 128 + vg * 16); const v4u g0 = gp[0], g1 = gp[1]; \
                const float ov[16] = {o0.x, o0.y, o0.z, o0.w, o1.x, o1.y, o1.z, o1.w, o2.x, o2.y, o2.z, o2.w, o3.x, o3.y, o3.z, o3.w}; \
                const float gf[16] = {bf_lo(g0.x), bf_hi(g0.x), bf_lo(g0.y), bf_hi(g0.y), bf_lo(g0.z), bf_hi(g0.z), bf_lo(g0.w), bf_hi(g0.w), bf_lo(g1.x), bf_hi(g1.x), bf_lo(g1.y), bf_hi(g1.y), bf_lo(g1.z), bf_hi(g1.z), bf_lo(g1.w), bf_hi(g1.w)}; \
                float yv[16]; _Pragma("unroll") for (int i = 0; i < 16; ++i) yv[i] = ov[i] * rr * hg_gain[vg * 16 + i] * (gf[i] * sigmoidf_(gf[i])); \
                GAS v4u* mp = (GAS v4u*)(MIX + tk * D + 512 + h * 128 + vg * 16); \
                mp[0] = (v4u){pk2(yv[0], yv[1]), pk2(yv[2], yv[3]), pk2(yv[4], yv[5]), pk2(yv[6], yv[7])}; mp[1] = (v4u){pk2(yv[8], yv[9]), pk2(yv[10], yv[11]), pk2(yv[12], yv[13]), pk2(yv[14], yv[15])}; } while (0)
#define SCAN_BAR() do { asm volatile("s_waitcnt lgkmcnt(0)" ::: "memory"); __builtin_amdgcn_s_barrier(); asm volatile("" ::: "memory"); } while (0)
            if (wave >= 4) {
                SCAN_LOAD(0); SCAN_COMMIT(0);
                SCAN_BAR();
                for (int n = 0; n < 64; ++n) {
                    if (n + 1 < 64) SCAN_LOAD(n + 1);
                    if (n >= 1) SCAN_POST(n - 1);
                    if (n + 1 < 64) SCAN_COMMIT(n + 1);
                    SCAN_BAR();
                }
                SCAN_POST(63);
                SCAN_BAR();
            } else {
                f32x16 S0, S1, S2, S3;
#pragma unroll
                for (int i = 0; i < 16; ++i) { S0[i] = 0.f; S1[i] = 0.f; S2[i] = 0.f; S3[i] = 0.f; }
                SCAN_BAR();
                for (int n = 0; n < 64; ++n) {
                    const LAS unsigned char* Bf = lds + RING_OFF + (n & 1) * BUFB;
                    pg8::bf16x8 qd[8], kd[8], vt[2];
#pragma unroll
                    for (int ks = 0; ks < 8; ++ks) { const int off = r * 256 + (((2 * ks + hh) ^ (r & 15)) * 16); qd[ks] = *(const LAS pg8::bf16x8*)(Bf + off); kd[ks] = *(const LAS pg8::bf16x8*)(Bf + 8192 + off); }
#pragma unroll
                    for (int sp = 0; sp < 2; ++sp) { const int row = 32 * sl + r; vt[sp] = *(const LAS pg8::bf16x8*)(Bf + 24576 + row * 64 + (((2 * sp + hh) ^ ((row >> 2) & 3)) * 16)); }
                    f32x16 X, O;
#pragma unroll
                    for (int i = 0; i < 16; ++i) { X[i] = 0.f; O[i] = 0.f; }
#pragma unroll
                    for (int ks = 0; ks < 8; ++ks) X = __builtin_amdgcn_mfma_f32_32x32x16_bf16(kd[ks], qd[ks], X, 0, 0, 0);
                    O = __builtin_amdgcn_mfma_f32_32x32x16_bf16(qd[0], pack8(S0, 0), O, 0, 0, 0); O = __builtin_amdgcn_mfma_f32_32x32x16_bf16(qd[1], pack8(S0, 1), O, 0, 0, 0);
                    O = __builtin_amdgcn_mfma_f32_32x32x16_bf16(qd[2], pack8(S1, 0), O, 0, 0, 0); O = __builtin_amdgcn_mfma_f32_32x32x16_bf16(qd[3], pack8(S1, 1), O, 0, 0, 0);
                    O = __builtin_amdgcn_mfma_f32_32x32x16_bf16(qd[4], pack8(S2, 0), O, 0, 0, 0); O = __builtin_amdgcn_mfma_f32_32x32x16_bf16(qd[5], pack8(S2, 1), O, 0, 0, 0);
                    O = __builtin_amdgcn_mfma_f32_32x32x16_bf16(qd[6], pack8(S3, 0), O, 0, 0, 0); O = __builtin_amdgcn_mfma_f32_32x32x16_bf16(qd[7], pack8(S3, 1), O, 0, 0, 0);
#pragma unroll
                    for (int i = 0; i < 16; ++i) { const int s_ = (i & 3) + 8 * (i >> 2) + 4 * hh; X[i] = (s_ <= r) ? X[i] : 0.f; }
                    O = __builtin_amdgcn_mfma_f32_32x32x16_bf16(pack8(X, 0), vt[0], O, 0, 0, 0); O = __builtin_amdgcn_mfma_f32_32x32x16_bf16(pack8(X, 1), vt[1], O, 0, 0, 0);
#define SCAN_SUPD(Sx, rt_) do { _Pragma("unroll") for (int sp = 0; sp < 2; ++sp) { const int row = 32 * (rt_) + r; \
                            const pg8::bf16x8 kt = *(const LAS pg8::bf16x8*)(Bf + 16384 + row * 64 + (((2 * sp + hh) ^ ((row >> 2) & 3)) * 16)); \
                            Sx = __builtin_amdgcn_mfma_f32_32x32x16_bf16(kt, vt[sp], Sx, 0, 0, 0); } \
                        _Pragma("unroll") for (int g = 0; g < 4; ++g) { const f32x4 dv = *(const LAS f32x4*)(Bf + 32768 + (32 * (rt_) + 8 * g + 4 * hh) * 4); \
                            Sx[4 * g] *= dv.x; Sx[4 * g + 1] *= dv.y; Sx[4 * g + 2] *= dv.z; Sx[4 * g + 3] *= dv.w; } } while (0)
                    SCAN_SUPD(S0, 0); SCAN_SUPD(S1, 1); SCAN_SUPD(S2, 2); SCAN_SUPD(S3, 3);
                    LAS float* ob = (LAS float*)(lds + RING_OFF + OB0 + (n & 1) * 16384);
#pragma unroll
                    for (int i = 0; i < 16; ++i) ob[((i & 3) + 8 * (i >> 2) + 4 * hh) * 128 + 32 * sl + r] = O[i];
                    SCAN_BAR();
                }
                SCAN_BAR();
            }
        }
        if (BOTH(3)) GRID_BAR();
    }


    if (IN(4)) {
        pg8::Gemm g{MIX, WOT, T, D, D}; pg8::StaticOrder S; S.init(T, D, G, (int)blockIdx.x);
        pg8::EpiResid E{x, X1, SS2};
        pg8::gemm_phase<pg8::EpiResid, pg8::StaticOrder, PG8_ALIGN, PG8_SP2>(lds + RING_OFF, g, S, E);
        if (BOTH(4)) GRID_BAR();
    }

    if (IN(5)) {
        pg8::Gemm g{X1, WQT, T, 2048, D}; pg8::StaticOrder S; S.init(T, 2048, G, (int)blockIdx.x);
        pg8::EpiScaleBf16<1> E{QB, 2048, SS2};
        pg8::gemm_phase<pg8::EpiScaleBf16<1>, pg8::StaticOrder, PG8_ALIGN, PG8_SP2>(lds + RING_OFF, g, S, E);
        if (BOTH(5)) GRID_BAR();
    }

    if (IN(6)) {
        const int r = lane & 31, hh = lane >> 5;
        for (int item = gw; item < (T / 32) * 8; item += NGW) {
            const int h = item & 7, tok = (item >> 3) * 32 + r;
            unsigned L[2][16];
#pragma unroll
            for (int p = 0; p < 2; ++p) {
                pg8::bf16x8 qf[8];
                const GAS pg8::bf16x8* qp = (const GAS pg8::bf16x8*)(QB + (size_t)tok * 2048 + h * 256 + p * 128 + 8 * hh);
#pragma unroll
                for (int ks = 0; ks < 8; ++ks) qf[ks] = qp[2 * ks];
                const GAS pg8::bf16x8* kp = (const GAS pg8::bf16x8*)(KEYB + (size_t)((h * 2 + p) * 128 + r) * 128 + 8 * hh);
                unsigned best[16];
#pragma unroll
                for (int nt = 0; nt < 4; ++nt) {
                    f32x16 acc;
#pragma unroll
                    for (int i = 0; i < 16; ++i) acc[i] = 0.f;
                    const GAS pg8::bf16x8* kb = kp + nt * 512; asm volatile("" : "+v"(kb));
#pragma unroll
                    for (int ks = 0; ks < 8; ++ks) acc = __builtin_amdgcn_mfma_f32_32x32x16_bf16(kb[2 * ks], qf[ks], acc, 0, 0, 0);
                    unsigned cur[16];
#pragma unroll
                    for (int i = 0; i < 16; ++i) { const int n = 32 * nt + (i & 3) + 8 * (i >> 2) + 4 * hh;
                        const float av = acc[i]; unsigned u = __builtin_bit_cast(unsigned, av); u ^= (unsigned)((int)u >> 31) | 0x80000000u;
                        cur[i] = (u & ~0x7Fu) | (unsigned)(127 - n); }
                    sort16_desc(cur);
                    if (nt == 0) {
#pragma unroll
                        for (int i = 0; i < 16; ++i) best[i] = cur[i];
                    } else merge16_desc(best, cur);
                }
                unsigned o[16];
#pragma unroll
                for (int i = 0; i < 16; ++i) o[i] = (unsigned)__shfl_xor((int)best[i], 32);
                merge16_desc(best, o);
#pragma unroll
                for (int i = 0; i < 16; ++i) L[p][i] = best[i];
            }
            float v1[16], v2[16];
#pragma unroll
            for (int j = 0; j < 16; ++j) { v1[j] = unkey(L[0][j] & ~0x7Fu); v2[j] = unkey(L[1][j] & ~0x7Fu); }
            unsigned ct[16];
#pragma unroll
            for (int j = 0; j < 16; ++j) ct[j] = ckey(v1[0] + v2[j], j);
#pragma unroll
            for (int i = 1; i < 16; ++i)
#pragma unroll
                for (int j = 0; j < 16; ++j) if ((i + 1) * (j + 1) <= 16) {
                    unsigned key = ckey(v1[i] + v2[j], i * 16 + j);
#pragma unroll
                    for (int t = 0; t < 16; ++t) { const unsigned mx = ct[t] > key ? ct[t] : key; key = ct[t] > key ? key : ct[t]; ct[t] = mx; }
                }
            float den = 0.f, ex[16]; const float cmax = unkey(ct[0] & ~0xFFu);
#pragma unroll
            for (int t = 0; t < 16; ++t) { ex[t] = __expf(unkey(ct[t] & ~0xFFu) - cmax); den += ex[t]; }
            const float inv = 1.0f / den;
            unsigned b1[4], b2[4];
#pragma unroll
            for (int w = 0; w < 4; ++w) { b1[w] = (L[0][4 * w] & 0x7Fu) | ((L[0][4 * w + 1] & 0x7Fu) << 8) | ((L[0][4 * w + 2] & 0x7Fu) << 16) | ((L[0][4 * w + 3] & 0x7Fu) << 24);
                b2[w] = (L[1][4 * w] & 0x7Fu) | ((L[1][4 * w + 1] & 0x7Fu) << 8) | ((L[1][4 * w + 2] & 0x7Fu) << 16) | ((L[1][4 * w + 3] & 0x7Fu) << 24); }
            unsigned ent[8];
#pragma unroll
            for (int t = 0; t < 8; ++t) { const unsigned hm = 0u - (unsigned)hh;
                const unsigned ck = ct[t] ^ ((ct[t] ^ ct[8 + t]) & hm); const unsigned e0 = __builtin_bit_cast(unsigned, ex[t]), e1 = __builtin_bit_cast(unsigned, ex[8 + t]);
                const float gt = __builtin_bit_cast(float, e0 ^ ((e0 ^ e1) & hm)) * inv;
                const unsigned flat = 255u - (ck & 0xFFu), ii = flat >> 4, jj = flat & 15u;
                const unsigned w1 = (ii & 8u) ? ((ii & 4u) ? b1[3] : b1[2]) : ((ii & 4u) ? b1[1] : b1[0]), w2 = (jj & 8u) ? ((jj & 4u) ? b2[3] : b2[2]) : ((jj & 4u) ? b2[1] : b2[0]);
                const unsigned n1 = 127u - ((w1 >> (8u * (ii & 3u))) & 0x7Fu), n2 = 127u - ((w2 >> (8u * (jj & 3u))) & 0x7Fu);
                ent[t] = (n1 * 128u + n2) | (pkh2(gt, 0.f) << 16); }
            GAS v4u* ep = (GAS v4u*)(EXPT + (size_t)tok * 128 + h * 16 + 8 * hh);
            ep[0] = (v4u){ent[0], ent[1], ent[2], ent[3]}; ep[1] = (v4u){ent[4], ent[5], ent[6], ent[7]};
        }
        if (BOTH(6)) GRID_BAR();
    }


    if (IN(7)) {
        constexpr int NT = 4;
        const unsigned srcl = (unsigned)(32 * (lane & 1) + 16 * ((lane >> 1) & 1)) << 2;
        for (int bt = gw; bt < T / NT; bt += NGW) {
            const int tok0 = bt * NT;
            unsigned e[NT][2]; float rs2[NT];
#pragma unroll
            for (int t = 0; t < NT; ++t) { const unsigned r0 = EXPT[(size_t)(tok0 + t) * 128 + lane], r1 = EXPT[(size_t)(tok0 + t) * 128 + 64 + lane];
                e[t][0] = (r0 << 16) | (r0 >> 16); e[t][1] = (r1 << 16) | (r1 >> 16); sort128_asc(e[t][0], e[t][1], lane);
                rs2[t] = 1.0f / sqrtf(SS2[tok0 + t] * (1.0f / D) + EPS); }
            float ah[NT][2];
            h2_t hx[NT][8];
#pragma unroll
            for (int t = 0; t < NT; ++t) { const GAS v4u* xr = (const GAS v4u*)(X1 + (size_t)(tok0 + t) * D); const v4u xa = __builtin_nontemporal_load(xr + lane), xb = __builtin_nontemporal_load(xr + 64 + lane);
                hx[t][0] = h2_of(pkh2(bf_lo(xa.x), bf_hi(xa.x))); hx[t][1] = h2_of(pkh2(bf_lo(xa.y), bf_hi(xa.y))); hx[t][2] = h2_of(pkh2(bf_lo(xa.z), bf_hi(xa.z))); hx[t][3] = h2_of(pkh2(bf_lo(xa.w), bf_hi(xa.w)));
                hx[t][4] = h2_of(pkh2(bf_lo(xb.x), bf_hi(xb.x))); hx[t][5] = h2_of(pkh2(bf_lo(xb.y), bf_hi(xb.y))); hx[t][6] = h2_of(pkh2(bf_lo(xb.z), bf_hi(xb.z))); hx[t][7] = h2_of(pkh2(bf_lo(xb.w), bf_hi(xb.w)));
                ah[t][0] = 0.f; ah[t][1] = 0.f; }
#define PEER_LOAD(buf, st_) do { _Pragma("unroll") for (int t = 0; t < NT; ++t) { const unsigned em_ = ((st_) & 16) ? 0xFFFFFFFFu : 0u; const unsigned esel = e[t][0] ^ ((e[t][0] ^ e[t][1]) & em_); \
                _Pragma("unroll") for (int q = 0; q < 4; ++q) { const unsigned id = (unsigned)__builtin_amdgcn_readlane((int)esel, 4 * ((st_) & 15) + q) >> 16; \
                    buf[t][q] = ((const GAS v4u*)(U8 + (size_t)id * D))[lane]; } } } while (0)
#define PEER_DOT2(w_, a_, b_, d_) do { const unsigned ww_ = (w_); d_ = __builtin_amdgcn_fdot2(__builtin_amdgcn_cvt_scalef32_pk_f16_fp8((int)ww_, 1.0f, false), a_, d_, false); d_ = __builtin_amdgcn_fdot2(__builtin_amdgcn_cvt_scalef32_pk_f16_fp8((int)ww_, 1.0f, true), b_, d_, false); } while (0)
#define PEER_DOTS(buf, st_) do { float p[16]; \
                _Pragma("unroll") for (int t = 0; t < NT; ++t) _Pragma("unroll") for (int q = 0; q < 4; ++q) { float d0 = 0.f, d1 = 0.f; \
                    PEER_DOT2(buf[t][q].x, hx[t][0], hx[t][1], d0); PEER_DOT2(buf[t][q].z, hx[t][4], hx[t][5], d1); PEER_DOT2(buf[t][q].y, hx[t][2], hx[t][3], d0); PEER_DOT2(buf[t][q].w, hx[t][6], hx[t][7], d1); p[4 * t + q] = d0 + d1; } \
                const float red = reduce16(p, lane); const bool hit = (lane >> 2) == ((st_) & 15), hi = ((st_) & 16) != 0; \
                _Pragma("unroll") for (int t = 0; t < NT; ++t) { const float got = __builtin_bit_cast(float, __builtin_amdgcn_ds_bpermute((int)(srcl + (unsigned)((8 * (t & 1) + 4 * (t >> 1)) << 2)), __builtin_bit_cast(int, red))); \
                    ah[t][0] = (hit && !hi) ? got : ah[t][0]; ah[t][1] = (hit && hi) ? got : ah[t][1]; } } while (0)
            {
                v4u ua[NT][4], ubb[NT][4];
                PEER_LOAD(ua, 0);
                for (int st = 0; st < 32; st += 2) {
                    PEER_LOAD(ubb, st + 1);
                    PEER_DOTS(ua, st);
                    if (st + 2 < 32) PEER_LOAD(ua, st + 2);
                    PEER_DOTS(ubb, st + 1);
                }
            }
            float wv[NT][2];
#pragma unroll
            for (int t = 0; t < NT; ++t)
#pragma unroll
                for (int g = 0; g < 2; ++g) { const float a = ah[t][g] * (rs2[t] * (1.0f / PEER_SU)); const float gate = (float)h2_of(e[t][g] & 0xFFFFu).x;
                    wv[t][g] = gate * (0.5f / PEER_SV) * a * (1.0f + erff(a * 0.7071067811865476f)); }
            f32x2 y[NT][8];
#pragma unroll
            for (int t = 0; t < NT; ++t)
#pragma unroll
                for (int i = 0; i < 8; ++i) y[t][i] = (f32x2){0.f, 0.f};
#define PEER_LOADB(buf, st_) do { _Pragma("unroll") for (int t = 0; t < NT; ++t) { const unsigned em_ = ((st_) & 32) ? 0xFFFFFFFFu : 0u; const unsigned esel = e[t][0] ^ ((e[t][0] ^ e[t][1]) & em_); \
                _Pragma("unroll") for (int q = 0; q < 2; ++q) { const unsigned id = (unsigned)__builtin_amdgcn_readlane((int)esel, 2 * ((st_) & 31) + q) >> 16; \
                    buf[t][q] = ((const GAS v4u*)(V8 + (size_t)id * D))[lane]; } } } while (0)
#define PEER_AXPY(buf, st_) do { _Pragma("unroll") for (int t = 0; t < NT; ++t) { const unsigned wm_ = ((st_) & 32) ? 0xFFFFFFFFu : 0u; const unsigned w0_ = __builtin_bit_cast(unsigned, wv[t][0]), w1_ = __builtin_bit_cast(unsigned, wv[t][1]); const unsigned wsel = w0_ ^ ((w0_ ^ w1_) & wm_); \
                _Pragma("unroll") for (int q = 0; q < 2; ++q) { const float wi = __builtin_bit_cast(float, __builtin_amdgcn_readlane((int)wsel, 2 * ((st_) & 31) + q)); const f32x2 w2 = {wi, wi}; \
                    const unsigned vw_[4] = {buf[t][q].x, buf[t][q].y, buf[t][q].z, buf[t][q].w}; \
                    _Pragma("unroll") for (int j = 0; j < 4; ++j) { y[t][2 * j] = __builtin_elementwise_fma(__builtin_amdgcn_cvt_pk_f32_fp8((int)vw_[j], false), w2, y[t][2 * j]); y[t][2 * j + 1] = __builtin_elementwise_fma(__builtin_amdgcn_cvt_pk_f32_fp8((int)vw_[j], true), w2, y[t][2 * j + 1]); } } } } while (0)
            {
                v4u va[NT][2], vbb[NT][2];
                PEER_LOADB(va, 0);
                for (int st = 0; st < 64; st += 2) {
                    PEER_LOADB(vbb, st + 1);
                    PEER_AXPY(va, st);
                    if (st + 2 < 64) PEER_LOADB(va, st + 2);
                    PEER_AXPY(vbb, st + 1);
                }
            }
#pragma unroll
            for (int t = 0; t < NT; ++t) { const size_t tok = (size_t)(tok0 + t);
                const GAS v4u* xr = (const GAS v4u*)(X1 + tok * D); const v4u xa = __builtin_nontemporal_load(xr + lane), xb = __builtin_nontemporal_load(xr + 64 + lane);
                const float xf[16] = {bf_lo(xa.x), bf_hi(xa.x), bf_lo(xa.y), bf_hi(xa.y), bf_lo(xa.z), bf_hi(xa.z), bf_lo(xa.w), bf_hi(xa.w),
                                      bf_lo(xb.x), bf_hi(xb.x), bf_lo(xb.y), bf_hi(xb.y), bf_lo(xb.z), bf_hi(xb.z), bf_lo(xb.w), bf_hi(xb.w)};
                float yy[16]; float ss = 0.f;
#pragma unroll
                for (int i = 0; i < 8; ++i) { yy[2 * i] = y[t][i].x + xf[2 * i]; yy[2 * i + 1] = y[t][i].y + xf[2 * i + 1]; ss += yy[2 * i] * yy[2 * i] + yy[2 * i + 1] * yy[2 * i + 1]; }
                ss = wave_sum(ss);
                const float r = 1.0f / sqrtf(ss * (1.0f / D) + EPS);
                const GAS f32x4* nfp = (const GAS f32x4*)norm_f; const f32x4 n0 = nfp[2 * lane], n1 = nfp[2 * lane + 1], n2 = nfp[128 + 2 * lane], n3 = nfp[128 + 2 * lane + 1];
                GAS f32x4* op = (GAS f32x4*)(out + tok * D);
                __builtin_nontemporal_store((f32x4){yy[0] * r * n0.x, yy[1] * r * n0.y, yy[2] * r * n0.z, yy[3] * r * n0.w}, op + 2 * lane);
                __builtin_nontemporal_store((f32x4){yy[4] * r * n1.x, yy[5] * r * n1.y, yy[6] * r * n1.z, yy[7] * r * n1.w}, op + 2 * lane + 1);
                __builtin_nontemporal_store((f32x4){yy[8] * r * n2.x, yy[9] * r * n2.y, yy[10] * r * n2.z, yy[11] * r * n2.w}, op + 128 + 2 * lane);
                __builtin_nontemporal_store((f32x4){yy[12] * r * n3.x, yy[13] * r * n3.y, yy[14] * r * n3.z, yy[15] * r * n3.w}, op + 128 + 2 * lane + 1); }
        }
    }

#undef IN
#undef BOTH
}

extern "C" void kernel_launch(void* const* d_in, const int* in_sizes, int n_in, void* d_out, int out_size, void* d_ws, size_t ws_size, hipStream_t stream) {
    static int grid = 0;
    if (grid == 0) {
        if (n_in != 14 || in_sizes[0] != T * D || out_size != T * D || ws_size < WS_END) { fprintf(stderr, "kernel_launch: unexpected shapes (n_in %d, in0 %d, out %d, ws %zu); nothing launched\n", n_in, n_in > 0 ? in_sizes[0] : -1, out_size, ws_size); grid = -1; return; }
        int dev = 0, cus = 0, per_cu = 0;
        if (hipGetDevice(&dev) != hipSuccess || hipDeviceGetAttribute(&cus, hipDeviceAttributeMultiprocessorCount, dev) != hipSuccess) { grid = -1; return; }
        if (hipFuncSetAttribute((const void*)hymba_fwd, hipFuncAttributeMaxDynamicSharedMemorySize, LDS_BYTES) != hipSuccess) { fprintf(stderr, "kernel_launch: hipFuncSetAttribute failed\n"); grid = -1; return; }
        if (hipOccupancyMaxActiveBlocksPerMultiprocessor(&per_cu, (const void*)hymba_fwd, NWAVES * 64, LDS_BYTES) != hipSuccess || per_cu < 1) { fprintf(stderr, "kernel_launch: occupancy query says %d blocks per CU\n", per_cu); (void)hipGetLastError(); grid = -1; return; }
        grid = cus;
    }
    if (grid < 0) return;
    if (hipMemsetAsync((char*)d_ws + WS_CTL, 0, CTL_ZERO_BYTES, stream) != hipSuccess) { fprintf(stderr, "kernel_launch: hipMemsetAsync failed\n"); return; }
    Args a{};
    for (int i = 0; i < 14; ++i) a.in[i] = (const float*)d_in[i];
    a.out = (float*)d_out; a.ws = (unsigned char*)d_ws;
    if (N_LAUNCHES == 1) {
        a.ph_lo = 0; a.ph_hi = NPHASES; a.li = 0;
        void* kargs[] = {&a};
        const hipError_t e = hipLaunchCooperativeKernel((const void*)hymba_fwd, dim3(grid), dim3(NWAVES * 64), kargs, LDS_BYTES, stream);
        if (e != hipSuccess) fprintf(stderr, "kernel_launch: cooperative launch failed: %s (grid %d)\n", hipGetErrorString(e), grid);
    } else {
        for (int li = 0; li < NPHASES; ++li) {
            a.ph_lo = li; a.ph_hi = li + 1; a.li = li;
            hipLaunchKernelGGL(hymba_fwd, dim3(grid), dim3(NWAVES * 64), LDS_BYTES, stream, a);
            const hipError_t le = hipPeekAtLastError();
            if (le != hipSuccess) { fprintf(stderr, "kernel_launch: launch %d failed: %s\n", li, hipGetErrorName(le)); break; }
        }
    }
}
```

```cpp
#include <hip/hip_runtime.h>
#include <cstdio>
#include <cstdint>
namespace pg8 {
#define PG8_LAS __attribute__((address_space(3)))
typedef unsigned short bf16_t;
typedef short bf16x8 __attribute__((ext_vector_type(8)));
typedef float f32x4 __attribute__((ext_vector_type(4)));
typedef unsigned u32x4 __attribute__((ext_vector_type(4)));
constexpr int BM = 256, BK = 64, HALF = 128, HTB = HALF * BK * 2  , STAGE_BYTES = 8 * HTB, NXCD = 8, WGM = 8;

__host__ __device__ __forceinline__ int lds_byte(int r, int c) { const int st = (r >> 4) * 2 + (c >> 5), rr = r & 15, cc = c & 31, ob = rr * 64 + cc * 2; return st * 1024 + (ob ^ (((ob >> 9) & 1) << 5)); }
__host__ __device__ __forceinline__ void stage_rc(int b, int& R, int& C) { const int st = b / 1024, sb = b % 1024, swz = sb ^ (((sb >> 9) & 1) << 5); R = (st >> 1) * 16 + swz / 64; C = (st & 1) * 32 + (swz % 64) / 2; }
__host__ __device__ __forceinline__ int perm32(int rho) { const int n = rho >> 4, i = rho & 15; return 8 * (i >> 2) + 4 * n + (i & 3); }

struct Unit { int pm, pn; };
struct Gemm { const bf16_t* A; const bf16_t* Bt; int M, N, K; };

struct StaticOrder {
    int nM, nN, nwg, G, c;
    __host__ __device__ void init(int M, int N, int G_, int c_) { nM = M / BM; nN = N / BM; nwg = nM * nN; G = G_; c = c_; }
    __host__ __device__ bool next(int i, Unit& u) const {
        const long L = (long)i * G + c; if (L >= nwg) return false;
        int wgid = (int)L; { const int q = nwg / NXCD, r = nwg % NXCD, xcd = wgid % NXCD, off = wgid / NXCD; wgid = (xcd < r ? xcd * (q + 1) : r * (q + 1) + (xcd - r) * q) + off; }
        const int nig = WGM * nN, gid = wgid / nig, fm = gid * WGM, gsz = (nM - fm) < WGM ? (nM - fm) : WGM;
        u.pm = fm + ((wgid % nig) % gsz); u.pn = (wgid % nig) / gsz; return true;
    }
    __device__ __forceinline__ void a_ready(const Unit&) const {}
    __device__ __forceinline__ void done(const Unit&) const {}
};

__device__ __forceinline__ unsigned cvt_pk_bf16(float lo, float hi) { unsigned r; asm volatile("v_cvt_pk_bf16_f32 %0, %1, %2" : "=v"(r) : "v"(lo), "v"(hi)); return r; }

template <int MODE> struct EpiScaleBf16 {
    static constexpr bool PERM = true, AFTER_DRAIN = false;
    bf16_t* O; int ldc; const float* rowv;
    __device__ __forceinline__ void operator()(const f32x4 (&acc)[2][2][4][2], const Unit& u, int wr, int wc, int fr, int fq) const {
        const int row0 = u.pm * BM + wr * 64 + fr, col0 = u.pn * BM + wc * 32 + 8 * fq;
#pragma unroll
        for (int ai = 0; ai < 2; ++ai)
#pragma unroll
            for (int m = 0; m < 4; ++m) { const int row = row0 + ai * HALF + m * 16; float s = rowv[row]; if (MODE == 1) s = 1.0f / sqrtf(s * (1.0f / 1024.0f) + 1e-6f);
                bf16_t* rowp = O + (size_t)row * ldc + col0;
#pragma unroll
                for (int bj = 0; bj < 2; ++bj) { const f32x4 v0 = acc[ai][bj][m][0] * s, v1 = acc[ai][bj][m][1] * s;
                    u32x4 w; w.x = cvt_pk_bf16(v0[0], v0[1]); w.y = cvt_pk_bf16(v0[2], v0[3]); w.z = cvt_pk_bf16(v1[0], v1[1]); w.w = cvt_pk_bf16(v1[2], v1[3]);
                    *(u32x4*)(rowp + bj * HALF) = w; } }
    }
};
struct EpiResid {
    static constexpr bool PERM = true, AFTER_DRAIN = false;
    const float* X; bf16_t* O; float* ss;
    __device__ __forceinline__ void operator()(const f32x4 (&acc)[2][2][4][2], const Unit& u, int wr, int wc, int fr, int fq) const {
        const int row0 = u.pm * BM + wr * 64 + fr, col0 = u.pn * BM + wc * 32 + 8 * fq;
#pragma unroll
        for (int ai = 0; ai < 2; ++ai)
#pragma unroll
            for (int m = 0; m < 4; ++m) { const int row = row0 + ai * HALF + m * 16; float part = 0.f;
#pragma unroll
                for (int bj = 0; bj < 2; ++bj) { const float* xp = X + (size_t)row * 1024 + col0 + bj * HALF;
                    const f32x4 v0 = acc[ai][bj][m][0] + *(const f32x4*)xp, v1 = acc[ai][bj][m][1] + *(const f32x4*)(xp + 4);
                    part += (v0[0] * v0[0] + v0[1] * v0[1]) + (v0[2] * v0[2] + v0[3] * v0[3]) + (v1[0] * v1[0] + v1[1] * v1[1]) + (v1[2] * v1[2] + v1[3] * v1[3]);
                    u32x4 w; w.x = cvt_pk_bf16(v0[0], v0[1]); w.y = cvt_pk_bf16(v0[2], v0[3]); w.z = cvt_pk_bf16(v1[0], v1[1]); w.w = cvt_pk_bf16(v1[2], v1[3]);
                    *(u32x4*)(O + (size_t)row * 1024 + col0 + bj * HALF) = w; }
                part += __shfl_xor(part, 16); part += __shfl_xor(part, 32);
                if (fq == 0) (void)__builtin_amdgcn_global_atomic_fadd_f32((__attribute__((address_space(1))) float*)(ss + row), part); }
    }
};

template <class Epi, class Sched, bool ALIGN_EPI = false, bool SP2 = false>
__device__ __forceinline__ void gemm_phase(PG8_LAS unsigned char* lds, const Gemm g, const Sched& S, const Epi& E) {
    const int tid = threadIdx.x, wid = __builtin_amdgcn_readfirstlane(tid >> 6), lane = tid & 63, wr = wid >> 2, wc = wid & 3, fr = lane & 15, fq = lane >> 4;
    const int K = g.K, nt = K / BK;
    unsigned voffA[2], voffB[2];
#pragma unroll
    for (int i = 0; i < 2; ++i) { int R, C; stage_rc(tid * 16 + i * 8192, R, C); const int Rb = Epi::PERM ? ((R & ~31) + perm32(R & 31)) : R;
        voffA[i] = (unsigned)(R * K + C) * 2u; voffB[i] = (unsigned)(Rb * K + C) * 2u; }
    const size_t kstep = (size_t)(BK * 2);
    const size_t hstep = (size_t)HALF * K * 2;
    const size_t tstep = 2 * hstep;
    const unsigned ldsw = (unsigned)wid * 1024u;
    const int aoff = lds_byte(wr * 64 + fr, fq * 8), boff = lds_byte(wc * 32 + fr, fq * 8);
#define PG8_SA(b, h) (((b) * 2 + (h)) * HTB)
#define PG8_SB(b, h) ((4 + (b) * 2 + (h)) * HTB)
#define PG8_STAGE(bufoff, gbase, voff) do { _Pragma("unroll") for (int _i = 0; _i < 2; ++_i) \
        __builtin_amdgcn_global_load_lds((const unsigned*)((const char*)(gbase) + (voff)[_i]), (PG8_LAS unsigned*)(lds + (bufoff) + ldsw + _i * 8192), 16, 0, 0); } while (0)
#define PG8_LDA(dst, b, h) do { _Pragma("unroll") for (int m = 0; m < 4; ++m) _Pragma("unroll") for (int k = 0; k < 2; ++k) dst[m][k] = *(const PG8_LAS bf16x8*)(lds + PG8_SA(b, h) + aoff + m * 2048 + k * 1024); } while (0)
#define PG8_LDB(dst, b, h) do { _Pragma("unroll") for (int n = 0; n < 2; ++n) _Pragma("unroll") for (int k = 0; k < 2; ++k) dst[n][k] = *(const PG8_LAS bf16x8*)(lds + PG8_SB(b, h) + boff + n * 2048 + k * 1024); } while (0)
#define PG8_MMA(ai, bj, At, Bt) do { __builtin_amdgcn_s_setprio(1); _Pragma("unroll") for (int m = 0; m < 4; ++m) _Pragma("unroll") for (int n = 0; n < 2; ++n) _Pragma("unroll") for (int k = 0; k < 2; ++k) \
        acc[ai][bj][m][n] = __builtin_amdgcn_mfma_f32_16x16x32_bf16(Bt[n][k], At[m][k], acc[ai][bj][m][n], 0, 0, 0); __builtin_amdgcn_s_setprio(0); } while (0)
#define PG8_WAIT_V(n) asm volatile("s_waitcnt vmcnt(" #n ")" ::: "memory")
#define PG8_WAIT_L(n) asm volatile("s_waitcnt lgkmcnt(" #n ")" ::: "memory")
#define PG8_BAR __builtin_amdgcn_s_barrier()
#define PG8_SCHED __builtin_amdgcn_sched_barrier(0)
    Unit cur, nxt; int ui = 0;
    if (!S.next(0, cur)) return;
    f32x4 acc[2][2][4][2];
#pragma unroll
    for (int a = 0; a < 2; ++a)
#pragma unroll
        for (int b = 0; b < 2; ++b)
#pragma unroll
            for (int m = 0; m < 4; ++m)
#pragma unroll
                for (int n = 0; n < 2; ++n) acc[a][b][m][n] = (f32x4){0.f, 0.f, 0.f, 0.f};
    bf16x8 At[4][2], B0[2][2], B1[2][2];
    const char* cA = (const char*)g.A + (size_t)cur.pm * tstep; const char* cB = (const char*)g.Bt + (size_t)cur.pn * tstep;
    S.a_ready(cur);
    if constexpr (SP2) {
        PG8_STAGE(PG8_SB(0, 0), cB, voffB); PG8_STAGE(PG8_SB(0, 1), cB + hstep, voffB); PG8_STAGE(PG8_SA(0, 0), cA, voffA); PG8_STAGE(PG8_SA(0, 1), cA + hstep, voffA);
        if (wr == 1) PG8_BAR;
        PG8_WAIT_V(2); PG8_BAR;
        PG8_STAGE(PG8_SB(1, 0), cB + kstep, voffB); PG8_STAGE(PG8_SA(1, 0), cA + kstep, voffA); PG8_STAGE(PG8_SB(1, 1), cB + hstep + kstep, voffB);
        PG8_WAIT_V(6); PG8_BAR;
    } else {
        PG8_STAGE(PG8_SB(0, 0), cB, voffB); PG8_STAGE(PG8_SA(0, 0), cA, voffA); PG8_STAGE(PG8_SB(0, 1), cB + hstep, voffB); PG8_STAGE(PG8_SA(0, 1), cA + hstep, voffA);
        if (wr == 1) PG8_BAR;
        PG8_WAIT_V(4); PG8_BAR;
        PG8_STAGE(PG8_SB(1, 0), cB + kstep, voffB); PG8_STAGE(PG8_SA(1, 0), cA + kstep, voffA); PG8_STAGE(PG8_SB(1, 1), cB + hstep + kstep, voffB);
        PG8_WAIT_V(6); PG8_BAR;
    }
    for (;;) {
        const bool has_next = S.next(ui + 1, nxt);
        const char* nA = has_next ? (const char*)g.A + (size_t)nxt.pm * tstep : cA; const char* nB = has_next ? (const char*)g.Bt + (size_t)nxt.pn * tstep : cB;
        for (int t = 0; t < nt; t += 2) {
            const bool last = (t == nt - 2);
            const char* a1 = cA + (size_t)(t + 1) * kstep;
            const char* a2 = last ? nA : cA + (size_t)(t + 2) * kstep; const char* b2 = last ? nB : cB + (size_t)(t + 2) * kstep;
            const char* a3 = a2 + kstep; const char* b3 = b2 + kstep;
            if (last && has_next) S.a_ready(nxt);
            if constexpr (SP2) {
            PG8_LDB(B0, 0, 0); PG8_LDB(B1, 0, 1); PG8_SCHED; PG8_LDA(At, 0, 0); PG8_STAGE(PG8_SA(1, 1), a1 + hstep, voffA);
            PG8_WAIT_V(8); PG8_WAIT_L(0); PG8_BAR; PG8_MMA(0, 0, At, B0); PG8_MMA(0, 1, At, B1); PG8_BAR; PG8_SCHED;
            PG8_LDA(At, 0, 1); PG8_STAGE(PG8_SB(0, 0), b2, voffB); PG8_STAGE(PG8_SB(0, 1), b2 + hstep, voffB); PG8_STAGE(PG8_SA(0, 0), a2, voffA);
            PG8_WAIT_V(8); PG8_WAIT_L(0); PG8_BAR; PG8_MMA(1, 0, At, B0); PG8_MMA(1, 1, At, B1); PG8_BAR; PG8_SCHED;
            PG8_LDB(B0, 1, 0); PG8_LDB(B1, 1, 1); PG8_SCHED; PG8_LDA(At, 1, 0); PG8_STAGE(PG8_SA(0, 1), a2 + hstep, voffA);
            PG8_WAIT_V(8); PG8_WAIT_L(0); PG8_BAR; PG8_MMA(0, 0, At, B0); PG8_MMA(0, 1, At, B1); PG8_BAR; PG8_SCHED;
            PG8_LDA(At, 1, 1); PG8_STAGE(PG8_SB(1, 0), b3, voffB); PG8_STAGE(PG8_SB(1, 1), b3 + hstep, voffB); PG8_STAGE(PG8_SA(1, 0), a3, voffA);
            PG8_WAIT_V(8); PG8_WAIT_L(0); PG8_BAR; PG8_MMA(1, 0, At, B0); PG8_MMA(1, 1, At, B1); PG8_BAR; PG8_SCHED;
            } else {
            PG8_LDB(B0, 0, 0); PG8_SCHED; PG8_LDA(At, 0, 0); PG8_STAGE(PG8_SA(1, 1), a1 + hstep, voffA);
            PG8_WAIT_L(8); PG8_BAR; PG8_WAIT_L(0); PG8_MMA(0, 0, At, B0); PG8_BAR; PG8_SCHED;
            PG8_LDB(B1, 0, 1); PG8_STAGE(PG8_SB(0, 0), b2, voffB);
            PG8_BAR; PG8_WAIT_L(0); PG8_MMA(0, 1, At, B1); PG8_BAR;
            PG8_LDA(At, 0, 1); PG8_STAGE(PG8_SA(0, 0), a2, voffA);
            PG8_BAR; PG8_WAIT_L(0); PG8_MMA(1, 0, At, B0); PG8_BAR; PG8_SCHED;
            PG8_STAGE(PG8_SB(0, 1), b2 + hstep, voffB);
            PG8_WAIT_V(6); PG8_BAR; PG8_MMA(1, 1, At, B1); PG8_BAR;
            PG8_LDB(B0, 1, 0); PG8_SCHED; PG8_LDA(At, 1, 0); PG8_STAGE(PG8_SA(0, 1), a2 + hstep, voffA);
            PG8_WAIT_L(8); PG8_BAR; PG8_WAIT_L(0); PG8_MMA(0, 0, At, B0); PG8_BAR; PG8_SCHED;
            PG8_LDB(B1, 1, 1); PG8_STAGE(PG8_SB(1, 0), b3, voffB);
            PG8_BAR; PG8_WAIT_L(0); PG8_MMA(0, 1, At, B1); PG8_BAR;
            PG8_LDA(At, 1, 1); PG8_STAGE(PG8_SA(1, 0), a3, voffA);
            PG8_BAR; PG8_WAIT_L(0); PG8_MMA(1, 0, At, B0); PG8_BAR; PG8_SCHED;
            PG8_STAGE(PG8_SB(1, 1), b3 + hstep, voffB);
            PG8_WAIT_V(6); PG8_BAR; PG8_MMA(1, 1, At, B1); PG8_BAR;
            }
        }
        if constexpr (ALIGN_EPI) { if (wr == 0) PG8_BAR; }
        if constexpr (!Epi::AFTER_DRAIN) { E(acc, cur, wr, wc, fr, fq); S.done(cur); }
        if (!has_next) break;
#pragma unroll
        for (int a = 0; a < 2; ++a)
#pragma unroll
            for (int b = 0; b < 2; ++b)
#pragma unroll
                for (int m = 0; m < 4; ++m)
#pragma unroll
                    for (int n = 0; n < 2; ++n) acc[a][b][m][n] = (f32x4){0.f, 0.f, 0.f, 0.f};
        cur = nxt; cA = nA; cB = nB; ++ui;
        if constexpr (ALIGN_EPI) { if (wr == 1) PG8_BAR; }
    }
    PG8_WAIT_V(0);
    if constexpr (!ALIGN_EPI) { if (wr == 0) PG8_BAR; }
    PG8_BAR;
    if constexpr (Epi::AFTER_DRAIN) { E.fused(acc, cur, wr, wc, fr, fq, lds, wid, lane); S.done(cur); }
#undef PG8_SA
#undef PG8_SB
#undef PG8_STAGE
#undef PG8_LDA
#undef PG8_LDB
#undef PG8_MMA
#undef PG8_WAIT_V
#undef PG8_WAIT_L
#undef PG8_BAR
#undef PG8_SCHED
}
}

#ifndef PG8_SP2
#define PG8_SP2 true
#endif
#ifndef PG8_ALIGN
#define PG8_ALIGN true
#endif
#ifndef MK_N_LAUNCHES
#define MK_N_LAUNCHES 1
#endif
constexpr int NWAVES = 8;
constexpr int NPHASES = 8;
constexpr int N_LAUNCHES = MK_N_LAUNCHES;

constexpr int NB = 32, SEQ = 2048, T = NB * SEQ, D = 1024, DIN = 3584;
constexpr int PC_C = 0, PC_H = 512, PC_B = 1024, PC_Q = 1536, PC_F = 2048, PC_V = 2560, PC_G = 3072;
constexpr int NEXP = 16384;
constexpr float EPS = 1e-6f;
constexpr float PEER_SU = 640.0f, PEER_SV = 64.0f;

constexpr size_t MiB = 1u << 20;
constexpr size_t WS_CTL = 0, CTL_ZERO_BYTES = 1 * MiB;
constexpr size_t WS_W1T = 2 * MiB, WS_WOT = 10 * MiB, WS_WQT = 12 * MiB, WS_RS1 = 16 * MiB, WS_SS2 = 17 * MiB;
constexpr size_t WS_KEYB = 18 * MiB;
constexpr size_t WS_U16 = 32 * MiB, WS_V16 = 64 * MiB, WS_EXP = 96 * MiB;
constexpr size_t WS_XB = 128 * MiB;
constexpr size_t WS_X1 = 256 * MiB;
constexpr size_t WS_PROJ = 384 * MiB;
constexpr size_t WS_F = 832 * MiB;
constexpr size_t WS_END = 960 * MiB;
constexpr int CW_BAR = 4096;

constexpr int RING_OFF = 0, RING_BYTES = 131072;
constexpr int LDSCTL_OFF = RING_BYTES, MISC_OFF = LDSCTL_OFF + 320;
constexpr int LDS_BYTES = 147456;

#define GAS __attribute__((address_space(1)))
#define LAS __attribute__((address_space(3)))
typedef unsigned short bf16;
typedef unsigned v4u __attribute__((ext_vector_type(4)));
typedef unsigned v2u __attribute__((ext_vector_type(2)));
typedef float f32x4 __attribute__((ext_vector_type(4)));
typedef float f32x2 __attribute__((ext_vector_type(2)));
typedef _Float16 h2_t __attribute__((ext_vector_type(2)));
typedef GAS unsigned gu32;
#define RLX_AGENT __ATOMIC_RELAXED, __HIP_MEMORY_SCOPE_AGENT
#define LDS_WAIT() asm volatile("s_waitcnt lgkmcnt(0)" ::: "memory")
#define VM_WAIT() asm volatile("s_waitcnt vmcnt(0)" ::: "memory")
__device__ __forceinline__ unsigned f2bf(float f) { unsigned u = __builtin_bit_cast(unsigned, f); return (u + 0x7fffu + ((u >> 16) & 1u)) >> 16; }
__device__ __forceinline__ unsigned pk2(float lo, float hi) { return f2bf(lo) | (f2bf(hi) << 16); }
__device__ __forceinline__ float bf_lo(unsigned w) { return __builtin_bit_cast(float, w << 16); }
__device__ __forceinline__ float bf_hi(unsigned w) { return __builtin_bit_cast(float, w & 0xffff0000u); }
__device__ __forceinline__ float bf1(bf16 v) { return __builtin_bit_cast(float, (unsigned)v << 16); }
__device__ __forceinline__ unsigned pkh2(float lo, float hi) { f32x2 v = {lo, hi}; h2_t h = __builtin_convertvector(v, h2_t); return __builtin_bit_cast(unsigned, h); }
__device__ __forceinline__ h2_t h2_of(unsigned w) { return __builtin_bit_cast(h2_t, w); }
__device__ __forceinline__ float swap32_add(float a, float b) { const v2u r = __builtin_amdgcn_permlane32_swap(__builtin_bit_cast(unsigned, a), __builtin_bit_cast(unsigned, b), false, false);
    const unsigned rx = r.x, ry = r.y; return __builtin_bit_cast(float, rx) + __builtin_bit_cast(float, ry); }
__device__ __forceinline__ float swap16_add(float a, float b) { const v2u r = __builtin_amdgcn_permlane16_swap(__builtin_bit_cast(unsigned, a), __builtin_bit_cast(unsigned, b), false, false);
    const unsigned rx = r.x, ry = r.y; return __builtin_bit_cast(float, rx) + __builtin_bit_cast(float, ry); }
template <int CTRL> __device__ __forceinline__ float dpp_f(float v) { return __builtin_bit_cast(float, __builtin_amdgcn_update_dpp(0, __builtin_bit_cast(int, v), CTRL, 0xF, 0xF, false)); }
template <int CTRL> __device__ __forceinline__ unsigned dpp_u(unsigned v) { return (unsigned)__builtin_amdgcn_update_dpp(0, (int)v, CTRL, 0xF, 0xF, false); }
__device__ __forceinline__ float wave_sum(float v) {
    v += dpp_f<0xB1>(v); v += dpp_f<0x4E>(v); v += dpp_f<0x124>(v); v += dpp_f<0x128>(v);
    v = swap16_add(v, v); v = swap32_add(v, v);
    return v;
}
typedef float f32x16 __attribute__((ext_vector_type(16)));
typedef __bf16 bf16x2_t __attribute__((ext_vector_type(2)));
__device__ __forceinline__ unsigned cvtpk(float lo, float hi) { f32x2 v = {lo, hi}; bf16x2_t b = __builtin_convertvector(v, bf16x2_t); return __builtin_bit_cast(unsigned, b); }
__device__ __forceinline__ pg8::bf16x8 pack8(const f32x16& x, int s) {
    v4u p; p.x = cvtpk(x[8 * s], x[8 * s + 1]); p.y = cvtpk(x[8 * s + 2], x[8 * s + 3]); p.z = cvtpk(x[8 * s + 4], x[8 * s + 5]); p.w = cvtpk(x[8 * s + 6], x[8 * s + 7]);
    return __builtin_bit_cast(pg8::bf16x8, p); }
__device__ __forceinline__ void ce_desc(unsigned& a, unsigned& b) { const unsigned mx = a > b ? a : b, mn = a > b ? b : a; a = mx; b = mn; }
__device__ __forceinline__ void sort16_desc(unsigned (&a)[16]) {
#pragma unroll
    for (int k = 2; k <= 16; k <<= 1)
#pragma unroll
        for (int j = k >> 1; j > 0; j >>= 1)
#pragma unroll
            for (int i = 0; i < 16; ++i) { const int l = i ^ j; if (l > i) { if ((i & k) == 0) ce_desc(a[i], a[l]); else ce_desc(a[l], a[i]); } }
}
__device__ __forceinline__ void merge16_desc(unsigned (&a)[16], const unsigned (&b)[16]) {
#pragma unroll
    for (int i = 0; i < 16; ++i) a[i] = a[i] > b[15 - i] ? a[i] : b[15 - i];
#pragma unroll
    for (int j = 8; j > 0; j >>= 1)
#pragma unroll
        for (int i = 0; i < 16; ++i) { const int l = i ^ j; if (l > i) ce_desc(a[i], a[l]); }
}
__device__ __forceinline__ float unkey(unsigned a) { a = (a & 0x80000000u) ? (a & 0x7FFFFFFFu) : ~a; return __builtin_bit_cast(float, a); }
__device__ __forceinline__ unsigned ckey(float s, int flat) { unsigned u = __builtin_bit_cast(unsigned, s); u ^= (unsigned)((int)u >> 31) | 0x80000000u; return (u & ~0xFFu) | (unsigned)(255 - flat); }
template <int J> __device__ __forceinline__ unsigned xor_lane(unsigned x, int lane) {
    if (J == 1) return dpp_u<0xB1>(x);
    if (J == 2) return dpp_u<0x4E>(x);
    if (J == 8) return dpp_u<0x128>(x);
    if (J == 16) { const v2u r = __builtin_amdgcn_permlane16_swap(x, x, false, false); const unsigned rx = r.x, ry = r.y; return (lane & 16) ? rx : ry; }
    if (J == 32) { const v2u r = __builtin_amdgcn_permlane32_swap(x, x, false, false); const unsigned rx = r.x, ry = r.y; return (lane & 32) ? rx : ry; }
    return (unsigned)__shfl_xor((int)x, J);
}
template <int K, int J, int N> __device__ __forceinline__ void sort128_stage(unsigned (&e)[N][2], int lane) {
#pragma unroll
    for (int t = 0; t < N; ++t) {
        if (J == 64) { const unsigned mn = e[t][0] < e[t][1] ? e[t][0] : e[t][1], mx = e[t][0] < e[t][1] ? e[t][1] : e[t][0]; e[t][0] = mn; e[t][1] = mx; }
        else {
            const unsigned p0 = xor_lane<J>(e[t][0], lane), p1 = xor_lane<J>(e[t][1], lane);
            const bool lower = (lane & J) == 0;
            const bool up0 = (K >= 64) ? true : ((lane & K) == 0);
            const bool up1 = (K == 128) ? true : (K == 64 ? false : ((lane & K) == 0));
            const unsigned mn0 = e[t][0] < p0 ? e[t][0] : p0, mx0 = e[t][0] < p0 ? p0 : e[t][0], mn1 = e[t][1] < p1 ? e[t][1] : p1, mx1 = e[t][1] < p1 ? p1 : e[t][1];
            e[t][0] = (lower == up0) ? mn0 : mx0; e[t][1] = (lower == up1) ? mn1 : mx1;
        }
    }
}
template <int N> __device__ __forceinline__ void sort128_asc(unsigned (&e)[N][2], int lane) {
#define S_(K, J) sort128_stage<K, J, N>(e, lane)
    S_(2, 1); S_(4, 2); S_(4, 1); S_(8, 4); S_(8, 2); S_(8, 1); S_(16, 8); S_(16, 4); S_(16, 2); S_(16, 1);
    S_(32, 16); S_(32, 8); S_(32, 4); S_(32, 2); S_(32, 1); S_(64, 32); S_(64, 16); S_(64, 8); S_(64, 4); S_(64, 2); S_(64, 1);
    S_(128, 64); S_(128, 32); S_(128, 16); S_(128, 8); S_(128, 4); S_(128, 2); S_(128, 1);
#undef S_
}
__device__ __forceinline__ float wave_max(float v) {
    v = fmaxf(v, dpp_f<0xB1>(v)); v = fmaxf(v, dpp_f<0x4E>(v)); v = fmaxf(v, dpp_f<0x124>(v)); v = fmaxf(v, dpp_f<0x128>(v));
    { const v2u r = __builtin_amdgcn_permlane16_swap(__builtin_bit_cast(unsigned, v), __builtin_bit_cast(unsigned, v), false, false); const unsigned rx = r.x, ry = r.y; v = fmaxf(__builtin_bit_cast(float, rx), __builtin_bit_cast(float, ry)); }
    { const v2u r = __builtin_amdgcn_permlane32_swap(__builtin_bit_cast(unsigned, v), __builtin_bit_cast(unsigned, v), false, false); const unsigned rx = r.x, ry = r.y; v = fmaxf(__builtin_bit_cast(float, rx), __builtin_bit_cast(float, ry)); }
    return v;
}
__device__ __forceinline__ int swap32_addi(int a, int b) { const v2u r = __builtin_amdgcn_permlane32_swap((unsigned)a, (unsigned)b, false, false); const unsigned rx = r.x, ry = r.y; return (int)(rx + ry); }
__device__ __forceinline__ int swap16_addi(int a, int b) { const v2u r = __builtin_amdgcn_permlane16_swap((unsigned)a, (unsigned)b, false, false); const unsigned rx = r.x, ry = r.y; return (int)(rx + ry); }
__device__ __forceinline__ int reduce16i(const int (&p)[16], int lane) {
    int q[8], r[4], u[2];
    const bool b3 = (lane & 8) != 0, b2 = (lane & 4) != 0;
#pragma unroll
    for (int i = 0; i < 8; ++i) q[i] = swap32_addi(p[2 * i], p[2 * i + 1]);
#pragma unroll
    for (int i = 0; i < 4; ++i) r[i] = swap16_addi(q[2 * i], q[2 * i + 1]);
#pragma unroll
    for (int i = 0; i < 2; ++i) { const int keep = b3 ? r[2 * i + 1] : r[2 * i], send = b3 ? r[2 * i] : r[2 * i + 1]; u[i] = keep + (int)dpp_u<0x128>((unsigned)send); }
    const int keep = b2 ? u[1] : u[0], send = b2 ? u[0] : u[1];
    int v = keep + __shfl_xor(send, 4);
    v += (int)dpp_u<0x4E>((unsigned)v); v += (int)dpp_u<0xB1>((unsigned)v);
    return v;
}
__device__ __forceinline__ float reduce16(const float (&p)[16], int lane) {
    float q[8], r[4], u[2];
    const bool b3 = (lane & 8) != 0, b2 = (lane & 4) != 0;
#pragma unroll
    for (int i = 0; i < 8; ++i) q[i] = swap32_add(p[2 * i], p[2 * i + 1]);
#pragma unroll
    for (int i = 0; i < 4; ++i) r[i] = swap16_add(q[2 * i], q[2 * i + 1]);
#pragma unroll
    for (int i = 0; i < 2; ++i) { const float keep = b3 ? r[2 * i + 1] : r[2 * i], send = b3 ? r[2 * i] : r[2 * i + 1]; u[i] = keep + dpp_f<0x128>(send); }
    const float keep = b2 ? u[1] : u[0], send = b2 ? u[0] : u[1];
    float v = keep + __shfl_xor(send, 4);
    v += dpp_f<0x4E>(v);
    v += dpp_f<0xB1>(v);
    return v;
}
__device__ __forceinline__ int swap23(int k) { return (k & ~12) | ((k & 4) << 1) | ((k & 8) >> 1); }
__device__ __forceinline__ float sigmoidf_(float x) { return 1.0f / (1.0f + __expf(-x)); }

#define XB_TMO      128
#define XB_XCNT(j)  (256  + 64 * (j))
#define XB_XSUB(j)  (1280 + 64 * (j))
#define XB_XGEN(j)  (2304 + 64 * (j))
#define XB_TOP      3328
#define XB_TOPGEN   3392
#define XCD_BAR_WORDS 3456
#define XB_SPIN_CAP (1u << 18)

__device__ __forceinline__ unsigned xb_ld(unsigned* p)              { return __hip_atomic_load(p, __ATOMIC_RELAXED, __HIP_MEMORY_SCOPE_AGENT); }
__device__ __forceinline__ unsigned xb_add(unsigned* p, unsigned v) { return __hip_atomic_fetch_add(p, v, __ATOMIC_RELAXED, __HIP_MEMORY_SCOPE_AGENT); }
__device__ __forceinline__ unsigned xb_xcc_id() { return (unsigned)__builtin_amdgcn_s_getreg((3 << 11) | 20) & 0xFu; }
#define XB_SPIN(cond, bar) do { unsigned _sp = 0; while (cond) { __builtin_amdgcn_s_sleep(1); \
    if ((++_sp & 255u) == 0u) { if (xb_ld(&(bar)[XB_TMO])) break; if (_sp > XB_SPIN_CAP) { atomicAdd(&(bar)[XB_TMO], 1u); break; } } } } while (0)

struct XcdBarrier {
    unsigned* bar; unsigned x;
    volatile LAS unsigned* st;
};

__device__ __forceinline__ XcdBarrier xcd_barrier_post(unsigned* bar, volatile LAS unsigned* st) {
    XcdBarrier b; b.bar = bar; b.x = xb_xcc_id(); b.st = st;
    if (threadIdx.x == 0) (void)xb_add(&bar[XB_XCNT(b.x)], 1u);
    return b;
}
__device__ __forceinline__ void xcd_barrier_complete(unsigned* bar, unsigned x, unsigned& nloc, unsigned& nx) {
    const unsigned G = gridDim.x * gridDim.y * gridDim.z;
    unsigned sum, cnt, mine, sp = 0u;
    for (;;) {
        sum = 0u; cnt = 0u; mine = 0u;
#pragma unroll
        for (unsigned j = 0; j < 16; ++j) { const unsigned c = xb_ld(&bar[XB_XCNT(j)]); sum += c; cnt += (c > 0u) ? 1u : 0u; mine = (j == x) ? c : mine; }
        if (sum == G) break;
        __builtin_amdgcn_s_sleep(1);
        if ((++sp & 255u) == 0u) { if (xb_ld(&bar[XB_TMO])) break; if (sp > XB_SPIN_CAP) { atomicAdd(&bar[XB_TMO], 1u); break; } }
    }
    nloc = mine > 0u ? mine : 1u; nx = cnt > 0u ? cnt : 1u;
}

__device__ __forceinline__ void xcd_barrier(const XcdBarrier& b) {
    asm volatile("s_waitcnt vmcnt(0)" ::: "memory");
    __syncthreads();
    if (threadIdx.x == 0) {
        unsigned* bar = b.bar;
        __builtin_amdgcn_s_waitcnt(0);
        unsigned nloc = b.st[0], nx = b.st[1];
        if (nloc == 0u) { xcd_barrier_complete(bar, b.x, nloc, nx); b.st[0] = nloc; b.st[1] = nx; }
        const unsigned old = xb_add(&bar[XB_XSUB(b.x)], 1u);
        const unsigned gen = old / nloc;
        if (old + 1u == (gen + 1u) * nloc) {
            __builtin_amdgcn_fence(__ATOMIC_RELEASE, "agent");
            asm volatile("s_waitcnt vmcnt(0)" ::: "memory");
            const unsigned og = xb_add(&bar[XB_TOP], 1u);
            const unsigned tg = og / nx;
            if (og + 1u == (tg + 1u) * nx) xb_add(&bar[XB_TOPGEN], 1u);
            else XB_SPIN(xb_ld(&bar[XB_TOPGEN]) == tg, bar);
            __builtin_amdgcn_fence(__ATOMIC_ACQUIRE, "agent");
            xb_add(&bar[XB_XGEN(b.x)], 1u);
            asm volatile("s_waitcnt vmcnt(0)" ::: "memory");
        } else {
            XB_SPIN(xb_ld(&bar[XB_XGEN(b.x)]) == gen, bar);
            __builtin_amdgcn_fence(__ATOMIC_ACQUIRE, "agent");
            asm volatile("s_waitcnt vmcnt(0)" ::: "memory");
        }
    }
    __syncthreads();
}


__device__ __forceinline__ void p0_transpose_item(const float* W, int K, int N, const float* gain, bf16* WT, LAS float* scr, int item, int lane) {
    const int nblk = N / 32, kb = item / nblk, nb = item % nblk, k0 = 64 * kb, n0 = 32 * nb;
#pragma unroll 8
    for (int i = 0; i < 32; ++i) { const int kk = 2 * i + (lane >> 5); const float g = gain ? gain[k0 + kk] : 1.0f; scr[kk * 33 + (lane & 31)] = W[(size_t)(k0 + kk) * N + n0 + (lane & 31)] * g; }
    LDS_WAIT(); asm volatile("" ::: "memory");
    const int c = lane & 7;
#pragma unroll
    for (int j = 0; j < 4; ++j) { const int n = (lane >> 3) + 8 * j; const LAS float* s = scr + (8 * c) * 33 + n;
        v4u o; o.x = pk2(s[0 * 33], s[1 * 33]); o.y = pk2(s[2 * 33], s[3 * 33]); o.z = pk2(s[4 * 33], s[5 * 33]); o.w = pk2(s[6 * 33], s[7 * 33]);
        *(GAS v4u*)(WT + (size_t)(n0 + n) * K + k0 + 8 * c) = o; }
    LDS_WAIT(); asm volatile("" ::: "memory");
}

struct Args { const float* in[14]; float* out; unsigned char* ws; int ph_lo, ph_hi, li, pad; };

__global__ void __launch_bounds__(NWAVES * 64, 2) hymba_fwd(Args args) {
    extern __shared__ __attribute__((aligned(16))) unsigned char lds_raw[];
    LAS unsigned char* lds = (LAS unsigned char*)lds_raw;
    volatile LAS unsigned* MISC = (volatile LAS unsigned*)(lds + MISC_OFF);
    const int tid = threadIdx.x, lane = tid & 63, wave = __builtin_amdgcn_readfirstlane(tid >> 6);
    const int G = gridDim.x;
    const int gw = (int)blockIdx.x * NWAVES + wave, NGW = G * NWAVES;
    unsigned char* ws = args.ws;
    gu32* ctl = (gu32*)(ws + WS_CTL);
    const float* x = args.in[0]; const float* norm_mix = args.in[1]; const float* w_in = args.in[2]; const float* conv_w = args.in[3]; const float* conv_gain = args.in[4];
    const float* hg_lb = args.in[5]; const float* hg_gain = args.in[6]; const float* w_out = args.in[7]; const float* norm_ffn = args.in[8]; const float* peer_wq = args.in[9];
    const float* peer_keys = args.in[10]; const float* peer_u = args.in[11]; const float* peer_v = args.in[12]; const float* norm_f = args.in[13];
    float* out = args.out;
    bf16* W1T = (bf16*)(ws + WS_W1T); bf16* WOT = (bf16*)(ws + WS_WOT); bf16* WQT = (bf16*)(ws + WS_WQT);
    float* RS1 = (float*)(ws + WS_RS1); float* SS2 = (float*)(ws + WS_SS2);
    unsigned char* U8 = ws + WS_U16; unsigned char* V8 = ws + WS_V16; unsigned* EXPT = (unsigned*)(ws + WS_EXP); bf16* KEYB = (bf16*)(ws + WS_KEYB);
    bf16* XB = (bf16*)(ws + WS_XB); bf16* MIX = (bf16*)(ws + WS_XB); bf16* X1 = (bf16*)(ws + WS_X1);
    bf16* PROJ = (bf16*)(ws + WS_PROJ); bf16* QB = (bf16*)(ws + WS_PROJ); float* DEC = (float*)(ws + WS_F); bf16* KDT = (bf16*)(ws + WS_X1); bf16* VTT = (bf16*)(ws + WS_X1 + 64 * MiB);

    for (int u = tid; u < (LDS_BYTES - LDSCTL_OFF) / 4; u += NWAVES * 64) ((LAS unsigned*)(lds + LDSCTL_OFF))[u] = 0u;
    __syncthreads();
    XcdBarrier bar; bar.bar = (unsigned*)(ctl + CW_BAR); bar.x = 0; bar.st = nullptr;
    if (N_LAUNCHES == 1) bar = xcd_barrier_post((unsigned*)(ctl + CW_BAR), MISC + 8);
#define GRID_BAR() do { if (N_LAUNCHES == 1) xcd_barrier(bar); } while (0)
    const int lo = args.ph_lo, hi = args.ph_hi;
#define IN(k) (lo <= (k) && (k) < hi)
#define BOTH(k) (IN(k) && IN((k) + 1))

    if (IN(0)) {
        LAS float* scr = (LAS float*)(lds + RING_OFF + wave * 16384);
        constexpr int I_1 = (D / 64) * (DIN / 32), I_O = (D / 64) * (D / 32), I_Q = (D / 64) * (2048 / 32);
        for (int it = gw; it < I_1 + I_O + I_Q; it += NGW) {
            int r = it;
            if (r < I_1) { p0_transpose_item(w_in, D, DIN, norm_mix, W1T, scr, r, lane); continue; } r -= I_1;
            if (r < I_O) { p0_transpose_item(w_out, D, D, nullptr, WOT, scr, r, lane); continue; } r -= I_O;
            p0_transpose_item(peer_wq, D, 2048, norm_ffn, WQT, scr, r, lane);
        }
        for (int m = gw; m < T; m += NGW) {
            const GAS f32x4* xr = (const GAS f32x4*)(x + (size_t)m * D) + lane; f32x4 v[4]; float s = 0.f;
#pragma unroll
            for (int j = 0; j < 4; ++j) { v[j] = xr[64 * j]; s += (v[j].x * v[j].x + v[j].y * v[j].y) + (v[j].z * v[j].z + v[j].w * v[j].w); }
            s = wave_sum(s);
            if (lane == 0) RS1[m] = 1.0f / sqrtf(s * (1.0f / D) + EPS);
            GAS unsigned long long* o8 = (GAS unsigned long long*)(XB + (size_t)m * D) + lane;
#pragma unroll
            for (int j = 0; j < 4; ++j) o8[64 * j] = (unsigned long long)pk2(v[j].x, v[j].y) | ((unsigned long long)pk2(v[j].z, v[j].w) << 32);
        }
        for (int r = gw; r < 2 * NEXP; r += NGW) {
            const int tb = r / NEXP, e = r % NEXP; const float sc = tb ? PEER_SV : PEER_SU;
            const GAS f32x4* src = (const GAS f32x4*)((tb ? peer_v : peer_u) + (size_t)e * D);
            f32x4 v[4] = {src[2 * lane], src[2 * lane + 1], src[128 + 2 * lane], src[128 + 2 * lane + 1]};
            if (!tb) { const GAS f32x4* gp = (const GAS f32x4*)norm_ffn; v[0] = v[0] * gp[2 * lane]; v[1] = v[1] * gp[2 * lane + 1]; v[2] = v[2] * gp[128 + 2 * lane]; v[3] = v[3] * gp[128 + 2 * lane + 1]; }
            unsigned o[4];
#pragma unroll
            for (int j = 0; j < 4; ++j) { f32x4 w = v[j] * sc;
                if (tb) { w.x = fminf(fmaxf(w.x, -240.f), 240.f); w.y = fminf(fmaxf(w.y, -240.f), 240.f); w.z = fminf(fmaxf(w.z, -240.f), 240.f); w.w = fminf(fmaxf(w.w, -240.f), 240.f);
                    int pk = 0; pk = __builtin_amdgcn_cvt_pk_fp8_f32(w.x, w.y, pk, false); pk = __builtin_amdgcn_cvt_pk_fp8_f32(w.z, w.w, pk, true); o[j] = (unsigned)pk; }
                else { const int i0 = (int)rintf(fminf(fmaxf(w.x, -127.f), 127.f)), i1 = (int)rintf(fminf(fmaxf(w.y, -127.f), 127.f)), i2 = (int)rintf(fminf(fmaxf(w.z, -127.f), 127.f)), i3 = (int)rintf(fminf(fmaxf(w.w, -127.f), 127.f));
                    o[j] = ((unsigned)i0 & 0xFFu) | (((unsigned)i1 & 0xFFu) << 8) | (((unsigned)i2 & 0xFFu) << 16) | (((unsigned)i3 & 0xFFu) << 24); } }
            ((GAS v4u*)((tb ? V8 : U8) + (size_t)e * D))[lane] = (v4u){o[0], o[1], o[2], o[3]};
        }
        for (int i = (int)blockIdx.x * NWAVES * 64 + tid; i < T; i += G * NWAVES * 64) SS2[i] = 0.f;
        for (int i = (int)blockIdx.x * NWAVES * 64 + tid; i < 8 * 2 * 128 * 128 / 2; i += G * NWAVES * 64) ((GAS unsigned*)KEYB)[i] = pk2(peer_keys[2 * i], peer_keys[2 * i + 1]);
        if (BOTH(0)) GRID_BAR();
    }

    if (IN(1)) {
        pg8::Gemm g{XB, W1T, T, DIN, D}; pg8::StaticOrder S; S.init(T, DIN, G, (int)blockIdx.x);
        pg8::EpiScaleBf16<0> E{PROJ, DIN, RS1};
        pg8::gemm_phase<pg8::EpiScaleBf16<0>, pg8::StaticOrder, PG8_ALIGN, PG8_SP2>(lds + RING_OFF, g, S, E);
        if (BOTH(1)) GRID_BAR();
    }

    if (IN(2)) {
        for (int item = gw; item < NB * 64 * 4; item += NGW) {
            const int h = item & 3, n = (item >> 2) & 63, b = item >> 8;
            const size_t tok0 = (size_t)b * SEQ + n * 32;
            const int c0 = h * 128 + 2 * lane, cs = h * 128 + swap23(2 * lane);
            const float lb0 = 1.0f / (1.0f + __expf(hg_lb[512 + c0] - hg_lb[c0])), lb1 = 1.0f / (1.0f + __expf(hg_lb[512 + c0 + 1] - hg_lb[c0 + 1]));
            unsigned qw[32], fw[32], vw[32];
#pragma unroll
            for (int c = 0; c < 32; ++c) { const bf16* pr = PROJ + (tok0 + c) * DIN;
                qw[c] = *(const GAS unsigned*)(pr + PC_Q + c0); fw[c] = *(const GAS unsigned*)(pr + PC_F + c0); vw[c] = *(const GAS unsigned*)(pr + PC_V + c0); }
            float eG0 = 1.f, eG1 = 1.f;
            unsigned kd0[16], kd1[16], vv0[16], vv1[16];
#pragma unroll
            for (int i = 0; i < 16; ++i) { kd0[i] = 0u; kd1[i] = 0u; vv0[i] = 0u; vv1[i] = 0u; }
#pragma unroll
            for (int c = 0; c < 32; ++c) { bf16* pr = PROJ + (tok0 + c) * DIN;
                const float f0 = lb0 + (1.0f - lb0) * sigmoidf_(bf_lo(fw[c])), f1 = lb1 + (1.0f - lb1) * sigmoidf_(bf_hi(fw[c]));
                eG0 *= f0; eG1 *= f1;
                const float q0 = bf_lo(qw[c]), q1 = bf_hi(qw[c]);
                const float qd0 = q0 * sigmoidf_(q0) * 0.08838834764831845f * eG0, qd1 = q1 * sigmoidf_(q1) * 0.08838834764831845f * eG1;
                const float kv0 = (1.0f - f0) / eG0, kv1 = (1.0f - f1) / eG1;
                *(GAS unsigned*)(pr + PC_Q + cs) = pk2(qd0, qd1);
                const unsigned kp = pk2(kv0, kv1);
                *(GAS unsigned*)(pr + PC_F + cs) = kp;
                const int pp = swap23(c), sh = 16 * (pp & 1);
                kd0[pp >> 1] |= (kp & 0xffffu) << sh; kd1[pp >> 1] |= (kp >> 16) << sh;
                vv0[pp >> 1] |= (vw[c] & 0xffffu) << sh; vv1[pp >> 1] |= (vw[c] >> 16) << sh; }
            GAS v4u* kt = (GAS v4u*)(KDT + ((size_t)item * 128 + 2 * lane) * 32);
            GAS v4u* vt = (GAS v4u*)(VTT + ((size_t)item * 128 + 2 * lane) * 32);
#pragma unroll
            for (int i = 0; i < 4; ++i) { kt[i] = (v4u){kd0[4 * i], kd0[4 * i + 1], kd0[4 * i + 2], kd0[4 * i + 3]}; kt[4 + i] = (v4u){kd1[4 * i], kd1[4 * i + 1], kd1[4 * i + 2], kd1[4 * i + 3]};
                vt[i] = (v4u){vv0[4 * i], vv0[4 * i + 1], vv0[4 * i + 2], vv0[4 * i + 3]}; vt[4 + i] = (v4u){vv1[4 * i], vv1[4 * i + 1], vv1[4 * i + 2], vv1[4 * i + 3]}; }
            *(GAS f32x2*)(DEC + (size_t)item * 128 + 2 * lane) = (f32x2){eG0, eG1};
        }
        if (BOTH(2)) GRID_BAR();
    }

    if (IN(3)) {
        constexpr int BUFB = 33792, OB0 = 2 * BUFB;
        for (int it = (int)blockIdx.x; it < NB * 4; it += G) {
            const int b = it >> 2, h = it & 3;
            const int lt = tid & 255, r = lane & 31, hh = lane >> 5, sl = wave;
            v4u st[9];
#define SCAN_LOAD(n_) do { const size_t tk0 = (size_t)b * SEQ + (n_) * 32; const size_t itm = (size_t)((b * 64 + (n_)) * 4 + h); \
                _Pragma("unroll") for (int i = 0; i < 2; ++i) { const int q = lt + 256 * i, row = q >> 4, cc = q & 15; const bf16* pr = PROJ + (tk0 + row) * DIN + h * 128 + cc * 8; \
                    st[i] = *(const GAS v4u*)(pr + PC_Q); st[2 + i] = *(const GAS v4u*)(pr + PC_F); \
                    st[4 + i] = ((const GAS v4u*)(KDT + itm * 4096))[q]; st[6 + i] = ((const GAS v4u*)(VTT + itm * 4096))[q]; } \
                if (lt < 32) st[8] = ((const GAS v4u*)(DEC + itm * 128))[lt]; } while (0)
#define SCAN_COMMIT(n_) do { LAS unsigned char* Bf = lds + RING_OFF + ((n_) & 1) * BUFB; \
                _Pragma("unroll") for (int i = 0; i < 2; ++i) { const int q = lt + 256 * i, row = q >> 4, cc = q & 15, k = q >> 2, c4 = q & 3; \
                    *(LAS v4u*)(Bf + row * 256 + ((cc ^ (row & 15)) * 16)) = st[i]; *(LAS v4u*)(Bf + 8192 + row * 256 + ((cc ^ (row & 15)) * 16)) = st[2 + i]; \
                    *(LAS v4u*)(Bf + 16384 + k * 64 + ((c4 ^ ((k >> 2) & 3)) * 16)) = st[4 + i]; *(LAS v4u*)(Bf + 24576 + k * 64 + ((c4 ^ ((k >> 2) & 3)) * 16)) = st[6 + i]; } \
                if (lt < 32) *(LAS v4u*)(Bf + 32768 + lt * 16) = st[8]; } while (0)
#define SCAN_POST(n_) do { const int pos = lt >> 3, vg = lt & 7; const LAS f32x4* ob = (const LAS f32x4*)(lds + RING_OFF + OB0 + ((n_) & 1) * 16384 + (pos * 128 + vg * 16) * 4); \
                const f32x4 o0 = ob[0], o1 = ob[1], o2 = ob[2], o3 = ob[3]; \
                float ss = (o0.x * o0.x + o0.y * o0.y) + (o0.z * o0.z + o0.w * o0.w) + (o1.x * o1.x + o1.y * o1.y) + (o1.z * o1.z + o1.w * o1.w) \
                         + (o2.x * o2.x + o2.y * o2.y) + (o2.z * o2.z + o2.w * o2.w) + (o3.x * o3.x + o3.y * o3.y) + (o3.z * o3.z + o3.w * o3.w); \
                ss += __shfl_xor(ss, 1); ss += __shfl_xor(ss, 2); ss += __shfl_xor(ss, 4); \
                const float rr = 1.0f / sqrtf(ss * (1.0f / 128.0f) + EPS); \
                const size_t tk = (size_t)b * SEQ + (n_) * 32 + pos; const GAS v4u* gp = (const GAS v4u*)(PROJ + tk * DIN + PC_G + h * 128 + vg * 16); const v4u g0 = gp[0], g1 = gp[1]; \
                const float ov[16] = {o0.x, o0.y, o0.z, o0.w, o1.x, o1.y, o1.z, o1.w, o2.x, o2.y, o2.z, o2.w, o3.x, o3.y, o3.z, o3.w}; \
                const float gf[16] = {bf_lo(g0.x), bf_hi(g0.x), bf_lo(g0.y), bf_hi(g0.y), bf_lo(g0.z), bf_hi(g0.z), bf_lo(g0.w), bf_hi(g0.w), bf_lo(g1.x), bf_hi(g1.x), bf_lo(g1.y), bf_hi(g1.y), bf_lo(g1.z), bf_hi(g1.z), bf_lo(g1.w), bf_hi(g1.w)}; \
                float yv[16]; _Pragma("unroll") for (int i = 0; i < 16; ++i) yv[i] = ov[i] * rr * hg_gain[vg * 16 + i] * (gf[i] * sigmoidf_(gf[i])); \
                GAS v4u* mp = (GAS v4u*)(MIX + tk * D + 512 + h * 128 + vg * 16); \
                mp[0] = (v4u){pk2(yv[0], yv[1]), pk2(yv[2], yv[3]), pk2(yv[4], yv[5]), pk2(yv[6], yv[7])}; mp[1] = (v4u){pk2(yv[8], yv[9]), pk2(yv[10], yv[11]), pk2(yv[12], yv[13]), pk2(yv[14], yv[15])}; } while (0)
#define SCAN_BAR() do { asm volatile("s_waitcnt lgkmcnt(0)" ::: "memory"); __builtin_amdgcn_s_barrier(); asm volatile("" ::: "memory"); } while (0)
            if (wave >= 4) {
                SCAN_LOAD(0); SCAN_COMMIT(0);
                SCAN_BAR();
                for (int n = 0; n < 64; ++n) {
                    if (n + 1 < 64) SCAN_LOAD(n + 1);
                    if (n >= 1) SCAN_POST(n - 1);
                    if (n + 1 < 64) SCAN_COMMIT(n + 1);
                    SCAN_BAR();
                }
                SCAN_POST(63);
                SCAN_BAR();
            } else {
                f32x16 S0, S1, S2, S3;
#pragma unroll
                for (int i = 0; i < 16; ++i) { S0[i] = 0.f; S1[i] = 0.f; S2[i] = 0.f; S3[i] = 0.f; }
                SCAN_BAR();
                for (int n = 0; n < 64; ++n) {
                    const LAS unsigned char* Bf = lds + RING_OFF + (n & 1) * BUFB;
                    pg8::bf16x8 qd[8], kd[8], vt[2];
#pragma unroll
                    for (int ks = 0; ks < 8; ++ks) { const int off = r * 256 + (((2 * ks + hh) ^ (r & 15)) * 16); qd[ks] = *(const LAS pg8::bf16x8*)(Bf + off); kd[ks] = *(const LAS pg8::bf16x8*)(Bf + 8192 + off); }
#pragma unroll
                    for (int sp = 0; sp < 2; ++sp) { const int row = 32 * sl + r; vt[sp] = *(const LAS pg8::bf16x8*)(Bf + 24576 + row * 64 + (((2 * sp + hh) ^ ((row >> 2) & 3)) * 16)); }
                    f32x16 X, O;
#pragma unroll
                    for (int i = 0; i < 16; ++i) { X[i] = 0.f; O[i] = 0.f; }
#pragma unroll
                    for (int ks = 0; ks < 8; ++ks) X = __builtin_amdgcn_mfma_f32_32x32x16_bf16(kd[ks], qd[ks], X, 0, 0, 0);
                    O = __builtin_amdgcn_mfma_f32_32x32x16_bf16(qd[0], pack8(S0, 0), O, 0, 0, 0); O = __builtin_amdgcn_mfma_f32_32x32x16_bf16(qd[1], pack8(S0, 1), O, 0, 0, 0);
                    O = __builtin_amdgcn_mfma_f32_32x32x16_bf16(qd[2], pack8(S1, 0), O, 0, 0, 0); O = __builtin_amdgcn_mfma_f32_32x32x16_bf16(qd[3], pack8(S1, 1), O, 0, 0, 0);
                    O = __builtin_amdgcn_mfma_f32_32x32x16_bf16(qd[4], pack8(S2, 0), O, 0, 0, 0); O = __builtin_amdgcn_mfma_f32_32x32x16_bf16(qd[5], pack8(S2, 1), O, 0, 0, 0);
                    O = __builtin_amdgcn_mfma_f32_32x32x16_bf16(qd[6], pack8(S3, 0), O, 0, 0, 0); O = __builtin_amdgcn_mfma_f32_32x32x16_bf16(qd[7], pack8(S3, 1), O, 0, 0, 0);
#pragma unroll
                    for (int i = 0; i < 16; ++i) { const int s_ = (i & 3) + 8 * (i >> 2) + 4 * hh; X[i] = (s_ <= r) ? X[i] : 0.f; }
                    O = __builtin_amdgcn_mfma_f32_32x32x16_bf16(pack8(X, 0), vt[0], O, 0, 0, 0); O = __builtin_amdgcn_mfma_f32_32x32x16_bf16(pack8(X, 1), vt[1], O, 0, 0, 0);
#define SCAN_SUPD(Sx, rt_) do { _Pragma("unroll") for (int sp = 0; sp < 2; ++sp) { const int row = 32 * (rt_) + r; \
                            const pg8::bf16x8 kt = *(const LAS pg8::bf16x8*)(Bf + 16384 + row * 64 + (((2 * sp + hh) ^ ((row >> 2) & 3)) * 16)); \
                            Sx = __builtin_amdgcn_mfma_f32_32x32x16_bf16(kt, vt[sp], Sx, 0, 0, 0); } \
                        _Pragma("unroll") for (int g = 0; g < 4; ++g) { const f32x4 dv = *(const LAS f32x4*)(Bf + 32768 + (32 * (rt_) + 8 * g + 4 * hh) * 4); \
                            Sx[4 * g] *= dv.x; Sx[4 * g + 1] *= dv.y; Sx[4 * g + 2] *= dv.z; Sx[4 * g + 3] *= dv.w; } } while (0)
                    SCAN_SUPD(S0, 0); SCAN_SUPD(S1, 1); SCAN_SUPD(S2, 2); SCAN_SUPD(S3, 3);
                    LAS float* ob = (LAS float*)(lds + RING_OFF + OB0 + (n & 1) * 16384);
#pragma unroll
                    for (int i = 0; i < 16; ++i) ob[((i & 3) + 8 * (i >> 2) + 4 * hh) * 128 + 32 * sl + r] = O[i];
                    SCAN_BAR();
                }
                SCAN_BAR();
            }
        }
        {
            const int cb = (G > NB * 4) ? (int)blockIdx.x - NB * 4 : (int)blockIdx.x, ncb = (G > NB * 4) ? G - NB * 4 : G;
            if (cb >= 0) for (int item = cb * NWAVES + wave; item < NB * 4 * 32; item += ncb * NWAVES) {
                const int seg = item & 31, gp = (item >> 5) & 3, b = item >> 7, c0 = gp * 128 + 2 * lane, t0 = seg * 64;
                const f32x2 w0 = *(const GAS f32x2*)(conv_w + c0), w1 = *(const GAS f32x2*)(conv_w + 512 + c0), w2 = *(const GAS f32x2*)(conv_w + 1024 + c0), gn = *(const GAS f32x2*)(conv_gain + c0);
                f32x2 u1 = {0.f, 0.f}, u2 = {0.f, 0.f};
                if (t0 > 0) { const bf16* p2 = PROJ + (size_t)(b * SEQ + t0 - 2) * DIN; const bf16* p1 = p2 + DIN;
                    const unsigned ca = *(const GAS unsigned*)(p2 + PC_C + c0), ha = *(const GAS unsigned*)(p2 + PC_H + c0), cbb = *(const GAS unsigned*)(p1 + PC_C + c0), hb = *(const GAS unsigned*)(p1 + PC_H + c0);
                    u2 = (f32x2){bf_lo(ca) * bf_lo(ha), bf_hi(ca) * bf_hi(ha)}; u1 = (f32x2){bf_lo(cbb) * bf_lo(hb), bf_hi(cbb) * bf_hi(hb)}; }
                for (int tb = t0; tb < t0 + 64; tb += 8) {
                    unsigned cw[8], hw[8], bw[8];
#pragma unroll
                    for (int i = 0; i < 8; ++i) { const bf16* pr = PROJ + ((size_t)b * SEQ + tb + i) * DIN; cw[i] = *(const GAS unsigned*)(pr + PC_C + c0); hw[i] = *(const GAS unsigned*)(pr + PC_H + c0); bw[i] = *(const GAS unsigned*)(pr + PC_B + c0); }
#pragma unroll
                    for (int i = 0; i < 8; ++i) { const f32x2 u = {bf_lo(cw[i]) * bf_lo(hw[i]), bf_hi(cw[i]) * bf_hi(hw[i])};
                        const f32x2 y = (f32x2){bf_lo(bw[i]), bf_hi(bw[i])} * (w0 * u2 + w1 * u1 + w2 * u);
                        float ss = y.x * y.x + y.y * y.y;
                        ss += dpp_f<0xB1>(ss); ss += dpp_f<0x4E>(ss); ss += dpp_f<0x124>(ss); ss += dpp_f<0x128>(ss); ss = swap16_add(ss, ss);
                        const float r = 1.0f / sqrtf(ss * (1.0f / 64.0f) + EPS);
                        *(GAS unsigned*)(MIX + ((size_t)b * SEQ + tb + i) * D + c0) = pk2(y.x * r * gn.x, y.y * r * gn.y); u2 = u1; u1 = u; }
                }
            }
        }
        if (BOTH(3)) GRID_BAR();
    }


    if (IN(4)) {
        pg8::Gemm g{MIX, WOT, T, D, D}; pg8::StaticOrder S; S.init(T, D, G, (int)blockIdx.x);
        pg8::EpiResid E{x, X1, SS2};
        pg8::gemm_phase<pg8::EpiResid, pg8::StaticOrder, PG8_ALIGN, PG8_SP2>(lds + RING_OFF, g, S, E);
        if (BOTH(4)) GRID_BAR();
    }

    if (IN(5)) {
        pg8::Gemm g{X1, WQT, T, 2048, D}; pg8::StaticOrder S; S.init(T, 2048, G, (int)blockIdx.x);
        pg8::EpiScaleBf16<1> E{QB, 2048, SS2};
        pg8::gemm_phase<pg8::EpiScaleBf16<1>, pg8::StaticOrder, PG8_ALIGN, PG8_SP2>(lds + RING_OFF, g, S, E);
        if (BOTH(5)) GRID_BAR();
    }

    if (IN(6)) {
        const int r = lane & 31, hh = lane >> 5;
        for (int item = gw; item < (T / 32) * 8; item += NGW) {
            const int h = item & 7, tok = (item >> 3) * 32 + r;
            unsigned L[2][16];
#pragma unroll
            for (int p = 0; p < 2; ++p) {
                pg8::bf16x8 qf[8];
                const GAS pg8::bf16x8* qp = (const GAS pg8::bf16x8*)(QB + (size_t)tok * 2048 + h * 256 + p * 128 + 8 * hh);
#pragma unroll
                for (int ks = 0; ks < 8; ++ks) qf[ks] = qp[2 * ks];
                const GAS pg8::bf16x8* kp = (const GAS pg8::bf16x8*)(KEYB + (size_t)((h * 2 + p) * 128 + r) * 128 + 8 * hh);
                unsigned best[16];
#pragma unroll
                for (int nt = 0; nt < 4; ++nt) {
                    f32x16 acc;
#pragma unroll
                    for (int i = 0; i < 16; ++i) acc[i] = 0.f;
                    const GAS pg8::bf16x8* kb = kp + nt * 512; asm volatile("" : "+v"(kb));
#pragma unroll
                    for (int ks = 0; ks < 8; ++ks) acc = __builtin_amdgcn_mfma_f32_32x32x16_bf16(kb[2 * ks], qf[ks], acc, 0, 0, 0);
                    unsigned cur[16];
#pragma unroll
                    for (int i = 0; i < 16; ++i) { const int n = 32 * nt + (i & 3) + 8 * (i >> 2) + 4 * hh;
                        const float av = acc[i]; unsigned u = __builtin_bit_cast(unsigned, av); u ^= (unsigned)((int)u >> 31) | 0x80000000u;
                        cur[i] = (u & ~0x7Fu) | (unsigned)(127 - n); }
                    sort16_desc(cur);
                    if (nt == 0) {
#pragma unroll
                        for (int i = 0; i < 16; ++i) best[i] = cur[i];
                    } else merge16_desc(best, cur);
                }
                unsigned o[16];
#pragma unroll
                for (int i = 0; i < 16; ++i) o[i] = (unsigned)__shfl_xor((int)best[i], 32);
                merge16_desc(best, o);
#pragma unroll
                for (int i = 0; i < 16; ++i) L[p][i] = best[i];
            }
            float v1[16], v2[16];
#pragma unroll
            for (int j = 0; j < 16; ++j) { v1[j] = unkey(L[0][j] & ~0x7Fu); v2[j] = unkey(L[1][j] & ~0x7Fu); }
            unsigned ct[16];
#pragma unroll
            for (int j = 0; j < 16; ++j) ct[j] = ckey(v1[0] + v2[j], j);
#pragma unroll
            for (int i = 1; i < 16; ++i)
#pragma unroll
                for (int j = 0; j < 16; ++j) if ((i + 1) * (j + 1) <= 16) {
                    unsigned key = ckey(v1[i] + v2[j], i * 16 + j);
#pragma unroll
                    for (int t = 0; t < 16; ++t) { const unsigned mx = ct[t] > key ? ct[t] : key; key = ct[t] > key ? key : ct[t]; ct[t] = mx; }
                }
            float den = 0.f, ex[16]; const float cmax = unkey(ct[0] & ~0xFFu);
#pragma unroll
            for (int t = 0; t < 16; ++t) { ex[t] = __expf(unkey(ct[t] & ~0xFFu) - cmax); den += ex[t]; }
            const float inv = 1.0f / den;
            unsigned b1[4], b2[4];
#pragma unroll
            for (int w = 0; w < 4; ++w) { b1[w] = (L[0][4 * w] & 0x7Fu) | ((L[0][4 * w + 1] & 0x7Fu) << 8) | ((L[0][4 * w + 2] & 0x7Fu) << 16) | ((L[0][4 * w + 3] & 0x7Fu) << 24);
                b2[w] = (L[1][4 * w] & 0x7Fu) | ((L[1][4 * w + 1] & 0x7Fu) << 8) | ((L[1][4 * w + 2] & 0x7Fu) << 16) | ((L[1][4 * w + 3] & 0x7Fu) << 24); }
            unsigned ent[8];
#pragma unroll
            for (int t = 0; t < 8; ++t) { const unsigned hm = 0u - (unsigned)hh;
                const unsigned ck = ct[t] ^ ((ct[t] ^ ct[8 + t]) & hm); const unsigned e0 = __builtin_bit_cast(unsigned, ex[t]), e1 = __builtin_bit_cast(unsigned, ex[8 + t]);
                const float gt = __builtin_bit_cast(float, e0 ^ ((e0 ^ e1) & hm)) * inv;
                const unsigned flat = 255u - (ck & 0xFFu), ii = flat >> 4, jj = flat & 15u;
                const unsigned w1 = (ii & 8u) ? ((ii & 4u) ? b1[3] : b1[2]) : ((ii & 4u) ? b1[1] : b1[0]), w2 = (jj & 8u) ? ((jj & 4u) ? b2[3] : b2[2]) : ((jj & 4u) ? b2[1] : b2[0]);
                const unsigned n1 = 127u - ((w1 >> (8u * (ii & 3u))) & 0x7Fu), n2 = 127u - ((w2 >> (8u * (jj & 3u))) & 0x7Fu);
                ent[t] = (n1 * 128u + n2) | (pkh2(gt, 0.f) << 16); }
            GAS v4u* ep = (GAS v4u*)(EXPT + (size_t)tok * 128 + h * 16 + 8 * hh);
            ep[0] = (v4u){ent[0], ent[1], ent[2], ent[3]}; ep[1] = (v4u){ent[4], ent[5], ent[6], ent[7]};
        }
        if (BOTH(6)) GRID_BAR();
    }


    if (IN(7)) {
        constexpr int NT = 4;
        const unsigned srcl = (unsigned)(32 * (lane & 1) + 16 * ((lane >> 1) & 1)) << 2;
        for (int bt = gw; bt < T / NT; bt += NGW) {
            const int tok0 = bt * NT;
            unsigned e[NT][2]; float rs2[NT];
#pragma unroll
            for (int t = 0; t < NT; ++t) { const unsigned r0 = EXPT[(size_t)(tok0 + t) * 128 + lane], r1 = EXPT[(size_t)(tok0 + t) * 128 + 64 + lane];
                e[t][0] = (r0 << 16) | (r0 >> 16); e[t][1] = (r1 << 16) | (r1 >> 16);
                rs2[t] = 1.0f / sqrtf(SS2[tok0 + t] * (1.0f / D) + EPS); }
            sort128_asc<NT>(e, lane);
            int ah[NT][2]; int hx[NT][4]; float xs[NT];
#pragma unroll
            for (int t = 0; t < NT; ++t) { const GAS v4u* xr = (const GAS v4u*)(X1 + (size_t)(tok0 + t) * D); const v4u xa = __builtin_nontemporal_load(xr + lane), xb = __builtin_nontemporal_load(xr + 64 + lane);
                const float xv[16] = {bf_lo(xa.x), bf_hi(xa.x), bf_lo(xa.y), bf_hi(xa.y), bf_lo(xa.z), bf_hi(xa.z), bf_lo(xa.w), bf_hi(xa.w), bf_lo(xb.x), bf_hi(xb.x), bf_lo(xb.y), bf_hi(xb.y), bf_lo(xb.z), bf_hi(xb.z), bf_lo(xb.w), bf_hi(xb.w)};
                float am = 0.f;
#pragma unroll
                for (int i = 0; i < 16; ++i) am = fmaxf(am, fabsf(xv[i]));
                am = fmaxf(wave_max(am), 1e-20f); const float sx = 127.0f / am; xs[t] = am * (1.0f / 127.0f);
#pragma unroll
                for (int w = 0; w < 4; ++w) { const int i0 = (int)rintf(xv[4 * w] * sx), i1 = (int)rintf(xv[4 * w + 1] * sx), i2 = (int)rintf(xv[4 * w + 2] * sx), i3 = (int)rintf(xv[4 * w + 3] * sx);
                    hx[t][w] = (int)(((unsigned)i0 & 0xFFu) | (((unsigned)i1 & 0xFFu) << 8) | (((unsigned)i2 & 0xFFu) << 16) | (((unsigned)i3 & 0xFFu) << 24)); }
                ah[t][0] = 0; ah[t][1] = 0; }
#define PEER_LOAD(buf, st_) do { _Pragma("unroll") for (int t = 0; t < NT; ++t) { const unsigned em_ = ((st_) & 16) ? 0xFFFFFFFFu : 0u; const unsigned esel = e[t][0] ^ ((e[t][0] ^ e[t][1]) & em_); \
                _Pragma("unroll") for (int q = 0; q < 4; ++q) { const unsigned id = (unsigned)__builtin_amdgcn_readlane((int)esel, 4 * ((st_) & 15) + q) >> 16; \
                    buf[t][q] = ((const GAS v4u*)(U8 + (size_t)id * D))[lane]; } } } while (0)
#define PEER_DOTS(buf, st_) do { int p[16]; \
                _Pragma("unroll") for (int t = 0; t < NT; ++t) _Pragma("unroll") for (int q = 0; q < 4; ++q) { \
                    const int d0 = __builtin_amdgcn_sdot4((int)buf[t][q].x, hx[t][0], 0, false), d1 = __builtin_amdgcn_sdot4((int)buf[t][q].z, hx[t][2], 0, false); \
                    p[4 * t + q] = __builtin_amdgcn_sdot4((int)buf[t][q].y, hx[t][1], d0, false) + __builtin_amdgcn_sdot4((int)buf[t][q].w, hx[t][3], d1, false); } \
                const int red = reduce16i(p, lane); const bool hit = (lane >> 2) == ((st_) & 15), hi = ((st_) & 16) != 0; \
                _Pragma("unroll") for (int t = 0; t < NT; ++t) { const int got = __builtin_amdgcn_ds_bpermute((int)(srcl + (unsigned)((8 * (t & 1) + 4 * (t >> 1)) << 2)), red); \
                    ah[t][0] = (hit && !hi) ? got : ah[t][0]; ah[t][1] = (hit && hi) ? got : ah[t][1]; } } while (0)
            {
                v4u ua[NT][4], ubb[NT][4];
                PEER_LOAD(ua, 0);
                for (int st = 0; st < 32; st += 2) {
                    PEER_LOAD(ubb, st + 1);
                    PEER_DOTS(ua, st);
                    if (st + 2 < 32) PEER_LOAD(ua, st + 2);
                    PEER_DOTS(ubb, st + 1);
                }
            }
            float wv[NT][2];
#pragma unroll
            for (int t = 0; t < NT; ++t)
#pragma unroll
                for (int g = 0; g < 2; ++g) { const float a = (float)ah[t][g] * (rs2[t] * xs[t] * (1.0f / PEER_SU)); const float gate = (float)h2_of(e[t][g] & 0xFFFFu).x;
                    wv[t][g] = gate * (0.5f / PEER_SV) * a * (1.0f + erff(a * 0.7071067811865476f)); }
            f32x2 y[NT][8];
#pragma unroll
            for (int t = 0; t < NT; ++t)
#pragma unroll
                for (int i = 0; i < 8; ++i) y[t][i] = (f32x2){0.f, 0.f};
#define PEER_LOADB(buf, st_) do { _Pragma("unroll") for (int t = 0; t < NT; ++t) { const unsigned em_ = ((st_) & 32) ? 0xFFFFFFFFu : 0u; const unsigned esel = e[t][0] ^ ((e[t][0] ^ e[t][1]) & em_); \
                _Pragma("unroll") for (int q = 0; q < 2; ++q) { const unsigned id = (unsigned)__builtin_amdgcn_readlane((int)esel, 2 * ((st_) & 31) + q) >> 16; \
                    buf[t][q] = ((const GAS v4u*)(V8 + (size_t)id * D))[lane]; } } } while (0)
#define PEER_AXPY(buf, st_) do { _Pragma("unroll") for (int t = 0; t < NT; ++t) { const unsigned wm_ = ((st_) & 32) ? 0xFFFFFFFFu : 0u; const unsigned w0_ = __builtin_bit_cast(unsigned, wv[t][0]), w1_ = __builtin_bit_cast(unsigned, wv[t][1]); const unsigned wsel = w0_ ^ ((w0_ ^ w1_) & wm_); \
                _Pragma("unroll") for (int q = 0; q < 2; ++q) { const float wi = __builtin_bit_cast(float, __builtin_amdgcn_readlane((int)wsel, 2 * ((st_) & 31) + q)); const f32x2 w2 = {wi, wi}; \
                    const unsigned vw_[4] = {buf[t][q].x, buf[t][q].y, buf[t][q].z, buf[t][q].w}; \
                    _Pragma("unroll") for (int j = 0; j < 4; ++j) { y[t][2 * j] = __builtin_elementwise_fma(__builtin_amdgcn_cvt_pk_f32_fp8((int)vw_[j], false), w2, y[t][2 * j]); y[t][2 * j + 1] = __builtin_elementwise_fma(__builtin_amdgcn_cvt_pk_f32_fp8((int)vw_[j], true), w2, y[t][2 * j + 1]); } } } } while (0)
            {
                v4u va[NT][2], vbb[NT][2];
                PEER_LOADB(va, 0);
                for (int st = 0; st < 64; st += 2) {
                    PEER_LOADB(vbb, st + 1);
                    PEER_AXPY(va, st);
                    if (st + 2 < 64) PEER_LOADB(va, st + 2);
                    PEER_AXPY(vbb, st + 1);
                }
            }
#pragma unroll
            for (int t = 0; t < NT; ++t) { const size_t tok = (size_t)(tok0 + t);
                const GAS v4u* xr = (const GAS v4u*)(X1 + tok * D); const v4u xa = __builtin_nontemporal_load(xr + lane), xb = __builtin_nontemporal_load(xr + 64 + lane);
                const float xf[16] = {bf_lo(xa.x), bf_hi(xa.x), bf_lo(xa.y), bf_hi(xa.y), bf_lo(xa.z), bf_hi(xa.z), bf_lo(xa.w), bf_hi(xa.w),
                                      bf_lo(xb.x), bf_hi(xb.x), bf_lo(xb.y), bf_hi(xb.y), bf_lo(xb.z), bf_hi(xb.z), bf_lo(xb.w), bf_hi(xb.w)};
                float yy[16]; float ss = 0.f;
#pragma unroll
                for (int i = 0; i < 8; ++i) { yy[2 * i] = y[t][i].x + xf[2 * i]; yy[2 * i + 1] = y[t][i].y + xf[2 * i + 1]; ss += yy[2 * i] * yy[2 * i] + yy[2 * i + 1] * yy[2 * i + 1]; }
                ss = wave_sum(ss);
                const float r = 1.0f / sqrtf(ss * (1.0f / D) + EPS);
                const GAS f32x4* nfp = (const GAS f32x4*)norm_f; const f32x4 n0 = nfp[2 * lane], n1 = nfp[2 * lane + 1], n2 = nfp[128 + 2 * lane], n3 = nfp[128 + 2 * lane + 1];
                GAS f32x4* op = (GAS f32x4*)(out + tok * D);
                __builtin_nontemporal_store((f32x4){yy[0] * r * n0.x, yy[1] * r * n0.y, yy[2] * r * n0.z, yy[3] * r * n0.w}, op + 2 * lane);
                __builtin_nontemporal_store((f32x4){yy[4] * r * n1.x, yy[5] * r * n1.y, yy[6] * r * n1.z, yy[7] * r * n1.w}, op + 2 * lane + 1);
                __builtin_nontemporal_store((f32x4){yy[8] * r * n2.x, yy[9] * r * n2.y, yy[10] * r * n2.z, yy[11] * r * n2.w}, op + 128 + 2 * lane);
                __builtin_nontemporal_store((f32x4){yy[12] * r * n3.x, yy[13] * r * n3.y, yy[14] * r * n3.z, yy[15] * r * n3.w}, op + 128 + 2 * lane + 1); }
        }
    }

#undef IN
#undef BOTH
}

extern "C" void kernel_launch(void* const* d_in, const int* in_sizes, int n_in, void* d_out, int out_size, void* d_ws, size_t ws_size, hipStream_t stream) {
    static int grid = 0;
    if (grid == 0) {
        if (n_in != 14 || in_sizes[0] != T * D || out_size != T * D || ws_size < WS_END) { fprintf(stderr, "kernel_launch: unexpected shapes (n_in %d, in0 %d, out %d, ws %zu); nothing launched\n", n_in, n_in > 0 ? in_sizes[0] : -1, out_size, ws_size); grid = -1; return; }
        int dev = 0, cus = 0, per_cu = 0;
        if (hipGetDevice(&dev) != hipSuccess || hipDeviceGetAttribute(&cus, hipDeviceAttributeMultiprocessorCount, dev) != hipSuccess) { grid = -1; return; }
        if (hipFuncSetAttribute((const void*)hymba_fwd, hipFuncAttributeMaxDynamicSharedMemorySize, LDS_BYTES) != hipSuccess) { fprintf(stderr, "kernel_launch: hipFuncSetAttribute failed\n"); grid = -1; return; }
        if (hipOccupancyMaxActiveBlocksPerMultiprocessor(&per_cu, (const void*)hymba_fwd, NWAVES * 64, LDS_BYTES) != hipSuccess || per_cu < 1) { fprintf(stderr, "kernel_launch: occupancy query says %d blocks per CU\n", per_cu); (void)hipGetLastError(); grid = -1; return; }
        grid = cus;
    }
    if (grid < 0) return;
    if (hipMemsetAsync((char*)d_ws + WS_CTL, 0, CTL_ZERO_BYTES, stream) != hipSuccess) { fprintf(stderr, "kernel_launch: hipMemsetAsync failed\n"); return; }
    Args a{};
    for (int i = 0; i < 14; ++i) a.in[i] = (const float*)d_in[i];
    a.out = (float*)d_out; a.ws = (unsigned char*)d_ws;
    if (N_LAUNCHES == 1) {
        a.ph_lo = 0; a.ph_hi = NPHASES; a.li = 0;
        void* kargs[] = {&a};
        const hipError_t e = hipLaunchCooperativeKernel((const void*)hymba_fwd, dim3(grid), dim3(NWAVES * 64), kargs, LDS_BYTES, stream);
        if (e != hipSuccess) fprintf(stderr, "kernel_launch: cooperative launch failed: %s (grid %d)\n", hipGetErrorString(e), grid);
    } else {
        for (int li = 0; li < NPHASES; ++li) {
            a.ph_lo = li; a.ph_hi = li + 1; a.li = li;
            hipLaunchKernelGGL(hymba_fwd, dim3(grid), dim3(NWAVES * 64), LDS_BYTES, stream, a);
            const hipError_t le = hipPeekAtLastError();
            if (le != hipSuccess) { fprintf(stderr, "kernel_launch: launch %d failed: %s\n", li, hipGetErrorName(le)); break; }
        }
    }
}
```

```cpp
#include <hip/hip_runtime.h>
#include <cstdio>
#include <cstdint>
namespace pg8 {
#define PG8_LAS __attribute__((address_space(3)))
typedef unsigned short bf16_t;
typedef short bf16x8 __attribute__((ext_vector_type(8)));
typedef float f32x4 __attribute__((ext_vector_type(4)));
typedef unsigned u32x4 __attribute__((ext_vector_type(4)));
constexpr int BM = 256, BK = 64, HALF = 128, HTB = HALF * BK * 2  , STAGE_BYTES = 8 * HTB, NXCD = 8, WGM = 8;

__host__ __device__ __forceinline__ int lds_byte(int r, int c) { const int st = (r >> 4) * 2 + (c >> 5), rr = r & 15, cc = c & 31, ob = rr * 64 + cc * 2; return st * 1024 + (ob ^ (((ob >> 9) & 1) << 5)); }
__host__ __device__ __forceinline__ void stage_rc(int b, int& R, int& C) { const int st = b / 1024, sb = b % 1024, swz = sb ^ (((sb >> 9) & 1) << 5); R = (st >> 1) * 16 + swz / 64; C = (st & 1) * 32 + (swz % 64) / 2; }
__host__ __device__ __forceinline__ int perm32(int rho) { const int n = rho >> 4, i = rho & 15; return 8 * (i >> 2) + 4 * n + (i & 3); }

struct Unit { int pm, pn; };
struct Gemm { const bf16_t* A; const bf16_t* Bt; int M, N, K; };

struct StaticOrder {
    int nM, nN, nwg, G, c;
    __host__ __device__ void init(int M, int N, int G_, int c_) { nM = M / BM; nN = N / BM; nwg = nM * nN; G = G_; c = c_; }
    __host__ __device__ bool next(int i, Unit& u) const {
        const long L = (long)i * G + c; if (L >= nwg) return false;
        int wgid = (int)L; { const int q = nwg / NXCD, r = nwg % NXCD, xcd = wgid % NXCD, off = wgid / NXCD; wgid = (xcd < r ? xcd * (q + 1) : r * (q + 1) + (xcd - r) * q) + off; }
        const int nig = WGM * nN, gid = wgid / nig, fm = gid * WGM, gsz = (nM - fm) < WGM ? (nM - fm) : WGM;
        u.pm = fm + ((wgid % nig) % gsz); u.pn = (wgid % nig) / gsz; return true;
    }
    __device__ __forceinline__ void a_ready(const Unit&) const {}
    __device__ __forceinline__ void done(const Unit&) const {}
};

__device__ __forceinline__ unsigned cvt_pk_bf16(float lo, float hi) { unsigned r; asm volatile("v_cvt_pk_bf16_f32 %0, %1, %2" : "=v"(r) : "v"(lo), "v"(hi)); return r; }

template <int MODE> struct EpiScaleBf16 {
    static constexpr bool PERM = true, AFTER_DRAIN = false;
    bf16_t* O; int ldc; const float* rowv;
    __device__ __forceinline__ void operator()(const f32x4 (&acc)[2][2][4][2], const Unit& u, int wr, int wc, int fr, int fq) const {
        const int row0 = u.pm * BM + wr * 64 + fr, col0 = u.pn * BM + wc * 32 + 8 * fq;
#pragma unroll
        for (int ai = 0; ai < 2; ++ai)
#pragma unroll
            for (int m = 0; m < 4; ++m) { const int row = row0 + ai * HALF + m * 16; float s = rowv[row]; if (MODE == 1) s = 1.0f / sqrtf(s * (1.0f / 1024.0f) + 1e-6f);
                bf16_t* rowp = O + (size_t)row * ldc + col0;
#pragma unroll
                for (int bj = 0; bj < 2; ++bj) { const f32x4 v0 = acc[ai][bj][m][0] * s, v1 = acc[ai][bj][m][1] * s;
                    u32x4 w; w.x = cvt_pk_bf16(v0[0], v0[1]); w.y = cvt_pk_bf16(v0[2], v0[3]); w.z = cvt_pk_bf16(v1[0], v1[1]); w.w = cvt_pk_bf16(v1[2], v1[3]);
                    *(u32x4*)(rowp + bj * HALF) = w; } }
    }
};
struct EpiResid {
    static constexpr bool PERM = true, AFTER_DRAIN = false;
    const float* X; bf16_t* O; float* ss;
    __device__ __forceinline__ void operator()(const f32x4 (&acc)[2][2][4][2], const Unit& u, int wr, int wc, int fr, int fq) const {
        const int row0 = u.pm * BM + wr * 64 + fr, col0 = u.pn * BM + wc * 32 + 8 * fq;
#pragma unroll
        for (int ai = 0; ai < 2; ++ai)
#pragma unroll
            for (int m = 0; m < 4; ++m) { const int row = row0 + ai * HALF + m * 16; float part = 0.f;
#pragma unroll
                for (int bj = 0; bj < 2; ++bj) { const float* xp = X + (size_t)row * 1024 + col0 + bj * HALF;
                    const f32x4 v0 = acc[ai][bj][m][0] + *(const f32x4*)xp, v1 = acc[ai][bj][m][1] + *(const f32x4*)(xp + 4);
                    part += (v0[0] * v0[0] + v0[1] * v0[1]) + (v0[2] * v0[2] + v0[3] * v0[3]) + (v1[0] * v1[0] + v1[1] * v1[1]) + (v1[2] * v1[2] + v1[3] * v1[3]);
                    u32x4 w; w.x = cvt_pk_bf16(v0[0], v0[1]); w.y = cvt_pk_bf16(v0[2], v0[3]); w.z = cvt_pk_bf16(v1[0], v1[1]); w.w = cvt_pk_bf16(v1[2], v1[3]);
                    *(u32x4*)(O + (size_t)row * 1024 + col0 + bj * HALF) = w; }
                part += __shfl_xor(part, 16); part += __shfl_xor(part, 32);
                if (fq == 0) (void)__builtin_amdgcn_global_atomic_fadd_f32((__attribute__((address_space(1))) float*)(ss + row), part); }
    }
};

template <class Epi, class Sched, bool ALIGN_EPI = false, bool SP2 = false>
__device__ __forceinline__ void gemm_phase(PG8_LAS unsigned char* lds, const Gemm g, const Sched& S, const Epi& E) {
    const int tid = threadIdx.x, wid = __builtin_amdgcn_readfirstlane(tid >> 6), lane = tid & 63, wr = wid >> 2, wc = wid & 3, fr = lane & 15, fq = lane >> 4;
    const int K = g.K, nt = K / BK;
    unsigned voffA[2], voffB[2];
#pragma unroll
    for (int i = 0; i < 2; ++i) { int R, C; stage_rc(tid * 16 + i * 8192, R, C); const int Rb = Epi::PERM ? ((R & ~31) + perm32(R & 31)) : R;
        voffA[i] = (unsigned)(R * K + C) * 2u; voffB[i] = (unsigned)(Rb * K + C) * 2u; }
    const size_t kstep = (size_t)(BK * 2);
    const size_t hstep = (size_t)HALF * K * 2;
    const size_t tstep = 2 * hstep;
    const unsigned ldsw = (unsigned)wid * 1024u;
    const int aoff = lds_byte(wr * 64 + fr, fq * 8), boff = lds_byte(wc * 32 + fr, fq * 8);
#define PG8_SA(b, h) (((b) * 2 + (h)) * HTB)
#define PG8_SB(b, h) ((4 + (b) * 2 + (h)) * HTB)
#define PG8_STAGE(bufoff, gbase, voff) do { _Pragma("unroll") for (int _i = 0; _i < 2; ++_i) \
        __builtin_amdgcn_global_load_lds((const unsigned*)((const char*)(gbase) + (voff)[_i]), (PG8_LAS unsigned*)(lds + (bufoff) + ldsw + _i * 8192), 16, 0, 0); } while (0)
#define PG8_LDA(dst, b, h) do { _Pragma("unroll") for (int m = 0; m < 4; ++m) _Pragma("unroll") for (int k = 0; k < 2; ++k) dst[m][k] = *(const PG8_LAS bf16x8*)(lds + PG8_SA(b, h) + aoff + m * 2048 + k * 1024); } while (0)
#define PG8_LDB(dst, b, h) do { _Pragma("unroll") for (int n = 0; n < 2; ++n) _Pragma("unroll") for (int k = 0; k < 2; ++k) dst[n][k] = *(const PG8_LAS bf16x8*)(lds + PG8_SB(b, h) + boff + n * 2048 + k * 1024); } while (0)
#define PG8_MMA(ai, bj, At, Bt) do { __builtin_amdgcn_s_setprio(1); _Pragma("unroll") for (int m = 0; m < 4; ++m) _Pragma("unroll") for (int n = 0; n < 2; ++n) _Pragma("unroll") for (int k = 0; k < 2; ++k) \
        acc[ai][bj][m][n] = __builtin_amdgcn_mfma_f32_16x16x32_bf16(Bt[n][k], At[m][k], acc[ai][bj][m][n], 0, 0, 0); __builtin_amdgcn_s_setprio(0); } while (0)
#define PG8_WAIT_V(n) asm volatile("s_waitcnt vmcnt(" #n ")" ::: "memory")
#define PG8_WAIT_L(n) asm volatile("s_waitcnt lgkmcnt(" #n ")" ::: "memory")
#define PG8_BAR __builtin_amdgcn_s_barrier()
#define PG8_SCHED __builtin_amdgcn_sched_barrier(0)
    Unit cur, nxt; int ui = 0;
    if (!S.next(0, cur)) return;
    f32x4 acc[2][2][4][2];
#pragma unroll
    for (int a = 0; a < 2; ++a)
#pragma unroll
        for (int b = 0; b < 2; ++b)
#pragma unroll
            for (int m = 0; m < 4; ++m)
#pragma unroll
                for (int n = 0; n < 2; ++n) acc[a][b][m][n] = (f32x4){0.f, 0.f, 0.f, 0.f};
    bf16x8 At[4][2], B0[2][2], B1[2][2];
    const char* cA = (const char*)g.A + (size_t)cur.pm * tstep; const char* cB = (const char*)g.Bt + (size_t)cur.pn * tstep;
    S.a_ready(cur);
    if constexpr (SP2) {
        PG8_STAGE(PG8_SB(0, 0), cB, voffB); PG8_STAGE(PG8_SB(0, 1), cB + hstep, voffB); PG8_STAGE(PG8_SA(0, 0), cA, voffA); PG8_STAGE(PG8_SA(0, 1), cA + hstep, voffA);
        if (wr == 1) PG8_BAR;
        PG8_WAIT_V(2); PG8_BAR;
        PG8_STAGE(PG8_SB(1, 0), cB + kstep, voffB); PG8_STAGE(PG8_SA(1, 0), cA + kstep, voffA); PG8_STAGE(PG8_SB(1, 1), cB + hstep + kstep, voffB);
        PG8_WAIT_V(6); PG8_BAR;
    } else {
        PG8_STAGE(PG8_SB(0, 0), cB, voffB); PG8_STAGE(PG8_SA(0, 0), cA, voffA); PG8_STAGE(PG8_SB(0, 1), cB + hstep, voffB); PG8_STAGE(PG8_SA(0, 1), cA + hstep, voffA);
        if (wr == 1) PG8_BAR;
        PG8_WAIT_V(4); PG8_BAR;
        PG8_STAGE(PG8_SB(1, 0), cB + kstep, voffB); PG8_STAGE(PG8_SA(1, 0), cA + kstep, voffA); PG8_STAGE(PG8_SB(1, 1), cB + hstep + kstep, voffB);
        PG8_WAIT_V(6); PG8_BAR;
    }
    for (;;) {
        const bool has_next = S.next(ui + 1, nxt);
        const char* nA = has_next ? (const char*)g.A + (size_t)nxt.pm * tstep : cA; const char* nB = has_next ? (const char*)g.Bt + (size_t)nxt.pn * tstep : cB;
        for (int t = 0; t < nt; t += 2) {
            const bool last = (t == nt - 2);
            const char* a1 = cA + (size_t)(t + 1) * kstep;
            const char* a2 = last ? nA : cA + (size_t)(t + 2) * kstep; const char* b2 = last ? nB : cB + (size_t)(t + 2) * kstep;
            const char* a3 = a2 + kstep; const char* b3 = b2 + kstep;
            if (last && has_next) S.a_ready(nxt);
            if constexpr (SP2) {
            PG8_LDB(B0, 0, 0); PG8_LDB(B1, 0, 1); PG8_SCHED; PG8_LDA(At, 0, 0); PG8_STAGE(PG8_SA(1, 1), a1 + hstep, voffA);
            PG8_WAIT_V(8); PG8_WAIT_L(0); PG8_BAR; PG8_MMA(0, 0, At, B0); PG8_MMA(0, 1, At, B1); PG8_BAR; PG8_SCHED;
            PG8_LDA(At, 0, 1); PG8_STAGE(PG8_SB(0, 0), b2, voffB); PG8_STAGE(PG8_SB(0, 1), b2 + hstep, voffB); PG8_STAGE(PG8_SA(0, 0), a2, voffA);
            PG8_WAIT_V(8); PG8_WAIT_L(0); PG8_BAR; PG8_MMA(1, 0, At, B0); PG8_MMA(1, 1, At, B1); PG8_BAR; PG8_SCHED;
            PG8_LDB(B0, 1, 0); PG8_LDB(B1, 1, 1); PG8_SCHED; PG8_LDA(At, 1, 0); PG8_STAGE(PG8_SA(0, 1), a2 + hstep, voffA);
            PG8_WAIT_V(8); PG8_WAIT_L(0); PG8_BAR; PG8_MMA(0, 0, At, B0); PG8_MMA(0, 1, At, B1); PG8_BAR; PG8_SCHED;
            PG8_LDA(At, 1, 1); PG8_STAGE(PG8_SB(1, 0), b3, voffB); PG8_STAGE(PG8_SB(1, 1), b3 + hstep, voffB); PG8_STAGE(PG8_SA(1, 0), a3, voffA);
            PG8_WAIT_V(8); PG8_WAIT_L(0); PG8_BAR; PG8_MMA(1, 0, At, B0); PG8_MMA(1, 1, At, B1); PG8_BAR; PG8_SCHED;
            } else {
            PG8_LDB(B0, 0, 0); PG8_SCHED; PG8_LDA(At, 0, 0); PG8_STAGE(PG8_SA(1, 1), a1 + hstep, voffA);
            PG8_WAIT_L(8); PG8_BAR; PG8_WAIT_L(0); PG8_MMA(0, 0, At, B0); PG8_BAR; PG8_SCHED;
            PG8_LDB(B1, 0, 1); PG8_STAGE(PG8_SB(0, 0), b2, voffB);
            PG8_BAR; PG8_WAIT_L(0); PG8_MMA(0, 1, At, B1); PG8_BAR;
            PG8_LDA(At, 0, 1); PG8_STAGE(PG8_SA(0, 0), a2, voffA);
            PG8_BAR; PG8_WAIT_L(0); PG8_MMA(1, 0, At, B0); PG8_BAR; PG8_SCHED;
            PG8_STAGE(PG8_SB(0, 1), b2 + hstep, voffB);
            PG8_WAIT_V(6); PG8_BAR; PG8_MMA(1, 1, At, B1); PG8_BAR;
            PG8_LDB(B0, 1, 0); PG8_SCHED; PG8_LDA(At, 1, 0); PG8_STAGE(PG8_SA(0, 1), a2 + hstep, voffA);
            PG8_WAIT_L(8); PG8_BAR; PG8_WAIT_L(0); PG8_MMA(0, 0, At, B0); PG8_BAR; PG8_SCHED;
            PG8_LDB(B1, 1, 1); PG8_STAGE(PG8_SB(1, 0), b3, voffB);
            PG8_BAR; PG8_WAIT_L(0); PG8_MMA(0, 1, At, B1); PG8_BAR;
            PG8_LDA(At, 1, 1); PG8_STAGE(PG8_SA(1, 0), a3, voffA);
            PG8_BAR; PG8_WAIT_L(0); PG8_MMA(1, 0, At, B0); PG8_BAR; PG8_SCHED;
            PG8_STAGE(PG8_SB(1, 1), b3 + hstep, voffB);
            PG8_WAIT_V(6); PG8_BAR; PG8_MMA(1, 1, At, B1); PG8_BAR;
            }
        }
        if constexpr (ALIGN_EPI) { if (wr == 0) PG8_BAR; }
        if constexpr (!Epi::AFTER_DRAIN) { E(acc, cur, wr, wc, fr, fq); S.done(cur); }
        if (!has_next) break;
#pragma unroll
        for (int a = 0; a < 2; ++a)
#pragma unroll
            for (int b = 0; b < 2; ++b)
#pragma unroll
                for (int m = 0; m < 4; ++m)
#pragma unroll
                    for (int n = 0; n < 2; ++n) acc[a][b][m][n] = (f32x4){0.f, 0.f, 0.f, 0.f};
        cur = nxt; cA = nA; cB = nB; ++ui;
        if constexpr (ALIGN_EPI) { if (wr == 1) PG8_BAR; }
    }
    PG8_WAIT_V(0);
    if constexpr (!ALIGN_EPI) { if (wr == 0) PG8_BAR; }
    PG8_BAR;
    if constexpr (Epi::AFTER_DRAIN) { E.fused(acc, cur, wr, wc, fr, fq, lds, wid, lane); S.done(cur); }
#undef PG8_SA
#undef PG8_SB
#undef PG8_STAGE
#undef PG8_LDA
#undef PG8_LDB
#undef PG8_MMA
#undef PG8_WAIT_V
#undef PG8_WAIT_L
#undef PG8_BAR
#undef PG8_SCHED
}
}

#ifndef PG8_SP2
#define PG8_SP2 true
#endif
#ifndef PG8_ALIGN
#define PG8_ALIGN true
#endif
#ifndef MK_N_LAUNCHES
#define MK_N_LAUNCHES 1
#endif
constexpr int NWAVES = 8;
constexpr int NPHASES = 8;
constexpr int N_LAUNCHES = MK_N_LAUNCHES;

constexpr int NB = 32, SEQ = 2048, T = NB * SEQ, D = 1024, DIN = 3584;
constexpr int PC_C = 0, PC_H = 512, PC_B = 1024, PC_Q = 1536, PC_F = 2048, PC_V = 2560, PC_G = 3072;
constexpr int NEXP = 16384;
constexpr float EPS = 1e-6f;
constexpr float PEER_SU = 640.0f, PEER_SV = 64.0f;

constexpr size_t MiB = 1u << 20;
constexpr size_t WS_CTL = 0, CTL_ZERO_BYTES = 1 * MiB;
constexpr size_t WS_W1T = 2 * MiB, WS_WOT = 10 * MiB, WS_WQT = 12 * MiB, WS_RS1 = 16 * MiB, WS_SS2 = 17 * MiB;
constexpr size_t WS_KEYB = 18 * MiB;
constexpr size_t WS_U16 = 32 * MiB, WS_V16 = 64 * MiB, WS_EXP = 96 * MiB;
constexpr size_t WS_XB = 128 * MiB;
constexpr size_t WS_X1 = 256 * MiB;
constexpr size_t WS_PROJ = 384 * MiB;
constexpr size_t WS_F = 832 * MiB;
constexpr size_t WS_END = 960 * MiB;
constexpr int CW_BAR = 4096;

constexpr int RING_OFF = 0, RING_BYTES = 131072;
constexpr int LDSCTL_OFF = RING_BYTES, MISC_OFF = LDSCTL_OFF + 320;
constexpr int LDS_BYTES = 147456;

#define GAS __attribute__((address_space(1)))
#define LAS __attribute__((address_space(3)))
typedef unsigned short bf16;
typedef unsigned v4u __attribute__((ext_vector_type(4)));
typedef unsigned v2u __attribute__((ext_vector_type(2)));
typedef float f32x4 __attribute__((ext_vector_type(4)));
typedef float f32x2 __attribute__((ext_vector_type(2)));
typedef _Float16 h2_t __attribute__((ext_vector_type(2)));
typedef GAS unsigned gu32;
#define RLX_AGENT __ATOMIC_RELAXED, __HIP_MEMORY_SCOPE_AGENT
#define LDS_WAIT() asm volatile("s_waitcnt lgkmcnt(0)" ::: "memory")
#define VM_WAIT() asm volatile("s_waitcnt vmcnt(0)" ::: "memory")
__device__ __forceinline__ unsigned f2bf(float f) { unsigned u = __builtin_bit_cast(unsigned, f); return (u + 0x7fffu + ((u >> 16) & 1u)) >> 16; }
__device__ __forceinline__ unsigned pk2(float lo, float hi) { return f2bf(lo) | (f2bf(hi) << 16); }
__device__ __forceinline__ float bf_lo(unsigned w) { return __builtin_bit_cast(float, w << 16); }
__device__ __forceinline__ float bf_hi(unsigned w) { return __builtin_bit_cast(float, w & 0xffff0000u); }
__device__ __forceinline__ float bf1(bf16 v) { return __builtin_bit_cast(float, (unsigned)v << 16); }
__device__ __forceinline__ unsigned pkh2(float lo, float hi) { f32x2 v = {lo, hi}; h2_t h = __builtin_convertvector(v, h2_t); return __builtin_bit_cast(unsigned, h); }
__device__ __forceinline__ h2_t h2_of(unsigned w) { return __builtin_bit_cast(h2_t, w); }
__device__ __forceinline__ float swap32_add(float a, float b) { const v2u r = __builtin_amdgcn_permlane32_swap(__builtin_bit_cast(unsigned, a), __builtin_bit_cast(unsigned, b), false, false);
    const unsigned rx = r.x, ry = r.y; return __builtin_bit_cast(float, rx) + __builtin_bit_cast(float, ry); }
__device__ __forceinline__ float swap16_add(float a, float b) { const v2u r = __builtin_amdgcn_permlane16_swap(__builtin_bit_cast(unsigned, a), __builtin_bit_cast(unsigned, b), false, false);
    const unsigned rx = r.x, ry = r.y; return __builtin_bit_cast(float, rx) + __builtin_bit_cast(float, ry); }
template <int CTRL> __device__ __forceinline__ float dpp_f(float v) { return __builtin_bit_cast(float, __builtin_amdgcn_update_dpp(0, __builtin_bit_cast(int, v), CTRL, 0xF, 0xF, false)); }
template <int CTRL> __device__ __forceinline__ unsigned dpp_u(unsigned v) { return (unsigned)__builtin_amdgcn_update_dpp(0, (int)v, CTRL, 0xF, 0xF, false); }
__device__ __forceinline__ float wave_sum(float v) {
    v += dpp_f<0xB1>(v); v += dpp_f<0x4E>(v); v += dpp_f<0x124>(v); v += dpp_f<0x128>(v);
    v = swap16_add(v, v); v = swap32_add(v, v);
    return v;
}
typedef float f32x16 __attribute__((ext_vector_type(16)));
typedef __bf16 bf16x2_t __attribute__((ext_vector_type(2)));
__device__ __forceinline__ unsigned cvtpk(float lo, float hi) { f32x2 v = {lo, hi}; bf16x2_t b = __builtin_convertvector(v, bf16x2_t); return __builtin_bit_cast(unsigned, b); }
__device__ __forceinline__ pg8::bf16x8 pack8(const f32x16& x, int s) {
    v4u p; p.x = cvtpk(x[8 * s], x[8 * s + 1]); p.y = cvtpk(x[8 * s + 2], x[8 * s + 3]); p.z = cvtpk(x[8 * s + 4], x[8 * s + 5]); p.w = cvtpk(x[8 * s + 6], x[8 * s + 7]);
    return __builtin_bit_cast(pg8::bf16x8, p); }
__device__ __forceinline__ void ce_desc(unsigned& a, unsigned& b) { const unsigned mx = a > b ? a : b, mn = a > b ? b : a; a = mx; b = mn; }
__device__ __forceinline__ void sort16_desc(unsigned (&a)[16]) {
#pragma unroll
    for (int k = 2; k <= 16; k <<= 1)
#pragma unroll
        for (int j = k >> 1; j > 0; j >>= 1)
#pragma unroll
            for (int i = 0; i < 16; ++i) { const int l = i ^ j; if (l > i) { if ((i & k) == 0) ce_desc(a[i], a[l]); else ce_desc(a[l], a[i]); } }
}
__device__ __forceinline__ void merge16_desc(unsigned (&a)[16], const unsigned (&b)[16]) {
#pragma unroll
    for (int i = 0; i < 16; ++i) a[i] = a[i] > b[15 - i] ? a[i] : b[15 - i];
#pragma unroll
    for (int j = 8; j > 0; j >>= 1)
#pragma unroll
        for (int i = 0; i < 16; ++i) { const int l = i ^ j; if (l > i) ce_desc(a[i], a[l]); }
}
__device__ __forceinline__ float unkey(unsigned a) { a = (a & 0x80000000u) ? (a & 0x7FFFFFFFu) : ~a; return __builtin_bit_cast(float, a); }
__device__ __forceinline__ unsigned ckey(float s, int flat) { unsigned u = __builtin_bit_cast(unsigned, s); u ^= (unsigned)((int)u >> 31) | 0x80000000u; return (u & ~0xFFu) | (unsigned)(255 - flat); }
template <int J> __device__ __forceinline__ unsigned xor_lane(unsigned x, int lane) {
    if (J == 1) return dpp_u<0xB1>(x);
    if (J == 2) return dpp_u<0x4E>(x);
    if (J == 8) return dpp_u<0x128>(x);
    if (J == 16) { const v2u r = __builtin_amdgcn_permlane16_swap(x, x, false, false); const unsigned rx = r.x, ry = r.y; return (lane & 16) ? rx : ry; }
    if (J == 32) { const v2u r = __builtin_amdgcn_permlane32_swap(x, x, false, false); const unsigned rx = r.x, ry = r.y; return (lane & 32) ? rx : ry; }
    return (unsigned)__shfl_xor((int)x, J);
}
template <int K, int J, int N> __device__ __forceinline__ void sort128_stage(unsigned (&e)[N][2], int lane) {
#pragma unroll
    for (int t = 0; t < N; ++t) {
        if (J == 64) { const unsigned mn = e[t][0] < e[t][1] ? e[t][0] : e[t][1], mx = e[t][0] < e[t][1] ? e[t][1] : e[t][0]; e[t][0] = mn; e[t][1] = mx; }
        else {
            const unsigned p0 = xor_lane<J>(e[t][0], lane), p1 = xor_lane<J>(e[t][1], lane);
            const bool lower = (lane & J) == 0;
            const bool up0 = (K >= 64) ? true : ((lane & K) == 0);
            const bool up1 = (K == 128) ? true : (K == 64 ? false : ((lane & K) == 0));
            const unsigned mn0 = e[t][0] < p0 ? e[t][0] : p0, mx0 = e[t][0] < p0 ? p0 : e[t][0], mn1 = e[t][1] < p1 ? e[t][1] : p1, mx1 = e[t][1] < p1 ? p1 : e[t][1];
            e[t][0] = (lower == up0) ? mn0 : mx0; e[t][1] = (lower == up1) ? mn1 : mx1;
        }
    }
}
template <int N> __device__ __forceinline__ void sort128_asc(unsigned (&e)[N][2], int lane) {
#define S_(K, J) sort128_stage<K, J, N>(e, lane)
    S_(2, 1); S_(4, 2); S_(4, 1); S_(8, 4); S_(8, 2); S_(8, 1); S_(16, 8); S_(16, 4); S_(16, 2); S_(16, 1);
    S_(32, 16); S_(32, 8); S_(32, 4); S_(32, 2); S_(32, 1); S_(64, 32); S_(64, 16); S_(64, 8); S_(64, 4); S_(64, 2); S_(64, 1);
    S_(128, 64); S_(128, 32); S_(128, 16); S_(128, 8); S_(128, 4); S_(128, 2); S_(128, 1);
#undef S_
}
__device__ __forceinline__ float wave_max(float v) {
    v = fmaxf(v, dpp_f<0xB1>(v)); v = fmaxf(v, dpp_f<0x4E>(v)); v = fmaxf(v, dpp_f<0x124>(v)); v = fmaxf(v, dpp_f<0x128>(v));
    { const v2u r = __builtin_amdgcn_permlane16_swap(__builtin_bit_cast(unsigned, v), __builtin_bit_cast(unsigned, v), false, false); const unsigned rx = r.x, ry = r.y; v = fmaxf(__builtin_bit_cast(float, rx), __builtin_bit_cast(float, ry)); }
    { const v2u r = __builtin_amdgcn_permlane32_swap(__builtin_bit_cast(unsigned, v), __builtin_bit_cast(unsigned, v), false, false); const unsigned rx = r.x, ry = r.y; v = fmaxf(__builtin_bit_cast(float, rx), __builtin_bit_cast(float, ry)); }
    return v;
}
__device__ __forceinline__ int swap32_addi(int a, int b) { const v2u r = __builtin_amdgcn_permlane32_swap((unsigned)a, (unsigned)b, false, false); const unsigned rx = r.x, ry = r.y; return (int)(rx + ry); }
__device__ __forceinline__ int swap16_addi(int a, int b) { const v2u r = __builtin_amdgcn_permlane16_swap((unsigned)a, (unsigned)b, false, false); const unsigned rx = r.x, ry = r.y; return (int)(rx + ry); }
__device__ __forceinline__ int reduce16i(const int (&p)[16], int lane) {
    int q[8], r[4], u[2];
    const bool b3 = (lane & 8) != 0, b2 = (lane & 4) != 0;
#pragma unroll
    for (int i = 0; i < 8; ++i) q[i] = swap32_addi(p[2 * i], p[2 * i + 1]);
#pragma unroll
    for (int i = 0; i < 4; ++i) r[i] = swap16_addi(q[2 * i], q[2 * i + 1]);
#pragma unroll
    for (int i = 0; i < 2; ++i) { const int keep = b3 ? r[2 * i + 1] : r[2 * i], send = b3 ? r[2 * i] : r[2 * i + 1]; u[i] = keep + (int)dpp_u<0x128>((unsigned)send); }
    const int keep = b2 ? u[1] : u[0], send = b2 ? u[0] : u[1];
    int v = keep + __shfl_xor(send, 4);
    v += (int)dpp_u<0x4E>((unsigned)v); v += (int)dpp_u<0xB1>((unsigned)v);
    return v;
}
__device__ __forceinline__ float reduce16(const float (&p)[16], int lane) {
    float q[8], r[4], u[2];
    const bool b3 = (lane & 8) != 0, b2 = (lane & 4) != 0;
#pragma unroll
    for (int i = 0; i < 8; ++i) q[i] = swap32_add(p[2 * i], p[2 * i + 1]);
#pragma unroll
    for (int i = 0; i < 4; ++i) r[i] = swap16_add(q[2 * i], q[2 * i + 1]);
#pragma unroll
    for (int i = 0; i < 2; ++i) { const float keep = b3 ? r[2 * i + 1] : r[2 * i], send = b3 ? r[2 * i] : r[2 * i + 1]; u[i] = keep + dpp_f<0x128>(send); }
    const float keep = b2 ? u[1] : u[0], send = b2 ? u[0] : u[1];
    float v = keep + __shfl_xor(send, 4);
    v += dpp_f<0x4E>(v);
    v += dpp_f<0xB1>(v);
    return v;
}
__device__ __forceinline__ int swap23(int k) { return (k & ~12) | ((k & 4) << 1) | ((k & 8) >> 1); }
__device__ __forceinline__ float sigmoidf_(float x) { return 1.0f / (1.0f + __expf(-x)); }

#define XB_TMO      128
#define XB_XCNT(j)  (256  + 64 * (j))
#define XB_XSUB(j)  (1280 + 64 * (j))
#define XB_XGEN(j)  (2304 + 64 * (j))
#define XB_TOP      3328
#define XB_TOPGEN   3392
#define XCD_BAR_WORDS 3456
#define XB_SPIN_CAP (1u << 18)

__device__ __forceinline__ unsigned xb_ld(unsigned* p)              { return __hip_atomic_load(p, __ATOMIC_RELAXED, __HIP_MEMORY_SCOPE_AGENT); }
__device__ __forceinline__ unsigned xb_add(unsigned* p, unsigned v) { return __hip_atomic_fetch_add(p, v, __ATOMIC_RELAXED, __HIP_MEMORY_SCOPE_AGENT); }
__device__ __forceinline__ unsigned xb_xcc_id() { return (unsigned)__builtin_amdgcn_s_getreg((3 << 11) | 20) & 0xFu; }
#define XB_SPIN(cond, bar) do { unsigned _sp = 0; while (cond) { __builtin_amdgcn_s_sleep(1); \
    if ((++_sp & 255u) == 0u) { if (xb_ld(&(bar)[XB_TMO])) break; if (_sp > XB_SPIN_CAP) { atomicAdd(&(bar)[XB_TMO], 1u); break; } } } } while (0)

struct XcdBarrier {
    unsigned* bar; unsigned x;
    volatile LAS unsigned* st;
};

__device__ __forceinline__ XcdBarrier xcd_barrier_post(unsigned* bar, volatile LAS unsigned* st) {
    XcdBarrier b; b.bar = bar; b.x = xb_xcc_id(); b.st = st;
    if (threadIdx.x == 0) (void)xb_add(&bar[XB_XCNT(b.x)], 1u);
    return b;
}
__device__ __forceinline__ void xcd_barrier_complete(unsigned* bar, unsigned x, unsigned& nloc, unsigned& nx) {
    const unsigned G = gridDim.x * gridDim.y * gridDim.z;
    unsigned sum, cnt, mine, sp = 0u;
    for (;;) {
        sum = 0u; cnt = 0u; mine = 0u;
#pragma unroll
        for (unsigned j = 0; j < 16; ++j) { const unsigned c = xb_ld(&bar[XB_XCNT(j)]); sum += c; cnt += (c > 0u) ? 1u : 0u; mine = (j == x) ? c : mine; }
        if (sum == G) break;
        __builtin_amdgcn_s_sleep(1);
        if ((++sp & 255u) == 0u) { if (xb_ld(&bar[XB_TMO])) break; if (sp > XB_SPIN_CAP) { atomicAdd(&bar[XB_TMO], 1u); break; } }
    }
    nloc = mine > 0u ? mine : 1u; nx = cnt > 0u ? cnt : 1u;
}

__device__ __forceinline__ void xcd_barrier(const XcdBarrier& b) {
    asm volatile("s_waitcnt vmcnt(0)" ::: "memory");
    __syncthreads();
    if (threadIdx.x == 0) {
        unsigned* bar = b.bar;
        __builtin_amdgcn_s_waitcnt(0);
        unsigned nloc = b.st[0], nx = b.st[1];
        if (nloc == 0u) { xcd_barrier_complete(bar, b.x, nloc, nx); b.st[0] = nloc; b.st[1] = nx; }
        const unsigned old = xb_add(&bar[XB_XSUB(b.x)], 1u);
        const unsigned gen = old / nloc;
        if (old + 1u == (gen + 1u) * nloc) {
            __builtin_amdgcn_fence(__ATOMIC_RELEASE, "agent");
            asm volatile("s_waitcnt vmcnt(0)" ::: "memory");
            const unsigned og = xb_add(&bar[XB_TOP], 1u);
            const unsigned tg = og / nx;
            if (og + 1u == (tg + 1u) * nx) xb_add(&bar[XB_TOPGEN], 1u);
            else XB_SPIN(xb_ld(&bar[XB_TOPGEN]) == tg, bar);
            __builtin_amdgcn_fence(__ATOMIC_ACQUIRE, "agent");
            xb_add(&bar[XB_XGEN(b.x)], 1u);
            asm volatile("s_waitcnt vmcnt(0)" ::: "memory");
        } else {
            XB_SPIN(xb_ld(&bar[XB_XGEN(b.x)]) == gen, bar);
            __builtin_amdgcn_fence(__ATOMIC_ACQUIRE, "agent");
            asm volatile("s_waitcnt vmcnt(0)" ::: "memory");
        }
    }
    __syncthreads();
}


__device__ __forceinline__ void p0_transpose_item(const float* W, int K, int N, const float* gain, bf16* WT, LAS float* scr, int item, int lane) {
    const int nblk = N / 32, kb = item / nblk, nb = item % nblk, k0 = 64 * kb, n0 = 32 * nb;
#pragma unroll 8
    for (int i = 0; i < 32; ++i) { const int kk = 2 * i + (lane >> 5); const float g = gain ? gain[k0 + kk] : 1.0f; scr[kk * 33 + (lane & 31)] = W[(size_t)(k0 + kk) * N + n0 + (lane & 31)] * g; }
    LDS_WAIT(); asm volatile("" ::: "memory");
    const int c = lane & 7;
#pragma unroll
    for (int j = 0; j < 4; ++j) { const int n = (lane >> 3) + 8 * j; const LAS float* s = scr + (8 * c) * 33 + n;
        v4u o; o.x = pk2(s[0 * 33], s[1 * 33]); o.y = pk2(s[2 * 33], s[3 * 33]); o.z = pk2(s[4 * 33], s[5 * 33]); o.w = pk2(s[6 * 33], s[7 * 33]);
        *(GAS v4u*)(WT + (size_t)(n0 + n) * K + k0 + 8 * c) = o; }
    LDS_WAIT(); asm volatile("" ::: "memory");
}

struct Args { const float* in[14]; float* out; unsigned char* ws; int ph_lo, ph_hi, li, pad; };

__global__ void __launch_bounds__(NWAVES * 64, 2) hymba_fwd(Args args) {
    extern __shared__ __attribute__((aligned(16))) unsigned char lds_raw[];
    LAS unsigned char* lds = (LAS unsigned char*)lds_raw;
    volatile LAS unsigned* MISC = (volatile LAS unsigned*)(lds + MISC_OFF);
    const int tid = threadIdx.x, lane = tid & 63, wave = __builtin_amdgcn_readfirstlane(tid >> 6);
    const int G = gridDim.x;
    const int gw = (int)blockIdx.x * NWAVES + wave, NGW = G * NWAVES;
    unsigned char* ws = args.ws;
    gu32* ctl = (gu32*)(ws + WS_CTL);
    const float* x = args.in[0]; const float* norm_mix = args.in[1]; const float* w_in = args.in[2]; const float* conv_w = args.in[3]; const float* conv_gain = args.in[4];
    const float* hg_lb = args.in[5]; const float* hg_gain = args.in[6]; const float* w_out = args.in[7]; const float* norm_ffn = args.in[8]; const float* peer_wq = args.in[9];
    const float* peer_keys = args.in[10]; const float* peer_u = args.in[11]; const float* peer_v = args.in[12]; const float* norm_f = args.in[13];
    float* out = args.out;
    bf16* W1T = (bf16*)(ws + WS_W1T); bf16* WOT = (bf16*)(ws + WS_WOT); bf16* WQT = (bf16*)(ws + WS_WQT);
    float* RS1 = (float*)(ws + WS_RS1); float* SS2 = (float*)(ws + WS_SS2);
    unsigned char* U8 = ws + WS_U16; unsigned char* V8 = ws + WS_V16; unsigned* EXPT = (unsigned*)(ws + WS_EXP); bf16* KEYB = (bf16*)(ws + WS_KEYB);
    bf16* XB = (bf16*)(ws + WS_XB); bf16* MIX = (bf16*)(ws + WS_XB); bf16* X1 = (bf16*)(ws + WS_X1);
    bf16* PROJ = (bf16*)(ws + WS_PROJ); bf16* QB = (bf16*)(ws + WS_PROJ); float* DEC = (float*)(ws + WS_F); bf16* KDT = (bf16*)(ws + WS_X1); bf16* VTT = (bf16*)(ws + WS_X1 + 64 * MiB);

    for (int u = tid; u < (LDS_BYTES - LDSCTL_OFF) / 4; u += NWAVES * 64) ((LAS unsigned*)(lds + LDSCTL_OFF))[u] = 0u;
    __syncthreads();
    XcdBarrier bar; bar.bar = (unsigned*)(ctl + CW_BAR); bar.x = 0; bar.st = nullptr;
    if (N_LAUNCHES == 1) bar = xcd_barrier_post((unsigned*)(ctl + CW_BAR), MISC + 8);
#define GRID_BAR() do { if (N_LAUNCHES == 1) xcd_barrier(bar); } while (0)
    const int lo = args.ph_lo, hi = args.ph_hi;
#define IN(k) (lo <= (k) && (k) < hi)
#define BOTH(k) (IN(k) && IN((k) + 1))

    if (IN(0)) {
        LAS float* scr = (LAS float*)(lds + RING_OFF + wave * 16384);
        constexpr int I_1 = (D / 64) * (DIN / 32), I_O = (D / 64) * (D / 32), I_Q = (D / 64) * (2048 / 32);
        for (int it = gw; it < I_1 + I_O + I_Q; it += NGW) {
            int r = it;
            if (r < I_1) { p0_transpose_item(w_in, D, DIN, norm_mix, W1T, scr, r, lane); continue; } r -= I_1;
            if (r < I_O) { p0_transpose_item(w_out, D, D, nullptr, WOT, scr, r, lane); continue; } r -= I_O;
            p0_transpose_item(peer_wq, D, 2048, norm_ffn, WQT, scr, r, lane);
        }
        for (int m = gw; m < T; m += NGW) {
            const GAS f32x4* xr = (const GAS f32x4*)(x + (size_t)m * D) + lane; f32x4 v[4]; float s = 0.f;
#pragma unroll
            for (int j = 0; j < 4; ++j) { v[j] = xr[64 * j]; s += (v[j].x * v[j].x + v[j].y * v[j].y) + (v[j].z * v[j].z + v[j].w * v[j].w); }
            s = wave_sum(s);
            if (lane == 0) RS1[m] = 1.0f / sqrtf(s * (1.0f / D) + EPS);
            GAS unsigned long long* o8 = (GAS unsigned long long*)(XB + (size_t)m * D) + lane;
#pragma unroll
            for (int j = 0; j < 4; ++j) o8[64 * j] = (unsigned long long)pk2(v[j].x, v[j].y) | ((unsigned long long)pk2(v[j].z, v[j].w) << 32);
        }
        for (int r = gw; r < 2 * NEXP; r += NGW) {
            const int tb = r / NEXP, e = r % NEXP; const float sc = tb ? PEER_SV : PEER_SU;
            const GAS f32x4* src = (const GAS f32x4*)((tb ? peer_v : peer_u) + (size_t)e * D);
            f32x4 v[4] = {src[2 * lane], src[2 * lane + 1], src[128 + 2 * lane], src[128 + 2 * lane + 1]};
            if (!tb) { const GAS f32x4* gp = (const GAS f32x4*)norm_ffn; v[0] = v[0] * gp[2 * lane]; v[1] = v[1] * gp[2 * lane + 1]; v[2] = v[2] * gp[128 + 2 * lane]; v[3] = v[3] * gp[128 + 2 * lane + 1]; }
            unsigned o[4];
#pragma unroll
            for (int j = 0; j < 4; ++j) { f32x4 w = v[j] * sc;
                if (tb) { w.x = fminf(fmaxf(w.x, -240.f), 240.f); w.y = fminf(fmaxf(w.y, -240.f), 240.f); w.z = fminf(fmaxf(w.z, -240.f), 240.f); w.w = fminf(fmaxf(w.w, -240.f), 240.f);
                    int pk = 0; pk = __builtin_amdgcn_cvt_pk_fp8_f32(w.x, w.y, pk, false); pk = __builtin_amdgcn_cvt_pk_fp8_f32(w.z, w.w, pk, true); o[j] = (unsigned)pk; }
                else { const int i0 = (int)rintf(fminf(fmaxf(w.x, -127.f), 127.f)), i1 = (int)rintf(fminf(fmaxf(w.y, -127.f), 127.f)), i2 = (int)rintf(fminf(fmaxf(w.z, -127.f), 127.f)), i3 = (int)rintf(fminf(fmaxf(w.w, -127.f), 127.f));
                    o[j] = ((unsigned)i0 & 0xFFu) | (((unsigned)i1 & 0xFFu) << 8) | (((unsigned)i2 & 0xFFu) << 16) | (((unsigned)i3 & 0xFFu) << 24); } }
            ((GAS v4u*)((tb ? V8 : U8) + (size_t)e * D))[lane] = (v4u){o[0], o[1], o[2], o[3]};
        }
        for (int i = (int)blockIdx.x * NWAVES * 64 + tid; i < T; i += G * NWAVES * 64) SS2[i] = 0.f;
        for (int i = (int)blockIdx.x * NWAVES * 64 + tid; i < 8 * 2 * 128 * 128 / 2; i += G * NWAVES * 64) ((GAS unsigned*)KEYB)[i] = pk2(peer_keys[2 * i], peer_keys[2 * i + 1]);
        if (BOTH(0)) GRID_BAR();
    }

    if (IN(1)) {
        pg8::Gemm g{XB, W1T, T, DIN, D}; pg8::StaticOrder S; S.init(T, DIN, G, (int)blockIdx.x);
        pg8::EpiScaleBf16<0> E{PROJ, DIN, RS1};
        pg8::gemm_phase<pg8::EpiScaleBf16<0>, pg8::StaticOrder, PG8_ALIGN, PG8_SP2>(lds + RING_OFF, g, S, E);
        if (BOTH(1)) GRID_BAR();
    }

    if (IN(2)) {
        for (int item = gw; item < NB * 64 * 4; item += NGW) {
            const int h = item & 3, n = (item >> 2) & 63, b = item >> 8;
            const size_t tok0 = (size_t)b * SEQ + n * 32;
            const int c0 = h * 128 + 2 * lane, cs = h * 128 + swap23(2 * lane);
            const float lb0 = 1.0f / (1.0f + __expf(hg_lb[512 + c0] - hg_lb[c0])), lb1 = 1.0f / (1.0f + __expf(hg_lb[512 + c0 + 1] - hg_lb[c0 + 1]));
            unsigned qw[32], fw[32], vw[32];
#pragma unroll
            for (int c = 0; c < 32; ++c) { const bf16* pr = PROJ + (tok0 + c) * DIN;
                qw[c] = *(const GAS unsigned*)(pr + PC_Q + c0); fw[c] = *(const GAS unsigned*)(pr + PC_F + c0); vw[c] = *(const GAS unsigned*)(pr + PC_V + c0); }
            float eG0 = 1.f, eG1 = 1.f;
            unsigned kd0[16], kd1[16], vv0[16], vv1[16];
#pragma unroll
            for (int i = 0; i < 16; ++i) { kd0[i] = 0u; kd1[i] = 0u; vv0[i] = 0u; vv1[i] = 0u; }
#pragma unroll
            for (int c = 0; c < 32; ++c) { bf16* pr = PROJ + (tok0 + c) * DIN;
                const float f0 = lb0 + (1.0f - lb0) * sigmoidf_(bf_lo(fw[c])), f1 = lb1 + (1.0f - lb1) * sigmoidf_(bf_hi(fw[c]));
                eG0 *= f0; eG1 *= f1;
                const float q0 = bf_lo(qw[c]), q1 = bf_hi(qw[c]);
                const float qd0 = q0 * sigmoidf_(q0) * 0.08838834764831845f * eG0, qd1 = q1 * sigmoidf_(q1) * 0.08838834764831845f * eG1;
                const float kv0 = (1.0f - f0) / eG0, kv1 = (1.0f - f1) / eG1;
                *(GAS unsigned*)(pr + PC_Q + cs) = pk2(qd0, qd1);
                const unsigned kp = pk2(kv0, kv1);
                *(GAS unsigned*)(pr + PC_F + cs) = kp;
                const int pp = swap23(c), sh = 16 * (pp & 1);
                kd0[pp >> 1] |= (kp & 0xffffu) << sh; kd1[pp >> 1] |= (kp >> 16) << sh;
                vv0[pp >> 1] |= (vw[c] & 0xffffu) << sh; vv1[pp >> 1] |= (vw[c] >> 16) << sh; }
            GAS v4u* kt = (GAS v4u*)(KDT + ((size_t)item * 128 + 2 * lane) * 32);
            GAS v4u* vt = (GAS v4u*)(VTT + ((size_t)item * 128 + 2 * lane) * 32);
#pragma unroll
            for (int i = 0; i < 4; ++i) { kt[i] = (v4u){kd0[4 * i], kd0[4 * i + 1], kd0[4 * i + 2], kd0[4 * i + 3]}; kt[4 + i] = (v4u){kd1[4 * i], kd1[4 * i + 1], kd1[4 * i + 2], kd1[4 * i + 3]};
                vt[i] = (v4u){vv0[4 * i], vv0[4 * i + 1], vv0[4 * i + 2], vv0[4 * i + 3]}; vt[4 + i] = (v4u){vv1[4 * i], vv1[4 * i + 1], vv1[4 * i + 2], vv1[4 * i + 3]}; }
            *(GAS f32x2*)(DEC + (size_t)item * 128 + 2 * lane) = (f32x2){eG0, eG1};
        }
        if (BOTH(2)) GRID_BAR();
    }

    if (IN(3)) {
        constexpr int BUFB = 33792, OB0 = 2 * BUFB;
        for (int it = (int)blockIdx.x; it < NB * 4; it += G) {
            const int b = it >> 2, h = it & 3;
            const int lt = tid & 255, r = lane & 31, hh = lane >> 5, sl = wave;
            v4u st[9];
#define SCAN_LOAD(n_) do { const size_t tk0 = (size_t)b * SEQ + (n_) * 32; const size_t itm = (size_t)((b * 64 + (n_)) * 4 + h); \
                _Pragma("unroll") for (int i = 0; i < 2; ++i) { const int q = lt + 256 * i, row = q >> 4, cc = q & 15; const bf16* pr = PROJ + (tk0 + row) * DIN + h * 128 + cc * 8; \
                    st[i] = *(const GAS v4u*)(pr + PC_Q); st[2 + i] = *(const GAS v4u*)(pr + PC_F); \
                    st[4 + i] = ((const GAS v4u*)(KDT + itm * 4096))[q]; st[6 + i] = ((const GAS v4u*)(VTT + itm * 4096))[q]; } \
                if (lt < 32) st[8] = ((const GAS v4u*)(DEC + itm * 128))[lt]; } while (0)
#define SCAN_COMMIT(n_) do { LAS unsigned char* Bf = lds + RING_OFF + ((n_) & 1) * BUFB; \
                _Pragma("unroll") for (int i = 0; i < 2; ++i) { const int q = lt + 256 * i, row = q >> 4, cc = q & 15, k = q >> 2, c4 = q & 3; \
                    *(LAS v4u*)(Bf + row * 256 + ((cc ^ (row & 15)) * 16)) = st[i]; *(LAS v4u*)(Bf + 8192 + row * 256 + ((cc ^ (row & 15)) * 16)) = st[2 + i]; \
                    *(LAS v4u*)(Bf + 16384 + k * 64 + ((c4 ^ ((k >> 2) & 3)) * 16)) = st[4 + i]; *(LAS v4u*)(Bf + 24576 + k * 64 + ((c4 ^ ((k >> 2) & 3)) * 16)) = st[6 + i]; } \
                if (lt < 32) *(LAS v4u*)(Bf + 32768 + lt * 16) = st[8]; } while (0)
#define SCAN_POST(n_) do { const int pos = lt >> 3, vg = lt & 7; const LAS f32x4* ob = (const LAS f32x4*)(lds + RING_OFF + OB0 + ((n_) & 1) * 16384 + (pos * 128 + vg * 16) * 4); \
                const f32x4 o0 = ob[0], o1 = ob[1], o2 = ob[2], o3 = ob[3]; \
                float ss = (o0.x * o0.x + o0.y * o0.y) + (o0.z * o0.z + o0.w * o0.w) + (o1.x * o1.x + o1.y * o1.y) + (o1.z * o1.z + o1.w * o1.w) \
                         + (o2.x * o2.x + o2.y * o2.y) + (o2.z * o2.z + o2.w * o2.w) + (o3.x * o3.x + o3.y * o3.y) + (o3.z * o3.z + o3.w * o3.w); \
                ss += __shfl_xor(ss, 1); ss += __shfl_xor(ss, 2); ss += __shfl_xor(ss, 4); \
                const float rr = 1.0f / sqrtf(ss * (1.0f / 128.0f) + EPS); \
                const size_t tk = (size_t)b * SEQ + (n_) * 32 + pos; const GAS v4u* gp = (const GAS v4u*)(PROJ + tk * DIN + PC_G + h * 128 + vg * 16); const v4u g0 = gp[0], g1 = gp[1]; \
                const float ov[16] = {o0.x, o0.y, o0.z, o0.w, o1.x, o1.y, o1.z, o1.w, o2.x, o2.y, o2.z, o2.w, o3.x, o3.y, o3.z, o3.w}; \
                const float gf[16] = {bf_lo(g0.x), bf_hi(g0.x), bf_lo(g0.y), bf_hi(g0.y), bf_lo(g0.z), bf_hi(g0.z), bf_lo(g0.w), bf_hi(g0.w), bf_lo(g1.x), bf_hi(g1.x), bf_lo(g1.y), bf_hi(g1.y), bf_lo(g1.z), bf_hi(g1.z), bf_lo(g1.w), bf_hi(g1.w)}; \
                float yv[16]; _Pragma("unroll") for (int i = 0; i < 16; ++i) yv[i] = ov[i] * rr * hg_gain[vg * 16 + i] * (gf[i] * sigmoidf_(gf[i])); \
                GAS v4u* mp = (GAS v4u*)(MIX + tk * D + 512 + h * 128 + vg * 16); \
                mp[0] = (v4u){pk2(yv[0], yv[1]), pk2(yv[2], yv[3]), pk2(yv[4], yv[5]), pk2(yv[6], yv[7])}; mp[1] = (v4u){pk2(yv[8], yv[9]), pk2(yv[10], yv[11]), pk2(yv[12], yv[13]), pk2(yv[14], yv[15])}; } while (0)
#define SCAN_BAR() do { asm volatile("s_waitcnt lgkmcnt(0)" ::: "memory"); __builtin_amdgcn_s_barrier(); asm volatile("" ::: "memory"); } while (0)
            if (wave >= 4) {
                SCAN_LOAD(0); SCAN_COMMIT(0);
                SCAN_BAR();
                for (int n = 0; n < 64; ++n) {
                    if (n + 1 < 64) SCAN_LOAD(n + 1);
                    if (n >= 1) SCAN_POST(n - 1);
                    if (n + 1 < 64) SCAN_COMMIT(n + 1);
                    SCAN_BAR();
                }
                SCAN_POST(63);
                SCAN_BAR();
            } else {
                f32x16 S0, S1, S2, S3;
#pragma unroll
                for (int i = 0; i < 16; ++i) { S0[i] = 0.f; S1[i] = 0.f; S2[i] = 0.f; S3[i] = 0.f; }
                SCAN_BAR();
                for (int n = 0; n < 64; ++n) {
                    const LAS unsigned char* Bf = lds + RING_OFF + (n & 1) * BUFB;
                    pg8::bf16x8 qd[8], kd[8], vt[2], kt[4][2];
#pragma unroll
                    for (int ks = 0; ks < 8; ++ks) { const int off = r * 256 + (((2 * ks + hh) ^ (r & 15)) * 16); qd[ks] = *(const LAS pg8::bf16x8*)(Bf + off); kd[ks] = *(const LAS pg8::bf16x8*)(Bf + 8192 + off); }
#pragma unroll
                    for (int sp = 0; sp < 2; ++sp) { const int row = 32 * sl + r; vt[sp] = *(const LAS pg8::bf16x8*)(Bf + 24576 + row * 64 + (((2 * sp + hh) ^ ((row >> 2) & 3)) * 16)); }
#pragma unroll
                    for (int rt = 0; rt < 4; ++rt)
#pragma unroll
                        for (int sp = 0; sp < 2; ++sp) { const int row = 32 * rt + r; kt[rt][sp] = *(const LAS pg8::bf16x8*)(Bf + 16384 + row * 64 + (((2 * sp + hh) ^ ((row >> 2) & 3)) * 16)); }
                    asm volatile("s_waitcnt lgkmcnt(0)" ::: "memory");
                    f32x16 X, O;
#pragma unroll
                    for (int i = 0; i < 16; ++i) { X[i] = 0.f; O[i] = 0.f; }
                    O = __builtin_amdgcn_mfma_f32_32x32x16_bf16(qd[0], pack8(S0, 0), O, 0, 0, 0); O = __builtin_amdgcn_mfma_f32_32x32x16_bf16(qd[1], pack8(S0, 1), O, 0, 0, 0);
                    O = __builtin_amdgcn_mfma_f32_32x32x16_bf16(qd[2], pack8(S1, 0), O, 0, 0, 0); O = __builtin_amdgcn_mfma_f32_32x32x16_bf16(qd[3], pack8(S1, 1), O, 0, 0, 0);
                    O = __builtin_amdgcn_mfma_f32_32x32x16_bf16(qd[4], pack8(S2, 0), O, 0, 0, 0); O = __builtin_amdgcn_mfma_f32_32x32x16_bf16(qd[5], pack8(S2, 1), O, 0, 0, 0);
                    O = __builtin_amdgcn_mfma_f32_32x32x16_bf16(qd[6], pack8(S3, 0), O, 0, 0, 0); O = __builtin_amdgcn_mfma_f32_32x32x16_bf16(qd[7], pack8(S3, 1), O, 0, 0, 0);
#pragma unroll
                    for (int ks = 0; ks < 8; ++ks) X = __builtin_amdgcn_mfma_f32_32x32x16_bf16(kd[ks], qd[ks], X, 0, 0, 0);
#define SCAN_SUPD(Sx, rt_) do { Sx = __builtin_amdgcn_mfma_f32_32x32x16_bf16(kt[rt_][0], vt[0], Sx, 0, 0, 0); Sx = __builtin_amdgcn_mfma_f32_32x32x16_bf16(kt[rt_][1], vt[1], Sx, 0, 0, 0); \
                        _Pragma("unroll") for (int g = 0; g < 4; ++g) { const f32x4 dv = *(const LAS f32x4*)(Bf + 32768 + (32 * (rt_) + 8 * g + 4 * hh) * 4); \
                            Sx[4 * g] *= dv.x; Sx[4 * g + 1] *= dv.y; Sx[4 * g + 2] *= dv.z; Sx[4 * g + 3] *= dv.w; } } while (0)
                    SCAN_SUPD(S0, 0); SCAN_SUPD(S1, 1); SCAN_SUPD(S2, 2); SCAN_SUPD(S3, 3);
#pragma unroll
                    for (int i = 0; i < 16; ++i) { const int s_ = (i & 3) + 8 * (i >> 2) + 4 * hh; X[i] = (s_ <= r) ? X[i] : 0.f; }
                    O = __builtin_amdgcn_mfma_f32_32x32x16_bf16(pack8(X, 0), vt[0], O, 0, 0, 0); O = __builtin_amdgcn_mfma_f32_32x32x16_bf16(pack8(X, 1), vt[1], O, 0, 0, 0);
                    LAS float* ob = (LAS float*)(lds + RING_OFF + OB0 + (n & 1) * 16384);
#pragma unroll
                    for (int i = 0; i < 16; ++i) ob[((i & 3) + 8 * (i >> 2) + 4 * hh) * 128 + 32 * sl + r] = O[i];
                    SCAN_BAR();
                }
                SCAN_BAR();
            }
        }
        {
            const int cb = (G > NB * 4) ? (int)blockIdx.x - NB * 4 : (int)blockIdx.x, ncb = (G > NB * 4) ? G - NB * 4 : G;
            if (cb >= 0) for (int item = cb * NWAVES + wave; item < NB * 4 * 32; item += ncb * NWAVES) {
                const int seg = item & 31, gp = (item >> 5) & 3, b = item >> 7, c0 = gp * 128 + 2 * lane, t0 = seg * 64;
                const f32x2 w0 = *(const GAS f32x2*)(conv_w + c0), w1 = *(const GAS f32x2*)(conv_w + 512 + c0), w2 = *(const GAS f32x2*)(conv_w + 1024 + c0), gn = *(const GAS f32x2*)(conv_gain + c0);
                f32x2 u1 = {0.f, 0.f}, u2 = {0.f, 0.f};
                if (t0 > 0) { const bf16* p2 = PROJ + (size_t)(b * SEQ + t0 - 2) * DIN; const bf16* p1 = p2 + DIN;
                    const unsigned ca = *(const GAS unsigned*)(p2 + PC_C + c0), ha = *(const GAS unsigned*)(p2 + PC_H + c0), cbb = *(const GAS unsigned*)(p1 + PC_C + c0), hb = *(const GAS unsigned*)(p1 + PC_H + c0);
                    u2 = (f32x2){bf_lo(ca) * bf_lo(ha), bf_hi(ca) * bf_hi(ha)}; u1 = (f32x2){bf_lo(cbb) * bf_lo(hb), bf_hi(cbb) * bf_hi(hb)}; }
                for (int tb = t0; tb < t0 + 64; tb += 8) {
                    unsigned cw[8], hw[8], bw[8];
#pragma unroll
                    for (int i = 0; i < 8; ++i) { const bf16* pr = PROJ + ((size_t)b * SEQ + tb + i) * DIN; cw[i] = *(const GAS unsigned*)(pr + PC_C + c0); hw[i] = *(const GAS unsigned*)(pr + PC_H + c0); bw[i] = *(const GAS unsigned*)(pr + PC_B + c0); }
#pragma unroll
                    for (int i = 0; i < 8; ++i) { const f32x2 u = {bf_lo(cw[i]) * bf_lo(hw[i]), bf_hi(cw[i]) * bf_hi(hw[i])};
                        const f32x2 y = (f32x2){bf_lo(bw[i]), bf_hi(bw[i])} * (w0 * u2 + w1 * u1 + w2 * u);
                        float ss = y.x * y.x + y.y * y.y;
                        ss += dpp_f<0xB1>(ss); ss += dpp_f<0x4E>(ss); ss += dpp_f<0x124>(ss); ss += dpp_f<0x128>(ss); ss = swap16_add(ss, ss);
                        const float r = 1.0f / sqrtf(ss * (1.0f / 64.0f) + EPS);
                        *(GAS unsigned*)(MIX + ((size_t)b * SEQ + tb + i) * D + c0) = pk2(y.x * r * gn.x, y.y * r * gn.y); u2 = u1; u1 = u; }
                }
            }
        }
        if (BOTH(3)) GRID_BAR();
    }


    if (IN(4)) {
        pg8::Gemm g{MIX, WOT, T, D, D}; pg8::StaticOrder S; S.init(T, D, G, (int)blockIdx.x);
        pg8::EpiResid E{x, X1, SS2};
        pg8::gemm_phase<pg8::EpiResid, pg8::StaticOrder, PG8_ALIGN, PG8_SP2>(lds + RING_OFF, g, S, E);
        if (BOTH(4)) GRID_BAR();
    }

    if (IN(5)) {
        pg8::Gemm g{X1, WQT, T, 2048, D}; pg8::StaticOrder S; S.init(T, 2048, G, (int)blockIdx.x);
        pg8::EpiScaleBf16<1> E{QB, 2048, SS2};
        pg8::gemm_phase<pg8::EpiScaleBf16<1>, pg8::StaticOrder, PG8_ALIGN, PG8_SP2>(lds + RING_OFF, g, S, E);
        if (BOTH(5)) GRID_BAR();
    }

    if (IN(6)) {
        const int r = lane & 31, hh = lane >> 5;
        for (int item = gw; item < (T / 32) * 8; item += NGW) {
            const int h = item & 7, tok = (item >> 3) * 32 + r;
            unsigned L[2][16];
#pragma unroll
            for (int p = 0; p < 2; ++p) {
                pg8::bf16x8 qf[8];
                const GAS pg8::bf16x8* qp = (const GAS pg8::bf16x8*)(QB + (size_t)tok * 2048 + h * 256 + p * 128 + 8 * hh);
#pragma unroll
                for (int ks = 0; ks < 8; ++ks) qf[ks] = qp[2 * ks];
                const GAS pg8::bf16x8* kp = (const GAS pg8::bf16x8*)(KEYB + (size_t)((h * 2 + p) * 128 + r) * 128 + 8 * hh);
                unsigned best[16];
#pragma unroll
                for (int nt = 0; nt < 4; ++nt) {
                    f32x16 acc;
#pragma unroll
                    for (int i = 0; i < 16; ++i) acc[i] = 0.f;
                    const GAS pg8::bf16x8* kb = kp + nt * 512; asm volatile("" : "+v"(kb));
#pragma unroll
                    for (int ks = 0; ks < 8; ++ks) acc = __builtin_amdgcn_mfma_f32_32x32x16_bf16(kb[2 * ks], qf[ks], acc, 0, 0, 0);
                    unsigned cur[16];
#pragma unroll
                    for (int i = 0; i < 16; ++i) { const int n = 32 * nt + (i & 3) + 8 * (i >> 2) + 4 * hh;
                        const float av = acc[i]; unsigned u = __builtin_bit_cast(unsigned, av); u ^= (unsigned)((int)u >> 31) | 0x80000000u;
                        cur[i] = (u & ~0x7Fu) | (unsigned)(127 - n); }
                    sort16_desc(cur);
                    if (nt == 0) {
#pragma unroll
                        for (int i = 0; i < 16; ++i) best[i] = cur[i];
                    } else merge16_desc(best, cur);
                }
                unsigned o[16];
#pragma unroll
                for (int i = 0; i < 16; ++i) o[i] = (unsigned)__shfl_xor((int)best[i], 32);
                merge16_desc(best, o);
#pragma unroll
                for (int i = 0; i < 16; ++i) L[p][i] = best[i];
            }
            float v1[16], v2[16];
#pragma unroll
            for (int j = 0; j < 16; ++j) { v1[j] = unkey(L[0][j] & ~0x7Fu); v2[j] = unkey(L[1][j] & ~0x7Fu); }
            unsigned ct[16];
#pragma unroll
            for (int j = 0; j < 16; ++j) ct[j] = ckey(v1[0] + v2[j], j);
#pragma unroll
            for (int i = 1; i < 16; ++i)
#pragma unroll
                for (int j = 0; j < 16; ++j) if ((i + 1) * (j + 1) <= 16) {
                    unsigned key = ckey(v1[i] + v2[j], i * 16 + j);
#pragma unroll
                    for (int t = 0; t < 16; ++t) { const unsigned mx = ct[t] > key ? ct[t] : key; key = ct[t] > key ? key : ct[t]; ct[t] = mx; }
                }
            float den = 0.f, ex[16]; const float cmax = unkey(ct[0] & ~0xFFu);
#pragma unroll
            for (int t = 0; t < 16; ++t) { ex[t] = __expf(unkey(ct[t] & ~0xFFu) - cmax); den += ex[t]; }
            const float inv = 1.0f / den;
            unsigned b1[4], b2[4];
#pragma unroll
            for (int w = 0; w < 4; ++w) { b1[w] = (L[0][4 * w] & 0x7Fu) | ((L[0][4 * w + 1] & 0x7Fu) << 8) | ((L[0][4 * w + 2] & 0x7Fu) << 16) | ((L[0][4 * w + 3] & 0x7Fu) << 24);
                b2[w] = (L[1][4 * w] & 0x7Fu) | ((L[1][4 * w + 1] & 0x7Fu) << 8) | ((L[1][4 * w + 2] & 0x7Fu) << 16) | ((L[1][4 * w + 3] & 0x7Fu) << 24); }
            unsigned ent[8];
#pragma unroll
            for (int t = 0; t < 8; ++t) { const unsigned hm = 0u - (unsigned)hh;
                const unsigned ck = ct[t] ^ ((ct[t] ^ ct[8 + t]) & hm); const unsigned e0 = __builtin_bit_cast(unsigned, ex[t]), e1 = __builtin_bit_cast(unsigned, ex[8 + t]);
                const float gt = __builtin_bit_cast(float, e0 ^ ((e0 ^ e1) & hm)) * inv;
                const unsigned flat = 255u - (ck & 0xFFu), ii = flat >> 4, jj = flat & 15u;
                const unsigned w1 = (ii & 8u) ? ((ii & 4u) ? b1[3] : b1[2]) : ((ii & 4u) ? b1[1] : b1[0]), w2 = (jj & 8u) ? ((jj & 4u) ? b2[3] : b2[2]) : ((jj & 4u) ? b2[1] : b2[0]);
                const unsigned n1 = 127u - ((w1 >> (8u * (ii & 3u))) & 0x7Fu), n2 = 127u - ((w2 >> (8u * (jj & 3u))) & 0x7Fu);
                ent[t] = (n1 * 128u + n2) | (pkh2(gt, 0.f) << 16); }
            GAS v4u* ep = (GAS v4u*)(EXPT + (size_t)tok * 128 + h * 16 + 8 * hh);
            ep[0] = (v4u){ent[0], ent[1], ent[2], ent[3]}; ep[1] = (v4u){ent[4], ent[5], ent[6], ent[7]};
        }
        if (BOTH(6)) GRID_BAR();
    }


    if (IN(7)) {
        constexpr int NT = 4;
        const unsigned srcl = (unsigned)(32 * (lane & 1) + 16 * ((lane >> 1) & 1)) << 2;
        for (int bt = gw; bt < T / NT; bt += NGW) {
            const int tok0 = bt * NT;
            unsigned e[NT][2]; float rs2[NT];
#pragma unroll
            for (int t = 0; t < NT; ++t) { const unsigned r0 = EXPT[(size_t)(tok0 + t) * 128 + lane], r1 = EXPT[(size_t)(tok0 + t) * 128 + 64 + lane];
                e[t][0] = (r0 << 16) | (r0 >> 16); e[t][1] = (r1 << 16) | (r1 >> 16);
                rs2[t] = 1.0f / sqrtf(SS2[tok0 + t] * (1.0f / D) + EPS); }
            sort128_asc<NT>(e, lane);
            int ah[NT][2]; int hx[NT][4]; float xs[NT];
#pragma unroll
            for (int t = 0; t < NT; ++t) { const GAS v4u* xr = (const GAS v4u*)(X1 + (size_t)(tok0 + t) * D); const v4u xa = __builtin_nontemporal_load(xr + lane), xb = __builtin_nontemporal_load(xr + 64 + lane);
                const float xv[16] = {bf_lo(xa.x), bf_hi(xa.x), bf_lo(xa.y), bf_hi(xa.y), bf_lo(xa.z), bf_hi(xa.z), bf_lo(xa.w), bf_hi(xa.w), bf_lo(xb.x), bf_hi(xb.x), bf_lo(xb.y), bf_hi(xb.y), bf_lo(xb.z), bf_hi(xb.z), bf_lo(xb.w), bf_hi(xb.w)};
                float am = 0.f;
#pragma unroll
                for (int i = 0; i < 16; ++i) am = fmaxf(am, fabsf(xv[i]));
                am = fmaxf(wave_max(am), 1e-20f); const float sx = 127.0f / am; xs[t] = am * (1.0f / 127.0f);
#pragma unroll
                for (int w = 0; w < 4; ++w) { const int i0 = (int)rintf(xv[4 * w] * sx), i1 = (int)rintf(xv[4 * w + 1] * sx), i2 = (int)rintf(xv[4 * w + 2] * sx), i3 = (int)rintf(xv[4 * w + 3] * sx);
                    hx[t][w] = (int)(((unsigned)i0 & 0xFFu) | (((unsigned)i1 & 0xFFu) << 8) | (((unsigned)i2 & 0xFFu) << 16) | (((unsigned)i3 & 0xFFu) << 24)); }
                ah[t][0] = 0; ah[t][1] = 0; }
#define PEER_LOAD(buf, st_) do { _Pragma("unroll") for (int t = 0; t < NT; ++t) { const unsigned em_ = ((st_) & 16) ? 0xFFFFFFFFu : 0u; const unsigned esel = e[t][0] ^ ((e[t][0] ^ e[t][1]) & em_); \
                _Pragma("unroll") for (int q = 0; q < 4; ++q) { const unsigned id = (unsigned)__builtin_amdgcn_readlane((int)esel, 4 * ((st_) & 15) + q) >> 16; \
                    buf[t][q] = ((const GAS v4u*)(U8 + (size_t)id * D))[lane]; } } } while (0)
#define PEER_DOTS(buf, st_) do { int p[16]; \
                _Pragma("unroll") for (int t = 0; t < NT; ++t) _Pragma("unroll") for (int q = 0; q < 4; ++q) { \
                    const int d0 = __builtin_amdgcn_sdot4((int)buf[t][q].x, hx[t][0], 0, false), d1 = __builtin_amdgcn_sdot4((int)buf[t][q].z, hx[t][2], 0, false); \
                    p[4 * t + q] = __builtin_amdgcn_sdot4((int)buf[t][q].y, hx[t][1], d0, false) + __builtin_amdgcn_sdot4((int)buf[t][q].w, hx[t][3], d1, false); } \
                const int red = reduce16i(p, lane); const bool hit = (lane >> 2) == ((st_) & 15), hi = ((st_) & 16) != 0; \
                _Pragma("unroll") for (int t = 0; t < NT; ++t) { const int got = __builtin_amdgcn_ds_bpermute((int)(srcl + (unsigned)((8 * (t & 1) + 4 * (t >> 1)) << 2)), red); \
                    ah[t][0] = (hit && !hi) ? got : ah[t][0]; ah[t][1] = (hit && hi) ? got : ah[t][1]; } } while (0)
            {
                v4u ua[NT][4], ubb[NT][4];
                PEER_LOAD(ua, 0);
                for (int st = 0; st < 32; st += 2) {
                    PEER_LOAD(ubb, st + 1);
                    PEER_DOTS(ua, st);
                    if (st + 2 < 32) PEER_LOAD(ua, st + 2);
                    PEER_DOTS(ubb, st + 1);
                }
            }
            float wv[NT][2];
#pragma unroll
            for (int t = 0; t < NT; ++t)
#pragma unroll
                for (int g = 0; g < 2; ++g) { const float a = (float)ah[t][g] * (rs2[t] * xs[t] * (1.0f / PEER_SU)); const float gate = (float)h2_of(e[t][g] & 0xFFFFu).x;
                    wv[t][g] = gate * (0.5f / PEER_SV) * a * (1.0f + erff(a * 0.7071067811865476f)); }
            f32x2 y[NT][8];
#pragma unroll
            for (int t = 0; t < NT; ++t)
#pragma unroll
                for (int i = 0; i < 8; ++i) y[t][i] = (f32x2){0.f, 0.f};
#define PEER_LOADB(buf, st_) do { _Pragma("unroll") for (int t = 0; t < NT; ++t) { const unsigned em_ = ((st_) & 32) ? 0xFFFFFFFFu : 0u; const unsigned esel = e[t][0] ^ ((e[t][0] ^ e[t][1]) & em_); \
                _Pragma("unroll") for (int q = 0; q < 2; ++q) { const unsigned id = (unsigned)__builtin_amdgcn_readlane((int)esel, 2 * ((st_) & 31) + q) >> 16; \
                    buf[t][q] = ((const GAS v4u*)(V8 + (size_t)id * D))[lane]; } } } while (0)
#define PEER_AXPY(buf, st_) do { _Pragma("unroll") for (int t = 0; t < NT; ++t) { const unsigned wm_ = ((st_) & 32) ? 0xFFFFFFFFu : 0u; const unsigned w0_ = __builtin_bit_cast(unsigned, wv[t][0]), w1_ = __builtin_bit_cast(unsigned, wv[t][1]); const unsigned wsel = w0_ ^ ((w0_ ^ w1_) & wm_); \
                _Pragma("unroll") for (int q = 0; q < 2; ++q) { const float wi = __builtin_bit_cast(float, __builtin_amdgcn_readlane((int)wsel, 2 * ((st_) & 31) + q)); const f32x2 w2 = {wi, wi}; \
                    const unsigned vw_[4] = {buf[t][q].x, buf[t][q].y, buf[t][q].z, buf[t][q].w}; \
                    _Pragma("unroll") for (int j = 0; j < 4; ++j) { y[t][2 * j] = __builtin_elementwise_fma(__builtin_amdgcn_cvt_pk_f32_fp8((int)vw_[j], false), w2, y[t][2 * j]); y[t][2 * j + 1] = __builtin_elementwise_fma(__builtin_amdgcn_cvt_pk_f32_fp8((int)vw_[j], true), w2, y[t][2 * j + 1]); } } } } while (0)
            {
                v4u va[NT][2], vbb[NT][2];
                PEER_LOADB(va, 0);
                for (int st = 0; st < 64; st += 2) {
                    PEER_LOADB(vbb, st + 1);
                    PEER_AXPY(va, st);
                    if (st + 2 < 64) PEER_LOADB(va, st + 2);
                    PEER_AXPY(vbb, st + 1);
                }
            }
#pragma unroll
            for (int t = 0; t < NT; ++t) { const size_t tok = (size_t)(tok0 + t);
                const GAS v4u* xr = (const GAS v4u*)(X1 + tok * D); const v4u xa = __builtin_nontemporal_load(xr + lane), xb = __builtin_nontemporal_load(xr + 64 + lane);
                const float xf[16] = {bf_lo(xa.x), bf_hi(xa.x), bf_lo(xa.y), bf_hi(xa.y), bf_lo(xa.z), bf_hi(xa.z), bf_lo(xa.w), bf_hi(xa.w),
                                      bf_lo(xb.x), bf_hi(xb.x), bf_lo(xb.y), bf_hi(xb.y), bf_lo(xb.z), bf_hi(xb.z), bf_lo(xb.w), bf_hi(xb.w)};
                float yy[16]; float ss = 0.f;
#pragma unroll
                for (int i = 0; i < 8; ++i) { yy[2 * i] = y[t][i].x + xf[2 * i]; yy[2 * i + 1] = y[t][i].y + xf[2 * i + 1]; ss += yy[2 * i] * yy[2 * i] + yy[2 * i + 1] * yy[2 * i + 1]; }
                ss = wave_sum(ss);
                const float r = 1.0f / sqrtf(ss * (1.0f / D) + EPS);
                const GAS f32x4* nfp = (const GAS f32x4*)norm_f; const f32x4 n0 = nfp[2 * lane], n1 = nfp[2 * lane + 1], n2 = nfp[128 + 2 * lane], n3 = nfp[128 + 2 * lane + 1];
                GAS f32x4* op = (GAS f32x4*)(out + tok * D);
                __builtin_nontemporal_store((f32x4){yy[0] * r * n0.x, yy[1] * r * n0.y, yy[2] * r * n0.z, yy[3] * r * n0.w}, op + 2 * lane);
                __builtin_nontemporal_store((f32x4){yy[4] * r * n1.x, yy[5] * r * n1.y, yy[6] * r * n1.z, yy[7] * r * n1.w}, op + 2 * lane + 1);
                __builtin_nontemporal_store((f32x4){yy[8] * r * n2.x, yy[9] * r * n2.y, yy[10] * r * n2.z, yy[11] * r * n2.w}, op + 128 + 2 * lane);
                __builtin_nontemporal_store((f32x4){yy[12] * r * n3.x, yy[13] * r * n3.y, yy[14] * r * n3.z, yy[15] * r * n3.w}, op + 128 + 2 * lane + 1); }
        }
    }

#undef IN
#undef BOTH
}

extern "C" void kernel_launch(void* const* d_in, const int* in_sizes, int n_in, void* d_out, int out_size, void* d_ws, size_t ws_size, hipStream_t stream) {
    static int grid = 0;
    if (grid == 0) {
        if (n_in != 14 || in_sizes[0] != T * D || out_size != T * D || ws_size < WS_END) { fprintf(stderr, "kernel_launch: unexpected shapes (n_in %d, in0 %d, out %d, ws %zu); nothing launched\n", n_in, n_in > 0 ? in_sizes[0] : -1, out_size, ws_size); grid = -1; return; }
        int dev = 0, cus = 0, per_cu = 0;
        if (hipGetDevice(&dev) != hipSuccess || hipDeviceGetAttribute(&cus, hipDeviceAttributeMultiprocessorCount, dev) != hipSuccess) { grid = -1; return; }
        if (hipFuncSetAttribute((const void*)hymba_fwd, hipFuncAttributeMaxDynamicSharedMemorySize, LDS_BYTES) != hipSuccess) { fprintf(stderr, "kernel_launch: hipFuncSetAttribute failed\n"); grid = -1; return; }
        if (hipOccupancyMaxActiveBlocksPerMultiprocessor(&per_cu, (const void*)hymba_fwd, NWAVES * 64, LDS_BYTES) != hipSuccess || per_cu < 1) { fprintf(stderr, "kernel_launch: occupancy query says %d blocks per CU\n", per_cu); (void)hipGetLastError(); grid = -1; return; }
        grid = cus;
    }
    if (grid < 0) return;
    if (hipMemsetAsync((char*)d_ws + WS_CTL, 0, CTL_ZERO_BYTES, stream) != hipSuccess) { fprintf(stderr, "kernel_launch: hipMemsetAsync failed\n"); return; }
    Args a{};
    for (int i = 0; i < 14; ++i) a.in[i] = (const float*)d_in[i];
    a.out = (float*)d_out; a.ws = (unsigned char*)d_ws;
    if (N_LAUNCHES == 1) {
        a.ph_lo = 0; a.ph_hi = NPHASES; a.li = 0;
        void* kargs[] = {&a};
        const hipError_t e = hipLaunchCooperativeKernel((const void*)hymba_fwd, dim3(grid), dim3(NWAVES * 64), kargs, LDS_BYTES, stream);
        if (e != hipSuccess) fprintf(stderr, "kernel_launch: cooperative launch failed: %s (grid %d)\n", hipGetErrorString(e), grid);
    } else {
        for (int li = 0; li < NPHASES; ++li) {
            a.ph_lo = li; a.ph_hi = li + 1; a.li = li;
            hipLaunchKernelGGL(hymba_fwd, dim3(grid), dim3(NWAVES * 64), LDS_BYTES, stream, a);
            const hipError_t le = hipPeekAtLastError();
            if (le != hipSuccess) { fprintf(stderr, "kernel_launch: launch %d failed: %s\n", li, hipGetErrorName(le)); break; }
        }
    }
}
```

```cpp
#include <hip/hip_runtime.h>
#include <cstdio>
#include <cstdint>
namespace pg8 {
#define PG8_LAS __attribute__((address_space(3)))
typedef unsigned short bf16_t;
typedef short bf16x8 __attribute__((ext_vector_type(8)));
typedef float f32x4 __attribute__((ext_vector_type(4)));
typedef unsigned u32x4 __attribute__((ext_vector_type(4)));
constexpr int BM = 256, BK = 64, HALF = 128, HTB = HALF * BK * 2  , STAGE_BYTES = 8 * HTB, NXCD = 8, WGM = 8;

__host__ __device__ __forceinline__ int lds_byte(int r, int c) { const int st = (r >> 4) * 2 + (c >> 5), rr = r & 15, cc = c & 31, ob = rr * 64 + cc * 2; return st * 1024 + (ob ^ (((ob >> 9) & 1) << 5)); }
__host__ __device__ __forceinline__ void stage_rc(int b, int& R, int& C) { const int st = b / 1024, sb = b % 1024, swz = sb ^ (((sb >> 9) & 1) << 5); R = (st >> 1) * 16 + swz / 64; C = (st & 1) * 32 + (swz % 64) / 2; }
__host__ __device__ __forceinline__ int perm32(int rho) { const int n = rho >> 4, i = rho & 15; return 8 * (i >> 2) + 4 * n + (i & 3); }

struct Unit { int pm, pn; };
struct Gemm { const bf16_t* A; const bf16_t* Bt; int M, N, K; };

struct StaticOrder {
    int nM, nN, nwg, G, c;
    __host__ __device__ void init(int M, int N, int G_, int c_) { nM = M / BM; nN = N / BM; nwg = nM * nN; G = G_; c = c_; }
    __host__ __device__ bool next(int i, Unit& u) const {
        const long L = (long)i * G + c; if (L >= nwg) return false;
        int wgid = (int)L; { const int q = nwg / NXCD, r = nwg % NXCD, xcd = wgid % NXCD, off = wgid / NXCD; wgid = (xcd < r ? xcd * (q + 1) : r * (q + 1) + (xcd - r) * q) + off; }
        const int nig = WGM * nN, gid = wgid / nig, fm = gid * WGM, gsz = (nM - fm) < WGM ? (nM - fm) : WGM;
        u.pm = fm + ((wgid % nig) % gsz); u.pn = (wgid % nig) / gsz; return true;
    }
    __device__ __forceinline__ void a_ready(const Unit&) const {}
    __device__ __forceinline__ void done(const Unit&) const {}
};

__device__ __forceinline__ unsigned cvt_pk_bf16(float lo, float hi) { unsigned r; asm volatile("v_cvt_pk_bf16_f32 %0, %1, %2" : "=v"(r) : "v"(lo), "v"(hi)); return r; }

template <int MODE> struct EpiScaleBf16 {
    static constexpr bool PERM = true, AFTER_DRAIN = false;
    bf16_t* O; int ldc; const float* rowv;
    __device__ __forceinline__ void operator()(const f32x4 (&acc)[2][2][4][2], const Unit& u, int wr, int wc, int fr, int fq) const {
        const int row0 = u.pm * BM + wr * 64 + fr, col0 = u.pn * BM + wc * 32 + 8 * fq;
#pragma unroll
        for (int ai = 0; ai < 2; ++ai)
#pragma unroll
            for (int m = 0; m < 4; ++m) { const int row = row0 + ai * HALF + m * 16; float s = rowv[row]; if (MODE == 1) s = 1.0f / sqrtf(s * (1.0f / 1024.0f) + 1e-6f);
                bf16_t* rowp = O + (size_t)row * ldc + col0;
#pragma unroll
                for (int bj = 0; bj < 2; ++bj) { const f32x4 v0 = acc[ai][bj][m][0] * s, v1 = acc[ai][bj][m][1] * s;
                    u32x4 w; w.x = cvt_pk_bf16(v0[0], v0[1]); w.y = cvt_pk_bf16(v0[2], v0[3]); w.z = cvt_pk_bf16(v1[0], v1[1]); w.w = cvt_pk_bf16(v1[2], v1[3]);
                    *(u32x4*)(rowp + bj * HALF) = w; } }
    }
};
struct EpiResid {
    static constexpr bool PERM = true, AFTER_DRAIN = false;
    const float* X; bf16_t* O; float* ss;
    __device__ __forceinline__ void operator()(const f32x4 (&acc)[2][2][4][2], const Unit& u, int wr, int wc, int fr, int fq) const {
        const int row0 = u.pm * BM + wr * 64 + fr, col0 = u.pn * BM + wc * 32 + 8 * fq;
#pragma unroll
        for (int ai = 0; ai < 2; ++ai)
#pragma unroll
            for (int m = 0; m < 4; ++m) { const int row = row0 + ai * HALF + m * 16; float part = 0.f;
#pragma unroll
                for (int bj = 0; bj < 2; ++bj) { const float* xp = X + (size_t)row * 1024 + col0 + bj * HALF;
                    const f32x4 v0 = acc[ai][bj][m][0] + *(const f32x4*)xp, v1 = acc[ai][bj][m][1] + *(const f32x4*)(xp + 4);
                    part += (v0[0] * v0[0] + v0[1] * v0[1]) + (v0[2] * v0[2] + v0[3] * v0[3]) + (v1[0] * v1[0] + v1[1] * v1[1]) + (v1[2] * v1[2] + v1[3] * v1[3]);
                    u32x4 w; w.x = cvt_pk_bf16(v0[0], v0[1]); w.y = cvt_pk_bf16(v0[2], v0[3]); w.z = cvt_pk_bf16(v1[0], v1[1]); w.w = cvt_pk_bf16(v1[2], v1[3]);
                    *(u32x4*)(O + (size_t)row * 1024 + col0 + bj * HALF) = w; }
                part += __shfl_xor(part, 16); part += __shfl_xor(part, 32);
                if (fq == 0) (void)__builtin_amdgcn_global_atomic_fadd_f32((__attribute__((address_space(1))) float*)(ss + row), part); }
    }
};

template <class Epi, class Sched, bool ALIGN_EPI = false, bool SP2 = false>
__device__ __forceinline__ void gemm_phase(PG8_LAS unsigned char* lds, const Gemm g, const Sched& S, const Epi& E) {
    const int tid = threadIdx.x, wid = __builtin_amdgcn_readfirstlane(tid >> 6), lane = tid & 63, wr = wid >> 2, wc = wid & 3, fr = lane & 15, fq = lane >> 4;
    const int K = g.K, nt = K / BK;
    unsigned voffA[2], voffB[2];
#pragma unroll
    for (int i = 0; i < 2; ++i) { int R, C; stage_rc(tid * 16 + i * 8192, R, C); const int Rb = Epi::PERM ? ((R & ~31) + perm32(R & 31)) : R;
        voffA[i] = (unsigned)(R * K + C) * 2u; voffB[i] = (unsigned)(Rb * K + C) * 2u; }
    const size_t kstep = (size_t)(BK * 2);
    const size_t hstep = (size_t)HALF * K * 2;
    const size_t tstep = 2 * hstep;
    const unsigned ldsw = (unsigned)wid * 1024u;
    const int aoff = lds_byte(wr * 64 + fr, fq * 8), boff = lds_byte(wc * 32 + fr, fq * 8);
#define PG8_SA(b, h) (((b) * 2 + (h)) * HTB)
#define PG8_SB(b, h) ((4 + (b) * 2 + (h)) * HTB)
#define PG8_STAGE(bufoff, gbase, voff) do { _Pragma("unroll") for (int _i = 0; _i < 2; ++_i) \
        __builtin_amdgcn_global_load_lds((const unsigned*)((const char*)(gbase) + (voff)[_i]), (PG8_LAS unsigned*)(lds + (bufoff) + ldsw + _i * 8192), 16, 0, 0); } while (0)
#define PG8_LDA(dst, b, h) do { _Pragma("unroll") for (int m = 0; m < 4; ++m) _Pragma("unroll") for (int k = 0; k < 2; ++k) dst[m][k] = *(const PG8_LAS bf16x8*)(lds + PG8_SA(b, h) + aoff + m * 2048 + k * 1024); } while (0)
#define PG8_LDB(dst, b, h) do { _Pragma("unroll") for (int n = 0; n < 2; ++n) _Pragma("unroll") for (int k = 0; k < 2; ++k) dst[n][k] = *(const PG8_LAS bf16x8*)(lds + PG8_SB(b, h) + boff + n * 2048 + k * 1024); } while (0)
#define PG8_MMA(ai, bj, At, Bt) do { __builtin_amdgcn_s_setprio(1); _Pragma("unroll") for (int m = 0; m < 4; ++m) _Pragma("unroll") for (int n = 0; n < 2; ++n) _Pragma("unroll") for (int k = 0; k < 2; ++k) \
        acc[ai][bj][m][n] = __builtin_amdgcn_mfma_f32_16x16x32_bf16(Bt[n][k], At[m][k], acc[ai][bj][m][n], 0, 0, 0); __builtin_amdgcn_s_setprio(0); } while (0)
#define PG8_WAIT_V(n) asm volatile("s_waitcnt vmcnt(" #n ")" ::: "memory")
#define PG8_WAIT_L(n) asm volatile("s_waitcnt lgkmcnt(" #n ")" ::: "memory")
#define PG8_BAR __builtin_amdgcn_s_barrier()
#define PG8_SCHED __builtin_amdgcn_sched_barrier(0)
    Unit cur, nxt; int ui = 0;
    if (!S.next(0, cur)) return;
    f32x4 acc[2][2][4][2];
#pragma unroll
    for (int a = 0; a < 2; ++a)
#pragma unroll
        for (int b = 0; b < 2; ++b)
#pragma unroll
            for (int m = 0; m < 4; ++m)
#pragma unroll
                for (int n = 0; n < 2; ++n) acc[a][b][m][n] = (f32x4){0.f, 0.f, 0.f, 0.f};
    bf16x8 At[4][2], B0[2][2], B1[2][2];
    const char* cA = (const char*)g.A + (size_t)cur.pm * tstep; const char* cB = (const char*)g.Bt + (size_t)cur.pn * tstep;
    S.a_ready(cur);
    if constexpr (SP2) {
        PG8_STAGE(PG8_SB(0, 0), cB, voffB); PG8_STAGE(PG8_SB(0, 1), cB + hstep, voffB); PG8_STAGE(PG8_SA(0, 0), cA, voffA); PG8_STAGE(PG8_SA(0, 1), cA + hstep, voffA);
        if (wr == 1) PG8_BAR;
        PG8_WAIT_V(2); PG8_BAR;
        PG8_STAGE(PG8_SB(1, 0), cB + kstep, voffB); PG8_STAGE(PG8_SA(1, 0), cA + kstep, voffA); PG8_STAGE(PG8_SB(1, 1), cB + hstep + kstep, voffB);
        PG8_WAIT_V(6); PG8_BAR;
    } else {
        PG8_STAGE(PG8_SB(0, 0), cB, voffB); PG8_STAGE(PG8_SA(0, 0), cA, voffA); PG8_STAGE(PG8_SB(0, 1), cB + hstep, voffB); PG8_STAGE(PG8_SA(0, 1), cA + hstep, voffA);
        if (wr == 1) PG8_BAR;
        PG8_WAIT_V(4); PG8_BAR;
        PG8_STAGE(PG8_SB(1, 0), cB + kstep, voffB); PG8_STAGE(PG8_SA(1, 0), cA + kstep, voffA); PG8_STAGE(PG8_SB(1, 1), cB + hstep + kstep, voffB);
        PG8_WAIT_V(6); PG8_BAR;
    }
    for (;;) {
        const bool has_next = S.next(ui + 1, nxt);
        const char* nA = has_next ? (const char*)g.A + (size_t)nxt.pm * tstep : cA; const char* nB = has_next ? (const char*)g.Bt + (size_t)nxt.pn * tstep : cB;
        for (int t = 0; t < nt; t += 2) {
            const bool last = (t == nt - 2);
            const char* a1 = cA + (size_t)(t + 1) * kstep;
            const char* a2 = last ? nA : cA + (size_t)(t + 2) * kstep; const char* b2 = last ? nB : cB + (size_t)(t + 2) * kstep;
            const char* a3 = a2 + kstep; const char* b3 = b2 + kstep;
            if (last && has_next) S.a_ready(nxt);
            if constexpr (SP2) {
            PG8_LDB(B0, 0, 0); PG8_LDB(B1, 0, 1); PG8_SCHED; PG8_LDA(At, 0, 0); PG8_STAGE(PG8_SA(1, 1), a1 + hstep, voffA);
            PG8_WAIT_V(8); PG8_WAIT_L(0); PG8_BAR; PG8_MMA(0, 0, At, B0); PG8_MMA(0, 1, At, B1); PG8_BAR; PG8_SCHED;
            PG8_LDA(At, 0, 1); PG8_STAGE(PG8_SB(0, 0), b2, voffB); PG8_STAGE(PG8_SB(0, 1), b2 + hstep, voffB); PG8_STAGE(PG8_SA(0, 0), a2, voffA);
            PG8_WAIT_V(8); PG8_WAIT_L(0); PG8_BAR; PG8_MMA(1, 0, At, B0); PG8_MMA(1, 1, At, B1); PG8_BAR; PG8_SCHED;
            PG8_LDB(B0, 1, 0); PG8_LDB(B1, 1, 1); PG8_SCHED; PG8_LDA(At, 1, 0); PG8_STAGE(PG8_SA(0, 1), a2 + hstep, voffA);
            PG8_WAIT_V(8); PG8_WAIT_L(0); PG8_BAR; PG8_MMA(0, 0, At, B0); PG8_MMA(0, 1, At, B1); PG8_BAR; PG8_SCHED;
            PG8_LDA(At, 1, 1); PG8_STAGE(PG8_SB(1, 0), b3, voffB); PG8_STAGE(PG8_SB(1, 1), b3 + hstep, voffB); PG8_STAGE(PG8_SA(1, 0), a3, voffA);
            PG8_WAIT_V(8); PG8_WAIT_L(0); PG8_BAR; PG8_MMA(1, 0, At, B0); PG8_MMA(1, 1, At, B1); PG8_BAR; PG8_SCHED;
            } else {
            PG8_LDB(B0, 0, 0); PG8_SCHED; PG8_LDA(At, 0, 0); PG8_STAGE(PG8_SA(1, 1), a1 + hstep, voffA);
            PG8_WAIT_L(8); PG8_BAR; PG8_WAIT_L(0); PG8_MMA(0, 0, At, B0); PG8_BAR; PG8_SCHED;
            PG8_LDB(B1, 0, 1); PG8_STAGE(PG8_SB(0, 0), b2, voffB);
            PG8_BAR; PG8_WAIT_L(0); PG8_MMA(0, 1, At, B1); PG8_BAR;
            PG8_LDA(At, 0, 1); PG8_STAGE(PG8_SA(0, 0), a2, voffA);
            PG8_BAR; PG8_WAIT_L(0); PG8_MMA(1, 0, At, B0); PG8_BAR; PG8_SCHED;
            PG8_STAGE(PG8_SB(0, 1), b2 + hstep, voffB);
            PG8_WAIT_V(6); PG8_BAR; PG8_MMA(1, 1, At, B1); PG8_BAR;
            PG8_LDB(B0, 1, 0); PG8_SCHED; PG8_LDA(At, 1, 0); PG8_STAGE(PG8_SA(0, 1), a2 + hstep, voffA);
            PG8_WAIT_L(8); PG8_BAR; PG8_WAIT_L(0); PG8_MMA(0, 0, At, B0); PG8_BAR; PG8_SCHED;
            PG8_LDB(B1, 1, 1); PG8_STAGE(PG8_SB(1, 0), b3, voffB);
            PG8_BAR; PG8_WAIT_L(0); PG8_MMA(0, 1, At, B1); PG8_BAR;
            PG8_LDA(At, 1, 1); PG8_STAGE(PG8_SA(1, 0), a3, voffA);
            PG8_BAR; PG8_WAIT_L(0); PG8_MMA(1, 0, At, B0); PG8_BAR; PG8_SCHED;
            PG8_STAGE(PG8_SB(1, 1), b3 + hstep, voffB);
            PG8_WAIT_V(6); PG8_BAR; PG8_MMA(1, 1, At, B1); PG8_BAR;
            }
        }
        if constexpr (ALIGN_EPI) { if (wr == 0) PG8_BAR; }
        if constexpr (!Epi::AFTER_DRAIN) { E(acc, cur, wr, wc, fr, fq); S.done(cur); }
        if (!has_next) break;
#pragma unroll
        for (int a = 0; a < 2; ++a)
#pragma unroll
            for (int b = 0; b < 2; ++b)
#pragma unroll
                for (int m = 0; m < 4; ++m)
#pragma unroll
                    for (int n = 0; n < 2; ++n) acc[a][b][m][n] = (f32x4){0.f, 0.f, 0.f, 0.f};
        cur = nxt; cA = nA; cB = nB; ++ui;
        if constexpr (ALIGN_EPI) { if (wr == 1) PG8_BAR; }
    }
    PG8_WAIT_V(0);
    if constexpr (!ALIGN_EPI) { if (wr == 0) PG8_BAR; }
    PG8_BAR;
    if constexpr (Epi::AFTER_DRAIN) { E.fused(acc, cur, wr, wc, fr, fq, lds, wid, lane); S.done(cur); }
#undef PG8_SA
#undef PG8_SB
#undef PG8_STAGE
#undef PG8_LDA
#undef PG8_LDB
#undef PG8_MMA
#undef PG8_WAIT_V
#undef PG8_WAIT_L
#undef PG8_BAR
#undef PG8_SCHED
}
}

#ifndef PG8_SP2
#define PG8_SP2 true
#endif
#ifndef PG8_ALIGN
#define PG8_ALIGN true
#endif
#ifndef MK_N_LAUNCHES
#define MK_N_LAUNCHES 1
#endif
constexpr int NWAVES = 8;
constexpr int NPHASES = 8;
constexpr int N_LAUNCHES = MK_N_LAUNCHES;

constexpr int NB = 32, SEQ = 2048, T = NB * SEQ, D = 1024, DIN = 3584;
constexpr int PC_C = 0, PC_H = 512, PC_B = 1024, PC_Q = 1536, PC_F = 2048, PC_V = 2560, PC_G = 3072;
constexpr int NEXP = 16384;
constexpr float EPS = 1e-6f;
constexpr float PEER_SU = 640.0f, PEER_SV = 64.0f;

constexpr size_t MiB = 1u << 20;
constexpr size_t WS_CTL = 0, CTL_ZERO_BYTES = 1 * MiB;
constexpr size_t WS_W1T = 2 * MiB, WS_WOT = 10 * MiB, WS_WQT = 12 * MiB, WS_RS1 = 16 * MiB, WS_SS2 = 17 * MiB;
constexpr size_t WS_KEYB = 18 * MiB;
constexpr size_t WS_U16 = 32 * MiB, WS_V16 = 64 * MiB, WS_EXP = 96 * MiB;
constexpr size_t WS_XB = 128 * MiB;
constexpr size_t WS_X1 = 256 * MiB;
constexpr size_t WS_PROJ = 384 * MiB;
constexpr size_t WS_F = 832 * MiB;
constexpr size_t WS_END = 960 * MiB;
constexpr int CW_BAR = 4096;

constexpr int RING_OFF = 0, RING_BYTES = 131072;
constexpr int LDSCTL_OFF = RING_BYTES, MISC_OFF = LDSCTL_OFF + 320;
constexpr int LDS_BYTES = 147456;

#define GAS __attribute__((address_space(1)))
#define LAS __attribute__((address_space(3)))
typedef unsigned short bf16;
typedef unsigned v4u __attribute__((ext_vector_type(4)));
typedef unsigned v2u __attribute__((ext_vector_type(2)));
typedef float f32x4 __attribute__((ext_vector_type(4)));
typedef float f32x2 __attribute__((ext_vector_type(2)));
typedef _Float16 h2_t __attribute__((ext_vector_type(2)));
typedef GAS unsigned gu32;
#define RLX_AGENT __ATOMIC_RELAXED, __HIP_MEMORY_SCOPE_AGENT
#define LDS_WAIT() asm volatile("s_waitcnt lgkmcnt(0)" ::: "memory")
#define VM_WAIT() asm volatile("s_waitcnt vmcnt(0)" ::: "memory")
__device__ __forceinline__ unsigned f2bf(float f) { unsigned u = __builtin_bit_cast(unsigned, f); return (u + 0x7fffu + ((u >> 16) & 1u)) >> 16; }
__device__ __forceinline__ unsigned pk2(float lo, float hi) { return f2bf(lo) | (f2bf(hi) << 16); }
__device__ __forceinline__ float bf_lo(unsigned w) { return __builtin_bit_cast(float, w << 16); }
__device__ __forceinline__ float bf_hi(unsigned w) { return __builtin_bit_cast(float, w & 0xffff0000u); }
__device__ __forceinline__ float bf1(bf16 v) { return __builtin_bit_cast(float, (unsigned)v << 16); }
__device__ __forceinline__ unsigned pkh2(float lo, float hi) { f32x2 v = {lo, hi}; h2_t h = __builtin_convertvector(v, h2_t); return __builtin_bit_cast(unsigned, h); }
__device__ __forceinline__ h2_t h2_of(unsigned w) { return __builtin_bit_cast(h2_t, w); }
__device__ __forceinline__ float swap32_add(float a, float b) { const v2u r = __builtin_amdgcn_permlane32_swap(__builtin_bit_cast(unsigned, a), __builtin_bit_cast(unsigned, b), false, false);
    const unsigned rx = r.x, ry = r.y; return __builtin_bit_cast(float, rx) + __builtin_bit_cast(float, ry); }
__device__ __forceinline__ float swap16_add(float a, float b) { const v2u r = __builtin_amdgcn_permlane16_swap(__builtin_bit_cast(unsigned, a), __builtin_bit_cast(unsigned, b), false, false);
    const unsigned rx = r.x, ry = r.y; return __builtin_bit_cast(float, rx) + __builtin_bit_cast(float, ry); }
template <int CTRL> __device__ __forceinline__ float dpp_f(float v) { return __builtin_bit_cast(float, __builtin_amdgcn_update_dpp(0, __builtin_bit_cast(int, v), CTRL, 0xF, 0xF, false)); }
template <int CTRL> __device__ __forceinline__ unsigned dpp_u(unsigned v) { return (unsigned)__builtin_amdgcn_update_dpp(0, (int)v, CTRL, 0xF, 0xF, false); }
__device__ __forceinline__ float wave_sum(float v) {
    v += dpp_f<0xB1>(v); v += dpp_f<0x4E>(v); v += dpp_f<0x124>(v); v += dpp_f<0x128>(v);
    v = swap16_add(v, v); v = swap32_add(v, v);
    return v;
}
typedef float f32x16 __attribute__((ext_vector_type(16)));
typedef __bf16 bf16x2_t __attribute__((ext_vector_type(2)));
__device__ __forceinline__ unsigned cvtpk(float lo, float hi) { f32x2 v = {lo, hi}; bf16x2_t b = __builtin_convertvector(v, bf16x2_t); return __builtin_bit_cast(unsigned, b); }
__device__ __forceinline__ pg8::bf16x8 pack8(const f32x16& x, int s) {
    v4u p; p.x = cvtpk(x[8 * s], x[8 * s + 1]); p.y = cvtpk(x[8 * s + 2], x[8 * s + 3]); p.z = cvtpk(x[8 * s + 4], x[8 * s + 5]); p.w = cvtpk(x[8 * s + 6], x[8 * s + 7]);
    return __builtin_bit_cast(pg8::bf16x8, p); }
__device__ __forceinline__ void ce_desc(unsigned& a, unsigned& b) { const unsigned mx = a > b ? a : b, mn = a > b ? b : a; a = mx; b = mn; }
__device__ __forceinline__ void sort16_desc(unsigned (&a)[16]) {
#pragma unroll
    for (int k = 2; k <= 16; k <<= 1)
#pragma unroll
        for (int j = k >> 1; j > 0; j >>= 1)
#pragma unroll
            for (int i = 0; i < 16; ++i) { const int l = i ^ j; if (l > i) { if ((i & k) == 0) ce_desc(a[i], a[l]); else ce_desc(a[l], a[i]); } }
}
__device__ __forceinline__ void merge16_desc(unsigned (&a)[16], const unsigned (&b)[16]) {
#pragma unroll
    for (int i = 0; i < 16; ++i) a[i] = a[i] > b[15 - i] ? a[i] : b[15 - i];
#pragma unroll
    for (int j = 8; j > 0; j >>= 1)
#pragma unroll
        for (int i = 0; i < 16; ++i) { const int l = i ^ j; if (l > i) ce_desc(a[i], a[l]); }
}
__device__ __forceinline__ float unkey(unsigned a) { a = (a & 0x80000000u) ? (a & 0x7FFFFFFFu) : ~a; return __builtin_bit_cast(float, a); }
__device__ __forceinline__ unsigned ckey(float s, int flat) { unsigned u = __builtin_bit_cast(unsigned, s); u ^= (unsigned)((int)u >> 31) | 0x80000000u; return (u & ~0xFFu) | (unsigned)(255 - flat); }
template <int J> __device__ __forceinline__ unsigned xor_lane(unsigned x, int lane) {
    if (J == 1) return dpp_u<0xB1>(x);
    if (J == 2) return dpp_u<0x4E>(x);
    if (J == 8) return dpp_u<0x128>(x);
    if (J == 16) { const v2u r = __builtin_amdgcn_permlane16_swap(x, x, false, false); const unsigned rx = r.x, ry = r.y; return (lane & 16) ? rx : ry; }
    if (J == 32) { const v2u r = __builtin_amdgcn_permlane32_swap(x, x, false, false); const unsigned rx = r.x, ry = r.y; return (lane & 32) ? rx : ry; }
    return (unsigned)__shfl_xor((int)x, J);
}
template <int K, int J, int N> __device__ __forceinline__ void sort128_stage(unsigned (&e)[N][2], int lane) {
#pragma unroll
    for (int t = 0; t < N; ++t) {
        if (J == 64) { const unsigned mn = e[t][0] < e[t][1] ? e[t][0] : e[t][1], mx = e[t][0] < e[t][1] ? e[t][1] : e[t][0]; e[t][0] = mn; e[t][1] = mx; }
        else {
            const unsigned p0 = xor_lane<J>(e[t][0], lane), p1 = xor_lane<J>(e[t][1], lane);
            const bool lower = (lane & J) == 0;
            const bool up0 = (K >= 64) ? true : ((lane & K) == 0);
            const bool up1 = (K == 128) ? true : (K == 64 ? false : ((lane & K) == 0));
            const unsigned mn0 = e[t][0] < p0 ? e[t][0] : p0, mx0 = e[t][0] < p0 ? p0 : e[t][0], mn1 = e[t][1] < p1 ? e[t][1] : p1, mx1 = e[t][1] < p1 ? p1 : e[t][1];
            e[t][0] = (lower == up0) ? mn0 : mx0; e[t][1] = (lower == up1) ? mn1 : mx1;
        }
    }
}
template <int N> __device__ __forceinline__ void sort128_asc(unsigned (&e)[N][2], int lane) {
#define S_(K, J) sort128_stage<K, J, N>(e, lane)
    S_(2, 1); S_(4, 2); S_(4, 1); S_(8, 4); S_(8, 2); S_(8, 1); S_(16, 8); S_(16, 4); S_(16, 2); S_(16, 1);
    S_(32, 16); S_(32, 8); S_(32, 4); S_(32, 2); S_(32, 1); S_(64, 32); S_(64, 16); S_(64, 8); S_(64, 4); S_(64, 2); S_(64, 1);
    S_(128, 64); S_(128, 32); S_(128, 16); S_(128, 8); S_(128, 4); S_(128, 2); S_(128, 1);
#undef S_
}
__device__ __forceinline__ float wave_max(float v) {
    v = fmaxf(v, dpp_f<0xB1>(v)); v = fmaxf(v, dpp_f<0x4E>(v)); v = fmaxf(v, dpp_f<0x124>(v)); v = fmaxf(v, dpp_f<0x128>(v));
    { const v2u r = __builtin_amdgcn_permlane16_swap(__builtin_bit_cast(unsigned, v), __builtin_bit_cast(unsigned, v), false, false); const unsigned rx = r.x, ry = r.y; v = fmaxf(__builtin_bit_cast(float, rx), __builtin_bit_cast(float, ry)); }
    { const v2u r = __builtin_amdgcn_permlane32_swap(__builtin_bit_cast(unsigned, v), __builtin_bit_cast(unsigned, v), false, false); const unsigned rx = r.x, ry = r.y; v = fmaxf(__builtin_bit_cast(float, rx), __builtin_bit_cast(float, ry)); }
    return v;
}
__device__ __forceinline__ int swap32_addi(int a, int b) { const v2u r = __builtin_amdgcn_permlane32_swap((unsigned)a, (unsigned)b, false, false); const unsigned rx = r.x, ry = r.y; return (int)(rx + ry); }
__device__ __forceinline__ int swap16_addi(int a, int b) { const v2u r = __builtin_amdgcn_permlane16_swap((unsigned)a, (unsigned)b, false, false); const unsigned rx = r.x, ry = r.y; return (int)(rx + ry); }
__device__ __forceinline__ int reduce16i(const int (&p)[16], int lane) {
    int q[8], r[4], u[2];
    const bool b3 = (lane & 8) != 0, b2 = (lane & 4) != 0;
#pragma unroll
    for (int i = 0; i < 8; ++i) q[i] = swap32_addi(p[2 * i], p[2 * i + 1]);
#pragma unroll
    for (int i = 0; i < 4; ++i) r[i] = swap16_addi(q[2 * i], q[2 * i + 1]);
#pragma unroll
    for (int i = 0; i < 2; ++i) { const int keep = b3 ? r[2 * i + 1] : r[2 * i], send = b3 ? r[2 * i] : r[2 * i + 1]; u[i] = keep + (int)dpp_u<0x128>((unsigned)send); }
    const int keep = b2 ? u[1] : u[0], send = b2 ? u[0] : u[1];
    int v = keep + __shfl_xor(send, 4);
    v += (int)dpp_u<0x4E>((unsigned)v); v += (int)dpp_u<0xB1>((unsigned)v);
    return v;
}
__device__ __forceinline__ float reduce16(const float (&p)[16], int lane) {
    float q[8], r[4], u[2];
    const bool b3 = (lane & 8) != 0, b2 = (lane & 4) != 0;
#pragma unroll
    for (int i = 0; i < 8; ++i) q[i] = swap32_add(p[2 * i], p[2 * i + 1]);
#pragma unroll
    for (int i = 0; i < 4; ++i) r[i] = swap16_add(q[2 * i], q[2 * i + 1]);
#pragma unroll
    for (int i = 0; i < 2; ++i) { const float keep = b3 ? r[2 * i + 1] : r[2 * i], send = b3 ? r[2 * i] : r[2 * i + 1]; u[i] = keep + dpp_f<0x128>(send); }
    const float keep = b2 ? u[1] : u[0], send = b2 ? u[0] : u[1];
    float v = keep + __shfl_xor(send, 4);
    v += dpp_f<0x4E>(v);
    v += dpp_f<0xB1>(v);
    return v;
}
__device__ __forceinline__ int swap23(int k) { return (k & ~12) | ((k & 4) << 1) | ((k & 8) >> 1); }
__device__ __forceinline__ float sigmoidf_(float x) { return 1.0f / (1.0f + __expf(-x)); }

#define XB_TMO      128
#define XB_XCNT(j)  (256  + 64 * (j))
#define XB_XSUB(j)  (1280 + 64 * (j))
#define XB_XGEN(j)  (2304 + 64 * (j))
#define XB_TOP      3328
#define XB_TOPGEN   3392
#define XCD_BAR_WORDS 3456
#define XB_SPIN_CAP (1u << 18)

__device__ __forceinline__ unsigned xb_ld(unsigned* p)              { return __hip_atomic_load(p, __ATOMIC_RELAXED, __HIP_MEMORY_SCOPE_AGENT); }
__device__ __forceinline__ unsigned xb_add(unsigned* p, unsigned v) { return __hip_atomic_fetch_add(p, v, __ATOMIC_RELAXED, __HIP_MEMORY_SCOPE_AGENT); }
__device__ __forceinline__ unsigned xb_xcc_id() { return (unsigned)__builtin_amdgcn_s_getreg((3 << 11) | 20) & 0xFu; }
#define XB_SPIN(cond, bar) do { unsigned _sp = 0; while (cond) { __builtin_amdgcn_s_sleep(1); \
    if ((++_sp & 255u) == 0u) { if (xb_ld(&(bar)[XB_TMO])) break; if (_sp > XB_SPIN_CAP) { atomicAdd(&(bar)[XB_TMO], 1u); break; } } } } while (0)

struct XcdBarrier {
    unsigned* bar; unsigned x;
    volatile LAS unsigned* st;
};

__device__ __forceinline__ XcdBarrier xcd_barrier_post(unsigned* bar, volatile LAS unsigned* st) {
    XcdBarrier b; b.bar = bar; b.x = xb_xcc_id(); b.st = st;
    if (threadIdx.x == 0) (void)xb_add(&bar[XB_XCNT(b.x)], 1u);
    return b;
}
__device__ __forceinline__ void xcd_barrier_complete(unsigned* bar, unsigned x, unsigned& nloc, unsigned& nx) {
    const unsigned G = gridDim.x * gridDim.y * gridDim.z;
    unsigned sum, cnt, mine, sp = 0u;
    for (;;) {
        sum = 0u; cnt = 0u; mine = 0u;
#pragma unroll
        for (unsigned j = 0; j < 16; ++j) { const unsigned c = xb_ld(&bar[XB_XCNT(j)]); sum += c; cnt += (c > 0u) ? 1u : 0u; mine = (j == x) ? c : mine; }
        if (sum == G) break;
        __builtin_amdgcn_s_sleep(1);
        if ((++sp & 255u) == 0u) { if (xb_ld(&bar[XB_TMO])) break; if (sp > XB_SPIN_CAP) { atomicAdd(&bar[XB_TMO], 1u); break; } }
    }
    nloc = mine > 0u ? mine : 1u; nx = cnt > 0u ? cnt : 1u;
}

__device__ __forceinline__ void xcd_barrier(const XcdBarrier& b) {
    asm volatile("s_waitcnt vmcnt(0)" ::: "memory");
    __syncthreads();
    if (threadIdx.x == 0) {
        unsigned* bar = b.bar;
        __builtin_amdgcn_s_waitcnt(0);
        unsigned nloc = b.st[0], nx = b.st[1];
        if (nloc == 0u) { xcd_barrier_complete(bar, b.x, nloc, nx); b.st[0] = nloc; b.st[1] = nx; }
        const unsigned old = xb_add(&bar[XB_XSUB(b.x)], 1u);
        const unsigned gen = old / nloc;
        if (old + 1u == (gen + 1u) * nloc) {
            __builtin_amdgcn_fence(__ATOMIC_RELEASE, "agent");
            asm volatile("s_waitcnt vmcnt(0)" ::: "memory");
            const unsigned og = xb_add(&bar[XB_TOP], 1u);
            const unsigned tg = og / nx;
            if (og + 1u == (tg + 1u) * nx) xb_add(&bar[XB_TOPGEN], 1u);
            else XB_SPIN(xb_ld(&bar[XB_TOPGEN]) == tg, bar);
            __builtin_amdgcn_fence(__ATOMIC_ACQUIRE, "agent");
            xb_add(&bar[XB_XGEN(b.x)], 1u);
            asm volatile("s_waitcnt vmcnt(0)" ::: "memory");
        } else {
            XB_SPIN(xb_ld(&bar[XB_XGEN(b.x)]) == gen, bar);
            __builtin_amdgcn_fence(__ATOMIC_ACQUIRE, "agent");
            asm volatile("s_waitcnt vmcnt(0)" ::: "memory");
        }
    }
    __syncthreads();
}


__device__ __forceinline__ void p0_transpose_item(const float* W, int K, int N, const float* gain, bf16* WT, LAS float* scr, int item, int lane) {
    const int nblk = N / 32, kb = item / nblk, nb = item % nblk, k0 = 64 * kb, n0 = 32 * nb;
#pragma unroll 8
    for (int i = 0; i < 32; ++i) { const int kk = 2 * i + (lane >> 5); const float g = gain ? gain[k0 + kk] : 1.0f; scr[kk * 33 + (lane & 31)] = W[(size_t)(k0 + kk) * N + n0 + (lane & 31)] * g; }
    LDS_WAIT(); asm volatile("" ::: "memory");
    const int c = lane & 7;
#pragma unroll
    for (int j = 0; j < 4; ++j) { const int n = (lane >> 3) + 8 * j; const LAS float* s = scr + (8 * c) * 33 + n;
        v4u o; o.x = pk2(s[0 * 33], s[1 * 33]); o.y = pk2(s[2 * 33], s[3 * 33]); o.z = pk2(s[4 * 33], s[5 * 33]); o.w = pk2(s[6 * 33], s[7 * 33]);
        *(GAS v4u*)(WT + (size_t)(n0 + n) * K + k0 + 8 * c) = o; }
    LDS_WAIT(); asm volatile("" ::: "memory");
}

struct Args { const float* in[14]; float* out; unsigned char* ws; int ph_lo, ph_hi, li, pad; };

__global__ void __launch_bounds__(NWAVES * 64, 2) hymba_fwd(Args args) {
    extern __shared__ __attribute__((aligned(16))) unsigned char lds_raw[];
    LAS unsigned char* lds = (LAS unsigned char*)lds_raw;
    volatile LAS unsigned* MISC = (volatile LAS unsigned*)(lds + MISC_OFF);
    const int tid = threadIdx.x, lane = tid & 63, wave = __builtin_amdgcn_readfirstlane(tid >> 6);
    const int G = gridDim.x;
    const int gw = (int)blockIdx.x * NWAVES + wave, NGW = G * NWAVES;
    unsigned char* ws = args.ws;
    gu32* ctl = (gu32*)(ws + WS_CTL);
    const float* x = args.in[0]; const float* norm_mix = args.in[1]; const float* w_in = args.in[2]; const float* conv_w = args.in[3]; const float* conv_gain = args.in[4];
    const float* hg_lb = args.in[5]; const float* hg_gain = args.in[6]; const float* w_out = args.in[7]; const float* norm_ffn = args.in[8]; const float* peer_wq = args.in[9];
    const float* peer_keys = args.in[10]; const float* peer_u = args.in[11]; const float* peer_v = args.in[12]; const float* norm_f = args.in[13];
    float* out = args.out;
    bf16* W1T = (bf16*)(ws + WS_W1T); bf16* WOT = (bf16*)(ws + WS_WOT); bf16* WQT = (bf16*)(ws + WS_WQT);
    float* RS1 = (float*)(ws + WS_RS1); float* SS2 = (float*)(ws + WS_SS2);
    unsigned char* U8 = ws + WS_U16; unsigned char* V8 = ws + WS_V16; unsigned* EXPT = (unsigned*)(ws + WS_EXP); bf16* KEYB = (bf16*)(ws + WS_KEYB);
    bf16* XB = (bf16*)(ws + WS_XB); bf16* MIX = (bf16*)(ws + WS_XB); bf16* X1 = (bf16*)(ws + WS_X1);
    bf16* PROJ = (bf16*)(ws + WS_PROJ); bf16* QB = (bf16*)(ws + WS_PROJ); float* DEC = (float*)(ws + WS_F); bf16* KDT = (bf16*)(ws + WS_X1); bf16* VTT = (bf16*)(ws + WS_X1 + 64 * MiB);

    for (int u = tid; u < (LDS_BYTES - LDSCTL_OFF) / 4; u += NWAVES * 64) ((LAS unsigned*)(lds + LDSCTL_OFF))[u] = 0u;
    __syncthreads();
    XcdBarrier bar; bar.bar = (unsigned*)(ctl + CW_BAR); bar.x = 0; bar.st = nullptr;
    if (N_LAUNCHES == 1) bar = xcd_barrier_post((unsigned*)(ctl + CW_BAR), MISC + 8);
#define GRID_BAR() do { if (N_LAUNCHES == 1) xcd_barrier(bar); } while (0)
    const int lo = args.ph_lo, hi = args.ph_hi;
#define IN(k) (lo <= (k) && (k) < hi)
#define BOTH(k) (IN(k) && IN((k) + 1))

    if (IN(0)) {
        LAS float* scr = (LAS float*)(lds + RING_OFF + wave * 16384);
        constexpr int I_1 = (D / 64) * (DIN / 32), I_O = (D / 64) * (D / 32), I_Q = (D / 64) * (2048 / 32);
        for (int it = gw; it < I_1 + I_O + I_Q; it += NGW) {
            int r = it;
            if (r < I_1) { p0_transpose_item(w_in, D, DIN, norm_mix, W1T, scr, r, lane); continue; } r -= I_1;
            if (r < I_O) { p0_transpose_item(w_out, D, D, nullptr, WOT, scr, r, lane); continue; } r -= I_O;
            p0_transpose_item(peer_wq, D, 2048, norm_ffn, WQT, scr, r, lane);
        }
        for (int m = gw; m < T; m += NGW) {
            const GAS f32x4* xr = (const GAS f32x4*)(x + (size_t)m * D) + lane; f32x4 v[4]; float s = 0.f;
#pragma unroll
            for (int j = 0; j < 4; ++j) { v[j] = xr[64 * j]; s += (v[j].x * v[j].x + v[j].y * v[j].y) + (v[j].z * v[j].z + v[j].w * v[j].w); }
            s = wave_sum(s);
            if (lane == 0) RS1[m] = 1.0f / sqrtf(s * (1.0f / D) + EPS);
            GAS unsigned long long* o8 = (GAS unsigned long long*)(XB + (size_t)m * D) + lane;
#pragma unroll
            for (int j = 0; j < 4; ++j) o8[64 * j] = (unsigned long long)pk2(v[j].x, v[j].y) | ((unsigned long long)pk2(v[j].z, v[j].w) << 32);
        }
        for (int r = gw; r < 2 * NEXP; r += NGW) {
            const int tb = r / NEXP, e = r % NEXP; const float sc = tb ? PEER_SV : PEER_SU;
            const GAS f32x4* src = (const GAS f32x4*)((tb ? peer_v : peer_u) + (size_t)e * D);
            f32x4 v[4] = {src[2 * lane], src[2 * lane + 1], src[128 + 2 * lane], src[128 + 2 * lane + 1]};
            if (!tb) { const GAS f32x4* gp = (const GAS f32x4*)norm_ffn; v[0] = v[0] * gp[2 * lane]; v[1] = v[1] * gp[2 * lane + 1]; v[2] = v[2] * gp[128 + 2 * lane]; v[3] = v[3] * gp[128 + 2 * lane + 1]; }
            unsigned o[4];
#pragma unroll
            for (int j = 0; j < 4; ++j) { f32x4 w = v[j] * sc;
                if (tb) { w.x = fminf(fmaxf(w.x, -240.f), 240.f); w.y = fminf(fmaxf(w.y, -240.f), 240.f); w.z = fminf(fmaxf(w.z, -240.f), 240.f); w.w = fminf(fmaxf(w.w, -240.f), 240.f);
                    int pk = 0; pk = __builtin_amdgcn_cvt_pk_fp8_f32(w.x, w.y, pk, false); pk = __builtin_amdgcn_cvt_pk_fp8_f32(w.z, w.w, pk, true); o[j] = (unsigned)pk; }
                else { const int i0 = (int)rintf(fminf(fmaxf(w.x, -127.f), 127.f)), i1 = (int)rintf(fminf(fmaxf(w.y, -127.f), 127.f)), i2 = (int)rintf(fminf(fmaxf(w.z, -127.f), 127.f)), i3 = (int)rintf(fminf(fmaxf(w.w, -127.f), 127.f));
                    o[j] = ((unsigned)i0 & 0xFFu) | (((unsigned)i1 & 0xFFu) << 8) | (((unsigned)i2 & 0xFFu) << 16) | (((unsigned)i3 & 0xFFu) << 24); } }
            ((GAS v4u*)((tb ? V8 : U8) + (size_t)e * D))[lane] = (v4u){o[0], o[1], o[2], o[3]};
        }
        for (int i = (int)blockIdx.x * NWAVES * 64 + tid; i < T; i += G * NWAVES * 64) SS2[i] = 0.f;
        for (int i = (int)blockIdx.x * NWAVES * 64 + tid; i < 8 * 2 * 128 * 128 / 2; i += G * NWAVES * 64) ((GAS unsigned*)KEYB)[i] = pk2(peer_keys[2 * i], peer_keys[2 * i + 1]);
        if (BOTH(0)) GRID_BAR();
    }

    if (IN(1)) {
        pg8::Gemm g{XB, W1T, T, DIN, D}; pg8::StaticOrder S; S.init(T, DIN, G, (int)blockIdx.x);
        pg8::EpiScaleBf16<0> E{PROJ, DIN, RS1};
        pg8::gemm_phase<pg8::EpiScaleBf16<0>, pg8::StaticOrder, PG8_ALIGN, PG8_SP2>(lds + RING_OFF, g, S, E);
        if (BOTH(1)) GRID_BAR();
    }

    if (IN(2)) {
        for (int item = gw; item < NB * 64 * 4; item += NGW) {
            const int h = item & 3, n = (item >> 2) & 63, b = item >> 8;
            const size_t tok0 = (size_t)b * SEQ + n * 32;
            const int c0 = h * 128 + 2 * lane, cs = h * 128 + swap23(2 * lane);
            const float lb0 = 1.0f / (1.0f + __expf(hg_lb[512 + c0] - hg_lb[c0])), lb1 = 1.0f / (1.0f + __expf(hg_lb[512 + c0 + 1] - hg_lb[c0 + 1]));
            unsigned qw[32], fw[32], vw[32];
#pragma unroll
            for (int c = 0; c < 32; ++c) { const bf16* pr = PROJ + (tok0 + c) * DIN;
                qw[c] = *(const GAS unsigned*)(pr + PC_Q + c0); fw[c] = *(const GAS unsigned*)(pr + PC_F + c0); vw[c] = *(const GAS unsigned*)(pr + PC_V + c0); }
            float eG0 = 1.f, eG1 = 1.f;
            unsigned kd0[16], kd1[16], vv0[16], vv1[16];
#pragma unroll
            for (int i = 0; i < 16; ++i) { kd0[i] = 0u; kd1[i] = 0u; vv0[i] = 0u; vv1[i] = 0u; }
#pragma unroll
            for (int c = 0; c < 32; ++c) { bf16* pr = PROJ + (tok0 + c) * DIN;
                const float f0 = lb0 + (1.0f - lb0) * sigmoidf_(bf_lo(fw[c])), f1 = lb1 + (1.0f - lb1) * sigmoidf_(bf_hi(fw[c]));
                eG0 *= f0; eG1 *= f1;
                const float q0 = bf_lo(qw[c]), q1 = bf_hi(qw[c]);
                const float qd0 = q0 * sigmoidf_(q0) * 0.08838834764831845f * eG0, qd1 = q1 * sigmoidf_(q1) * 0.08838834764831845f * eG1;
                const float kv0 = (1.0f - f0) / eG0, kv1 = (1.0f - f1) / eG1;
                *(GAS unsigned*)(pr + PC_Q + cs) = pk2(qd0, qd1);
                const unsigned kp = pk2(kv0, kv1);
                *(GAS unsigned*)(pr + PC_F + cs) = kp;
                const int pp = swap23(c), sh = 16 * (pp & 1);
                kd0[pp >> 1] |= (kp & 0xffffu) << sh; kd1[pp >> 1] |= (kp >> 16) << sh;
                vv0[pp >> 1] |= (vw[c] & 0xffffu) << sh; vv1[pp >> 1] |= (vw[c] >> 16) << sh; }
            GAS v4u* kt = (GAS v4u*)(KDT + ((size_t)item * 128 + 2 * lane) * 32);
            GAS v4u* vt = (GAS v4u*)(VTT + ((size_t)item * 128 + 2 * lane) * 32);
#pragma unroll
            for (int i = 0; i < 4; ++i) { kt[i] = (v4u){kd0[4 * i], kd0[4 * i + 1], kd0[4 * i + 2], kd0[4 * i + 3]}; kt[4 + i] = (v4u){kd1[4 * i], kd1[4 * i + 1], kd1[4 * i + 2], kd1[4 * i + 3]};
                vt[i] = (v4u){vv0[4 * i], vv0[4 * i + 1], vv0[4 * i + 2], vv0[4 * i + 3]}; vt[4 + i] = (v4u){vv1[4 * i], vv1[4 * i + 1], vv1[4 * i + 2], vv1[4 * i + 3]}; }
            *(GAS f32x2*)(DEC + (size_t)item * 128 + 2 * lane) = (f32x2){eG0, eG1};
        }
        if (BOTH(2)) GRID_BAR();
    }

    if (IN(3)) {
        constexpr int BUFB = 33792, OB0 = 2 * BUFB;
        for (int it = (int)blockIdx.x; it < NB * 4; it += G) {
            const int b = it >> 2, h = it & 3;
            const int lt = tid & 255, r = lane & 31, hh = lane >> 5, sl = wave;
            v4u st[9];
#define SCAN_LOAD(n_) do { const size_t tk0 = (size_t)b * SEQ + (n_) * 32; const size_t itm = (size_t)((b * 64 + (n_)) * 4 + h); \
                _Pragma("unroll") for (int i = 0; i < 2; ++i) { const int q = lt + 256 * i, row = q >> 4, cc = q & 15; const bf16* pr = PROJ + (tk0 + row) * DIN + h * 128 + cc * 8; \
                    st[i] = *(const GAS v4u*)(pr + PC_Q); st[2 + i] = *(const GAS v4u*)(pr + PC_F); \
                    st[4 + i] = ((const GAS v4u*)(KDT + itm * 4096))[q]; st[6 + i] = ((const GAS v4u*)(VTT + itm * 4096))[q]; } \
                if (lt < 32) st[8] = ((const GAS v4u*)(DEC + itm * 128))[lt]; } while (0)
#define SCAN_COMMIT(n_) do { LAS unsigned char* Bf = lds + RING_OFF + ((n_) & 1) * BUFB; \
                _Pragma("unroll") for (int i = 0; i < 2; ++i) { const int q = lt + 256 * i, row = q >> 4, cc = q & 15, k = q >> 2, c4 = q & 3; \
                    *(LAS v4u*)(Bf + row * 256 + ((cc ^ (row & 15)) * 16)) = st[i]; *(LAS v4u*)(Bf + 8192 + row * 256 + ((cc ^ (row & 15)) * 16)) = st[2 + i]; \
                    *(LAS v4u*)(Bf + 16384 + k * 64 + ((c4 ^ ((k >> 2) & 3)) * 16)) = st[4 + i]; *(LAS v4u*)(Bf + 24576 + k * 64 + ((c4 ^ ((k >> 2) & 3)) * 16)) = st[6 + i]; } \
                if (lt < 32) *(LAS v4u*)(Bf + 32768 + lt * 16) = st[8]; } while (0)
#define SCAN_POST(n_) do { const int pos = lt >> 3, vg = lt & 7; const LAS f32x4* ob = (const LAS f32x4*)(lds + RING_OFF + OB0 + ((n_) & 1) * 16384 + (pos * 128 + vg * 16) * 4); \
                const f32x4 o0 = ob[0], o1 = ob[1], o2 = ob[2], o3 = ob[3]; \
                float ss = (o0.x * o0.x + o0.y * o0.y) + (o0.z * o0.z + o0.w * o0.w) + (o1.x * o1.x + o1.y * o1.y) + (o1.z * o1.z + o1.w * o1.w) \
                         + (o2.x * o2.x + o2.y * o2.y) + (o2.z * o2.z + o2.w * o2.w) + (o3.x * o3.x + o3.y * o3.y) + (o3.z * o3.z + o3.w * o3.w); \
                ss += __shfl_xor(ss, 1); ss += __shfl_xor(ss, 2); ss += __shfl_xor(ss, 4); \
                const float rr = 1.0f / sqrtf(ss * (1.0f / 128.0f) + EPS); \
                const size_t tk = (size_t)b * SEQ + (n_) * 32 + pos; const GAS v4u* gp = (const GAS v4u*)(PROJ + tk * DIN + PC_G + h * 128 + vg * 16); const v4u g0 = gp[0], g1 = gp[1]; \
                const float ov[16] = {o0.x, o0.y, o0.z, o0.w, o1.x, o1.y, o1.z, o1.w, o2.x, o2.y, o2.z, o2.w, o3.x, o3.y, o3.z, o3.w}; \
                const float gf[16] = {bf_lo(g0.x), bf_hi(g0.x), bf_lo(g0.y), bf_hi(g0.y), bf_lo(g0.z), bf_hi(g0.z), bf_lo(g0.w), bf_hi(g0.w), bf_lo(g1.x), bf_hi(g1.x), bf_lo(g1.y), bf_hi(g1.y), bf_lo(g1.z), bf_hi(g1.z), bf_lo(g1.w), bf_hi(g1.w)}; \
                float yv[16]; _Pragma("unroll") for (int i = 0; i < 16; ++i) yv[i] = ov[i] * rr * hg_gain[vg * 16 + i] * (gf[i] * sigmoidf_(gf[i])); \
                GAS v4u* mp = (GAS v4u*)(MIX + tk * D + 512 + h * 128 + vg * 16); \
                mp[0] = (v4u){pk2(yv[0], yv[1]), pk2(yv[2], yv[3]), pk2(yv[4], yv[5]), pk2(yv[6], yv[7])}; mp[1] = (v4u){pk2(yv[8], yv[9]), pk2(yv[10], yv[11]), pk2(yv[12], yv[13]), pk2(yv[14], yv[15])}; } while (0)
#define SCAN_BAR() do { asm volatile("s_waitcnt lgkmcnt(0)" ::: "memory"); __builtin_amdgcn_s_barrier(); asm volatile("" ::: "memory"); } while (0)
            if (wave >= 4) {
                SCAN_LOAD(0); SCAN_COMMIT(0);
                SCAN_BAR();
                for (int n = 0; n < 64; ++n) {
                    if (n + 1 < 64) SCAN_LOAD(n + 1);
                    if (n >= 1) SCAN_POST(n - 1);
                    if (n + 1 < 64) SCAN_COMMIT(n + 1);
                    SCAN_BAR();
                }
                SCAN_POST(63);
                SCAN_BAR();
            } else {
                f32x16 S0, S1, S2, S3;
#pragma unroll
                for (int i = 0; i < 16; ++i) { S0[i] = 0.f; S1[i] = 0.f; S2[i] = 0.f; S3[i] = 0.f; }
                SCAN_BAR();
                for (int n = 0; n < 64; ++n) {
                    const LAS unsigned char* Bf = lds + RING_OFF + (n & 1) * BUFB;
                    pg8::bf16x8 qd[8], kd[8], vt[2], kt[4][2];
#pragma unroll
                    for (int ks = 0; ks < 8; ++ks) { const int off = r * 256 + (((2 * ks + hh) ^ (r & 15)) * 16); qd[ks] = *(const LAS pg8::bf16x8*)(Bf + off); kd[ks] = *(const LAS pg8::bf16x8*)(Bf + 8192 + off); }
#pragma unroll
                    for (int sp = 0; sp < 2; ++sp) { const int row = 32 * sl + r; vt[sp] = *(const LAS pg8::bf16x8*)(Bf + 24576 + row * 64 + (((2 * sp + hh) ^ ((row >> 2) & 3)) * 16)); }
#pragma unroll
                    for (int rt = 0; rt < 4; ++rt)
#pragma unroll
                        for (int sp = 0; sp < 2; ++sp) { const int row = 32 * rt + r; kt[rt][sp] = *(const LAS pg8::bf16x8*)(Bf + 16384 + row * 64 + (((2 * sp + hh) ^ ((row >> 2) & 3)) * 16)); }
                    asm volatile("s_waitcnt lgkmcnt(0)" ::: "memory");
                    f32x16 X, O;
#pragma unroll
                    for (int i = 0; i < 16; ++i) { X[i] = 0.f; O[i] = 0.f; }
                    O = __builtin_amdgcn_mfma_f32_32x32x16_bf16(qd[0], pack8(S0, 0), O, 0, 0, 0); O = __builtin_amdgcn_mfma_f32_32x32x16_bf16(qd[1], pack8(S0, 1), O, 0, 0, 0);
                    O = __builtin_amdgcn_mfma_f32_32x32x16_bf16(qd[2], pack8(S1, 0), O, 0, 0, 0); O = __builtin_amdgcn_mfma_f32_32x32x16_bf16(qd[3], pack8(S1, 1), O, 0, 0, 0);
                    O = __builtin_amdgcn_mfma_f32_32x32x16_bf16(qd[4], pack8(S2, 0), O, 0, 0, 0); O = __builtin_amdgcn_mfma_f32_32x32x16_bf16(qd[5], pack8(S2, 1), O, 0, 0, 0);
                    O = __builtin_amdgcn_mfma_f32_32x32x16_bf16(qd[6], pack8(S3, 0), O, 0, 0, 0); O = __builtin_amdgcn_mfma_f32_32x32x16_bf16(qd[7], pack8(S3, 1), O, 0, 0, 0);
#pragma unroll
                    for (int ks = 0; ks < 8; ++ks) X = __builtin_amdgcn_mfma_f32_32x32x16_bf16(kd[ks], qd[ks], X, 0, 0, 0);
#define SCAN_SUPD(Sx, rt_) do { Sx = __builtin_amdgcn_mfma_f32_32x32x16_bf16(kt[rt_][0], vt[0], Sx, 0, 0, 0); Sx = __builtin_amdgcn_mfma_f32_32x32x16_bf16(kt[rt_][1], vt[1], Sx, 0, 0, 0); \
                        _Pragma("unroll") for (int g = 0; g < 4; ++g) { const f32x4 dv = *(const LAS f32x4*)(Bf + 32768 + (32 * (rt_) + 8 * g + 4 * hh) * 4); \
                            Sx[4 * g] *= dv.x; Sx[4 * g + 1] *= dv.y; Sx[4 * g + 2] *= dv.z; Sx[4 * g + 3] *= dv.w; } } while (0)
                    SCAN_SUPD(S0, 0); SCAN_SUPD(S1, 1); SCAN_SUPD(S2, 2); SCAN_SUPD(S3, 3);
#pragma unroll
                    for (int i = 0; i < 16; ++i) { const int s_ = (i & 3) + 8 * (i >> 2) + 4 * hh; X[i] = (s_ <= r) ? X[i] : 0.f; }
                    O = __builtin_amdgcn_mfma_f32_32x32x16_bf16(pack8(X, 0), vt[0], O, 0, 0, 0); O = __builtin_amdgcn_mfma_f32_32x32x16_bf16(pack8(X, 1), vt[1], O, 0, 0, 0);
                    LAS float* ob = (LAS float*)(lds + RING_OFF + OB0 + (n & 1) * 16384);
#pragma unroll
                    for (int i = 0; i < 16; ++i) ob[((i & 3) + 8 * (i >> 2) + 4 * hh) * 128 + 32 * sl + r] = O[i];
                    SCAN_BAR();
                }
                SCAN_BAR();
            }
        }
        {
            const int cb = (G > NB * 4) ? (int)blockIdx.x - NB * 4 : (int)blockIdx.x, ncb = (G > NB * 4) ? G - NB * 4 : G;
            if (cb >= 0) for (int item = cb * NWAVES + wave; item < NB * 4 * 32; item += ncb * NWAVES) {
                const int seg = item & 31, gp = (item >> 5) & 3, b = item >> 7, c0 = gp * 128 + 2 * lane, t0 = seg * 64;
                const f32x2 w0 = *(const GAS f32x2*)(conv_w + c0), w1 = *(const GAS f32x2*)(conv_w + 512 + c0), w2 = *(const GAS f32x2*)(conv_w + 1024 + c0), gn = *(const GAS f32x2*)(conv_gain + c0);
                f32x2 u1 = {0.f, 0.f}, u2 = {0.f, 0.f};
                if (t0 > 0) { const bf16* p2 = PROJ + (size_t)(b * SEQ + t0 - 2) * DIN; const bf16* p1 = p2 + DIN;
                    const unsigned ca = *(const GAS unsigned*)(p2 + PC_C + c0), ha = *(const GAS unsigned*)(p2 + PC_H + c0), cbb = *(const GAS unsigned*)(p1 + PC_C + c0), hb = *(const GAS unsigned*)(p1 + PC_H + c0);
                    u2 = (f32x2){bf_lo(ca) * bf_lo(ha), bf_hi(ca) * bf_hi(ha)}; u1 = (f32x2){bf_lo(cbb) * bf_lo(hb), bf_hi(cbb) * bf_hi(hb)}; }
                for (int tb = t0; tb < t0 + 64; tb += 8) {
                    unsigned cw[8], hw[8], bw[8];
#pragma unroll
                    for (int i = 0; i < 8; ++i) { const bf16* pr = PROJ + ((size_t)b * SEQ + tb + i) * DIN; cw[i] = *(const GAS unsigned*)(pr + PC_C + c0); hw[i] = *(const GAS unsigned*)(pr + PC_H + c0); bw[i] = *(const GAS unsigned*)(pr + PC_B + c0); }
#pragma unroll
                    for (int i = 0; i < 8; ++i) { const f32x2 u = {bf_lo(cw[i]) * bf_lo(hw[i]), bf_hi(cw[i]) * bf_hi(hw[i])};
                        const f32x2 y = (f32x2){bf_lo(bw[i]), bf_hi(bw[i])} * (w0 * u2 + w1 * u1 + w2 * u);
                        float ss = y.x * y.x + y.y * y.y;
                        ss += dpp_f<0xB1>(ss); ss += dpp_f<0x4E>(ss); ss += dpp_f<0x124>(ss); ss += dpp_f<0x128>(ss); ss = swap16_add(ss, ss);
                        const float r = 1.0f / sqrtf(ss * (1.0f / 64.0f) + EPS);
                        *(GAS unsigned*)(MIX + ((size_t)b * SEQ + tb + i) * D + c0) = pk2(y.x * r * gn.x, y.y * r * gn.y); u2 = u1; u1 = u; }
                }
            }
        }
        if (BOTH(3)) GRID_BAR();
    }


    if (IN(4)) {
        pg8::Gemm g{MIX, WOT, T, D, D}; pg8::StaticOrder S; S.init(T, D, G, (int)blockIdx.x);
        pg8::EpiResid E{x, X1, SS2};
        pg8::gemm_phase<pg8::EpiResid, pg8::StaticOrder, PG8_ALIGN, PG8_SP2>(lds + RING_OFF, g, S, E);
        if (BOTH(4)) GRID_BAR();
    }

    if (IN(5)) {
        pg8::Gemm g{X1, WQT, T, 2048, D}; pg8::StaticOrder S; S.init(T, 2048, G, (int)blockIdx.x);
        pg8::EpiScaleBf16<1> E{QB, 2048, SS2};
        pg8::gemm_phase<pg8::EpiScaleBf16<1>, pg8::StaticOrder, PG8_ALIGN, PG8_SP2>(lds + RING_OFF, g, S, E);
        if (BOTH(5)) GRID_BAR();
    }

    if (IN(6)) {
        const int r = lane & 31, hh = lane >> 5;
        for (int item = gw; item < (T / 32) * 8; item += NGW) {
            const int h = item & 7, tok = (item >> 3) * 32 + r;
            unsigned L[2][16];
#pragma unroll
            for (int p = 0; p < 2; ++p) {
                pg8::bf16x8 qf[8];
                const GAS pg8::bf16x8* qp = (const GAS pg8::bf16x8*)(QB + (size_t)tok * 2048 + h * 256 + p * 128 + 8 * hh);
#pragma unroll
                for (int ks = 0; ks < 8; ++ks) qf[ks] = qp[2 * ks];
                const GAS pg8::bf16x8* kp = (const GAS pg8::bf16x8*)(KEYB + (size_t)((h * 2 + p) * 128 + r) * 128 + 8 * hh);
                unsigned best[16];
#pragma unroll
                for (int nt = 0; nt < 4; ++nt) {
                    f32x16 acc;
#pragma unroll
                    for (int i = 0; i < 16; ++i) acc[i] = 0.f;
                    const GAS pg8::bf16x8* kb = kp + nt * 512; asm volatile("" : "+v"(kb));
#pragma unroll
                    for (int ks = 0; ks < 8; ++ks) acc = __builtin_amdgcn_mfma_f32_32x32x16_bf16(kb[2 * ks], qf[ks], acc, 0, 0, 0);
                    unsigned cur[16];
#pragma unroll
                    for (int i = 0; i < 16; ++i) { const int n = 32 * nt + (i & 3) + 8 * (i >> 2) + 4 * hh;
                        const float av = acc[i]; unsigned u = __builtin_bit_cast(unsigned, av); u ^= (unsigned)((int)u >> 31) | 0x80000000u;
                        cur[i] = (u & ~0x7Fu) | (unsigned)(127 - n); }
                    sort16_desc(cur);
                    if (nt == 0) {
#pragma unroll
                        for (int i = 0; i < 16; ++i) best[i] = cur[i];
                    } else merge16_desc(best, cur);
                }
                unsigned o[16];
#pragma unroll
                for (int i = 0; i < 16; ++i) o[i] = (unsigned)__shfl_xor((int)best[i], 32);
                merge16_desc(best, o);
#pragma unroll
                for (int i = 0; i < 16; ++i) L[p][i] = best[i];
            }
            float v1[16], v2[16];
#pragma unroll
            for (int j = 0; j < 16; ++j) { v1[j] = unkey(L[0][j] & ~0x7Fu); v2[j] = unkey(L[1][j] & ~0x7Fu); }
            unsigned ct[16];
#pragma unroll
            for (int j = 0; j < 16; ++j) ct[j] = ckey(v1[0] + v2[j], j);
#pragma unroll
            for (int i = 1; i < 16; ++i)
#pragma unroll
                for (int j = 0; j < 16; ++j) if ((i + 1) * (j + 1) <= 16) {
                    unsigned key = ckey(v1[i] + v2[j], i * 16 + j);
#pragma unroll
                    for (int t = 0; t < 16; ++t) { const unsigned mx = ct[t] > key ? ct[t] : key; key = ct[t] > key ? key : ct[t]; ct[t] = mx; }
                }
            float den = 0.f, ex[16]; const float cmax = unkey(ct[0] & ~0xFFu);
#pragma unroll
            for (int t = 0; t < 16; ++t) { ex[t] = __expf(unkey(ct[t] & ~0xFFu) - cmax); den += ex[t]; }
            const float inv = 1.0f / den;
            unsigned b1[4], b2[4];
#pragma unroll
            for (int w = 0; w < 4; ++w) { b1[w] = (L[0][4 * w] & 0x7Fu) | ((L[0][4 * w + 1] & 0x7Fu) << 8) | ((L[0][4 * w + 2] & 0x7Fu) << 16) | ((L[0][4 * w + 3] & 0x7Fu) << 24);
                b2[w] = (L[1][4 * w] & 0x7Fu) | ((L[1][4 * w + 1] & 0x7Fu) << 8) | ((L[1][4 * w + 2] & 0x7Fu) << 16) | ((L[1][4 * w + 3] & 0x7Fu) << 24); }
            unsigned ent[8];
#pragma unroll
            for (int t = 0; t < 8; ++t) { const unsigned hm = 0u - (unsigned)hh;
                const unsigned ck = ct[t] ^ ((ct[t] ^ ct[8 + t]) & hm); const unsigned e0 = __builtin_bit_cast(unsigned, ex[t]), e1 = __builtin_bit_cast(unsigned, ex[8 + t]);
                const float gt = __builtin_bit_cast(float, e0 ^ ((e0 ^ e1) & hm)) * inv;
                const unsigned flat = 255u - (ck & 0xFFu), ii = flat >> 4, jj = flat & 15u;
                const unsigned w1 = (ii & 8u) ? ((ii & 4u) ? b1[3] : b1[2]) : ((ii & 4u) ? b1[1] : b1[0]), w2 = (jj & 8u) ? ((jj & 4u) ? b2[3] : b2[2]) : ((jj & 4u) ? b2[1] : b2[0]);
                const unsigned n1 = 127u - ((w1 >> (8u * (ii & 3u))) & 0x7Fu), n2 = 127u - ((w2 >> (8u * (jj & 3u))) & 0x7Fu);
                ent[t] = (n1 * 128u + n2) | (pkh2(gt, 0.f) << 16); }
            GAS v4u* ep = (GAS v4u*)(EXPT + (size_t)tok * 128 + h * 16 + 8 * hh);
            ep[0] = (v4u){ent[0], ent[1], ent[2], ent[3]}; ep[1] = (v4u){ent[4], ent[5], ent[6], ent[7]};
        }
        if (BOTH(6)) GRID_BAR();
    }


    if (IN(7)) {
        constexpr int NT = 4;
        unsigned pace_round = 0u;
        unsigned* pace_cnt = (unsigned*)(ctl + 16384) + 64 * bar.x;
        const unsigned pace_n = (N_LAUNCHES == 1) ? MISC[8] : 0u;
#define PEER_PACE() do { if (pace_n) { ++pace_round; __syncthreads(); if (tid == 0) { xb_add(pace_cnt, 1u); unsigned sp_ = 0; while (xb_ld(pace_cnt) < pace_n * pace_round && ++sp_ < 20000u) __builtin_amdgcn_s_sleep(1); } __syncthreads(); } } while (0)
        const unsigned srcl = (unsigned)(32 * (lane & 1) + 16 * ((lane >> 1) & 1)) << 2;
        for (int bt0 = 0; bt0 < T / NT; bt0 += NGW) {
            const int bt = (bt0 + gw < T / NT) ? bt0 + gw : bt0 + gw - NGW;
            const int tok0 = bt * NT;
            unsigned e[NT][2]; float rs2[NT];
#pragma unroll
            for (int t = 0; t < NT; ++t) { const unsigned r0 = EXPT[(size_t)(tok0 + t) * 128 + lane], r1 = EXPT[(size_t)(tok0 + t) * 128 + 64 + lane];
                e[t][0] = (r0 << 16) | (r0 >> 16); e[t][1] = (r1 << 16) | (r1 >> 16);
                rs2[t] = 1.0f / sqrtf(SS2[tok0 + t] * (1.0f / D) + EPS); }
            sort128_asc<NT>(e, lane);
            PEER_PACE();
            int ah[NT][2]; int hx[NT][4]; float xs[NT];
#pragma unroll
            for (int t = 0; t < NT; ++t) { const GAS v4u* xr = (const GAS v4u*)(X1 + (size_t)(tok0 + t) * D); const v4u xa = __builtin_nontemporal_load(xr + lane), xb = __builtin_nontemporal_load(xr + 64 + lane);
                const float xv[16] = {bf_lo(xa.x), bf_hi(xa.x), bf_lo(xa.y), bf_hi(xa.y), bf_lo(xa.z), bf_hi(xa.z), bf_lo(xa.w), bf_hi(xa.w), bf_lo(xb.x), bf_hi(xb.x), bf_lo(xb.y), bf_hi(xb.y), bf_lo(xb.z), bf_hi(xb.z), bf_lo(xb.w), bf_hi(xb.w)};
                float am = 0.f;
#pragma unroll
                for (int i = 0; i < 16; ++i) am = fmaxf(am, fabsf(xv[i]));
                am = fmaxf(wave_max(am), 1e-20f); const float sx = 127.0f / am; xs[t] = am * (1.0f / 127.0f);
#pragma unroll
                for (int w = 0; w < 4; ++w) { const int i0 = (int)rintf(xv[4 * w] * sx), i1 = (int)rintf(xv[4 * w + 1] * sx), i2 = (int)rintf(xv[4 * w + 2] * sx), i3 = (int)rintf(xv[4 * w + 3] * sx);
                    hx[t][w] = (int)(((unsigned)i0 & 0xFFu) | (((unsigned)i1 & 0xFFu) << 8) | (((unsigned)i2 & 0xFFu) << 16) | (((unsigned)i3 & 0xFFu) << 24)); }
                ah[t][0] = 0; ah[t][1] = 0; }
#define PEER_LOAD(buf, st_) do { _Pragma("unroll") for (int t = 0; t < NT; ++t) { const unsigned em_ = ((st_) & 16) ? 0xFFFFFFFFu : 0u; const unsigned esel = e[t][0] ^ ((e[t][0] ^ e[t][1]) & em_); \
                _Pragma("unroll") for (int q = 0; q < 4; ++q) { const unsigned id = (unsigned)__builtin_amdgcn_readlane((int)esel, 4 * ((st_) & 15) + q) >> 16; \
                    buf[t][q] = ((const GAS v4u*)(U8 + (size_t)id * D))[lane]; } } } while (0)
#define PEER_DOTS(buf, st_) do { int p[16]; \
                _Pragma("unroll") for (int t = 0; t < NT; ++t) _Pragma("unroll") for (int q = 0; q < 4; ++q) { \
                    const int d0 = __builtin_amdgcn_sdot4((int)buf[t][q].x, hx[t][0], 0, false), d1 = __builtin_amdgcn_sdot4((int)buf[t][q].z, hx[t][2], 0, false); \
                    p[4 * t + q] = __builtin_amdgcn_sdot4((int)buf[t][q].y, hx[t][1], d0, false) + __builtin_amdgcn_sdot4((int)buf[t][q].w, hx[t][3], d1, false); } \
                const int red = reduce16i(p, lane); const bool hit = (lane >> 2) == ((st_) & 15), hi = ((st_) & 16) != 0; \
                _Pragma("unroll") for (int t = 0; t < NT; ++t) { const int got = __builtin_amdgcn_ds_bpermute((int)(srcl + (unsigned)((8 * (t & 1) + 4 * (t >> 1)) << 2)), red); \
                    ah[t][0] = (hit && !hi) ? got : ah[t][0]; ah[t][1] = (hit && hi) ? got : ah[t][1]; } } while (0)
            {
                v4u ua[NT][4], ubb[NT][4];
                PEER_LOAD(ua, 0);
                for (int st = 0; st < 32; st += 2) {
                    PEER_LOAD(ubb, st + 1);
                    PEER_DOTS(ua, st);
                    if (st + 2 < 32) PEER_LOAD(ua, st + 2);
                    PEER_DOTS(ubb, st + 1);
                }
            }
            float wv[NT][2];
#pragma unroll
            for (int t = 0; t < NT; ++t)
#pragma unroll
                for (int g = 0; g < 2; ++g) { const float a = (float)ah[t][g] * (rs2[t] * xs[t] * (1.0f / PEER_SU)); const float gate = (float)h2_of(e[t][g] & 0xFFFFu).x;
                    wv[t][g] = gate * (0.5f / PEER_SV) * a * (1.0f + erff(a * 0.7071067811865476f)); }
            PEER_PACE();
            f32x2 y[NT][8];
#pragma unroll
            for (int t = 0; t < NT; ++t)
#pragma unroll
                for (int i = 0; i < 8; ++i) y[t][i] = (f32x2){0.f, 0.f};
#define PEER_LOADB(buf, st_) do { _Pragma("unroll") for (int t = 0; t < NT; ++t) { const unsigned em_ = ((st_) & 32) ? 0xFFFFFFFFu : 0u; const unsigned esel = e[t][0] ^ ((e[t][0] ^ e[t][1]) & em_); \
                _Pragma("unroll") for (int q = 0; q < 2; ++q) { const unsigned id = (unsigned)__builtin_amdgcn_readlane((int)esel, 2 * ((st_) & 31) + q) >> 16; \
                    buf[t][q] = ((const GAS v4u*)(V8 + (size_t)id * D))[lane]; } } } while (0)
#define PEER_AXPY(buf, st_) do { _Pragma("unroll") for (int t = 0; t < NT; ++t) { const unsigned wm_ = ((st_) & 32) ? 0xFFFFFFFFu : 0u; const unsigned w0_ = __builtin_bit_cast(unsigned, wv[t][0]), w1_ = __builtin_bit_cast(unsigned, wv[t][1]); const unsigned wsel = w0_ ^ ((w0_ ^ w1_) & wm_); \
                _Pragma("unroll") for (int q = 0; q < 2; ++q) { const float wi = __builtin_bit_cast(float, __builtin_amdgcn_readlane((int)wsel, 2 * ((st_) & 31) + q)); const f32x2 w2 = {wi, wi}; \
                    const unsigned vw_[4] = {buf[t][q].x, buf[t][q].y, buf[t][q].z, buf[t][q].w}; \
                    _Pragma("unroll") for (int j = 0; j < 4; ++j) { y[t][2 * j] = __builtin_elementwise_fma(__builtin_amdgcn_cvt_pk_f32_fp8((int)vw_[j], false), w2, y[t][2 * j]); y[t][2 * j + 1] = __builtin_elementwise_fma(__builtin_amdgcn_cvt_pk_f32_fp8((int)vw_[j], true), w2, y[t][2 * j + 1]); } } } } while (0)
            {
                v4u va[NT][2], vbb[NT][2];
                PEER_LOADB(va, 0);
                for (int st = 0; st < 64; st += 2) {
                    PEER_LOADB(vbb, st + 1);
                    PEER_AXPY(va, st);
                    if (st + 2 < 64) PEER_LOADB(va, st + 2);
                    PEER_AXPY(vbb, st + 1);
                }
            }
#pragma unroll
            for (int t = 0; t < NT; ++t) { const size_t tok = (size_t)(tok0 + t);
                const GAS v4u* xr = (const GAS v4u*)(X1 + tok * D); const v4u xa = __builtin_nontemporal_load(xr + lane), xb = __builtin_nontemporal_load(xr + 64 + lane);
                const float xf[16] = {bf_lo(xa.x), bf_hi(xa.x), bf_lo(xa.y), bf_hi(xa.y), bf_lo(xa.z), bf_hi(xa.z), bf_lo(xa.w), bf_hi(xa.w),
                                      bf_lo(xb.x), bf_hi(xb.x), bf_lo(xb.y), bf_hi(xb.y), bf_lo(xb.z), bf_hi(xb.z), bf_lo(xb.w), bf_hi(xb.w)};
                float yy[16]; float ss = 0.f;
#pragma unroll
                for (int i = 0; i < 8; ++i) { yy[2 * i] = y[t][i].x + xf[2 * i]; yy[2 * i + 1] = y[t][i].y + xf[2 * i + 1]; ss += yy[2 * i] * yy[2 * i] + yy[2 * i + 1] * yy[2 * i + 1]; }
                ss = wave_sum(ss);
                const float r = 1.0f / sqrtf(ss * (1.0f / D) + EPS);
                const GAS f32x4* nfp = (const GAS f32x4*)norm_f; const f32x4 n0 = nfp[2 * lane], n1 = nfp[2 * lane + 1], n2 = nfp[128 + 2 * lane], n3 = nfp[128 + 2 * lane + 1];
                GAS f32x4* op = (GAS f32x4*)(out + tok * D);
                __builtin_nontemporal_store((f32x4){yy[0] * r * n0.x, yy[1] * r * n0.y, yy[2] * r * n0.z, yy[3] * r * n0.w}, op + 2 * lane);
                __builtin_nontemporal_store((f32x4){yy[4] * r * n1.x, yy[5] * r * n1.y, yy[6] * r * n1.z, yy[7] * r * n1.w}, op + 2 * lane + 1);
                __builtin_nontemporal_store((f32x4){yy[8] * r * n2.x, yy[9] * r * n2.y, yy[10] * r * n2.z, yy[11] * r * n2.w}, op + 128 + 2 * lane);
                __builtin_nontemporal_store((f32x4){yy[12] * r * n3.x, yy[13] * r * n3.y, yy[14] * r * n3.z, yy[15] * r * n3.w}, op + 128 + 2 * lane + 1); }
        }
    }

#undef IN
#undef BOTH
}

extern "C" void kernel_launch(void* const* d_in, const int* in_sizes, int n_in, void* d_out, int out_size, void* d_ws, size_t ws_size, hipStream_t stream) {
    static int grid = 0;
    if (grid == 0) {
        if (n_in != 14 || in_sizes[0] != T * D || out_size != T * D || ws_size < WS_END) { fprintf(stderr, "kernel_launch: unexpected shapes (n_in %d, in0 %d, out %d, ws %zu); nothing launched\n", n_in, n_in > 0 ? in_sizes[0] : -1, out_size, ws_size); grid = -1; return; }
        int dev = 0, cus = 0, per_cu = 0;
        if (hipGetDevice(&dev) != hipSuccess || hipDeviceGetAttribute(&cus, hipDeviceAttributeMultiprocessorCount, dev) != hipSuccess) { grid = -1; return; }
        if (hipFuncSetAttribute((const void*)hymba_fwd, hipFuncAttributeMaxDynamicSharedMemorySize, LDS_BYTES) != hipSuccess) { fprintf(stderr, "kernel_launch: hipFuncSetAttribute failed\n"); grid = -1; return; }
        if (hipOccupancyMaxActiveBlocksPerMultiprocessor(&per_cu, (const void*)hymba_fwd, NWAVES * 64, LDS_BYTES) != hipSuccess || per_cu < 1) { fprintf(stderr, "kernel_launch: occupancy query says %d blocks per CU\n", per_cu); (void)hipGetLastError(); grid = -1; return; }
        grid = cus;
    }
    if (grid < 0) return;
    if (hipMemsetAsync((char*)d_ws + WS_CTL, 0, CTL_ZERO_BYTES, stream) != hipSuccess) { fprintf(stderr, "kernel_launch: hipMemsetAsync failed\n"); return; }
    Args a{};
    for (int i = 0; i < 14; ++i) a.in[i] = (const float*)d_in[i];
    a.out = (float*)d_out; a.ws = (unsigned char*)d_ws;
    if (N_LAUNCHES == 1) {
        a.ph_lo = 0; a.ph_hi = NPHASES; a.li = 0;
        void* kargs[] = {&a};
        const hipError_t e = hipLaunchCooperativeKernel((const void*)hymba_fwd, dim3(grid), dim3(NWAVES * 64), kargs, LDS_BYTES, stream);
        if (e != hipSuccess) fprintf(stderr, "kernel_launch: cooperative launch failed: %s (grid %d)\n", hipGetErrorString(e), grid);
    } else {
        for (int li = 0; li < NPHASES; ++li) {
            a.ph_lo = li; a.ph_hi = li + 1; a.li = li;
            hipLaunchKernelGGL(hymba_fwd, dim3(grid), dim3(NWAVES * 64), LDS_BYTES, stream, a);
            const hipError_t le = hipPeekAtLastError();
            if (le != hipSuccess) { fprintf(stderr, "kernel_launch: launch %d failed: %s\n", li, hipGetErrorName(le)); break; }
        }
    }
}
```

```cpp
#include <hip/hip_runtime.h>
#include <cstdio>
#include <cstdint>
namespace pg8 {
#define PG8_LAS __attribute__((address_space(3)))
typedef unsigned short bf16_t;
typedef short bf16x8 __attribute__((ext_vector_type(8)));
typedef float f32x4 __attribute__((ext_vector_type(4)));
typedef unsigned u32x4 __attribute__((ext_vector_type(4)));
constexpr int BM = 256, BK = 64, HALF = 128, HTB = HALF * BK * 2  , STAGE_BYTES = 8 * HTB, NXCD = 8, WGM = 8;

__host__ __device__ __forceinline__ int lds_byte(int r, int c) { const int st = (r >> 4) * 2 + (c >> 5), rr = r & 15, cc = c & 31, ob = rr * 64 + cc * 2; return st * 1024 + (ob ^ (((ob >> 9) & 1) << 5)); }
__host__ __device__ __forceinline__ void stage_rc(int b, int& R, int& C) { const int st = b / 1024, sb = b % 1024, swz = sb ^ (((sb >> 9) & 1) << 5); R = (st >> 1) * 16 + swz / 64; C = (st & 1) * 32 + (swz % 64) / 2; }
__host__ __device__ __forceinline__ int perm32(int rho) { const int n = rho >> 4, i = rho & 15; return 8 * (i >> 2) + 4 * n + (i & 3); }

struct Unit { int pm, pn; };
struct Gemm { const bf16_t* A; const bf16_t* Bt; int M, N, K; };

struct StaticOrder {
    int nM, nN, nwg, G, c;
    __host__ __device__ void init(int M, int N, int G_, int c_) { nM = M / BM; nN = N / BM; nwg = nM * nN; G = G_; c = c_; }
    __host__ __device__ bool next(int i, Unit& u) const {
        const long L = (long)i * G + c; if (L >= nwg) return false;
        int wgid = (int)L; { const int q = nwg / NXCD, r = nwg % NXCD, xcd = wgid % NXCD, off = wgid / NXCD; wgid = (xcd < r ? xcd * (q + 1) : r * (q + 1) + (xcd - r) * q) + off; }
        const int nig = WGM * nN, gid = wgid / nig, fm = gid * WGM, gsz = (nM - fm) < WGM ? (nM - fm) : WGM;
        u.pm = fm + ((wgid % nig) % gsz); u.pn = (wgid % nig) / gsz; return true;
    }
    __device__ __forceinline__ void a_ready(const Unit&) const {}
    __device__ __forceinline__ void done(const Unit&) const {}
};

__device__ __forceinline__ unsigned cvt_pk_bf16(float lo, float hi) { unsigned r; asm volatile("v_cvt_pk_bf16_f32 %0, %1, %2" : "=v"(r) : "v"(lo), "v"(hi)); return r; }

template <int MODE> struct EpiScaleBf16 {
    static constexpr bool PERM = true, AFTER_DRAIN = false;
    bf16_t* O; int ldc; const float* rowv;
    __device__ __forceinline__ void operator()(const f32x4 (&acc)[2][2][4][2], const Unit& u, int wr, int wc, int fr, int fq) const {
        const int row0 = u.pm * BM + wr * 64 + fr, col0 = u.pn * BM + wc * 32 + 8 * fq;
#pragma unroll
        for (int ai = 0; ai < 2; ++ai)
#pragma unroll
            for (int m = 0; m < 4; ++m) { const int row = row0 + ai * HALF + m * 16; float s = rowv[row]; if (MODE == 1) s = 1.0f / sqrtf(s * (1.0f / 1024.0f) + 1e-6f);
                bf16_t* rowp = O + (size_t)row * ldc + col0;
#pragma unroll
                for (int bj = 0; bj < 2; ++bj) { const f32x4 v0 = acc[ai][bj][m][0] * s, v1 = acc[ai][bj][m][1] * s;
                    u32x4 w; w.x = cvt_pk_bf16(v0[0], v0[1]); w.y = cvt_pk_bf16(v0[2], v0[3]); w.z = cvt_pk_bf16(v1[0], v1[1]); w.w = cvt_pk_bf16(v1[2], v1[3]);
                    *(u32x4*)(rowp + bj * HALF) = w; } }
    }
};
struct EpiResid {
    static constexpr bool PERM = true, AFTER_DRAIN = false;
    const float* X; bf16_t* O; float* ss;
    __device__ __forceinline__ void operator()(const f32x4 (&acc)[2][2][4][2], const Unit& u, int wr, int wc, int fr, int fq) const {
        const int row0 = u.pm * BM + wr * 64 + fr, col0 = u.pn * BM + wc * 32 + 8 * fq;
#pragma unroll
        for (int ai = 0; ai < 2; ++ai)
#pragma unroll
            for (int m = 0; m < 4; ++m) { const int row = row0 + ai * HALF + m * 16; float part = 0.f;
#pragma unroll
                for (int bj = 0; bj < 2; ++bj) { const float* xp = X + (size_t)row * 1024 + col0 + bj * HALF;
                    const f32x4 v0 = acc[ai][bj][m][0] + *(const f32x4*)xp, v1 = acc[ai][bj][m][1] + *(const f32x4*)(xp + 4);
                    part += (v0[0] * v0[0] + v0[1] * v0[1]) + (v0[2] * v0[2] + v0[3] * v0[3]) + (v1[0] * v1[0] + v1[1] * v1[1]) + (v1[2] * v1[2] + v1[3] * v1[3]);
                    u32x4 w; w.x = cvt_pk_bf16(v0[0], v0[1]); w.y = cvt_pk_bf16(v0[2], v0[3]); w.z = cvt_pk_bf16(v1[0], v1[1]); w.w = cvt_pk_bf16(v1[2], v1[3]);
                    *(u32x4*)(O + (size_t)row * 1024 + col0 + bj * HALF) = w; }
                part += __shfl_xor(part, 16); part += __shfl_xor(part, 32);
                if (fq == 0) (void)__builtin_amdgcn_global_atomic_fadd_f32((__attribute__((address_space(1))) float*)(ss + row), part); }
    }
};

template <class Epi, class Sched, bool ALIGN_EPI = false, bool SP2 = false>
__device__ __forceinline__ void gemm_phase(PG8_LAS unsigned char* lds, const Gemm g, const Sched& S, const Epi& E) {
    const int tid = threadIdx.x, wid = __builtin_amdgcn_readfirstlane(tid >> 6), lane = tid & 63, wr = wid >> 2, wc = wid & 3, fr = lane & 15, fq = lane >> 4;
    const int K = g.K, nt = K / BK;
    unsigned voffA[2], voffB[2];
#pragma unroll
    for (int i = 0; i < 2; ++i) { int R, C; stage_rc(tid * 16 + i * 8192, R, C); const int Rb = Epi::PERM ? ((R & ~31) + perm32(R & 31)) : R;
        voffA[i] = (unsigned)(R * K + C) * 2u; voffB[i] = (unsigned)(Rb * K + C) * 2u; }
    const size_t kstep = (size_t)(BK * 2);
    const size_t hstep = (size_t)HALF * K * 2;
    const size_t tstep = 2 * hstep;
    const unsigned ldsw = (unsigned)wid * 1024u;
    const int aoff = lds_byte(wr * 64 + fr, fq * 8), boff = lds_byte(wc * 32 + fr, fq * 8);
#define PG8_SA(b, h) (((b) * 2 + (h)) * HTB)
#define PG8_SB(b, h) ((4 + (b) * 2 + (h)) * HTB)
#define PG8_STAGE(bufoff, gbase, voff) do { _Pragma("unroll") for (int _i = 0; _i < 2; ++_i) \
        __builtin_amdgcn_global_load_lds((const unsigned*)((const char*)(gbase) + (voff)[_i]), (PG8_LAS unsigned*)(lds + (bufoff) + ldsw + _i * 8192), 16, 0, 0); } while (0)
#define PG8_LDA(dst, b, h) do { _Pragma("unroll") for (int m = 0; m < 4; ++m) _Pragma("unroll") for (int k = 0; k < 2; ++k) dst[m][k] = *(const PG8_LAS bf16x8*)(lds + PG8_SA(b, h) + aoff + m * 2048 + k * 1024); } while (0)
#define PG8_LDB(dst, b, h) do { _Pragma("unroll") for (int n = 0; n < 2; ++n) _Pragma("unroll") for (int k = 0; k < 2; ++k) dst[n][k] = *(const PG8_LAS bf16x8*)(lds + PG8_SB(b, h) + boff + n * 2048 + k * 1024); } while (0)
#define PG8_MMA(ai, bj, At, Bt) do { __builtin_amdgcn_s_setprio(1); _Pragma("unroll") for (int m = 0; m < 4; ++m) _Pragma("unroll") for (int n = 0; n < 2; ++n) _Pragma("unroll") for (int k = 0; k < 2; ++k) \
        acc[ai][bj][m][n] = __builtin_amdgcn_mfma_f32_16x16x32_bf16(Bt[n][k], At[m][k], acc[ai][bj][m][n], 0, 0, 0); __builtin_amdgcn_s_setprio(0); } while (0)
#define PG8_WAIT_V(n) asm volatile("s_waitcnt vmcnt(" #n ")" ::: "memory")
#define PG8_WAIT_L(n) asm volatile("s_waitcnt lgkmcnt(" #n ")" ::: "memory")
#define PG8_BAR __builtin_amdgcn_s_barrier()
#define PG8_SCHED __builtin_amdgcn_sched_barrier(0)
    Unit cur, nxt; int ui = 0;
    if (!S.next(0, cur)) return;
    f32x4 acc[2][2][4][2];
#pragma unroll
    for (int a = 0; a < 2; ++a)
#pragma unroll
        for (int b = 0; b < 2; ++b)
#pragma unroll
            for (int m = 0; m < 4; ++m)
#pragma unroll
                for (int n = 0; n < 2; ++n) acc[a][b][m][n] = (f32x4){0.f, 0.f, 0.f, 0.f};
    bf16x8 At[4][2], B0[2][2], B1[2][2];
    const char* cA = (const char*)g.A + (size_t)cur.pm * tstep; const char* cB = (const char*)g.Bt + (size_t)cur.pn * tstep;
    S.a_ready(cur);
    if constexpr (SP2) {
        PG8_STAGE(PG8_SB(0, 0), cB, voffB); PG8_STAGE(PG8_SB(0, 1), cB + hstep, voffB); PG8_STAGE(PG8_SA(0, 0), cA, voffA); PG8_STAGE(PG8_SA(0, 1), cA + hstep, voffA);
        if (wr == 1) PG8_BAR;
        PG8_WAIT_V(2); PG8_BAR;
        PG8_STAGE(PG8_SB(1, 0), cB + kstep, voffB); PG8_STAGE(PG8_SA(1, 0), cA + kstep, voffA); PG8_STAGE(PG8_SB(1, 1), cB + hstep + kstep, voffB);
        PG8_WAIT_V(6); PG8_BAR;
    } else {
        PG8_STAGE(PG8_SB(0, 0), cB, voffB); PG8_STAGE(PG8_SA(0, 0), cA, voffA); PG8_STAGE(PG8_SB(0, 1), cB + hstep, voffB); PG8_STAGE(PG8_SA(0, 1), cA + hstep, voffA);
        if (wr == 1) PG8_BAR;
        PG8_WAIT_V(4); PG8_BAR;
        PG8_STAGE(PG8_SB(1, 0), cB + kstep, voffB); PG8_STAGE(PG8_SA(1, 0), cA + kstep, voffA); PG8_STAGE(PG8_SB(1, 1), cB + hstep + kstep, voffB);
        PG8_WAIT_V(6); PG8_BAR;
    }
    for (;;) {
        const bool has_next = S.next(ui + 1, nxt);
        const char* nA = has_next ? (const char*)g.A + (size_t)nxt.pm * tstep : cA; const char* nB = has_next ? (const char*)g.Bt + (size_t)nxt.pn * tstep : cB;
        for (int t = 0; t < nt; t += 2) {
            const bool last = (t == nt - 2);
            const char* a1 = cA + (size_t)(t + 1) * kstep;
            const char* a2 = last ? nA : cA + (size_t)(t + 2) * kstep; const char* b2 = last ? nB : cB + (size_t)(t + 2) * kstep;
            const char* a3 = a2 + kstep; const char* b3 = b2 + kstep;
            if (last && has_next) S.a_ready(nxt);
            if constexpr (SP2) {
            PG8_LDB(B0, 0, 0); PG8_LDB(B1, 0, 1); PG8_SCHED; PG8_LDA(At, 0, 0); PG8_STAGE(PG8_SA(1, 1), a1 + hstep, voffA);
            PG8_WAIT_V(8); PG8_WAIT_L(0); PG8_BAR; PG8_MMA(0, 0, At, B0); PG8_MMA(0, 1, At, B1); PG8_BAR; PG8_SCHED;
            PG8_LDA(At, 0, 1); PG8_STAGE(PG8_SB(0, 0), b2, voffB); PG8_STAGE(PG8_SB(0, 1), b2 + hstep, voffB); PG8_STAGE(PG8_SA(0, 0), a2, voffA);
            PG8_WAIT_V(8); PG8_WAIT_L(0); PG8_BAR; PG8_MMA(1, 0, At, B0); PG8_MMA(1, 1, At, B1); PG8_BAR; PG8_SCHED;
            PG8_LDB(B0, 1, 0); PG8_LDB(B1, 1, 1); PG8_SCHED; PG8_LDA(At, 1, 0); PG8_STAGE(PG8_SA(0, 1), a2 + hstep, voffA);
            PG8_WAIT_V(8); PG8_WAIT_L(0); PG8_BAR; PG8_MMA(0, 0, At, B0); PG8_MMA(0, 1, At, B1); PG8_BAR; PG8_SCHED;
            PG8_LDA(At, 1, 1); PG8_STAGE(PG8_SB(1, 0), b3, voffB); PG8_STAGE(PG8_SB(1, 1), b3 + hstep, voffB); PG8_STAGE(PG8_SA(1, 0), a3, voffA);
            PG8_WAIT_V(8); PG8_WAIT_L(0); PG8_BAR; PG8_MMA(1, 0, At, B0); PG8_MMA(1, 1, At, B1); PG8_BAR; PG8_SCHED;
            } else {
            PG8_LDB(B0, 0, 0); PG8_SCHED; PG8_LDA(At, 0, 0); PG8_STAGE(PG8_SA(1, 1), a1 + hstep, voffA);
            PG8_WAIT_L(8); PG8_BAR; PG8_WAIT_L(0); PG8_MMA(0, 0, At, B0); PG8_BAR; PG8_SCHED;
            PG8_LDB(B1, 0, 1); PG8_STAGE(PG8_SB(0, 0), b2, voffB);
            PG8_BAR; PG8_WAIT_L(0); PG8_MMA(0, 1, At, B1); PG8_BAR;
            PG8_LDA(At, 0, 1); PG8_STAGE(PG8_SA(0, 0), a2, voffA);
            PG8_BAR; PG8_WAIT_L(0); PG8_MMA(1, 0, At, B0); PG8_BAR; PG8_SCHED;
            PG8_STAGE(PG8_SB(0, 1), b2 + hstep, voffB);
            PG8_WAIT_V(6); PG8_BAR; PG8_MMA(1, 1, At, B1); PG8_BAR;
            PG8_LDB(B0, 1, 0); PG8_SCHED; PG8_LDA(At, 1, 0); PG8_STAGE(PG8_SA(0, 1), a2 + hstep, voffA);
            PG8_WAIT_L(8); PG8_BAR; PG8_WAIT_L(0); PG8_MMA(0, 0, At, B0); PG8_BAR; PG8_SCHED;
            PG8_LDB(B1, 1, 1); PG8_STAGE(PG8_SB(1, 0), b3, voffB);
            PG8_BAR; PG8_WAIT_L(0); PG8_MMA(0, 1, At, B1); PG8_BAR;
            PG8_LDA(At, 1, 1); PG8_STAGE(PG8_SA(1, 0), a3, voffA);
            PG8_BAR; PG8_WAIT_L(0); PG8_MMA(1, 0, At, B0); PG8_BAR; PG8_SCHED;
            PG8_STAGE(PG8_SB(1, 1), b3 + hstep, voffB);
            PG8_WAIT_V(6); PG8_BAR; PG8_MMA(1, 1, At, B1); PG8_BAR;
            }
        }
        if constexpr (ALIGN_EPI) { if (wr == 0) PG8_BAR; }
        if constexpr (!Epi::AFTER_DRAIN) { E(acc, cur, wr, wc, fr, fq); S.done(cur); }
        if (!has_next) break;
#pragma unroll
        for (int a = 0; a < 2; ++a)
#pragma unroll
            for (int b = 0; b < 2; ++b)
#pragma unroll
                for (int m = 0; m < 4; ++m)
#pragma unroll
                    for (int n = 0; n < 2; ++n) acc[a][b][m][n] = (f32x4){0.f, 0.f, 0.f, 0.f};
        cur = nxt; cA = nA; cB = nB; ++ui;
        if constexpr (ALIGN_EPI) { if (wr == 1) PG8_BAR; }
    }
    PG8_WAIT_V(0);
    if constexpr (!ALIGN_EPI) { if (wr == 0) PG8_BAR; }
    PG8_BAR;
    if constexpr (Epi::AFTER_DRAIN) { E.fused(acc, cur, wr, wc, fr, fq, lds, wid, lane); S.done(cur); }
#undef PG8_SA
#undef PG8_SB
#undef PG8_STAGE
#undef PG8_LDA
#undef PG8_LDB
#undef PG8_MMA
#undef PG8_WAIT_V
#undef PG8_WAIT_L
#undef PG8_BAR
#undef PG8_SCHED
}
}

#ifndef PG8_SP2
#define PG8_SP2 true
#endif
#ifndef PG8_ALIGN
#define PG8_ALIGN true
#endif
#ifndef MK_N_LAUNCHES
#define MK_N_LAUNCHES 1
#endif
constexpr int NWAVES = 8;
constexpr int NPHASES = 8;
constexpr int N_LAUNCHES = MK_N_LAUNCHES;

constexpr int NB = 32, SEQ = 2048, T = NB * SEQ, D = 1024, DIN = 3584;
constexpr int PC_C = 0, PC_H = 512, PC_B = 1024, PC_Q = 1536, PC_F = 2048, PC_V = 2560, PC_G = 3072;
constexpr int NEXP = 16384;
constexpr float EPS = 1e-6f;
constexpr float PEER_SU = 640.0f, PEER_SV = 64.0f;

constexpr size_t MiB = 1u << 20;
constexpr size_t WS_CTL = 0, CTL_ZERO_BYTES = 1 * MiB;
constexpr size_t WS_W1T = 2 * MiB, WS_WOT = 10 * MiB, WS_WQT = 12 * MiB, WS_RS1 = 16 * MiB, WS_SS2 = 17 * MiB;
constexpr size_t WS_KEYB = 18 * MiB;
constexpr size_t WS_U16 = 32 * MiB, WS_V16 = 64 * MiB, WS_EXP = 96 * MiB;
constexpr size_t WS_XB = 128 * MiB;
constexpr size_t WS_X1 = 256 * MiB;
constexpr size_t WS_PROJ = 384 * MiB;
constexpr size_t WS_F = 832 * MiB;
constexpr size_t WS_END = 960 * MiB;
constexpr int CW_BAR = 4096;

constexpr int RING_OFF = 0, RING_BYTES = 131072;
constexpr int LDSCTL_OFF = RING_BYTES, MISC_OFF = LDSCTL_OFF + 320;
constexpr int LDS_BYTES = 147456;

#define GAS __attribute__((address_space(1)))
#define LAS __attribute__((address_space(3)))
typedef unsigned short bf16;
typedef unsigned v4u __attribute__((ext_vector_type(4)));
typedef unsigned v2u __attribute__((ext_vector_type(2)));
typedef float f32x4 __attribute__((ext_vector_type(4)));
typedef float f32x2 __attribute__((ext_vector_type(2)));
typedef _Float16 h2_t __attribute__((ext_vector_type(2)));
typedef GAS unsigned gu32;
#define RLX_AGENT __ATOMIC_RELAXED, __HIP_MEMORY_SCOPE_AGENT
#define LDS_WAIT() asm volatile("s_waitcnt lgkmcnt(0)" ::: "memory")
#define VM_WAIT() asm volatile("s_waitcnt vmcnt(0)" ::: "memory")
__device__ __forceinline__ unsigned f2bf(float f) { unsigned u = __builtin_bit_cast(unsigned, f); return (u + 0x7fffu + ((u >> 16) & 1u)) >> 16; }
__device__ __forceinline__ unsigned pk2(float lo, float hi) { return f2bf(lo) | (f2bf(hi) << 16); }
__device__ __forceinline__ float bf_lo(unsigned w) { return __builtin_bit_cast(float, w << 16); }
__device__ __forceinline__ float bf_hi(unsigned w) { return __builtin_bit_cast(float, w & 0xffff0000u); }
__device__ __forceinline__ float bf1(bf16 v) { return __builtin_bit_cast(float, (unsigned)v << 16); }
__device__ __forceinline__ unsigned pkh2(float lo, float hi) { f32x2 v = {lo, hi}; h2_t h = __builtin_convertvector(v, h2_t); return __builtin_bit_cast(unsigned, h); }
__device__ __forceinline__ h2_t h2_of(unsigned w) { return __builtin_bit_cast(h2_t, w); }
__device__ __forceinline__ float swap32_add(float a, float b) { const v2u r = __builtin_amdgcn_permlane32_swap(__builtin_bit_cast(unsigned, a), __builtin_bit_cast(unsigned, b), false, false);
    const unsigned rx = r.x, ry = r.y; return __builtin_bit_cast(float, rx) + __builtin_bit_cast(float, ry); }
__device__ __forceinline__ float swap16_add(float a, float b) { const v2u r = __builtin_amdgcn_permlane16_swap(__builtin_bit_cast(unsigned, a), __builtin_bit_cast(unsigned, b), false, false);
    const unsigned rx = r.x, ry = r.y; return __builtin_bit_cast(float, rx) + __builtin_bit_cast(float, ry); }
template <int CTRL> __device__ __forceinline__ float dpp_f(float v) { return __builtin_bit_cast(float, __builtin_amdgcn_update_dpp(0, __builtin_bit_cast(int, v), CTRL, 0xF, 0xF, false)); }
template <int CTRL> __device__ __forceinline__ unsigned dpp_u(unsigned v) { return (unsigned)__builtin_amdgcn_update_dpp(0, (int)v, CTRL, 0xF, 0xF, false); }
__device__ __forceinline__ float wave_sum(float v) {
    v += dpp_f<0xB1>(v); v += dpp_f<0x4E>(v); v += dpp_f<0x124>(v); v += dpp_f<0x128>(v);
    v = swap16_add(v, v); v = swap32_add(v, v);
    return v;
}
typedef float f32x16 __attribute__((ext_vector_type(16)));
typedef __bf16 bf16x2_t __attribute__((ext_vector_type(2)));
__device__ __forceinline__ unsigned cvtpk(float lo, float hi) { f32x2 v = {lo, hi}; bf16x2_t b = __builtin_convertvector(v, bf16x2_t); return __builtin_bit_cast(unsigned, b); }
__device__ __forceinline__ pg8::bf16x8 pack8(const f32x16& x, int s) {
    v4u p; p.x = cvtpk(x[8 * s], x[8 * s + 1]); p.y = cvtpk(x[8 * s + 2], x[8 * s + 3]); p.z = cvtpk(x[8 * s + 4], x[8 * s + 5]); p.w = cvtpk(x[8 * s + 6], x[8 * s + 7]);
    return __builtin_bit_cast(pg8::bf16x8, p); }
__device__ __forceinline__ void ce_desc(unsigned& a, unsigned& b) { const unsigned mx = a > b ? a : b, mn = a > b ? b : a; a = mx; b = mn; }
__device__ __forceinline__ void sort16_desc(unsigned (&a)[16]) {
#pragma unroll
    for (int k = 2; k <= 16; k <<= 1)
#pragma unroll
        for (int j = k >> 1; j > 0; j >>= 1)
#pragma unroll
            for (int i = 0; i < 16; ++i) { const int l = i ^ j; if (l > i) { if ((i & k) == 0) ce_desc(a[i], a[l]); else ce_desc(a[l], a[i]); } }
}
__device__ __forceinline__ void merge16_desc(unsigned (&a)[16], const unsigned (&b)[16]) {
#pragma unroll
    for (int i = 0; i < 16; ++i) a[i] = a[i] > b[15 - i] ? a[i] : b[15 - i];
#pragma unroll
    for (int j = 8; j > 0; j >>= 1)
#pragma unroll
        for (int i = 0; i < 16; ++i) { const int l = i ^ j; if (l > i) ce_desc(a[i], a[l]); }
}
__device__ __forceinline__ float unkey(unsigned a) { a = (a & 0x80000000u) ? (a & 0x7FFFFFFFu) : ~a; return __builtin_bit_cast(float, a); }
__device__ __forceinline__ unsigned ckey(float s, int flat) { unsigned u = __builtin_bit_cast(unsigned, s); u ^= (unsigned)((int)u >> 31) | 0x80000000u; return (u & ~0xFFu) | (unsigned)(255 - flat); }
template <int J> __device__ __forceinline__ unsigned xor_lane(unsigned x, int lane) {
    if (J == 1) return dpp_u<0xB1>(x);
    if (J == 2) return dpp_u<0x4E>(x);
    if (J == 8) return dpp_u<0x128>(x);
    if (J == 16) { const v2u r = __builtin_amdgcn_permlane16_swap(x, x, false, false); const unsigned rx = r.x, ry = r.y; return (lane & 16) ? rx : ry; }
    if (J == 32) { const v2u r = __builtin_amdgcn_permlane32_swap(x, x, false, false); const unsigned rx = r.x, ry = r.y; return (lane & 32) ? rx : ry; }
    return (unsigned)__shfl_xor((int)x, J);
}
template <int K, int J, int N> __device__ __forceinline__ void sort128_stage(unsigned (&e)[N][2], int lane) {
#pragma unroll
    for (int t = 0; t < N; ++t) {
        if (J == 64) { const unsigned mn = e[t][0] < e[t][1] ? e[t][0] : e[t][1], mx = e[t][0] < e[t][1] ? e[t][1] : e[t][0]; e[t][0] = mn; e[t][1] = mx; }
        else {
            const unsigned p0 = xor_lane<J>(e[t][0], lane), p1 = xor_lane<J>(e[t][1], lane);
            const bool lower = (lane & J) == 0;
            const bool up0 = (K >= 64) ? true : ((lane & K) == 0);
            const bool up1 = (K == 128) ? true : (K == 64 ? false : ((lane & K) == 0));
            const unsigned mn0 = e[t][0] < p0 ? e[t][0] : p0, mx0 = e[t][0] < p0 ? p0 : e[t][0], mn1 = e[t][1] < p1 ? e[t][1] : p1, mx1 = e[t][1] < p1 ? p1 : e[t][1];
            e[t][0] = (lower == up0) ? mn0 : mx0; e[t][1] = (lower == up1) ? mn1 : mx1;
        }
    }
}
template <int N> __device__ __forceinline__ void sort128_asc(unsigned (&e)[N][2], int lane) {
#define S_(K, J) sort128_stage<K, J, N>(e, lane)
    S_(2, 1); S_(4, 2); S_(4, 1); S_(8, 4); S_(8, 2); S_(8, 1); S_(16, 8); S_(16, 4); S_(16, 2); S_(16, 1);
    S_(32, 16); S_(32, 8); S_(32, 4); S_(32, 2); S_(32, 1); S_(64, 32); S_(64, 16); S_(64, 8); S_(64, 4); S_(64, 2); S_(64, 1);
    S_(128, 64); S_(128, 32); S_(128, 16); S_(128, 8); S_(128, 4); S_(128, 2); S_(128, 1);
#undef S_
}
__device__ __forceinline__ float wave_max(float v) {
    v = fmaxf(v, dpp_f<0xB1>(v)); v = fmaxf(v, dpp_f<0x4E>(v)); v = fmaxf(v, dpp_f<0x124>(v)); v = fmaxf(v, dpp_f<0x128>(v));
    { const v2u r = __builtin_amdgcn_permlane16_swap(__builtin_bit_cast(unsigned, v), __builtin_bit_cast(unsigned, v), false, false); const unsigned rx = r.x, ry = r.y; v = fmaxf(__builtin_bit_cast(float, rx), __builtin_bit_cast(float, ry)); }
    { const v2u r = __builtin_amdgcn_permlane32_swap(__builtin_bit_cast(unsigned, v), __builtin_bit_cast(unsigned, v), false, false); const unsigned rx = r.x, ry = r.y; v = fmaxf(__builtin_bit_cast(float, rx), __builtin_bit_cast(float, ry)); }
    return v;
}
__device__ __forceinline__ int swap32_addi(int a, int b) { const v2u r = __builtin_amdgcn_permlane32_swap((unsigned)a, (unsigned)b, false, false); const unsigned rx = r.x, ry = r.y; return (int)(rx + ry); }
__device__ __forceinline__ int swap16_addi(int a, int b) { const v2u r = __builtin_amdgcn_permlane16_swap((unsigned)a, (unsigned)b, false, false); const unsigned rx = r.x, ry = r.y; return (int)(rx + ry); }
__device__ __forceinline__ int reduce16i(const int (&p)[16], int lane) {
    int q[8], r[4], u[2];
    const bool b3 = (lane & 8) != 0, b2 = (lane & 4) != 0;
#pragma unroll
    for (int i = 0; i < 8; ++i) q[i] = swap32_addi(p[2 * i], p[2 * i + 1]);
#pragma unroll
    for (int i = 0; i < 4; ++i) r[i] = swap16_addi(q[2 * i], q[2 * i + 1]);
#pragma unroll
    for (int i = 0; i < 2; ++i) { const int keep = b3 ? r[2 * i + 1] : r[2 * i], send = b3 ? r[2 * i] : r[2 * i + 1]; u[i] = keep + (int)dpp_u<0x128>((unsigned)send); }
    const int keep = b2 ? u[1] : u[0], send = b2 ? u[0] : u[1];
    int v = keep + __shfl_xor(send, 4);
    v += (int)dpp_u<0x4E>((unsigned)v); v += (int)dpp_u<0xB1>((unsigned)v);
    return v;
}
__device__ __forceinline__ float reduce16(const float (&p)[16], int lane) {
    float q[8], r[4], u[2];
    const bool b3 = (lane & 8) != 0, b2 = (lane & 4) != 0;
#pragma unroll
    for (int i = 0; i < 8; ++i) q[i] = swap32_add(p[2 * i], p[2 * i + 1]);
#pragma unroll
    for (int i = 0; i < 4; ++i) r[i] = swap16_add(q[2 * i], q[2 * i + 1]);
#pragma unroll
    for (int i = 0; i < 2; ++i) { const float keep = b3 ? r[2 * i + 1] : r[2 * i], send = b3 ? r[2 * i] : r[2 * i + 1]; u[i] = keep + dpp_f<0x128>(send); }
    const float keep = b2 ? u[1] : u[0], send = b2 ? u[0] : u[1];
    float v = keep + __shfl_xor(send, 4);
    v += dpp_f<0x4E>(v);
    v += dpp_f<0xB1>(v);
    return v;
}
__device__ __forceinline__ int swap23(int k) { return (k & ~12) | ((k & 4) << 1) | ((k & 8) >> 1); }
__device__ __forceinline__ float sigmoidf_(float x) { return 1.0f / (1.0f + __expf(-x)); }

#define XB_TMO      128
#define XB_XCNT(j)  (256  + 64 * (j))
#define XB_XSUB(j)  (1280 + 64 * (j))
#define XB_XGEN(j)  (2304 + 64 * (j))
#define XB_TOP      3328
#define XB_TOPGEN   3392
#define XCD_BAR_WORDS 3456
#define XB_SPIN_CAP (1u << 18)

__device__ __forceinline__ unsigned xb_ld(unsigned* p)              { return __hip_atomic_load(p, __ATOMIC_RELAXED, __HIP_MEMORY_SCOPE_AGENT); }
__device__ __forceinline__ unsigned xb_add(unsigned* p, unsigned v) { return __hip_atomic_fetch_add(p, v, __ATOMIC_RELAXED, __HIP_MEMORY_SCOPE_AGENT); }
__device__ __forceinline__ unsigned xb_xcc_id() { return (unsigned)__builtin_amdgcn_s_getreg((3 << 11) | 20) & 0xFu; }
#define XB_SPIN(cond, bar) do { unsigned _sp = 0; while (cond) { __builtin_amdgcn_s_sleep(1); \
    if ((++_sp & 255u) == 0u) { if (xb_ld(&(bar)[XB_TMO])) break; if (_sp > XB_SPIN_CAP) { atomicAdd(&(bar)[XB_TMO], 1u); break; } } } } while (0)

struct XcdBarrier {
    unsigned* bar; unsigned x;
    volatile LAS unsigned* st;
};

__device__ __forceinline__ XcdBarrier xcd_barrier_post(unsigned* bar, volatile LAS unsigned* st) {
    XcdBarrier b; b.bar = bar; b.x = xb_xcc_id(); b.st = st;
    if (threadIdx.x == 0) (void)xb_add(&bar[XB_XCNT(b.x)], 1u);
    return b;
}
__device__ __forceinline__ void xcd_barrier_complete(unsigned* bar, unsigned x, unsigned& nloc, unsigned& nx) {
    const unsigned G = gridDim.x * gridDim.y * gridDim.z;
    unsigned sum, cnt, mine, sp = 0u;
    for (;;) {
        sum = 0u; cnt = 0u; mine = 0u;
#pragma unroll
        for (unsigned j = 0; j < 16; ++j) { const unsigned c = xb_ld(&bar[XB_XCNT(j)]); sum += c; cnt += (c > 0u) ? 1u : 0u; mine = (j == x) ? c : mine; }
        if (sum == G) break;
        __builtin_amdgcn_s_sleep(1);
        if ((++sp & 255u) == 0u) { if (xb_ld(&bar[XB_TMO])) break; if (sp > XB_SPIN_CAP) { atomicAdd(&bar[XB_TMO], 1u); break; } }
    }
    nloc = mine > 0u ? mine : 1u; nx = cnt > 0u ? cnt : 1u;
}

__device__ __forceinline__ void xcd_barrier(const XcdBarrier& b) {
    asm volatile("s_waitcnt vmcnt(0)" ::: "memory");
    __syncthreads();
    if (threadIdx.x == 0) {
        unsigned* bar = b.bar;
        __builtin_amdgcn_s_waitcnt(0);
        unsigned nloc = b.st[0], nx = b.st[1];
        if (nloc == 0u) { xcd_barrier_complete(bar, b.x, nloc, nx); b.st[0] = nloc; b.st[1] = nx; }
        const unsigned old = xb_add(&bar[XB_XSUB(b.x)], 1u);
        const unsigned gen = old / nloc;
        if (old + 1u == (gen + 1u) * nloc) {
            __builtin_amdgcn_fence(__ATOMIC_RELEASE, "agent");
            asm volatile("s_waitcnt vmcnt(0)" ::: "memory");
            const unsigned og = xb_add(&bar[XB_TOP], 1u);
            const unsigned tg = og / nx;
            if (og + 1u == (tg + 1u) * nx) xb_add(&bar[XB_TOPGEN], 1u);
            else XB_SPIN(xb_ld(&bar[XB_TOPGEN]) == tg, bar);
            __builtin_amdgcn_fence(__ATOMIC_ACQUIRE, "agent");
            xb_add(&bar[XB_XGEN(b.x)], 1u);
            asm volatile("s_waitcnt vmcnt(0)" ::: "memory");
        } else {
            XB_SPIN(xb_ld(&bar[XB_XGEN(b.x)]) == gen, bar);
            __builtin_amdgcn_fence(__ATOMIC_ACQUIRE, "agent");
            asm volatile("s_waitcnt vmcnt(0)" ::: "memory");
        }
    }
    __syncthreads();
}


__device__ __forceinline__ void p0_transpose_item(const float* W, int K, int N, const float* gain, bf16* WT, LAS float* scr, int item, int lane) {
    const int nblk = N / 32, kb = item / nblk, nb = item % nblk, k0 = 64 * kb, n0 = 32 * nb;
#pragma unroll 8
    for (int i = 0; i < 32; ++i) { const int kk = 2 * i + (lane >> 5); const float g = gain ? gain[k0 + kk] : 1.0f; scr[kk * 33 + (lane & 31)] = W[(size_t)(k0 + kk) * N + n0 + (lane & 31)] * g; }
    LDS_WAIT(); asm volatile("" ::: "memory");
    const int c = lane & 7;
#pragma unroll
    for (int j = 0; j < 4; ++j) { const int n = (lane >> 3) + 8 * j; const LAS float* s = scr + (8 * c) * 33 + n;
        v4u o; o.x = pk2(s[0 * 33], s[1 * 33]); o.y = pk2(s[2 * 33], s[3 * 33]); o.z = pk2(s[4 * 33], s[5 * 33]); o.w = pk2(s[6 * 33], s[7 * 33]);
        *(GAS v4u*)(WT + (size_t)(n0 + n) * K + k0 + 8 * c) = o; }
    LDS_WAIT(); asm volatile("" ::: "memory");
}

struct Args { const float* in[14]; float* out; unsigned char* ws; int ph_lo, ph_hi, li, pad; };

__global__ void __launch_bounds__(NWAVES * 64, 2) hymba_fwd(Args args) {
    extern __shared__ __attribute__((aligned(16))) unsigned char lds_raw[];
    LAS unsigned char* lds = (LAS unsigned char*)lds_raw;
    volatile LAS unsigned* MISC = (volatile LAS unsigned*)(lds + MISC_OFF);
    const int tid = threadIdx.x, lane = tid & 63, wave = __builtin_amdgcn_readfirstlane(tid >> 6);
    const int G = gridDim.x;
    const int gw = (int)blockIdx.x * NWAVES + wave, NGW = G * NWAVES;
    unsigned char* ws = args.ws;
    gu32* ctl = (gu32*)(ws + WS_CTL);
    const float* x = args.in[0]; const float* norm_mix = args.in[1]; const float* w_in = args.in[2]; const float* conv_w = args.in[3]; const float* conv_gain = args.in[4];
    const float* hg_lb = args.in[5]; const float* hg_gain = args.in[6]; const float* w_out = args.in[7]; const float* norm_ffn = args.in[8]; const float* peer_wq = args.in[9];
    const float* peer_keys = args.in[10]; const float* peer_u = args.in[11]; const float* peer_v = args.in[12]; const float* norm_f = args.in[13];
    float* out = args.out;
    bf16* W1T = (bf16*)(ws + WS_W1T); bf16* WOT = (bf16*)(ws + WS_WOT); bf16* WQT = (bf16*)(ws + WS_WQT);
    float* RS1 = (float*)(ws + WS_RS1); float* SS2 = (float*)(ws + WS_SS2);
    unsigned char* U8 = ws + WS_U16; unsigned char* V8 = ws + WS_V16; unsigned* EXPT = (unsigned*)(ws + WS_EXP); bf16* KEYB = (bf16*)(ws + WS_KEYB);
    bf16* XB = (bf16*)(ws + WS_XB); bf16* MIX = (bf16*)(ws + WS_XB); bf16* X1 = (bf16*)(ws + WS_X1);
    bf16* PROJ = (bf16*)(ws + WS_PROJ); bf16* QB = (bf16*)(ws + WS_PROJ); float* DEC = (float*)(ws + WS_F); bf16* KDT = (bf16*)(ws + WS_X1); bf16* VTT = (bf16*)(ws + WS_X1 + 64 * MiB);

    for (int u = tid; u < (LDS_BYTES - LDSCTL_OFF) / 4; u += NWAVES * 64) ((LAS unsigned*)(lds + LDSCTL_OFF))[u] = 0u;
    __syncthreads();
    XcdBarrier bar; bar.bar = (unsigned*)(ctl + CW_BAR); bar.x = 0; bar.st = nullptr;
    if (N_LAUNCHES == 1) bar = xcd_barrier_post((unsigned*)(ctl + CW_BAR), MISC + 8);
#define GRID_BAR() do { if (N_LAUNCHES == 1) xcd_barrier(bar); } while (0)
    const int lo = args.ph_lo, hi = args.ph_hi;
#define IN(k) (lo <= (k) && (k) < hi)
#define BOTH(k) (IN(k) && IN((k) + 1))

    if (IN(0)) {
        LAS float* scr = (LAS float*)(lds + RING_OFF + wave * 16384);
        constexpr int I_1 = (D / 64) * (DIN / 32), I_O = (D / 64) * (D / 32), I_Q = (D / 64) * (2048 / 32);
        for (int it = gw; it < I_1 + I_O + I_Q; it += NGW) {
            int r = it;
            if (r < I_1) { p0_transpose_item(w_in, D, DIN, norm_mix, W1T, scr, r, lane); continue; } r -= I_1;
            if (r < I_O) { p0_transpose_item(w_out, D, D, nullptr, WOT, scr, r, lane); continue; } r -= I_O;
            p0_transpose_item(peer_wq, D, 2048, norm_ffn, WQT, scr, r, lane);
        }
        for (int m = gw; m < T; m += NGW) {
            const GAS f32x4* xr = (const GAS f32x4*)(x + (size_t)m * D) + lane; f32x4 v[4]; float s = 0.f;
#pragma unroll
            for (int j = 0; j < 4; ++j) { v[j] = xr[64 * j]; s += (v[j].x * v[j].x + v[j].y * v[j].y) + (v[j].z * v[j].z + v[j].w * v[j].w); }
            s = wave_sum(s);
            if (lane == 0) RS1[m] = 1.0f / sqrtf(s * (1.0f / D) + EPS);
            GAS unsigned long long* o8 = (GAS unsigned long long*)(XB + (size_t)m * D) + lane;
#pragma unroll
            for (int j = 0; j < 4; ++j) o8[64 * j] = (unsigned long long)pk2(v[j].x, v[j].y) | ((unsigned long long)pk2(v[j].z, v[j].w) << 32);
        }
        for (int r = gw; r < 2 * NEXP; r += NGW) {
            const int tb = r / NEXP, e = r % NEXP; const float sc = tb ? PEER_SV : PEER_SU;
            const GAS f32x4* src = (const GAS f32x4*)((tb ? peer_v : peer_u) + (size_t)e * D);
            f32x4 v[4] = {src[2 * lane], src[2 * lane + 1], src[128 + 2 * lane], src[128 + 2 * lane + 1]};
            if (!tb) { const GAS f32x4* gp = (const GAS f32x4*)norm_ffn; v[0] = v[0] * gp[2 * lane]; v[1] = v[1] * gp[2 * lane + 1]; v[2] = v[2] * gp[128 + 2 * lane]; v[3] = v[3] * gp[128 + 2 * lane + 1]; }
            unsigned o[4];
#pragma unroll
            for (int j = 0; j < 4; ++j) { f32x4 w = v[j] * sc;
                if (tb) { w.x = fminf(fmaxf(w.x, -240.f), 240.f); w.y = fminf(fmaxf(w.y, -240.f), 240.f); w.z = fminf(fmaxf(w.z, -240.f), 240.f); w.w = fminf(fmaxf(w.w, -240.f), 240.f);
                    int pk = 0; pk = __builtin_amdgcn_cvt_pk_fp8_f32(w.x, w.y, pk, false); pk = __builtin_amdgcn_cvt_pk_fp8_f32(w.z, w.w, pk, true); o[j] = (unsigned)pk; }
                else { const int i0 = (int)rintf(fminf(fmaxf(w.x, -127.f), 127.f)), i1 = (int)rintf(fminf(fmaxf(w.y, -127.f), 127.f)), i2 = (int)rintf(fminf(fmaxf(w.z, -127.f), 127.f)), i3 = (int)rintf(fminf(fmaxf(w.w, -127.f), 127.f));
                    o[j] = ((unsigned)i0 & 0xFFu) | (((unsigned)i1 & 0xFFu) << 8) | (((unsigned)i2 & 0xFFu) << 16) | (((unsigned)i3 & 0xFFu) << 24); } }
            ((GAS v4u*)((tb ? V8 : U8) + (size_t)e * D))[lane] = (v4u){o[0], o[1], o[2], o[3]};
        }
        for (int i = (int)blockIdx.x * NWAVES * 64 + tid; i < T; i += G * NWAVES * 64) SS2[i] = 0.f;
        for (int i = (int)blockIdx.x * NWAVES * 64 + tid; i < 8 * 2 * 128 * 128 / 2; i += G * NWAVES * 64) ((GAS unsigned*)KEYB)[i] = pk2(peer_keys[2 * i], peer_keys[2 * i + 1]);
        if (BOTH(0)) GRID_BAR();
    }

    if (IN(1)) {
        pg8::Gemm g{XB, W1T, T, DIN, D}; pg8::StaticOrder S; S.init(T, DIN, G, (int)blockIdx.x);
        pg8::EpiScaleBf16<0> E{PROJ, DIN, RS1};
        pg8::gemm_phase<pg8::EpiScaleBf16<0>, pg8::StaticOrder, PG8_ALIGN, PG8_SP2>(lds + RING_OFF, g, S, E);
        if (BOTH(1)) GRID_BAR();
    }

    if (IN(2)) {
        for (int item = gw; item < NB * 64 * 4; item += NGW) {
            const int h = item & 3, n = (item >> 2) & 63, b = item >> 8;
            const size_t tok0 = (size_t)b * SEQ + n * 32;
            const int c0 = h * 128 + 2 * lane, cs = h * 128 + swap23(2 * lane);
            const float lb0 = 1.0f / (1.0f + __expf(hg_lb[512 + c0] - hg_lb[c0])), lb1 = 1.0f / (1.0f + __expf(hg_lb[512 + c0 + 1] - hg_lb[c0 + 1]));
            unsigned qw[32], fw[32], vw[32];
#pragma unroll
            for (int c = 0; c < 32; ++c) { const bf16* pr = PROJ + (tok0 + c) * DIN;
                qw[c] = *(const GAS unsigned*)(pr + PC_Q + c0); fw[c] = *(const GAS unsigned*)(pr + PC_F + c0); vw[c] = *(const GAS unsigned*)(pr + PC_V + c0); }
            float eG0 = 1.f, eG1 = 1.f;
            unsigned kd0[16], kd1[16], vv0[16], vv1[16];
#pragma unroll
            for (int i = 0; i < 16; ++i) { kd0[i] = 0u; kd1[i] = 0u; vv0[i] = 0u; vv1[i] = 0u; }
#pragma unroll
            for (int c = 0; c < 32; ++c) { bf16* pr = PROJ + (tok0 + c) * DIN;
                const float f0 = lb0 + (1.0f - lb0) * sigmoidf_(bf_lo(fw[c])), f1 = lb1 + (1.0f - lb1) * sigmoidf_(bf_hi(fw[c]));
                eG0 *= f0; eG1 *= f1;
                const float q0 = bf_lo(qw[c]), q1 = bf_hi(qw[c]);
                const float qd0 = q0 * sigmoidf_(q0) * 0.08838834764831845f * eG0, qd1 = q1 * sigmoidf_(q1) * 0.08838834764831845f * eG1;
                const float kv0 = (1.0f - f0) / eG0, kv1 = (1.0f - f1) / eG1;
                *(GAS unsigned*)(pr + PC_Q + cs) = pk2(qd0, qd1);
                const unsigned kp = pk2(kv0, kv1);
                *(GAS unsigned*)(pr + PC_F + cs) = kp;
                const int pp = swap23(c), sh = 16 * (pp & 1);
                kd0[pp >> 1] |= (kp & 0xffffu) << sh; kd1[pp >> 1] |= (kp >> 16) << sh;
                vv0[pp >> 1] |= (vw[c] & 0xffffu) << sh; vv1[pp >> 1] |= (vw[c] >> 16) << sh; }
            GAS v4u* kt = (GAS v4u*)(KDT + ((size_t)item * 128 + 2 * lane) * 32);
            GAS v4u* vt = (GAS v4u*)(VTT + ((size_t)item * 128 + 2 * lane) * 32);
#pragma unroll
            for (int i = 0; i < 4; ++i) { kt[i] = (v4u){kd0[4 * i], kd0[4 * i + 1], kd0[4 * i + 2], kd0[4 * i + 3]}; kt[4 + i] = (v4u){kd1[4 * i], kd1[4 * i + 1], kd1[4 * i + 2], kd1[4 * i + 3]};
                vt[i] = (v4u){vv0[4 * i], vv0[4 * i + 1], vv0[4 * i + 2], vv0[4 * i + 3]}; vt[4 + i] = (v4u){vv1[4 * i], vv1[4 * i + 1], vv1[4 * i + 2], vv1[4 * i + 3]}; }
            *(GAS f32x2*)(DEC + (size_t)item * 128 + 2 * lane) = (f32x2){eG0, eG1};
        }
        if (BOTH(2)) GRID_BAR();
    }

    if (IN(3)) {
        constexpr int BUFB = 33792, OB0 = 2 * BUFB;
        for (int it = (int)blockIdx.x; it < NB * 4; it += G) {
            const int b = it >> 2, h = it & 3;
            const int lt = tid & 255, r = lane & 31, hh = lane >> 5, sl = wave;
            v4u st[9];
#define SCAN_LOAD(n_) do { const size_t tk0 = (size_t)b * SEQ + (n_) * 32; const size_t itm = (size_t)((b * 64 + (n_)) * 4 + h); \
                _Pragma("unroll") for (int i = 0; i < 2; ++i) { const int q = lt + 256 * i, row = q >> 4, cc = q & 15; const bf16* pr = PROJ + (tk0 + row) * DIN + h * 128 + cc * 8; \
                    st[i] = *(const GAS v4u*)(pr + PC_Q); st[2 + i] = *(const GAS v4u*)(pr + PC_F); \
                    st[4 + i] = ((const GAS v4u*)(KDT + itm * 4096))[q]; st[6 + i] = ((const GAS v4u*)(VTT + itm * 4096))[q]; } \
                if (lt < 32) st[8] = ((const GAS v4u*)(DEC + itm * 128))[lt]; } while (0)
#define SCAN_COMMIT(n_) do { LAS unsigned char* Bf = lds + RING_OFF + ((n_) & 1) * BUFB; \
                _Pragma("unroll") for (int i = 0; i < 2; ++i) { const int q = lt + 256 * i, row = q >> 4, cc = q & 15, k = q >> 2, c4 = q & 3; \
                    *(LAS v4u*)(Bf + row * 256 + ((cc ^ (row & 15)) * 16)) = st[i]; *(LAS v4u*)(Bf + 8192 + row * 256 + ((cc ^ (row & 15)) * 16)) = st[2 + i]; \
                    *(LAS v4u*)(Bf + 16384 + k * 64 + ((c4 ^ ((k >> 2) & 3)) * 16)) = st[4 + i]; *(LAS v4u*)(Bf + 24576 + k * 64 + ((c4 ^ ((k >> 2) & 3)) * 16)) = st[6 + i]; } \
                if (lt < 32) *(LAS v4u*)(Bf + 32768 + lt * 16) = st[8]; } while (0)
#define SCAN_POST(n_) do { const int pos = lt >> 3, vg = lt & 7; const LAS f32x4* ob = (const LAS f32x4*)(lds + RING_OFF + OB0 + ((n_) & 1) * 16384 + (pos * 128 + vg * 16) * 4); \
                const f32x4 o0 = ob[0], o1 = ob[1], o2 = ob[2], o3 = ob[3]; \
                float ss = (o0.x * o0.x + o0.y * o0.y) + (o0.z * o0.z + o0.w * o0.w) + (o1.x * o1.x + o1.y * o1.y) + (o1.z * o1.z + o1.w * o1.w) \
                         + (o2.x * o2.x + o2.y * o2.y) + (o2.z * o2.z + o2.w * o2.w) + (o3.x * o3.x + o3.y * o3.y) + (o3.z * o3.z + o3.w * o3.w); \
                ss += dpp_f<0xB1>(ss); ss += dpp_f<0x4E>(ss); ss += dpp_f<0x141>(ss);     \
                const float rr = 1.0f / sqrtf(ss * (1.0f / 128.0f) + EPS); \
                const size_t tk = (size_t)b * SEQ + (n_) * 32 + pos; const v4u g0 = gp0, g1 = gp1; \
                const float ov[16] = {o0.x, o0.y, o0.z, o0.w, o1.x, o1.y, o1.z, o1.w, o2.x, o2.y, o2.z, o2.w, o3.x, o3.y, o3.z, o3.w}; \
                const float gf[16] = {bf_lo(g0.x), bf_hi(g0.x), bf_lo(g0.y), bf_hi(g0.y), bf_lo(g0.z), bf_hi(g0.z), bf_lo(g0.w), bf_hi(g0.w), bf_lo(g1.x), bf_hi(g1.x), bf_lo(g1.y), bf_hi(g1.y), bf_lo(g1.z), bf_hi(g1.z), bf_lo(g1.w), bf_hi(g1.w)}; \
                float yv[16]; _Pragma("unroll") for (int i = 0; i < 16; ++i) yv[i] = ov[i] * rr * gnl[i] * (gf[i] * sigmoidf_(gf[i])); \
                GAS v4u* mp = (GAS v4u*)(MIX + tk * D + 512 + h * 128 + vg * 16); \
                mp[0] = (v4u){pk2(yv[0], yv[1]), pk2(yv[2], yv[3]), pk2(yv[4], yv[5]), pk2(yv[6], yv[7])}; mp[1] = (v4u){pk2(yv[8], yv[9]), pk2(yv[10], yv[11]), pk2(yv[12], yv[13]), pk2(yv[14], yv[15])}; } while (0)
#define SCAN_GLOAD(n_) do { const GAS v4u* gp = (const GAS v4u*)(PROJ + ((size_t)b * SEQ + (n_) * 32 + (lt >> 3)) * DIN + PC_G + h * 128 + (lt & 7) * 16); gq0 = gp[0]; gq1 = gp[1]; } while (0)
#define SCAN_BAR() do { asm volatile("s_waitcnt lgkmcnt(0)" ::: "memory"); __builtin_amdgcn_s_barrier(); asm volatile("" ::: "memory"); } while (0)
            if (wave >= 4) {
                v4u gp0 = {0u, 0u, 0u, 0u}, gp1 = {0u, 0u, 0u, 0u}, gq0, gq1;
                float gnl[16];
#pragma unroll
                for (int i = 0; i < 16; ++i) gnl[i] = hg_gain[(lt & 7) * 16 + i];
                SCAN_LOAD(0); SCAN_COMMIT(0);
                SCAN_BAR();
                for (int n = 0; n < 64; ++n) {
                    if (n + 1 < 64) SCAN_LOAD(n + 1);
                    SCAN_GLOAD(n);
                    if (n >= 1) SCAN_POST(n - 1);
                    if (n + 1 < 64) SCAN_COMMIT(n + 1);
                    gp0 = gq0; gp1 = gq1;
                    SCAN_BAR();
                }
                SCAN_POST(63);
                SCAN_BAR();
            } else {
                f32x16 S0, S1, S2, S3;
#pragma unroll
                for (int i = 0; i < 16; ++i) { S0[i] = 0.f; S1[i] = 0.f; S2[i] = 0.f; S3[i] = 0.f; }
                SCAN_BAR();
                for (int n = 0; n < 64; ++n) {
                    const LAS unsigned char* Bf = lds + RING_OFF + (n & 1) * BUFB;
                    pg8::bf16x8 qd[8], kd[8], vt[2], kt[4][2];
#pragma unroll
                    for (int ks = 0; ks < 8; ++ks) { const int off = r * 256 + (((2 * ks + hh) ^ (r & 15)) * 16); qd[ks] = *(const LAS pg8::bf16x8*)(Bf + off); kd[ks] = *(const LAS pg8::bf16x8*)(Bf + 8192 + off); }
#pragma unroll
                    for (int sp = 0; sp < 2; ++sp) { const int row = 32 * sl + r; vt[sp] = *(const LAS pg8::bf16x8*)(Bf + 24576 + row * 64 + (((2 * sp + hh) ^ ((row >> 2) & 3)) * 16)); }
#pragma unroll
                    for (int rt = 0; rt < 4; ++rt)
#pragma unroll
                        for (int sp = 0; sp < 2; ++sp) { const int row = 32 * rt + r; kt[rt][sp] = *(const LAS pg8::bf16x8*)(Bf + 16384 + row * 64 + (((2 * sp + hh) ^ ((row >> 2) & 3)) * 16)); }
                    asm volatile("s_waitcnt lgkmcnt(0)" ::: "memory");
                    f32x16 X, O;
#pragma unroll
                    for (int i = 0; i < 16; ++i) { X[i] = 0.f; O[i] = 0.f; }
                    O = __builtin_amdgcn_mfma_f32_32x32x16_bf16(qd[0], pack8(S0, 0), O, 0, 0, 0); O = __builtin_amdgcn_mfma_f32_32x32x16_bf16(qd[1], pack8(S0, 1), O, 0, 0, 0);
                    O = __builtin_amdgcn_mfma_f32_32x32x16_bf16(qd[2], pack8(S1, 0), O, 0, 0, 0); O = __builtin_amdgcn_mfma_f32_32x32x16_bf16(qd[3], pack8(S1, 1), O, 0, 0, 0);
                    O = __builtin_amdgcn_mfma_f32_32x32x16_bf16(qd[4], pack8(S2, 0), O, 0, 0, 0); O = __builtin_amdgcn_mfma_f32_32x32x16_bf16(qd[5], pack8(S2, 1), O, 0, 0, 0);
                    O = __builtin_amdgcn_mfma_f32_32x32x16_bf16(qd[6], pack8(S3, 0), O, 0, 0, 0); O = __builtin_amdgcn_mfma_f32_32x32x16_bf16(qd[7], pack8(S3, 1), O, 0, 0, 0);
#pragma unroll
                    for (int ks = 0; ks < 8; ++ks) X = __builtin_amdgcn_mfma_f32_32x32x16_bf16(kd[ks], qd[ks], X, 0, 0, 0);
#define SCAN_SUPD(Sx, rt_) do { Sx = __builtin_amdgcn_mfma_f32_32x32x16_bf16(kt[rt_][0], vt[0], Sx, 0, 0, 0); Sx = __builtin_amdgcn_mfma_f32_32x32x16_bf16(kt[rt_][1], vt[1], Sx, 0, 0, 0); \
                        _Pragma("unroll") for (int g = 0; g < 4; ++g) { const f32x4 dv = *(const LAS f32x4*)(Bf + 32768 + (32 * (rt_) + 8 * g + 4 * hh) * 4); \
                            Sx[4 * g] *= dv.x; Sx[4 * g + 1] *= dv.y; Sx[4 * g + 2] *= dv.z; Sx[4 * g + 3] *= dv.w; } } while (0)
                    SCAN_SUPD(S0, 0); SCAN_SUPD(S1, 1); SCAN_SUPD(S2, 2); SCAN_SUPD(S3, 3);
#pragma unroll
                    for (int i = 0; i < 16; ++i) { const int s_ = (i & 3) + 8 * (i >> 2) + 4 * hh; X[i] = (s_ <= r) ? X[i] : 0.f; }
                    O = __builtin_amdgcn_mfma_f32_32x32x16_bf16(pack8(X, 0), vt[0], O, 0, 0, 0); O = __builtin_amdgcn_mfma_f32_32x32x16_bf16(pack8(X, 1), vt[1], O, 0, 0, 0);
                    LAS float* ob = (LAS float*)(lds + RING_OFF + OB0 + (n & 1) * 16384);
#pragma unroll
                    for (int i = 0; i < 16; ++i) ob[((i & 3) + 8 * (i >> 2) + 4 * hh) * 128 + 32 * sl + r] = O[i];
                    SCAN_BAR();
                }
                SCAN_BAR();
            }
        }
        {
            const int cb = (G > NB * 4) ? (int)blockIdx.x - NB * 4 : (int)blockIdx.x, ncb = (G > NB * 4) ? G - NB * 4 : G;
            if (cb >= 0) for (int item = cb * NWAVES + wave; item < NB * 4 * 32; item += ncb * NWAVES) {
                const int seg = item & 31, gp = (item >> 5) & 3, b = item >> 7, c0 = gp * 128 + 2 * lane, t0 = seg * 64;
                const f32x2 w0 = *(const GAS f32x2*)(conv_w + c0), w1 = *(const GAS f32x2*)(conv_w + 512 + c0), w2 = *(const GAS f32x2*)(conv_w + 1024 + c0), gn = *(const GAS f32x2*)(conv_gain + c0);
                f32x2 u1 = {0.f, 0.f}, u2 = {0.f, 0.f};
                if (t0 > 0) { const bf16* p2 = PROJ + (size_t)(b * SEQ + t0 - 2) * DIN; const bf16* p1 = p2 + DIN;
                    const unsigned ca = *(const GAS unsigned*)(p2 + PC_C + c0), ha = *(const GAS unsigned*)(p2 + PC_H + c0), cbb = *(const GAS unsigned*)(p1 + PC_C + c0), hb = *(const GAS unsigned*)(p1 + PC_H + c0);
                    u2 = (f32x2){bf_lo(ca) * bf_lo(ha), bf_hi(ca) * bf_hi(ha)}; u1 = (f32x2){bf_lo(cbb) * bf_lo(hb), bf_hi(cbb) * bf_hi(hb)}; }
                for (int tb = t0; tb < t0 + 64; tb += 8) {
                    unsigned cw[8], hw[8], bw[8];
#pragma unroll
                    for (int i = 0; i < 8; ++i) { const bf16* pr = PROJ + ((size_t)b * SEQ + tb + i) * DIN; cw[i] = *(const GAS unsigned*)(pr + PC_C + c0); hw[i] = *(const GAS unsigned*)(pr + PC_H + c0); bw[i] = *(const GAS unsigned*)(pr + PC_B + c0); }
#pragma unroll
                    for (int i = 0; i < 8; ++i) { const f32x2 u = {bf_lo(cw[i]) * bf_lo(hw[i]), bf_hi(cw[i]) * bf_hi(hw[i])};
                        const f32x2 y = (f32x2){bf_lo(bw[i]), bf_hi(bw[i])} * (w0 * u2 + w1 * u1 + w2 * u);
                        float ss = y.x * y.x + y.y * y.y;
                        ss += dpp_f<0xB1>(ss); ss += dpp_f<0x4E>(ss); ss += dpp_f<0x124>(ss); ss += dpp_f<0x128>(ss); ss = swap16_add(ss, ss);
                        const float r = 1.0f / sqrtf(ss * (1.0f / 64.0f) + EPS);
                        *(GAS unsigned*)(MIX + ((size_t)b * SEQ + tb + i) * D + c0) = pk2(y.x * r * gn.x, y.y * r * gn.y); u2 = u1; u1 = u; }
                }
            }
        }
        if (BOTH(3)) GRID_BAR();
    }


    if (IN(4)) {
        pg8::Gemm g{MIX, WOT, T, D, D}; pg8::StaticOrder S; S.init(T, D, G, (int)blockIdx.x);
        pg8::EpiResid E{x, X1, SS2};
        pg8::gemm_phase<pg8::EpiResid, pg8::StaticOrder, PG8_ALIGN, PG8_SP2>(lds + RING_OFF, g, S, E);
        if (BOTH(4)) GRID_BAR();
    }

    if (IN(5)) {
        pg8::Gemm g{X1, WQT, T, 2048, D}; pg8::StaticOrder S; S.init(T, 2048, G, (int)blockIdx.x);
        pg8::EpiScaleBf16<1> E{QB, 2048, SS2};
        pg8::gemm_phase<pg8::EpiScaleBf16<1>, pg8::StaticOrder, PG8_ALIGN, PG8_SP2>(lds + RING_OFF, g, S, E);
        if (BOTH(5)) GRID_BAR();
    }

    if (IN(6)) {
        const int r = lane & 31, hh = lane >> 5;
        for (int item = gw; item < (T / 32) * 8; item += NGW) {
            const int h = item & 7, tok = (item >> 3) * 32 + r;
            unsigned L[2][16];
#pragma unroll
            for (int p = 0; p < 2; ++p) {
                pg8::bf16x8 qf[8];
                const GAS pg8::bf16x8* qp = (const GAS pg8::bf16x8*)(QB + (size_t)tok * 2048 + h * 256 + p * 128 + 8 * hh);
#pragma unroll
                for (int ks = 0; ks < 8; ++ks) qf[ks] = qp[2 * ks];
                const GAS pg8::bf16x8* kp = (const GAS pg8::bf16x8*)(KEYB + (size_t)((h * 2 + p) * 128 + r) * 128 + 8 * hh);
                unsigned best[16];
#pragma unroll
                for (int nt = 0; nt < 4; ++nt) {
                    f32x16 acc;
#pragma unroll
                    for (int i = 0; i < 16; ++i) acc[i] = 0.f;
                    const GAS pg8::bf16x8* kb = kp + nt * 512; asm volatile("" : "+v"(kb));
#pragma unroll
                    for (int ks = 0; ks < 8; ++ks) acc = __builtin_amdgcn_mfma_f32_32x32x16_bf16(kb[2 * ks], qf[ks], acc, 0, 0, 0);
                    unsigned cur[16];
#pragma unroll
                    for (int i = 0; i < 16; ++i) { const int n = 32 * nt + (i & 3) + 8 * (i >> 2) + 4 * hh;
                        const float av = acc[i]; unsigned u = __builtin_bit_cast(unsigned, av); u ^= (unsigned)((int)u >> 31) | 0x80000000u;
                        cur[i] = (u & ~0x7Fu) | (unsigned)(127 - n); }
                    sort16_desc(cur);
                    if (nt == 0) {
#pragma unroll
                        for (int i = 0; i < 16; ++i) best[i] = cur[i];
                    } else merge16_desc(best, cur);
                }
                unsigned o[16];
#pragma unroll
                for (int i = 0; i < 16; ++i) o[i] = (unsigned)__shfl_xor((int)best[i], 32);
                merge16_desc(best, o);
#pragma unroll
                for (int i = 0; i < 16; ++i) L[p][i] = best[i];
            }
            float v1[16], v2[16];
#pragma unroll
            for (int j = 0; j < 16; ++j) { v1[j] = unkey(L[0][j] & ~0x7Fu); v2[j] = unkey(L[1][j] & ~0x7Fu); }
            unsigned ct[16];
#pragma unroll
            for (int j = 0; j < 16; ++j) ct[j] = ckey(v1[0] + v2[j], j);
#pragma unroll
            for (int i = 1; i < 16; ++i)
#pragma unroll
                for (int j = 0; j < 16; ++j) if ((i + 1) * (j + 1) <= 16) {
                    unsigned key = ckey(v1[i] + v2[j], i * 16 + j);
#pragma unroll
                    for (int t = 0; t < 16; ++t) { const unsigned mx = ct[t] > key ? ct[t] : key; key = ct[t] > key ? key : ct[t]; ct[t] = mx; }
                }
            float den = 0.f, ex[16]; const float cmax = unkey(ct[0] & ~0xFFu);
#pragma unroll
            for (int t = 0; t < 16; ++t) { ex[t] = __expf(unkey(ct[t] & ~0xFFu) - cmax); den += ex[t]; }
            const float inv = 1.0f / den;
            unsigned b1[4], b2[4];
#pragma unroll
            for (int w = 0; w < 4; ++w) { b1[w] = (L[0][4 * w] & 0x7Fu) | ((L[0][4 * w + 1] & 0x7Fu) << 8) | ((L[0][4 * w + 2] & 0x7Fu) << 16) | ((L[0][4 * w + 3] & 0x7Fu) << 24);
                b2[w] = (L[1][4 * w] & 0x7Fu) | ((L[1][4 * w + 1] & 0x7Fu) << 8) | ((L[1][4 * w + 2] & 0x7Fu) << 16) | ((L[1][4 * w + 3] & 0x7Fu) << 24); }
            unsigned ent[8];
#pragma unroll
            for (int t = 0; t < 8; ++t) { const unsigned hm = 0u - (unsigned)hh;
                const unsigned ck = ct[t] ^ ((ct[t] ^ ct[8 + t]) & hm); const unsigned e0 = __builtin_bit_cast(unsigned, ex[t]), e1 = __builtin_bit_cast(unsigned, ex[8 + t]);
                const float gt = __builtin_bit_cast(float, e0 ^ ((e0 ^ e1) & hm)) * inv;
                const unsigned flat = 255u - (ck & 0xFFu), ii = flat >> 4, jj = flat & 15u;
                const unsigned w1 = (ii & 8u) ? ((ii & 4u) ? b1[3] : b1[2]) : ((ii & 4u) ? b1[1] : b1[0]), w2 = (jj & 8u) ? ((jj & 4u) ? b2[3] : b2[2]) : ((jj & 4u) ? b2[1] : b2[0]);
                const unsigned n1 = 127u - ((w1 >> (8u * (ii & 3u))) & 0x7Fu), n2 = 127u - ((w2 >> (8u * (jj & 3u))) & 0x7Fu);
                ent[t] = (n1 * 128u + n2) | (pkh2(gt, 0.f) << 16); }
            GAS v4u* ep = (GAS v4u*)(EXPT + (size_t)tok * 128 + h * 16 + 8 * hh);
            ep[0] = (v4u){ent[0], ent[1], ent[2], ent[3]}; ep[1] = (v4u){ent[4], ent[5], ent[6], ent[7]};
        }
        if (BOTH(6)) GRID_BAR();
    }


    if (IN(7)) {
        constexpr int NT = 4;
        unsigned pace_round = 0u;
        unsigned* pace_cnt = (unsigned*)(ctl + 16384) + 64 * bar.x;
        const unsigned pace_n = (N_LAUNCHES == 1) ? MISC[8] : 0u;
#define PEER_PACE() do { if (pace_n) { ++pace_round; __syncthreads(); if (tid == 0) { xb_add(pace_cnt, 1u); unsigned sp_ = 0; while (xb_ld(pace_cnt) < pace_n * pace_round && ++sp_ < 20000u) __builtin_amdgcn_s_sleep(1); } __syncthreads(); } } while (0)
        const unsigned srcl = (unsigned)(32 * (lane & 1) + 16 * ((lane >> 1) & 1)) << 2;
        for (int bt0 = 0; bt0 < T / NT; bt0 += NGW) {
            const int bt = (bt0 + gw < T / NT) ? bt0 + gw : bt0 + gw - NGW;
            const int tok0 = bt * NT;
            unsigned e[NT][2]; float rs2[NT];
#pragma unroll
            for (int t = 0; t < NT; ++t) { const unsigned r0 = EXPT[(size_t)(tok0 + t) * 128 + lane], r1 = EXPT[(size_t)(tok0 + t) * 128 + 64 + lane];
                e[t][0] = (r0 << 16) | (r0 >> 16); e[t][1] = (r1 << 16) | (r1 >> 16);
                rs2[t] = 1.0f / sqrtf(SS2[tok0 + t] * (1.0f / D) + EPS); }
            sort128_asc<NT>(e, lane);
            PEER_PACE();
            int ah[NT][2]; int hx[NT][4]; float xs[NT];
#pragma unroll
            for (int t = 0; t < NT; ++t) { const GAS v4u* xr = (const GAS v4u*)(X1 + (size_t)(tok0 + t) * D); const v4u xa = __builtin_nontemporal_load(xr + lane), xb = __builtin_nontemporal_load(xr + 64 + lane);
                const float xv[16] = {bf_lo(xa.x), bf_hi(xa.x), bf_lo(xa.y), bf_hi(xa.y), bf_lo(xa.z), bf_hi(xa.z), bf_lo(xa.w), bf_hi(xa.w), bf_lo(xb.x), bf_hi(xb.x), bf_lo(xb.y), bf_hi(xb.y), bf_lo(xb.z), bf_hi(xb.z), bf_lo(xb.w), bf_hi(xb.w)};
                float am = 0.f;
#pragma unroll
                for (int i = 0; i < 16; ++i) am = fmaxf(am, fabsf(xv[i]));
                am = fmaxf(wave_max(am), 1e-20f); const float sx = 127.0f / am; xs[t] = am * (1.0f / 127.0f);
#pragma unroll
                for (int w = 0; w < 4; ++w) { const int i0 = (int)rintf(xv[4 * w] * sx), i1 = (int)rintf(xv[4 * w + 1] * sx), i2 = (int)rintf(xv[4 * w + 2] * sx), i3 = (int)rintf(xv[4 * w + 3] * sx);
                    hx[t][w] = (int)(((unsigned)i0 & 0xFFu) | (((unsigned)i1 & 0xFFu) << 8) | (((unsigned)i2 & 0xFFu) << 16) | (((unsigned)i3 & 0xFFu) << 24)); }
                ah[t][0] = 0; ah[t][1] = 0; }
#define PEER_LOAD(buf, st_) do { _Pragma("unroll") for (int t = 0; t < NT; ++t) { const unsigned em_ = ((st_) & 16) ? 0xFFFFFFFFu : 0u; const unsigned esel = e[t][0] ^ ((e[t][0] ^ e[t][1]) & em_); \
                _Pragma("unroll") for (int q = 0; q < 4; ++q) { const unsigned id = (unsigned)__builtin_amdgcn_readlane((int)esel, 4 * ((st_) & 15) + q) >> 16; \
                    buf[t][q] = ((const GAS v4u*)(U8 + (size_t)id * D))[lane]; } } } while (0)
#define PEER_DOTS(buf, st_) do { int p[16]; \
                _Pragma("unroll") for (int t = 0; t < NT; ++t) _Pragma("unroll") for (int q = 0; q < 4; ++q) { \
                    const int d0 = __builtin_amdgcn_sdot4((int)buf[t][q].x, hx[t][0], 0, false), d1 = __builtin_amdgcn_sdot4((int)buf[t][q].z, hx[t][2], 0, false); \
                    p[4 * t + q] = __builtin_amdgcn_sdot4((int)buf[t][q].y, hx[t][1], d0, false) + __builtin_amdgcn_sdot4((int)buf[t][q].w, hx[t][3], d1, false); } \
                const int red = reduce16i(p, lane); const bool hit = (lane >> 2) == ((st_) & 15), hi = ((st_) & 16) != 0; \
                _Pragma("unroll") for (int t = 0; t < NT; ++t) { const int got = __builtin_amdgcn_ds_bpermute((int)(srcl + (unsigned)((8 * (t & 1) + 4 * (t >> 1)) << 2)), red); \
                    ah[t][0] = (hit && !hi) ? got : ah[t][0]; ah[t][1] = (hit && hi) ? got : ah[t][1]; } } while (0)
            {
                v4u ua[NT][4], ubb[NT][4];
                PEER_LOAD(ua, 0);
                for (int st = 0; st < 32; st += 2) {
                    PEER_LOAD(ubb, st + 1);
                    PEER_DOTS(ua, st);
                    if (st + 2 < 32) PEER_LOAD(ua, st + 2);
                    PEER_DOTS(ubb, st + 1);
                }
            }
            float wv[NT][2];
#pragma unroll
            for (int t = 0; t < NT; ++t)
#pragma unroll
                for (int g = 0; g < 2; ++g) { const float a = (float)ah[t][g] * (rs2[t] * xs[t] * (1.0f / PEER_SU)); const float gate = (float)h2_of(e[t][g] & 0xFFFFu).x;
                    wv[t][g] = gate * (0.5f / PEER_SV) * a * (1.0f + erff(a * 0.7071067811865476f)); }
            f32x2 y[NT][8];
#pragma unroll
            for (int t = 0; t < NT; ++t)
#pragma unroll
                for (int i = 0; i < 8; ++i) y[t][i] = (f32x2){0.f, 0.f};
#define PEER_LOADB(buf, st_) do { _Pragma("unroll") for (int t = 0; t < NT; ++t) { const unsigned em_ = ((st_) & 32) ? 0xFFFFFFFFu : 0u; const unsigned esel = e[t][0] ^ ((e[t][0] ^ e[t][1]) & em_); \
                _Pragma("unroll") for (int q = 0; q < 2; ++q) { const unsigned id = (unsigned)__builtin_amdgcn_readlane((int)esel, 2 * ((st_) & 31) + q) >> 16; \
                    buf[t][q] = ((const GAS v4u*)(V8 + (size_t)id * D))[lane]; } } } while (0)
#define PEER_AXPY(buf, st_) do { _Pragma("unroll") for (int t = 0; t < NT; ++t) { const unsigned wm_ = ((st_) & 32) ? 0xFFFFFFFFu : 0u; const unsigned w0_ = __builtin_bit_cast(unsigned, wv[t][0]), w1_ = __builtin_bit_cast(unsigned, wv[t][1]); const unsigned wsel = w0_ ^ ((w0_ ^ w1_) & wm_); \
                _Pragma("unroll") for (int q = 0; q < 2; ++q) { const float wi = __builtin_bit_cast(float, __builtin_amdgcn_readlane((int)wsel, 2 * ((st_) & 31) + q)); const f32x2 w2 = {wi, wi}; \
                    const unsigned vw_[4] = {buf[t][q].x, buf[t][q].y, buf[t][q].z, buf[t][q].w}; \
                    _Pragma("unroll") for (int j = 0; j < 4; ++j) { y[t][2 * j] = __builtin_elementwise_fma(__builtin_amdgcn_cvt_pk_f32_fp8((int)vw_[j], false), w2, y[t][2 * j]); y[t][2 * j + 1] = __builtin_elementwise_fma(__builtin_amdgcn_cvt_pk_f32_fp8((int)vw_[j], true), w2, y[t][2 * j + 1]); } } } } while (0)
            {
                v4u va[NT][2], vbb[NT][2];
                PEER_LOADB(va, 0);
                for (int st = 0; st < 64; st += 2) {
                    PEER_LOADB(vbb, st + 1);
                    PEER_AXPY(va, st);
                    if (st + 2 < 64) PEER_LOADB(va, st + 2);
                    PEER_AXPY(vbb, st + 1);
                }
            }
#pragma unroll
            for (int t = 0; t < NT; ++t) { const size_t tok = (size_t)(tok0 + t);
                const GAS v4u* xr = (const GAS v4u*)(X1 + tok * D); const v4u xa = __builtin_nontemporal_load(xr + lane), xb = __builtin_nontemporal_load(xr + 64 + lane);
                const float xf[16] = {bf_lo(xa.x), bf_hi(xa.x), bf_lo(xa.y), bf_hi(xa.y), bf_lo(xa.z), bf_hi(xa.z), bf_lo(xa.w), bf_hi(xa.w),
                                      bf_lo(xb.x), bf_hi(xb.x), bf_lo(xb.y), bf_hi(xb.y), bf_lo(xb.z), bf_hi(xb.z), bf_lo(xb.w), bf_hi(xb.w)};
                float yy[16]; float ss = 0.f;
#pragma unroll
                for (int i = 0; i < 8; ++i) { yy[2 * i] = y[t][i].x + xf[2 * i]; yy[2 * i + 1] = y[t][i].y + xf[2 * i + 1]; ss += yy[2 * i] * yy[2 * i] + yy[2 * i + 1] * yy[2 * i + 1]; }
                ss = wave_sum(ss);
                const float r = 1.0f / sqrtf(ss * (1.0f / D) + EPS);
                const GAS f32x4* nfp = (const GAS f32x4*)norm_f; const f32x4 n0 = nfp[2 * lane], n1 = nfp[2 * lane + 1], n2 = nfp[128 + 2 * lane], n3 = nfp[128 + 2 * lane + 1];
                GAS f32x4* op = (GAS f32x4*)(out + tok * D);
                __builtin_nontemporal_store((f32x4){yy[0] * r * n0.x, yy[1] * r * n0.y, yy[2] * r * n0.z, yy[3] * r * n0.w}, op + 2 * lane);
                __builtin_nontemporal_store((f32x4){yy[4] * r * n1.x, yy[5] * r * n1.y, yy[6] * r * n1.z, yy[7] * r * n1.w}, op + 2 * lane + 1);
                __builtin_nontemporal_store((f32x4){yy[8] * r * n2.x, yy[9] * r * n2.y, yy[10] * r * n2.z, yy[11] * r * n2.w}, op + 128 + 2 * lane);
                __builtin_nontemporal_store((f32x4){yy[12] * r * n3.x, yy[13] * r * n3.y, yy[14] * r * n3.z, yy[15] * r * n3.w}, op + 128 + 2 * lane + 1); }
        }
    }

#undef IN
#undef BOTH
}

extern "C" void kernel_launch(void* const* d_in, const int* in_sizes, int n_in, void* d_out, int out_size, void* d_ws, size_t ws_size, hipStream_t stream) {
    static int grid = 0;
    if (grid == 0) {
        if (n_in != 14 || in_sizes[0] != T * D || out_size != T * D || ws_size < WS_END) { fprintf(stderr, "kernel_launch: unexpected shapes (n_in %d, in0 %d, out %d, ws %zu); nothing launched\n", n_in, n_in > 0 ? in_sizes[0] : -1, out_size, ws_size); grid = -1; return; }
        int dev = 0, cus = 0, per_cu = 0;
        if (hipGetDevice(&dev) != hipSuccess || hipDeviceGetAttribute(&cus, hipDeviceAttributeMultiprocessorCount, dev) != hipSuccess) { grid = -1; return; }
        if (hipFuncSetAttribute((const void*)hymba_fwd, hipFuncAttributeMaxDynamicSharedMemorySize, LDS_BYTES) != hipSuccess) { fprintf(stderr, "kernel_launch: hipFuncSetAttribute failed\n"); grid = -1; return; }
        if (hipOccupancyMaxActiveBlocksPerMultiprocessor(&per_cu, (const void*)hymba_fwd, NWAVES * 64, LDS_BYTES) != hipSuccess || per_cu < 1) { fprintf(stderr, "kernel_launch: occupancy query says %d blocks per CU\n", per_cu); (void)hipGetLastError(); grid = -1; return; }
        grid = cus;
    }
    if (grid < 0) return;
    if (hipMemsetAsync((char*)d_ws + WS_CTL, 0, CTL_ZERO_BYTES, stream) != hipSuccess) { fprintf(stderr, "kernel_launch: hipMemsetAsync failed\n"); return; }
    Args a{};
    for (int i = 0; i < 14; ++i) a.in[i] = (const float*)d_in[i];
    a.out = (float*)d_out; a.ws = (unsigned char*)d_ws;
    if (N_LAUNCHES == 1) {
        a.ph_lo = 0; a.ph_hi = NPHASES; a.li = 0;
        void* kargs[] = {&a};
        const hipError_t e = hipLaunchCooperativeKernel((const void*)hymba_fwd, dim3(grid), dim3(NWAVES * 64), kargs, LDS_BYTES, stream);
        if (e != hipSuccess) fprintf(stderr, "kernel_launch: cooperative launch failed: %s (grid %d)\n", hipGetErrorString(e), grid);
    } else {
        for (int li = 0; li < NPHASES; ++li) {
            a.ph_lo = li; a.ph_hi = li + 1; a.li = li;
            hipLaunchKernelGGL(hymba_fwd, dim3(grid), dim3(NWAVES * 64), LDS_BYTES, stream, a);
            const hipError_t le = hipPeekAtLastError();
            if (le != hipSuccess) { fprintf(stderr, "kernel_launch: launch %d failed: %s\n", li, hipGetErrorName(le)); break; }
        }
    }
}
```

```cpp
#include <hip/hip_runtime.h>
#include <cstdio>
#include <cstdint>
namespace pg8 {
#define PG8_LAS __attribute__((address_space(3)))
typedef unsigned short bf16_t;
typedef short bf16x8 __attribute__((ext_vector_type(8)));
typedef float f32x4 __attribute__((ext_vector_type(4)));
typedef unsigned u32x4 __attribute__((ext_vector_type(4)));
constexpr int BM = 256, BK = 64, HALF = 128, HTB = HALF * BK * 2  , STAGE_BYTES = 8 * HTB, NXCD = 8, WGM = 8;

__host__ __device__ __forceinline__ int lds_byte(int r, int c) { const int st = (r >> 4) * 2 + (c >> 5), rr = r & 15, cc = c & 31, ob = rr * 64 + cc * 2; return st * 1024 + (ob ^ (((ob >> 9) & 1) << 5)); }
__host__ __device__ __forceinline__ void stage_rc(int b, int& R, int& C) { const int st = b / 1024, sb = b % 1024, swz = sb ^ (((sb >> 9) & 1) << 5); R = (st >> 1) * 16 + swz / 64; C = (st & 1) * 32 + (swz % 64) / 2; }
__host__ __device__ __forceinline__ int perm32(int rho) { const int n = rho >> 4, i = rho & 15; return 8 * (i >> 2) + 4 * n + (i & 3); }

struct Unit { int pm, pn; };
struct Gemm { const bf16_t* A; const bf16_t* Bt; int M, N, K; };

struct StaticOrder {
    int nM, nN, nwg, G, c;
    __host__ __device__ void init(int M, int N, int G_, int c_) { nM = M / BM; nN = N / BM; nwg = nM * nN; G = G_; c = c_; }
    __host__ __device__ bool next(int i, Unit& u) const {
        const long L = (long)i * G + c; if (L >= nwg) return false;
        int wgid = (int)L; { const int q = nwg / NXCD, r = nwg % NXCD, xcd = wgid % NXCD, off = wgid / NXCD; wgid = (xcd < r ? xcd * (q + 1) : r * (q + 1) + (xcd - r) * q) + off; }
        const int nig = WGM * nN, gid = wgid / nig, fm = gid * WGM, gsz = (nM - fm) < WGM ? (nM - fm) : WGM;
        u.pm = fm + ((wgid % nig) % gsz); u.pn = (wgid % nig) / gsz; return true;
    }
    __device__ __forceinline__ void a_ready(const Unit&) const {}
    __device__ __forceinline__ void done(const Unit&) const {}
};

__device__ __forceinline__ unsigned cvt_pk_bf16(float lo, float hi) { unsigned r; asm volatile("v_cvt_pk_bf16_f32 %0, %1, %2" : "=v"(r) : "v"(lo), "v"(hi)); return r; }

template <int MODE> struct EpiScaleBf16 {
    static constexpr bool PERM = true, AFTER_DRAIN = false;
    bf16_t* O; int ldc; const float* rowv;
    __device__ __forceinline__ void operator()(const f32x4 (&acc)[2][2][4][2], const Unit& u, int wr, int wc, int fr, int fq) const {
        const int row0 = u.pm * BM + wr * 64 + fr, col0 = u.pn * BM + wc * 32 + 8 * fq;
#pragma unroll
        for (int ai = 0; ai < 2; ++ai)
#pragma unroll
            for (int m = 0; m < 4; ++m) { const int row = row0 + ai * HALF + m * 16; float s = rowv[row]; if (MODE == 1) s = 1.0f / sqrtf(s * (1.0f / 1024.0f) + 1e-6f);
                bf16_t* rowp = O + (size_t)row * ldc + col0;
#pragma unroll
                for (int bj = 0; bj < 2; ++bj) { const f32x4 v0 = acc[ai][bj][m][0] * s, v1 = acc[ai][bj][m][1] * s;
                    u32x4 w; w.x = cvt_pk_bf16(v0[0], v0[1]); w.y = cvt_pk_bf16(v0[2], v0[3]); w.z = cvt_pk_bf16(v1[0], v1[1]); w.w = cvt_pk_bf16(v1[2], v1[3]);
                    *(u32x4*)(rowp + bj * HALF) = w; } }
    }
};
struct EpiResid {
    static constexpr bool PERM = true, AFTER_DRAIN = false;
    const float* X; bf16_t* O; float* ss;
    __device__ __forceinline__ void operator()(const f32x4 (&acc)[2][2][4][2], const Unit& u, int wr, int wc, int fr, int fq) const {
        const int row0 = u.pm * BM + wr * 64 + fr, col0 = u.pn * BM + wc * 32 + 8 * fq;
#pragma unroll
        for (int ai = 0; ai < 2; ++ai)
#pragma unroll
            for (int m = 0; m < 4; ++m) { const int row = row0 + ai * HALF + m * 16; float part = 0.f;
#pragma unroll
                for (int bj = 0; bj < 2; ++bj) { const float* xp = X + (size_t)row * 1024 + col0 + bj * HALF;
                    const f32x4 v0 = acc[ai][bj][m][0] + *(const f32x4*)xp, v1 = acc[ai][bj][m][1] + *(const f32x4*)(xp + 4);
                    part += (v0[0] * v0[0] + v0[1] * v0[1]) + (v0[2] * v0[2] + v0[3] * v0[3]) + (v1[0] * v1[0] + v1[1] * v1[1]) + (v1[2] * v1[2] + v1[3] * v1[3]);
                    u32x4 w; w.x = cvt_pk_bf16(v0[0], v0[1]); w.y = cvt_pk_bf16(v0[2], v0[3]); w.z = cvt_pk_bf16(v1[0], v1[1]); w.w = cvt_pk_bf16(v1[2], v1[3]);
                    *(u32x4*)(O + (size_t)row * 1024 + col0 + bj * HALF) = w; }
                part += __shfl_xor(part, 16); part += __shfl_xor(part, 32);
                if (fq == 0) (void)__builtin_amdgcn_global_atomic_fadd_f32((__attribute__((address_space(1))) float*)(ss + row), part); }
    }
};

template <class Epi, class Sched, bool ALIGN_EPI = false, bool SP2 = false>
__device__ __forceinline__ void gemm_phase(PG8_LAS unsigned char* lds, const Gemm g, const Sched& S, const Epi& E) {
    const int tid = threadIdx.x, wid = __builtin_amdgcn_readfirstlane(tid >> 6), lane = tid & 63, wr = wid >> 2, wc = wid & 3, fr = lane & 15, fq = lane >> 4;
    const int K = g.K, nt = K / BK;
    unsigned voffA[2], voffB[2];
#pragma unroll
    for (int i = 0; i < 2; ++i) { int R, C; stage_rc(tid * 16 + i * 8192, R, C); const int Rb = Epi::PERM ? ((R & ~31) + perm32(R & 31)) : R;
        voffA[i] = (unsigned)(R * K + C) * 2u; voffB[i] = (unsigned)(Rb * K + C) * 2u; }
    const size_t kstep = (size_t)(BK * 2);
    const size_t hstep = (size_t)HALF * K * 2;
    const size_t tstep = 2 * hstep;
    const unsigned ldsw = (unsigned)wid * 1024u;
    const int aoff = lds_byte(wr * 64 + fr, fq * 8), boff = lds_byte(wc * 32 + fr, fq * 8);
#define PG8_SA(b, h) (((b) * 2 + (h)) * HTB)
#define PG8_SB(b, h) ((4 + (b) * 2 + (h)) * HTB)
#define PG8_STAGE(bufoff, gbase, voff) do { _Pragma("unroll") for (int _i = 0; _i < 2; ++_i) \
        __builtin_amdgcn_global_load_lds((const unsigned*)((const char*)(gbase) + (voff)[_i]), (PG8_LAS unsigned*)(lds + (bufoff) + ldsw + _i * 8192), 16, 0, 0); } while (0)
#define PG8_LDA(dst, b, h) do { _Pragma("unroll") for (int m = 0; m < 4; ++m) _Pragma("unroll") for (int k = 0; k < 2; ++k) dst[m][k] = *(const PG8_LAS bf16x8*)(lds + PG8_SA(b, h) + aoff + m * 2048 + k * 1024); } while (0)
#define PG8_LDB(dst, b, h) do { _Pragma("unroll") for (int n = 0; n < 2; ++n) _Pragma("unroll") for (int k = 0; k < 2; ++k) dst[n][k] = *(const PG8_LAS bf16x8*)(lds + PG8_SB(b, h) + boff + n * 2048 + k * 1024); } while (0)
#define PG8_MMA(ai, bj, At, Bt) do { __builtin_amdgcn_s_setprio(1); _Pragma("unroll") for (int m = 0; m < 4; ++m) _Pragma("unroll") for (int n = 0; n < 2; ++n) _Pragma("unroll") for (int k = 0; k < 2; ++k) \
        acc[ai][bj][m][n] = __builtin_amdgcn_mfma_f32_16x16x32_bf16(Bt[n][k], At[m][k], acc[ai][bj][m][n], 0, 0, 0); __builtin_amdgcn_s_setprio(0); } while (0)
#define PG8_WAIT_V(n) asm volatile("s_waitcnt vmcnt(" #n ")" ::: "memory")
#define PG8_WAIT_L(n) asm volatile("s_waitcnt lgkmcnt(" #n ")" ::: "memory")
#define PG8_BAR __builtin_amdgcn_s_barrier()
#define PG8_SCHED __builtin_amdgcn_sched_barrier(0)
    Unit cur, nxt; int ui = 0;
    if (!S.next(0, cur)) return;
    f32x4 acc[2][2][4][2];
#pragma unroll
    for (int a = 0; a < 2; ++a)
#pragma unroll
        for (int b = 0; b < 2; ++b)
#pragma unroll
            for (int m = 0; m < 4; ++m)
#pragma unroll
                for (int n = 0; n < 2; ++n) acc[a][b][m][n] = (f32x4){0.f, 0.f, 0.f, 0.f};
    bf16x8 At[4][2], B0[2][2], B1[2][2];
    const char* cA = (const char*)g.A + (size_t)cur.pm * tstep; const char* cB = (const char*)g.Bt + (size_t)cur.pn * tstep;
    S.a_ready(cur);
    if constexpr (SP2) {
        PG8_STAGE(PG8_SB(0, 0), cB, voffB); PG8_STAGE(PG8_SB(0, 1), cB + hstep, voffB); PG8_STAGE(PG8_SA(0, 0), cA, voffA); PG8_STAGE(PG8_SA(0, 1), cA + hstep, voffA);
        if (wr == 1) PG8_BAR;
        PG8_WAIT_V(2); PG8_BAR;
        PG8_STAGE(PG8_SB(1, 0), cB + kstep, voffB); PG8_STAGE(PG8_SA(1, 0), cA + kstep, voffA); PG8_STAGE(PG8_SB(1, 1), cB + hstep + kstep, voffB);
        PG8_WAIT_V(6); PG8_BAR;
    } else {
        PG8_STAGE(PG8_SB(0, 0), cB, voffB); PG8_STAGE(PG8_SA(0, 0), cA, voffA); PG8_STAGE(PG8_SB(0, 1), cB + hstep, voffB); PG8_STAGE(PG8_SA(0, 1), cA + hstep, voffA);
        if (wr == 1) PG8_BAR;
        PG8_WAIT_V(4); PG8_BAR;
        PG8_STAGE(PG8_SB(1, 0), cB + kstep, voffB); PG8_STAGE(PG8_SA(1, 0), cA + kstep, voffA); PG8_STAGE(PG8_SB(1, 1), cB + hstep + kstep, voffB);
        PG8_WAIT_V(6); PG8_BAR;
    }
    for (;;) {
        const bool has_next = S.next(ui + 1, nxt);
        const char* nA = has_next ? (const char*)g.A + (size_t)nxt.pm * tstep : cA; const char* nB = has_next ? (const char*)g.Bt + (size_t)nxt.pn * tstep : cB;
        for (int t = 0; t < nt; t += 2) {
            const bool last = (t == nt - 2);
            const char* a1 = cA + (size_t)(t + 1) * kstep;
            const char* a2 = last ? nA : cA + (size_t)(t + 2) * kstep; const char* b2 = last ? nB : cB + (size_t)(t + 2) * kstep;
            const char* a3 = a2 + kstep; const char* b3 = b2 + kstep;
            if (last && has_next) S.a_ready(nxt);
            if constexpr (SP2) {
            PG8_LDB(B0, 0, 0); PG8_LDB(B1, 0, 1); PG8_SCHED; PG8_LDA(At, 0, 0); PG8_STAGE(PG8_SA(1, 1), a1 + hstep, voffA);
            PG8_WAIT_V(8); PG8_WAIT_L(0); PG8_BAR; PG8_MMA(0, 0, At, B0); PG8_MMA(0, 1, At, B1); PG8_BAR; PG8_SCHED;
            PG8_LDA(At, 0, 1); PG8_STAGE(PG8_SB(0, 0), b2, voffB); PG8_STAGE(PG8_SB(0, 1), b2 + hstep, voffB); PG8_STAGE(PG8_SA(0, 0), a2, voffA);
            PG8_WAIT_V(8); PG8_WAIT_L(0); PG8_BAR; PG8_MMA(1, 0, At, B0); PG8_MMA(1, 1, At, B1); PG8_BAR; PG8_SCHED;
            PG8_LDB(B0, 1, 0); PG8_LDB(B1, 1, 1); PG8_SCHED; PG8_LDA(At, 1, 0); PG8_STAGE(PG8_SA(0, 1), a2 + hstep, voffA);
            PG8_WAIT_V(8); PG8_WAIT_L(0); PG8_BAR; PG8_MMA(0, 0, At, B0); PG8_MMA(0, 1, At, B1); PG8_BAR; PG8_SCHED;
            PG8_LDA(At, 1, 1); PG8_STAGE(PG8_SB(1, 0), b3, voffB); PG8_STAGE(PG8_SB(1, 1), b3 + hstep, voffB); PG8_STAGE(PG8_SA(1, 0), a3, voffA);
            PG8_WAIT_V(8); PG8_WAIT_L(0); PG8_BAR; PG8_MMA(1, 0, At, B0); PG8_MMA(1, 1, At, B1); PG8_BAR; PG8_SCHED;
            } else {
            PG8_LDB(B0, 0, 0); PG8_SCHED; PG8_LDA(At, 0, 0); PG8_STAGE(PG8_SA(1, 1), a1 + hstep, voffA);
            PG8_WAIT_L(8); PG8_BAR; PG8_WAIT_L(0); PG8_MMA(0, 0, At, B0); PG8_BAR; PG8_SCHED;
            PG8_LDB(B1, 0, 1); PG8_STAGE(PG8_SB(0, 0), b2, voffB);
            PG8_BAR; PG8_WAIT_L(0); PG8_MMA(0, 1, At, B1); PG8_BAR;
            PG8_LDA(At, 0, 1); PG8_STAGE(PG8_SA(0, 0), a2, voffA);
            PG8_BAR; PG8_WAIT_L(0); PG8_MMA(1, 0, At, B0); PG8_BAR; PG8_SCHED;
            PG8_STAGE(PG8_SB(0, 1), b2 + hstep, voffB);
            PG8_WAIT_V(6); PG8_BAR; PG8_MMA(1, 1, At, B1); PG8_BAR;
            PG8_LDB(B0, 1, 0); PG8_SCHED; PG8_LDA(At, 1, 0); PG8_STAGE(PG8_SA(0, 1), a2 + hstep, voffA);
            PG8_WAIT_L(8); PG8_BAR; PG8_WAIT_L(0); PG8_MMA(0, 0, At, B0); PG8_BAR; PG8_SCHED;
            PG8_LDB(B1, 1, 1); PG8_STAGE(PG8_SB(1, 0), b3, voffB);
            PG8_BAR; PG8_WAIT_L(0); PG8_MMA(0, 1, At, B1); PG8_BAR;
            PG8_LDA(At, 1, 1); PG8_STAGE(PG8_SA(1, 0), a3, voffA);
            PG8_BAR; PG8_WAIT_L(0); PG8_MMA(1, 0, At, B0); PG8_BAR; PG8_SCHED;
            PG8_STAGE(PG8_SB(1, 1), b3 + hstep, voffB);
            PG8_WAIT_V(6); PG8_BAR; PG8_MMA(1, 1, At, B1); PG8_BAR;
            }
        }
        if constexpr (ALIGN_EPI) { if (wr == 0) PG8_BAR; }
        if constexpr (!Epi::AFTER_DRAIN) { E(acc, cur, wr, wc, fr, fq); S.done(cur); }
        if (!has_next) break;
#pragma unroll
        for (int a = 0; a < 2; ++a)
#pragma unroll
            for (int b = 0; b < 2; ++b)
#pragma unroll
                for (int m = 0; m < 4; ++m)
#pragma unroll
                    for (int n = 0; n < 2; ++n) acc[a][b][m][n] = (f32x4){0.f, 0.f, 0.f, 0.f};
        cur = nxt; cA = nA; cB = nB; ++ui;
        if constexpr (ALIGN_EPI) { if (wr == 1) PG8_BAR; }
    }
    PG8_WAIT_V(0);
    if constexpr (!ALIGN_EPI) { if (wr == 0) PG8_BAR; }
    PG8_BAR;
    if constexpr (Epi::AFTER_DRAIN) { E.fused(acc, cur, wr, wc, fr, fq, lds, wid, lane); S.done(cur); }
#undef PG8_SA
#undef PG8_SB
#undef PG8_STAGE
#undef PG8_LDA
#undef PG8_LDB
#undef PG8_MMA
#undef PG8_WAIT_V
#undef PG8_WAIT_L
#undef PG8_BAR
#undef PG8_SCHED
}
}

#ifndef PG8_SP2
#define PG8_SP2 true
#endif
#ifndef PG8_ALIGN
#define PG8_ALIGN true
#endif
#ifndef MK_N_LAUNCHES
#define MK_N_LAUNCHES 1
#endif
constexpr int NWAVES = 8;
constexpr int NPHASES = 8;
constexpr int N_LAUNCHES = MK_N_LAUNCHES;

constexpr int NB = 32, SEQ = 2048, T = NB * SEQ, D = 1024, DIN = 3584;
constexpr int PC_C = 0, PC_H = 512, PC_B = 1024, PC_Q = 1536, PC_F = 2048, PC_V = 2560, PC_G = 3072;
constexpr int NEXP = 16384;
constexpr float EPS = 1e-6f;
constexpr float PEER_SU = 640.0f, PEER_SV = 64.0f;

constexpr size_t MiB = 1u << 20;
constexpr size_t WS_CTL = 0, CTL_ZERO_BYTES = 1 * MiB;
constexpr size_t WS_W1T = 2 * MiB, WS_WOT = 10 * MiB, WS_WQT = 12 * MiB, WS_RS1 = 16 * MiB, WS_SS2 = 17 * MiB;
constexpr size_t WS_KEYB = 18 * MiB;
constexpr size_t WS_U16 = 32 * MiB, WS_V16 = 64 * MiB, WS_EXP = 96 * MiB;
constexpr size_t WS_XB = 128 * MiB;
constexpr size_t WS_X1 = 256 * MiB;
constexpr size_t WS_PROJ = 384 * MiB;
constexpr size_t WS_F = 832 * MiB;
constexpr size_t WS_END = 960 * MiB;
constexpr int CW_BAR = 4096;

constexpr int RING_OFF = 0, RING_BYTES = 131072;
constexpr int LDSCTL_OFF = RING_BYTES, MISC_OFF = LDSCTL_OFF + 320;
constexpr int LDS_BYTES = 147456;

#define GAS __attribute__((address_space(1)))
#define LAS __attribute__((address_space(3)))
typedef unsigned short bf16;
typedef unsigned v4u __attribute__((ext_vector_type(4)));
typedef unsigned v2u __attribute__((ext_vector_type(2)));
typedef float f32x4 __attribute__((ext_vector_type(4)));
typedef float f32x2 __attribute__((ext_vector_type(2)));
typedef _Float16 h2_t __attribute__((ext_vector_type(2)));
typedef GAS unsigned gu32;
#define RLX_AGENT __ATOMIC_RELAXED, __HIP_MEMORY_SCOPE_AGENT
#define LDS_WAIT() asm volatile("s_waitcnt lgkmcnt(0)" ::: "memory")
#define VM_WAIT() asm volatile("s_waitcnt vmcnt(0)" ::: "memory")
__device__ __forceinline__ unsigned f2bf(float f) { unsigned u = __builtin_bit_cast(unsigned, f); return (u + 0x7fffu + ((u >> 16) & 1u)) >> 16; }
__device__ __forceinline__ unsigned pk2(float lo, float hi) { return f2bf(lo) | (f2bf(hi) << 16); }
__device__ __forceinline__ float bf_lo(unsigned w) { return __builtin_bit_cast(float, w << 16); }
__device__ __forceinline__ float bf_hi(unsigned w) { return __builtin_bit_cast(float, w & 0xffff0000u); }
__device__ __forceinline__ float bf1(bf16 v) { return __builtin_bit_cast(float, (unsigned)v << 16); }
__device__ __forceinline__ unsigned pkh2(float lo, float hi) { f32x2 v = {lo, hi}; h2_t h = __builtin_convertvector(v, h2_t); return __builtin_bit_cast(unsigned, h); }
__device__ __forceinline__ h2_t h2_of(unsigned w) { return __builtin_bit_cast(h2_t, w); }
__device__ __forceinline__ float swap32_add(float a, float b) { const v2u r = __builtin_amdgcn_permlane32_swap(__builtin_bit_cast(unsigned, a), __builtin_bit_cast(unsigned, b), false, false);
    const unsigned rx = r.x, ry = r.y; return __builtin_bit_cast(float, rx) + __builtin_bit_cast(float, ry); }
__device__ __forceinline__ float swap16_add(float a, float b) { const v2u r = __builtin_amdgcn_permlane16_swap(__builtin_bit_cast(unsigned, a), __builtin_bit_cast(unsigned, b), false, false);
    const unsigned rx = r.x, ry = r.y; return __builtin_bit_cast(float, rx) + __builtin_bit_cast(float, ry); }
template <int CTRL> __device__ __forceinline__ float dpp_f(float v) { return __builtin_bit_cast(float, __builtin_amdgcn_update_dpp(0, __builtin_bit_cast(int, v), CTRL, 0xF, 0xF, false)); }
template <int CTRL> __device__ __forceinline__ unsigned dpp_u(unsigned v) { return (unsigned)__builtin_amdgcn_update_dpp(0, (int)v, CTRL, 0xF, 0xF, false); }
__device__ __forceinline__ float wave_sum(float v) {
    v += dpp_f<0xB1>(v); v += dpp_f<0x4E>(v); v += dpp_f<0x124>(v); v += dpp_f<0x128>(v);
    v = swap16_add(v, v); v = swap32_add(v, v);
    return v;
}
typedef float f32x16 __attribute__((ext_vector_type(16)));
typedef __bf16 bf16x2_t __attribute__((ext_vector_type(2)));
__device__ __forceinline__ unsigned cvtpk(float lo, float hi) { f32x2 v = {lo, hi}; bf16x2_t b = __builtin_convertvector(v, bf16x2_t); return __builtin_bit_cast(unsigned, b); }
__device__ __forceinline__ pg8::bf16x8 pack8(const f32x16& x, int s) {
    v4u p; p.x = cvtpk(x[8 * s], x[8 * s + 1]); p.y = cvtpk(x[8 * s + 2], x[8 * s + 3]); p.z = cvtpk(x[8 * s + 4], x[8 * s + 5]); p.w = cvtpk(x[8 * s + 6], x[8 * s + 7]);
    return __builtin_bit_cast(pg8::bf16x8, p); }
__device__ __forceinline__ void ce_desc(unsigned& a, unsigned& b) { const unsigned mx = a > b ? a : b, mn = a > b ? b : a; a = mx; b = mn; }
__device__ __forceinline__ void sort16_desc(unsigned (&a)[16]) {
#pragma unroll
    for (int k = 2; k <= 16; k <<= 1)
#pragma unroll
        for (int j = k >> 1; j > 0; j >>= 1)
#pragma unroll
            for (int i = 0; i < 16; ++i) { const int l = i ^ j; if (l > i) { if ((i & k) == 0) ce_desc(a[i], a[l]); else ce_desc(a[l], a[i]); } }
}
__device__ __forceinline__ void merge16_desc(unsigned (&a)[16], const unsigned (&b)[16]) {
#pragma unroll
    for (int i = 0; i < 16; ++i) a[i] = a[i] > b[15 - i] ? a[i] : b[15 - i];
#pragma unroll
    for (int j = 8; j > 0; j >>= 1)
#pragma unroll
        for (int i = 0; i < 16; ++i) { const int l = i ^ j; if (l > i) ce_desc(a[i], a[l]); }
}
__device__ __forceinline__ void sort16_desc2(unsigned (&a)[16], unsigned (&b)[16]) {
#pragma unroll
    for (int k = 2; k <= 16; k <<= 1)
#pragma unroll
        for (int j = k >> 1; j > 0; j >>= 1)
#pragma unroll
            for (int i = 0; i < 16; ++i) { const int l = i ^ j; if (l > i) { if ((i & k) == 0) { ce_desc(a[i], a[l]); ce_desc(b[i], b[l]); } else { ce_desc(a[l], a[i]); ce_desc(b[l], b[i]); } } }
}
__device__ __forceinline__ void merge16_desc2(unsigned (&a)[16], const unsigned (&x)[16], unsigned (&b)[16], const unsigned (&y)[16]) {
#pragma unroll
    for (int i = 0; i < 16; ++i) { a[i] = a[i] > x[15 - i] ? a[i] : x[15 - i]; b[i] = b[i] > y[15 - i] ? b[i] : y[15 - i]; }
#pragma unroll
    for (int j = 8; j > 0; j >>= 1)
#pragma unroll
        for (int i = 0; i < 16; ++i) { const int l = i ^ j; if (l > i) { ce_desc(a[i], a[l]); ce_desc(b[i], b[l]); } }
}
__device__ __forceinline__ float unkey(unsigned a) { a = (a & 0x80000000u) ? (a & 0x7FFFFFFFu) : ~a; return __builtin_bit_cast(float, a); }
__device__ __forceinline__ unsigned ckey(float s, int flat) { unsigned u = __builtin_bit_cast(unsigned, s); u ^= (unsigned)((int)u >> 31) | 0x80000000u; return (u & ~0xFFu) | (unsigned)(255 - flat); }
template <int J> __device__ __forceinline__ unsigned xor_lane(unsigned x, int lane) {
    if (J == 1) return dpp_u<0xB1>(x);
    if (J == 2) return dpp_u<0x4E>(x);
    if (J == 8) return dpp_u<0x128>(x);
    if (J == 16) { const v2u r = __builtin_amdgcn_permlane16_swap(x, x, false, false); const unsigned rx = r.x, ry = r.y; return (lane & 16) ? rx : ry; }
    if (J == 32) { const v2u r = __builtin_amdgcn_permlane32_swap(x, x, false, false); const unsigned rx = r.x, ry = r.y; return (lane & 32) ? rx : ry; }
    return (unsigned)__shfl_xor((int)x, J);
}
template <int K, int J, int N> __device__ __forceinline__ void sort128_stage(unsigned (&e)[N][2], int lane) {
#pragma unroll
    for (int t = 0; t < N; ++t) {
        if (J == 64) { const unsigned mn = e[t][0] < e[t][1] ? e[t][0] : e[t][1], mx = e[t][0] < e[t][1] ? e[t][1] : e[t][0]; e[t][0] = mn; e[t][1] = mx; }
        else {
            const unsigned p0 = xor_lane<J>(e[t][0], lane), p1 = xor_lane<J>(e[t][1], lane);
            const bool lower = (lane & J) == 0;
            const bool up0 = (K >= 64) ? true : ((lane & K) == 0);
            const bool up1 = (K == 128) ? true : (K == 64 ? false : ((lane & K) == 0));
            const unsigned mn0 = e[t][0] < p0 ? e[t][0] : p0, mx0 = e[t][0] < p0 ? p0 : e[t][0], mn1 = e[t][1] < p1 ? e[t][1] : p1, mx1 = e[t][1] < p1 ? p1 : e[t][1];
            e[t][0] = (lower == up0) ? mn0 : mx0; e[t][1] = (lower == up1) ? mn1 : mx1;
        }
    }
}
template <int N> __device__ __forceinline__ void sort128_asc(unsigned (&e)[N][2], int lane) {
#define S_(K, J) sort128_stage<K, J, N>(e, lane)
    S_(2, 1); S_(4, 2); S_(4, 1); S_(8, 4); S_(8, 2); S_(8, 1); S_(16, 8); S_(16, 4); S_(16, 2); S_(16, 1);
    S_(32, 16); S_(32, 8); S_(32, 4); S_(32, 2); S_(32, 1); S_(64, 32); S_(64, 16); S_(64, 8); S_(64, 4); S_(64, 2); S_(64, 1);
    S_(128, 64); S_(128, 32); S_(128, 16); S_(128, 8); S_(128, 4); S_(128, 2); S_(128, 1);
#undef S_
}
__device__ __forceinline__ float wave_max(float v) {
    v = fmaxf(v, dpp_f<0xB1>(v)); v = fmaxf(v, dpp_f<0x4E>(v)); v = fmaxf(v, dpp_f<0x124>(v)); v = fmaxf(v, dpp_f<0x128>(v));
    { const v2u r = __builtin_amdgcn_permlane16_swap(__builtin_bit_cast(unsigned, v), __builtin_bit_cast(unsigned, v), false, false); const unsigned rx = r.x, ry = r.y; v = fmaxf(__builtin_bit_cast(float, rx), __builtin_bit_cast(float, ry)); }
    { const v2u r = __builtin_amdgcn_permlane32_swap(__builtin_bit_cast(unsigned, v), __builtin_bit_cast(unsigned, v), false, false); const unsigned rx = r.x, ry = r.y; v = fmaxf(__builtin_bit_cast(float, rx), __builtin_bit_cast(float, ry)); }
    return v;
}
__device__ __forceinline__ int swap32_addi(int a, int b) { const v2u r = __builtin_amdgcn_permlane32_swap((unsigned)a, (unsigned)b, false, false); const unsigned rx = r.x, ry = r.y; return (int)(rx + ry); }
__device__ __forceinline__ int swap16_addi(int a, int b) { const v2u r = __builtin_amdgcn_permlane16_swap((unsigned)a, (unsigned)b, false, false); const unsigned rx = r.x, ry = r.y; return (int)(rx + ry); }
__device__ __forceinline__ int reduce16i(const int (&p)[16], int lane) {
    int q[8], r[4], u[2];
    const bool b3 = (lane & 8) != 0, b2 = (lane & 4) != 0;
#pragma unroll
    for (int i = 0; i < 8; ++i) q[i] = swap32_addi(p[2 * i], p[2 * i + 1]);
#pragma unroll
    for (int i = 0; i < 4; ++i) r[i] = swap16_addi(q[2 * i], q[2 * i + 1]);
#pragma unroll
    for (int i = 0; i < 2; ++i) { const int keep = b3 ? r[2 * i + 1] : r[2 * i], send = b3 ? r[2 * i] : r[2 * i + 1]; u[i] = keep + (int)dpp_u<0x128>((unsigned)send); }
    const int keep = b2 ? u[1] : u[0], send = b2 ? u[0] : u[1];
    int v = keep + __shfl_xor(send, 4);
    v += (int)dpp_u<0x4E>((unsigned)v); v += (int)dpp_u<0xB1>((unsigned)v);
    return v;
}
__device__ __forceinline__ float reduce16(const float (&p)[16], int lane) {
    float q[8], r[4], u[2];
    const bool b3 = (lane & 8) != 0, b2 = (lane & 4) != 0;
#pragma unroll
    for (int i = 0; i < 8; ++i) q[i] = swap32_add(p[2 * i], p[2 * i + 1]);
#pragma unroll
    for (int i = 0; i < 4; ++i) r[i] = swap16_add(q[2 * i], q[2 * i + 1]);
#pragma unroll
    for (int i = 0; i < 2; ++i) { const float keep = b3 ? r[2 * i + 1] : r[2 * i], send = b3 ? r[2 * i] : r[2 * i + 1]; u[i] = keep + dpp_f<0x128>(send); }
    const float keep = b2 ? u[1] : u[0], send = b2 ? u[0] : u[1];
    float v = keep + __shfl_xor(send, 4);
    v += dpp_f<0x4E>(v);
    v += dpp_f<0xB1>(v);
    return v;
}
__device__ __forceinline__ int swap23(int k) { return (k & ~12) | ((k & 4) << 1) | ((k & 8) >> 1); }
__device__ __forceinline__ float sigmoidf_(float x) { return 1.0f / (1.0f + __expf(-x)); }

#define XB_TMO      128
#define XB_XCNT(j)  (256  + 64 * (j))
#define XB_XSUB(j)  (1280 + 64 * (j))
#define XB_XGEN(j)  (2304 + 64 * (j))
#define XB_TOP      3328
#define XB_TOPGEN   3392
#define XCD_BAR_WORDS 3456
#define XB_SPIN_CAP (1u << 18)

__device__ __forceinline__ unsigned xb_ld(unsigned* p)              { return __hip_atomic_load(p, __ATOMIC_RELAXED, __HIP_MEMORY_SCOPE_AGENT); }
__device__ __forceinline__ unsigned xb_add(unsigned* p, unsigned v) { return __hip_atomic_fetch_add(p, v, __ATOMIC_RELAXED, __HIP_MEMORY_SCOPE_AGENT); }
__device__ __forceinline__ unsigned xb_xcc_id() { return (unsigned)__builtin_amdgcn_s_getreg((3 << 11) | 20) & 0xFu; }
#define XB_SPIN(cond, bar) do { unsigned _sp = 0; while (cond) { __builtin_amdgcn_s_sleep(1); \
    if ((++_sp & 255u) == 0u) { if (xb_ld(&(bar)[XB_TMO])) break; if (_sp > XB_SPIN_CAP) { atomicAdd(&(bar)[XB_TMO], 1u); break; } } } } while (0)

struct XcdBarrier {
    unsigned* bar; unsigned x;
    volatile LAS unsigned* st;
};

__device__ __forceinline__ XcdBarrier xcd_barrier_post(unsigned* bar, volatile LAS unsigned* st) {
    XcdBarrier b; b.bar = bar; b.x = xb_xcc_id(); b.st = st;
    if (threadIdx.x == 0) (void)xb_add(&bar[XB_XCNT(b.x)], 1u);
    return b;
}
__device__ __forceinline__ void xcd_barrier_complete(unsigned* bar, unsigned x, unsigned& nloc, unsigned& nx) {
    const unsigned G = gridDim.x * gridDim.y * gridDim.z;
    unsigned sum, cnt, mine, sp = 0u;
    for (;;) {
        sum = 0u; cnt = 0u; mine = 0u;
#pragma unroll
        for (unsigned j = 0; j < 16; ++j) { const unsigned c = xb_ld(&bar[XB_XCNT(j)]); sum += c; cnt += (c > 0u) ? 1u : 0u; mine = (j == x) ? c : mine; }
        if (sum == G) break;
        __builtin_amdgcn_s_sleep(1);
        if ((++sp & 255u) == 0u) { if (xb_ld(&bar[XB_TMO])) break; if (sp > XB_SPIN_CAP) { atomicAdd(&bar[XB_TMO], 1u); break; } }
    }
    nloc = mine > 0u ? mine : 1u; nx = cnt > 0u ? cnt : 1u;
}

__device__ __forceinline__ void xcd_barrier(const XcdBarrier& b) {
    asm volatile("s_waitcnt vmcnt(0)" ::: "memory");
    __syncthreads();
    if (threadIdx.x == 0) {
        unsigned* bar = b.bar;
        __builtin_amdgcn_s_waitcnt(0);
        unsigned nloc = b.st[0], nx = b.st[1];
        if (nloc == 0u) { xcd_barrier_complete(bar, b.x, nloc, nx); b.st[0] = nloc; b.st[1] = nx; }
        const unsigned old = xb_add(&bar[XB_XSUB(b.x)], 1u);
        const unsigned gen = old / nloc;
        if (old + 1u == (gen + 1u) * nloc) {
            __builtin_amdgcn_fence(__ATOMIC_RELEASE, "agent");
            asm volatile("s_waitcnt vmcnt(0)" ::: "memory");
            const unsigned og = xb_add(&bar[XB_TOP], 1u);
            const unsigned tg = og / nx;
            if (og + 1u == (tg + 1u) * nx) xb_add(&bar[XB_TOPGEN], 1u);
            else XB_SPIN(xb_ld(&bar[XB_TOPGEN]) == tg, bar);
            __builtin_amdgcn_fence(__ATOMIC_ACQUIRE, "agent");
            xb_add(&bar[XB_XGEN(b.x)], 1u);
            asm volatile("s_waitcnt vmcnt(0)" ::: "memory");
        } else {
            XB_SPIN(xb_ld(&bar[XB_XGEN(b.x)]) == gen, bar);
            __builtin_amdgcn_fence(__ATOMIC_ACQUIRE, "agent");
            asm volatile("s_waitcnt vmcnt(0)" ::: "memory");
        }
    }
    __syncthreads();
}


__device__ __forceinline__ void p0_transpose_item(const float* W, int K, int N, const float* gain, bf16* WT, LAS float* scr, int item, int lane) {
    const int nblk = N / 32, kb = item / nblk, nb = item % nblk, k0 = 64 * kb, n0 = 32 * nb;
#pragma unroll 8
    for (int i = 0; i < 32; ++i) { const int kk = 2 * i + (lane >> 5); const float g = gain ? gain[k0 + kk] : 1.0f; scr[kk * 33 + (lane & 31)] = W[(size_t)(k0 + kk) * N + n0 + (lane & 31)] * g; }
    LDS_WAIT(); asm volatile("" ::: "memory");
    const int c = lane & 7;
#pragma unroll
    for (int j = 0; j < 4; ++j) { const int n = (lane >> 3) + 8 * j; const LAS float* s = scr + (8 * c) * 33 + n;
        v4u o; o.x = pk2(s[0 * 33], s[1 * 33]); o.y = pk2(s[2 * 33], s[3 * 33]); o.z = pk2(s[4 * 33], s[5 * 33]); o.w = pk2(s[6 * 33], s[7 * 33]);
        *(GAS v4u*)(WT + (size_t)(n0 + n) * K + k0 + 8 * c) = o; }
    LDS_WAIT(); asm volatile("" ::: "memory");
}

struct Args { const float* in[14]; float* out; unsigned char* ws; int ph_lo, ph_hi, li, pad; };

__global__ void __launch_bounds__(NWAVES * 64, 2) hymba_fwd(Args args) {
    extern __shared__ __attribute__((aligned(16))) unsigned char lds_raw[];
    LAS unsigned char* lds = (LAS unsigned char*)lds_raw;
    volatile LAS unsigned* MISC = (volatile LAS unsigned*)(lds + MISC_OFF);
    const int tid = threadIdx.x, lane = tid & 63, wave = __builtin_amdgcn_readfirstlane(tid >> 6);
    const int G = gridDim.x;
    const int gw = (int)blockIdx.x * NWAVES + wave, NGW = G * NWAVES;
    unsigned char* ws = args.ws;
    gu32* ctl = (gu32*)(ws + WS_CTL);
    const float* x = args.in[0]; const float* norm_mix = args.in[1]; const float* w_in = args.in[2]; const float* conv_w = args.in[3]; const float* conv_gain = args.in[4];
    const float* hg_lb = args.in[5]; const float* hg_gain = args.in[6]; const float* w_out = args.in[7]; const float* norm_ffn = args.in[8]; const float* peer_wq = args.in[9];
    const float* peer_keys = args.in[10]; const float* peer_u = args.in[11]; const float* peer_v = args.in[12]; const float* norm_f = args.in[13];
    float* out = args.out;
    bf16* W1T = (bf16*)(ws + WS_W1T); bf16* WOT = (bf16*)(ws + WS_WOT); bf16* WQT = (bf16*)(ws + WS_WQT);
    float* RS1 = (float*)(ws + WS_RS1); float* SS2 = (float*)(ws + WS_SS2);
    unsigned char* U8 = ws + WS_U16; unsigned char* V8 = ws + WS_V16; unsigned* EXPT = (unsigned*)(ws + WS_EXP); bf16* KEYB = (bf16*)(ws + WS_KEYB);
    bf16* XB = (bf16*)(ws + WS_XB); bf16* MIX = (bf16*)(ws + WS_XB); bf16* X1 = (bf16*)(ws + WS_X1);
    bf16* PROJ = (bf16*)(ws + WS_PROJ); bf16* QB = (bf16*)(ws + WS_PROJ); float* DEC = (float*)(ws + WS_F); bf16* KDT = (bf16*)(ws + WS_X1); bf16* VTT = (bf16*)(ws + WS_X1 + 64 * MiB);

    for (int u = tid; u < (LDS_BYTES - LDSCTL_OFF) / 4; u += NWAVES * 64) ((LAS unsigned*)(lds + LDSCTL_OFF))[u] = 0u;
    __syncthreads();
    XcdBarrier bar; bar.bar = (unsigned*)(ctl + CW_BAR); bar.x = 0; bar.st = nullptr;
    if (N_LAUNCHES == 1) bar = xcd_barrier_post((unsigned*)(ctl + CW_BAR), MISC + 8);
#define GRID_BAR() do { if (N_LAUNCHES == 1) xcd_barrier(bar); } while (0)
    const int lo = args.ph_lo, hi = args.ph_hi;
#define IN(k) (lo <= (k) && (k) < hi)
#define BOTH(k) (IN(k) && IN((k) + 1))

    if (IN(0)) {
        LAS float* scr = (LAS float*)(lds + RING_OFF + wave * 16384);
        constexpr int I_1 = (D / 64) * (DIN / 32);
        for (int it = gw; it < I_1; it += NGW) p0_transpose_item(w_in, D, DIN, norm_mix, W1T, scr, it, lane);
        for (int m = gw; m < T; m += NGW) {
            const GAS f32x4* xr = (const GAS f32x4*)(x + (size_t)m * D) + lane; f32x4 v[4]; float s = 0.f;
#pragma unroll
            for (int j = 0; j < 4; ++j) { v[j] = xr[64 * j]; s += (v[j].x * v[j].x + v[j].y * v[j].y) + (v[j].z * v[j].z + v[j].w * v[j].w); }
            s = wave_sum(s);
            if (lane == 0) RS1[m] = 1.0f / sqrtf(s * (1.0f / D) + EPS);
            GAS unsigned long long* o8 = (GAS unsigned long long*)(XB + (size_t)m * D) + lane;
#pragma unroll
            for (int j = 0; j < 4; ++j) o8[64 * j] = (unsigned long long)pk2(v[j].x, v[j].y) | ((unsigned long long)pk2(v[j].z, v[j].w) << 32);
        }
        for (int i = (int)blockIdx.x * NWAVES * 64 + tid; i < T; i += G * NWAVES * 64) SS2[i] = 0.f;
        if (BOTH(0)) GRID_BAR();
    }

    if (IN(1)) {
        pg8::Gemm g{XB, W1T, T, DIN, D}; pg8::StaticOrder S; S.init(T, DIN, G, (int)blockIdx.x);
        pg8::EpiScaleBf16<0> E{PROJ, DIN, RS1};
        pg8::gemm_phase<pg8::EpiScaleBf16<0>, pg8::StaticOrder, PG8_ALIGN, PG8_SP2>(lds + RING_OFF, g, S, E);
        if (BOTH(1)) GRID_BAR();
    }

    if (IN(2)) {
        for (int item = gw; item < NB * 64 * 4; item += NGW) {
            const int h = item & 3, n = (item >> 2) & 63, b = item >> 8;
            const size_t tok0 = (size_t)b * SEQ + n * 32;
            const int c0 = h * 128 + 2 * lane, cs = h * 128 + swap23(2 * lane);
            const float lb0 = 1.0f / (1.0f + __expf(hg_lb[512 + c0] - hg_lb[c0])), lb1 = 1.0f / (1.0f + __expf(hg_lb[512 + c0 + 1] - hg_lb[c0 + 1]));
            unsigned qw[32], fw[32], vw[32];
#pragma unroll
            for (int c = 0; c < 32; ++c) { const bf16* pr = PROJ + (tok0 + c) * DIN;
                qw[c] = *(const GAS unsigned*)(pr + PC_Q + c0); fw[c] = *(const GAS unsigned*)(pr + PC_F + c0); vw[c] = *(const GAS unsigned*)(pr + PC_V + c0); }
            float eG0 = 1.f, eG1 = 1.f;
            unsigned kd0[16], kd1[16], vv0[16], vv1[16];
#pragma unroll
            for (int i = 0; i < 16; ++i) { kd0[i] = 0u; kd1[i] = 0u; vv0[i] = 0u; vv1[i] = 0u; }
#pragma unroll
            for (int c = 0; c < 32; ++c) { bf16* pr = PROJ + (tok0 + c) * DIN;
                const float f0 = lb0 + (1.0f - lb0) * sigmoidf_(bf_lo(fw[c])), f1 = lb1 + (1.0f - lb1) * sigmoidf_(bf_hi(fw[c]));
                eG0 *= f0; eG1 *= f1;
                const float q0 = bf_lo(qw[c]), q1 = bf_hi(qw[c]);
                const float qd0 = q0 * sigmoidf_(q0) * 0.08838834764831845f * eG0, qd1 = q1 * sigmoidf_(q1) * 0.08838834764831845f * eG1;
                const float kv0 = (1.0f - f0) / eG0, kv1 = (1.0f - f1) / eG1;
                *(GAS unsigned*)(pr + PC_Q + cs) = pk2(qd0, qd1);
                const unsigned kp = pk2(kv0, kv1);
                *(GAS unsigned*)(pr + PC_F + cs) = kp;
                const int pp = swap23(c), sh = 16 * (pp & 1);
                kd0[pp >> 1] |= (kp & 0xffffu) << sh; kd1[pp >> 1] |= (kp >> 16) << sh;
                vv0[pp >> 1] |= (vw[c] & 0xffffu) << sh; vv1[pp >> 1] |= (vw[c] >> 16) << sh; }
            GAS v4u* kt = (GAS v4u*)(KDT + ((size_t)item * 128 + 2 * lane) * 32);
            GAS v4u* vt = (GAS v4u*)(VTT + ((size_t)item * 128 + 2 * lane) * 32);
#pragma unroll
            for (int i = 0; i < 4; ++i) { kt[i] = (v4u){kd0[4 * i], kd0[4 * i + 1], kd0[4 * i + 2], kd0[4 * i + 3]}; kt[4 + i] = (v4u){kd1[4 * i], kd1[4 * i + 1], kd1[4 * i + 2], kd1[4 * i + 3]};
                vt[i] = (v4u){vv0[4 * i], vv0[4 * i + 1], vv0[4 * i + 2], vv0[4 * i + 3]}; vt[4 + i] = (v4u){vv1[4 * i], vv1[4 * i + 1], vv1[4 * i + 2], vv1[4 * i + 3]}; }
            *(GAS f32x2*)(DEC + (size_t)item * 128 + 2 * lane) = (f32x2){eG0, eG1};
        }
        if (BOTH(2)) GRID_BAR();
    }

    if (IN(3)) {
        constexpr int BUFB = 33792, OB0 = 2 * BUFB;
        for (int it = (int)blockIdx.x; it < NB * 4; it += G) {
            const int b = it >> 2, h = it & 3;
            const int lt = tid & 255, r = lane & 31, hh = lane >> 5, sl = wave;
            v4u st[9];
#define SCAN_LOAD(n_) do { const size_t tk0 = (size_t)b * SEQ + (n_) * 32; const size_t itm = (size_t)((b * 64 + (n_)) * 4 + h); \
                _Pragma("unroll") for (int i = 0; i < 2; ++i) { const int q = lt + 256 * i, row = q >> 4, cc = q & 15; const bf16* pr = PROJ + (tk0 + row) * DIN + h * 128 + cc * 8; \
                    st[i] = *(const GAS v4u*)(pr + PC_Q); st[2 + i] = *(const GAS v4u*)(pr + PC_F); \
                    st[4 + i] = ((const GAS v4u*)(KDT + itm * 4096))[q]; st[6 + i] = ((const GAS v4u*)(VTT + itm * 4096))[q]; } \
                if (lt < 32) st[8] = ((const GAS v4u*)(DEC + itm * 128))[lt]; } while (0)
#define SCAN_COMMIT(n_) do { LAS unsigned char* Bf = lds + RING_OFF + ((n_) & 1) * BUFB; \
                _Pragma("unroll") for (int i = 0; i < 2; ++i) { const int q = lt + 256 * i, row = q >> 4, cc = q & 15, k = q >> 2, c4 = q & 3; \
                    *(LAS v4u*)(Bf + row * 256 + ((cc ^ (row & 15)) * 16)) = st[i]; *(LAS v4u*)(Bf + 8192 + row * 256 + ((cc ^ (row & 15)) * 16)) = st[2 + i]; \
                    *(LAS v4u*)(Bf + 16384 + k * 64 + ((c4 ^ ((k >> 2) & 3)) * 16)) = st[4 + i]; *(LAS v4u*)(Bf + 24576 + k * 64 + ((c4 ^ ((k >> 2) & 3)) * 16)) = st[6 + i]; } \
                if (lt < 32) *(LAS v4u*)(Bf + 32768 + lt * 16) = st[8]; } while (0)
#define SCAN_POST(n_) do { const int pos = lt >> 3, vg = lt & 7; const LAS f32x4* ob = (const LAS f32x4*)(lds + RING_OFF + OB0 + ((n_) & 1) * 16384 + (pos * 128 + vg * 16) * 4); \
                const f32x4 o0 = ob[0], o1 = ob[1], o2 = ob[2], o3 = ob[3]; \
                float ss = (o0.x * o0.x + o0.y * o0.y) + (o0.z * o0.z + o0.w * o0.w) + (o1.x * o1.x + o1.y * o1.y) + (o1.z * o1.z + o1.w * o1.w) \
                         + (o2.x * o2.x + o2.y * o2.y) + (o2.z * o2.z + o2.w * o2.w) + (o3.x * o3.x + o3.y * o3.y) + (o3.z * o3.z + o3.w * o3.w); \
                ss += dpp_f<0xB1>(ss); ss += dpp_f<0x4E>(ss); ss += dpp_f<0x141>(ss);     \
                const float rr = 1.0f / sqrtf(ss * (1.0f / 128.0f) + EPS); \
                const size_t tk = (size_t)b * SEQ + (n_) * 32 + pos; const v4u g0 = gp0, g1 = gp1; \
                const float ov[16] = {o0.x, o0.y, o0.z, o0.w, o1.x, o1.y, o1.z, o1.w, o2.x, o2.y, o2.z, o2.w, o3.x, o3.y, o3.z, o3.w}; \
                const float gf[16] = {bf_lo(g0.x), bf_hi(g0.x), bf_lo(g0.y), bf_hi(g0.y), bf_lo(g0.z), bf_hi(g0.z), bf_lo(g0.w), bf_hi(g0.w), bf_lo(g1.x), bf_hi(g1.x), bf_lo(g1.y), bf_hi(g1.y), bf_lo(g1.z), bf_hi(g1.z), bf_lo(g1.w), bf_hi(g1.w)}; \
                float yv[16]; _Pragma("unroll") for (int i = 0; i < 16; ++i) yv[i] = ov[i] * rr * gnl[i] * (gf[i] * sigmoidf_(gf[i])); \
                GAS v4u* mp = (GAS v4u*)(MIX + tk * D + 512 + h * 128 + vg * 16); \
                mp[0] = (v4u){pk2(yv[0], yv[1]), pk2(yv[2], yv[3]), pk2(yv[4], yv[5]), pk2(yv[6], yv[7])}; mp[1] = (v4u){pk2(yv[8], yv[9]), pk2(yv[10], yv[11]), pk2(yv[12], yv[13]), pk2(yv[14], yv[15])}; } while (0)
#define SCAN_GLOAD(n_) do { const GAS v4u* gp = (const GAS v4u*)(PROJ + ((size_t)b * SEQ + (n_) * 32 + (lt >> 3)) * DIN + PC_G + h * 128 + (lt & 7) * 16); gq0 = gp[0]; gq1 = gp[1]; } while (0)
#define SCAN_BAR() do { asm volatile("s_waitcnt lgkmcnt(0)" ::: "memory"); __builtin_amdgcn_s_barrier(); asm volatile("" ::: "memory"); } while (0)
            if (wave >= 4) {
                v4u gp0 = {0u, 0u, 0u, 0u}, gp1 = {0u, 0u, 0u, 0u}, gq0, gq1;
                float gnl[16];
#pragma unroll
                for (int i = 0; i < 16; ++i) gnl[i] = hg_gain[(lt & 7) * 16 + i];
                SCAN_LOAD(0); SCAN_COMMIT(0);
                SCAN_BAR();
                for (int n = 0; n < 64; ++n) {
                    if (n + 1 < 64) SCAN_LOAD(n + 1);
                    SCAN_GLOAD(n);
                    if (n >= 1) SCAN_POST(n - 1);
                    if (n + 1 < 64) SCAN_COMMIT(n + 1);
                    gp0 = gq0; gp1 = gq1;
                    SCAN_BAR();
                }
                SCAN_POST(63);
                SCAN_BAR();
            } else {
                f32x16 S0, S1, S2, S3;
#pragma unroll
                for (int i = 0; i < 16; ++i) { S0[i] = 0.f; S1[i] = 0.f; S2[i] = 0.f; S3[i] = 0.f; }
                SCAN_BAR();
                for (int n = 0; n < 64; ++n) {
                    const LAS unsigned char* Bf = lds + RING_OFF + (n & 1) * BUFB;
                    pg8::bf16x8 qd[8], kd[8], vt[2], kt[4][2];
#pragma unroll
                    for (int ks = 0; ks < 8; ++ks) { const int off = r * 256 + (((2 * ks + hh) ^ (r & 15)) * 16); qd[ks] = *(const LAS pg8::bf16x8*)(Bf + off); kd[ks] = *(const LAS pg8::bf16x8*)(Bf + 8192 + off); }
#pragma unroll
                    for (int sp = 0; sp < 2; ++sp) { const int row = 32 * sl + r; vt[sp] = *(const LAS pg8::bf16x8*)(Bf + 24576 + row * 64 + (((2 * sp + hh) ^ ((row >> 2) & 3)) * 16)); }
#pragma unroll
                    for (int rt = 0; rt < 4; ++rt)
#pragma unroll
                        for (int sp = 0; sp < 2; ++sp) { const int row = 32 * rt + r; kt[rt][sp] = *(const LAS pg8::bf16x8*)(Bf + 16384 + row * 64 + (((2 * sp + hh) ^ ((row >> 2) & 3)) * 16)); }
                    asm volatile("s_waitcnt lgkmcnt(0)" ::: "memory");
                    f32x16 X, O;
#pragma unroll
                    for (int i = 0; i < 16; ++i) { X[i] = 0.f; O[i] = 0.f; }
                    O = __builtin_amdgcn_mfma_f32_32x32x16_bf16(qd[0], pack8(S0, 0), O, 0, 0, 0); O = __builtin_amdgcn_mfma_f32_32x32x16_bf16(qd[1], pack8(S0, 1), O, 0, 0, 0);
                    O = __builtin_amdgcn_mfma_f32_32x32x16_bf16(qd[2], pack8(S1, 0), O, 0, 0, 0); O = __builtin_amdgcn_mfma_f32_32x32x16_bf16(qd[3], pack8(S1, 1), O, 0, 0, 0);
                    O = __builtin_amdgcn_mfma_f32_32x32x16_bf16(qd[4], pack8(S2, 0), O, 0, 0, 0); O = __builtin_amdgcn_mfma_f32_32x32x16_bf16(qd[5], pack8(S2, 1), O, 0, 0, 0);
                    O = __builtin_amdgcn_mfma_f32_32x32x16_bf16(qd[6], pack8(S3, 0), O, 0, 0, 0); O = __builtin_amdgcn_mfma_f32_32x32x16_bf16(qd[7], pack8(S3, 1), O, 0, 0, 0);
#pragma unroll
                    for (int ks = 0; ks < 8; ++ks) X = __builtin_amdgcn_mfma_f32_32x32x16_bf16(kd[ks], qd[ks], X, 0, 0, 0);
#define SCAN_SUPD(Sx, rt_) do { Sx = __builtin_amdgcn_mfma_f32_32x32x16_bf16(kt[rt_][0], vt[0], Sx, 0, 0, 0); Sx = __builtin_amdgcn_mfma_f32_32x32x16_bf16(kt[rt_][1], vt[1], Sx, 0, 0, 0); \
                        _Pragma("unroll") for (int g = 0; g < 4; ++g) { const f32x4 dv = *(const LAS f32x4*)(Bf + 32768 + (32 * (rt_) + 8 * g + 4 * hh) * 4); \
                            Sx[4 * g] *= dv.x; Sx[4 * g + 1] *= dv.y; Sx[4 * g + 2] *= dv.z; Sx[4 * g + 3] *= dv.w; } } while (0)
                    SCAN_SUPD(S0, 0); SCAN_SUPD(S1, 1); SCAN_SUPD(S2, 2); SCAN_SUPD(S3, 3);
#pragma unroll
                    for (int i = 0; i < 16; ++i) { const int s_ = (i & 3) + 8 * (i >> 2) + 4 * hh; X[i] = (s_ <= r) ? X[i] : 0.f; }
                    O = __builtin_amdgcn_mfma_f32_32x32x16_bf16(pack8(X, 0), vt[0], O, 0, 0, 0); O = __builtin_amdgcn_mfma_f32_32x32x16_bf16(pack8(X, 1), vt[1], O, 0, 0, 0);
                    LAS float* ob = (LAS float*)(lds + RING_OFF + OB0 + (n & 1) * 16384);
#pragma unroll
                    for (int i = 0; i < 16; ++i) ob[((i & 3) + 8 * (i >> 2) + 4 * hh) * 128 + 32 * sl + r] = O[i];
                    SCAN_BAR();
                }
                SCAN_BAR();
            }
        }
        {
            const int cb = (G > NB * 4) ? (int)blockIdx.x - NB * 4 : (int)blockIdx.x, ncb = (G > NB * 4) ? G - NB * 4 : G;
            if (cb >= 0) for (int item = cb * NWAVES + wave; item < NB * 4 * 32; item += ncb * NWAVES) {
                const int seg = item & 31, gp = (item >> 5) & 3, b = item >> 7, c0 = gp * 128 + 2 * lane, t0 = seg * 64;
                const f32x2 w0 = *(const GAS f32x2*)(conv_w + c0), w1 = *(const GAS f32x2*)(conv_w + 512 + c0), w2 = *(const GAS f32x2*)(conv_w + 1024 + c0), gn = *(const GAS f32x2*)(conv_gain + c0);
                f32x2 u1 = {0.f, 0.f}, u2 = {0.f, 0.f};
                if (t0 > 0) { const bf16* p2 = PROJ + (size_t)(b * SEQ + t0 - 2) * DIN; const bf16* p1 = p2 + DIN;
                    const unsigned ca = *(const GAS unsigned*)(p2 + PC_C + c0), ha = *(const GAS unsigned*)(p2 + PC_H + c0), cbb = *(const GAS unsigned*)(p1 + PC_C + c0), hb = *(const GAS unsigned*)(p1 + PC_H + c0);
                    u2 = (f32x2){bf_lo(ca) * bf_lo(ha), bf_hi(ca) * bf_hi(ha)}; u1 = (f32x2){bf_lo(cbb) * bf_lo(hb), bf_hi(cbb) * bf_hi(hb)}; }
                for (int tb = t0; tb < t0 + 64; tb += 8) {
                    unsigned cw[8], hw[8], bw[8];
#pragma unroll
                    for (int i = 0; i < 8; ++i) { const bf16* pr = PROJ + ((size_t)b * SEQ + tb + i) * DIN; cw[i] = *(const GAS unsigned*)(pr + PC_C + c0); hw[i] = *(const GAS unsigned*)(pr + PC_H + c0); bw[i] = *(const GAS unsigned*)(pr + PC_B + c0); }
#pragma unroll
                    for (int i = 0; i < 8; ++i) { const f32x2 u = {bf_lo(cw[i]) * bf_lo(hw[i]), bf_hi(cw[i]) * bf_hi(hw[i])};
                        const f32x2 y = (f32x2){bf_lo(bw[i]), bf_hi(bw[i])} * (w0 * u2 + w1 * u1 + w2 * u);
                        float ss = y.x * y.x + y.y * y.y;
                        ss += dpp_f<0xB1>(ss); ss += dpp_f<0x4E>(ss); ss += dpp_f<0x124>(ss); ss += dpp_f<0x128>(ss); ss = swap16_add(ss, ss);
                        const float r = 1.0f / sqrtf(ss * (1.0f / 64.0f) + EPS);
                        *(GAS unsigned*)(MIX + ((size_t)b * SEQ + tb + i) * D + c0) = pk2(y.x * r * gn.x, y.y * r * gn.y); u2 = u1; u1 = u; }
                }
            }
        }
        {
            const int cb = (G > NB * 4) ? (int)blockIdx.x - NB * 4 : (int)blockIdx.x, ncb = (G > NB * 4) ? G - NB * 4 : G;
            if (cb >= 0) {
                const int dw = cb * NWAVES + wave, ndw = ncb * NWAVES;
                LAS float* scr = (LAS float*)(lds + RING_OFF + wave * 16384);
                constexpr int I_O = (D / 64) * (D / 32), I_Q = (D / 64) * (2048 / 32);
                for (int it = dw; it < I_O + I_Q; it += ndw) { if (it < I_O) p0_transpose_item(w_out, D, D, nullptr, WOT, scr, it, lane); else p0_transpose_item(peer_wq, D, 2048, norm_ffn, WQT, scr, it - I_O, lane); }
                for (int i = dw * 64 + lane; i < 8 * 2 * 128 * 128 / 2; i += ndw * 64) ((GAS unsigned*)KEYB)[i] = pk2(peer_keys[2 * i], peer_keys[2 * i + 1]);
                for (int r = dw; r < 2 * NEXP; r += ndw) {
                    const int tb = r / NEXP, e = r % NEXP; const float sc = tb ? PEER_SV : PEER_SU;
                    const GAS f32x4* src = (const GAS f32x4*)((tb ? peer_v : peer_u) + (size_t)e * D);
                    f32x4 v[4] = {src[2 * lane], src[2 * lane + 1], src[128 + 2 * lane], src[128 + 2 * lane + 1]};
                    if (!tb) { const GAS f32x4* gp = (const GAS f32x4*)norm_ffn; v[0] = v[0] * gp[2 * lane]; v[1] = v[1] * gp[2 * lane + 1]; v[2] = v[2] * gp[128 + 2 * lane]; v[3] = v[3] * gp[128 + 2 * lane + 1]; }
                    unsigned o[4];
        #pragma unroll
                    for (int j = 0; j < 4; ++j) { f32x4 w = v[j] * sc;
                        if (tb) { w.x = fminf(fmaxf(w.x, -240.f), 240.f); w.y = fminf(fmaxf(w.y, -240.f), 240.f); w.z = fminf(fmaxf(w.z, -240.f), 240.f); w.w = fminf(fmaxf(w.w, -240.f), 240.f);
                            int pk = 0; pk = __builtin_amdgcn_cvt_pk_fp8_f32(w.x, w.y, pk, false); pk = __builtin_amdgcn_cvt_pk_fp8_f32(w.z, w.w, pk, true); o[j] = (unsigned)pk; }
                        else { const int i0 = (int)rintf(fminf(fmaxf(w.x, -127.f), 127.f)), i1 = (int)rintf(fminf(fmaxf(w.y, -127.f), 127.f)), i2 = (int)rintf(fminf(fmaxf(w.z, -127.f), 127.f)), i3 = (int)rintf(fminf(fmaxf(w.w, -127.f), 127.f));
                            o[j] = ((unsigned)i0 & 0xFFu) | (((unsigned)i1 & 0xFFu) << 8) | (((unsigned)i2 & 0xFFu) << 16) | (((unsigned)i3 & 0xFFu) << 24); } }
                    ((GAS v4u*)((tb ? V8 : U8) + (size_t)e * D))[lane] = (v4u){o[0], o[1], o[2], o[3]};
                }
            }
        }
        if (BOTH(3)) GRID_BAR();
    }


    if (IN(4)) {
        pg8::Gemm g{MIX, WOT, T, D, D}; pg8::StaticOrder S; S.init(T, D, G, (int)blockIdx.x);
        pg8::EpiResid E{x, X1, SS2};
        pg8::gemm_phase<pg8::EpiResid, pg8::StaticOrder, PG8_ALIGN, PG8_SP2>(lds + RING_OFF, g, S, E);
        if (BOTH(4)) GRID_BAR();
    }

    if (IN(5)) {
        pg8::Gemm g{X1, WQT, T, 2048, D}; pg8::StaticOrder S; S.init(T, 2048, G, (int)blockIdx.x);
        pg8::EpiScaleBf16<1> E{QB, 2048, SS2};
        pg8::gemm_phase<pg8::EpiScaleBf16<1>, pg8::StaticOrder, PG8_ALIGN, PG8_SP2>(lds + RING_OFF, g, S, E);
        if (BOTH(5)) GRID_BAR();
    }

    if (IN(6)) {
        const int r = lane & 31, hh = lane >> 5;
#define P6_STAGE(hb_) do { LAS unsigned char* kd_ = lds + RING_OFF + ((hb_) & 1) * 65536; \
            _Pragma("unroll") for (int i_ = 0; i_ < 8; ++i_) { const int idx_ = wave * 8 + i_, row_ = 4 * idx_ + (lane >> 4), cs_ = (lane & 15) ^ (row_ & 15); \
                __builtin_amdgcn_global_load_lds((const GAS unsigned*)(KEYB + (size_t)(hb_) * 32768 + (size_t)row_ * 128 + cs_ * 8), (LAS unsigned*)(kd_ + idx_ * 1024), 16, 0, 0); } } while (0)
        for (int tg0 = 0; tg0 < T / 32; tg0 += NGW) {
          const int tgi = (tg0 + gw < T / 32) ? tg0 + gw : tg0 + gw - NGW;
          const int tok = tgi * 32 + r;
          P6_STAGE(0);
          __syncthreads();
          for (int h = 0; h < 8; ++h) {
            if (h + 1 < 8) P6_STAGE(h + 1);
            const LAS unsigned char* kl = lds + RING_OFF + (h & 1) * 65536;
            unsigned L[2][16];
#pragma unroll
            for (int p = 0; p < 2; ++p) {
                pg8::bf16x8 qf[8];
                const GAS pg8::bf16x8* qp = (const GAS pg8::bf16x8*)(QB + (size_t)tok * 2048 + h * 256 + p * 128 + 8 * hh);
#pragma unroll
                for (int ks = 0; ks < 8; ++ks) qf[ks] = qp[2 * ks];
                const LAS unsigned char* kp = kl + p * 32768 + r * 256;
#pragma unroll
                for (int np = 0; np < 2; ++np) {
                    f32x16 acc0, acc1;
#pragma unroll
                    for (int i = 0; i < 16; ++i) { acc0[i] = 0.f; acc1[i] = 0.f; }
#pragma unroll
                    for (int ks = 0; ks < 8; ++ks) { const int sw = ((2 * ks + hh) ^ (r & 15)) * 16;
                        acc0 = __builtin_amdgcn_mfma_f32_32x32x16_bf16(*(const LAS pg8::bf16x8*)(kp + (2 * np) * 8192 + sw), qf[ks], acc0, 0, 0, 0);
                        acc1 = __builtin_amdgcn_mfma_f32_32x32x16_bf16(*(const LAS pg8::bf16x8*)(kp + (2 * np + 1) * 8192 + sw), qf[ks], acc1, 0, 0, 0); }
                    unsigned c0[16], c1[16];
#pragma unroll
                    for (int i = 0; i < 16; ++i) { const unsigned pay = (unsigned)(127 - (64 * np + (i & 3) + 8 * (i >> 2) + 4 * hh));
                        const float a0 = acc0[i], a1 = acc1[i]; unsigned u0 = __builtin_bit_cast(unsigned, a0), u1 = __builtin_bit_cast(unsigned, a1);
                        u0 ^= (unsigned)((int)u0 >> 31) | 0x80000000u; u1 ^= (unsigned)((int)u1 >> 31) | 0x80000000u;
                        c0[i] = (u0 & ~0x7Fu) | pay; c1[i] = (u1 & ~0x7Fu) | (pay - 32u); }
                    sort16_desc2(c0, c1);
                    merge16_desc(c0, c1);
                    if (np == 0) {
#pragma unroll
                        for (int i = 0; i < 16; ++i) L[p][i] = c0[i];
                    } else merge16_desc(L[p], c0);
                }
                unsigned o[16];
#pragma unroll
                for (int i = 0; i < 16; ++i) o[i] = (unsigned)__shfl_xor((int)L[p][i], 32);
                merge16_desc(L[p], o);
            }
            float v1[16], v2[16];
#pragma unroll
            for (int j = 0; j < 16; ++j) { v1[j] = unkey(L[0][j] & ~0x7Fu); v2[j] = unkey(L[1][j] & ~0x7Fu); }
            const unsigned hm = 0u - (unsigned)hh;
            unsigned ct[16];
#pragma unroll
            for (int t = 0; t < 16; ++t) { const unsigned rk = ckey(v1[0] + v2[t], t), ck = (t < 15) ? ckey(v1[t + 1] + v2[0], 16 * (t + 1)) : 0u; ct[t] = rk ^ ((rk ^ ck) & hm); }
            {
                constexpr int CI[20] = {1, 1, 1, 1, 1, 1, 1, 2, 3, 4,   5, 6, 7, 2, 2, 2, 3, 3, 4, 0};
                constexpr int CJ[20] = {1, 2, 3, 4, 5, 6, 7, 1, 1, 1,   1, 1, 1, 2, 3, 4, 2, 3, 2, 0};
#pragma unroll
                for (int s_ = 0; s_ < 10; ++s_) {
                    const int ia = CI[s_], ja = CJ[s_], ib = CI[10 + s_], jb = CJ[10 + s_];
                    const unsigned xa = __builtin_bit_cast(unsigned, v1[ia]), xb = __builtin_bit_cast(unsigned, v1[ib]), ya = __builtin_bit_cast(unsigned, v2[ja]), yb = __builtin_bit_cast(unsigned, v2[jb]);
                    const float xs = __builtin_bit_cast(float, xa ^ ((xa ^ xb) & hm)), ys = __builtin_bit_cast(float, ya ^ ((ya ^ yb) & hm));
                    const unsigned pa = 255u - (unsigned)(ia * 16 + ja), pb = 255u - (unsigned)(ib * 16 + jb);
                    const float sm = xs + ys; unsigned u = __builtin_bit_cast(unsigned, sm); u ^= (unsigned)((int)u >> 31) | 0x80000000u;
                    unsigned key = (u & ~0xFFu) | (pa ^ ((pa ^ pb) & hm));
                    if (s_ == 9) key &= ~hm;
#pragma unroll
                    for (int t = 0; t < 16; ++t) { const unsigned mx = ct[t] > key ? ct[t] : key; key = ct[t] > key ? key : ct[t]; ct[t] = mx; }
                }
                unsigned oc[16];
#pragma unroll
                for (int t = 0; t < 16; ++t) oc[t] = (unsigned)__shfl_xor((int)ct[t], 32);
                merge16_desc(ct, oc);
            }
            float den = 0.f, ex[16]; const float cmax = unkey(ct[0] & ~0xFFu);
#pragma unroll
            for (int t = 0; t < 16; ++t) { ex[t] = __expf(unkey(ct[t] & ~0xFFu) - cmax); den += ex[t]; }
            const float inv = 1.0f / den;
            unsigned b1[4], b2[4];
#pragma unroll
            for (int w = 0; w < 4; ++w) { b1[w] = (L[0][4 * w] & 0x7Fu) | ((L[0][4 * w + 1] & 0x7Fu) << 8) | ((L[0][4 * w + 2] & 0x7Fu) << 16) | ((L[0][4 * w + 3] & 0x7Fu) << 24);
                b2[w] = (L[1][4 * w] & 0x7Fu) | ((L[1][4 * w + 1] & 0x7Fu) << 8) | ((L[1][4 * w + 2] & 0x7Fu) << 16) | ((L[1][4 * w + 3] & 0x7Fu) << 24); }
            unsigned ent[8];
#pragma unroll
            for (int t = 0; t < 8; ++t) {
                const unsigned ck = ct[t] ^ ((ct[t] ^ ct[8 + t]) & hm); const unsigned e0 = __builtin_bit_cast(unsigned, ex[t]), e1 = __builtin_bit_cast(unsigned, ex[8 + t]);
                const float gt = __builtin_bit_cast(float, e0 ^ ((e0 ^ e1) & hm)) * inv;
                const unsigned flat = 255u - (ck & 0xFFu), ii = flat >> 4, jj = flat & 15u;
                const unsigned w1 = (ii & 8u) ? ((ii & 4u) ? b1[3] : b1[2]) : ((ii & 4u) ? b1[1] : b1[0]), w2 = (jj & 8u) ? ((jj & 4u) ? b2[3] : b2[2]) : ((jj & 4u) ? b2[1] : b2[0]);
                const unsigned n1 = 127u - ((w1 >> (8u * (ii & 3u))) & 0x7Fu), n2 = 127u - ((w2 >> (8u * (jj & 3u))) & 0x7Fu);
                ent[t] = (n1 * 128u + n2) | (pkh2(gt, 0.f) << 16); }
            GAS v4u* ep = (GAS v4u*)(EXPT + (size_t)tok * 128 + h * 16 + 8 * hh);
            ep[0] = (v4u){ent[0], ent[1], ent[2], ent[3]}; ep[1] = (v4u){ent[4], ent[5], ent[6], ent[7]};
            __syncthreads();
          }
        }
        if (BOTH(6)) GRID_BAR();
    }


    if (IN(7)) {
        constexpr int NT = 4;
        unsigned pace_round = 0u;
        unsigned* pace_cnt = (unsigned*)(ctl + 16384) + 64 * bar.x;
        const unsigned pace_n = (N_LAUNCHES == 1) ? MISC[8] : 0u;
#define PEER_PACE() do { if (pace_n) { ++pace_round; __syncthreads(); if (tid == 0) { xb_add(pace_cnt, 1u); unsigned sp_ = 0; while (xb_ld(pace_cnt) < pace_n * pace_round && ++sp_ < 20000u) __builtin_amdgcn_s_sleep(1); } __syncthreads(); } } while (0)
        const unsigned srcl = (unsigned)(32 * (lane & 1) + 16 * ((lane >> 1) & 1)) << 2;
        for (int bt0 = 0; bt0 < T / NT; bt0 += NGW) {
            const int bt = (bt0 + gw < T / NT) ? bt0 + gw : bt0 + gw - NGW;
            const int tok0 = bt * NT;
            unsigned e[NT][2]; float rs2[NT];
#pragma unroll
            for (int t = 0; t < NT; ++t) { const unsigned r0 = EXPT[(size_t)(tok0 + t) * 128 + lane], r1 = EXPT[(size_t)(tok0 + t) * 128 + 64 + lane];
                e[t][0] = (r0 << 16) | (r0 >> 16); e[t][1] = (r1 << 16) | (r1 >> 16);
                rs2[t] = 1.0f / sqrtf(SS2[tok0 + t] * (1.0f / D) + EPS); }
            sort128_asc<NT>(e, lane);
            PEER_PACE();
            int ah[NT][2]; int hx[NT][4]; float xs[NT];
#pragma unroll
            for (int t = 0; t < NT; ++t) { const GAS v4u* xr = (const GAS v4u*)(X1 + (size_t)(tok0 + t) * D); const v4u xa = __builtin_nontemporal_load(xr + lane), xb = __builtin_nontemporal_load(xr + 64 + lane);
                const float xv[16] = {bf_lo(xa.x), bf_hi(xa.x), bf_lo(xa.y), bf_hi(xa.y), bf_lo(xa.z), bf_hi(xa.z), bf_lo(xa.w), bf_hi(xa.w), bf_lo(xb.x), bf_hi(xb.x), bf_lo(xb.y), bf_hi(xb.y), bf_lo(xb.z), bf_hi(xb.z), bf_lo(xb.w), bf_hi(xb.w)};
                float am = 0.f;
#pragma unroll
                for (int i = 0; i < 16; ++i) am = fmaxf(am, fabsf(xv[i]));
                am = fmaxf(wave_max(am), 1e-20f); const float sx = 127.0f / am; xs[t] = am * (1.0f / 127.0f);
#pragma unroll
                for (int w = 0; w < 4; ++w) { const int i0 = (int)rintf(xv[4 * w] * sx), i1 = (int)rintf(xv[4 * w + 1] * sx), i2 = (int)rintf(xv[4 * w + 2] * sx), i3 = (int)rintf(xv[4 * w + 3] * sx);
                    hx[t][w] = (int)(((unsigned)i0 & 0xFFu) | (((unsigned)i1 & 0xFFu) << 8) | (((unsigned)i2 & 0xFFu) << 16) | (((unsigned)i3 & 0xFFu) << 24)); }
                ah[t][0] = 0; ah[t][1] = 0; }
#define PEER_LOAD(buf, st_) do { _Pragma("unroll") for (int t = 0; t < NT; ++t) { const unsigned em_ = ((st_) & 16) ? 0xFFFFFFFFu : 0u; const unsigned esel = e[t][0] ^ ((e[t][0] ^ e[t][1]) & em_); \
                _Pragma("unroll") for (int q = 0; q < 4; ++q) { const unsigned id = (unsigned)__builtin_amdgcn_readlane((int)esel, 4 * ((st_) & 15) + q) >> 16; \
                    buf[t][q] = ((const GAS v4u*)(U8 + (size_t)id * D))[lane]; } } } while (0)
#define PEER_DOTS(buf, st_) do { int p[16]; \
                _Pragma("unroll") for (int t = 0; t < NT; ++t) _Pragma("unroll") for (int q = 0; q < 4; ++q) { \
                    const int d0 = __builtin_amdgcn_sdot4((int)buf[t][q].x, hx[t][0], 0, false), d1 = __builtin_amdgcn_sdot4((int)buf[t][q].z, hx[t][2], 0, false); \
                    p[4 * t + q] = __builtin_amdgcn_sdot4((int)buf[t][q].y, hx[t][1], d0, false) + __builtin_amdgcn_sdot4((int)buf[t][q].w, hx[t][3], d1, false); } \
                const int red = reduce16i(p, lane); const bool hit = (lane >> 2) == ((st_) & 15), hi = ((st_) & 16) != 0; \
                _Pragma("unroll") for (int t = 0; t < NT; ++t) { const int got = __builtin_amdgcn_ds_bpermute((int)(srcl + (unsigned)((8 * (t & 1) + 4 * (t >> 1)) << 2)), red); \
                    ah[t][0] = (hit && !hi) ? got : ah[t][0]; ah[t][1] = (hit && hi) ? got : ah[t][1]; } } while (0)
            {
                v4u ua[NT][4], ubb[NT][4];
                PEER_LOAD(ua, 0);
                for (int st = 0; st < 32; st += 2) {
                    PEER_LOAD(ubb, st + 1);
                    PEER_DOTS(ua, st);
                    if (st + 2 < 32) PEER_LOAD(ua, st + 2);
                    PEER_DOTS(ubb, st + 1);
                }
            }
            float wv[NT][2];
#pragma unroll
            for (int t = 0; t < NT; ++t)
#pragma unroll
                for (int g = 0; g < 2; ++g) { const float a = (float)ah[t][g] * (rs2[t] * xs[t] * (1.0f / PEER_SU)); const float gate = (float)h2_of(e[t][g] & 0xFFFFu).x;
                    wv[t][g] = gate * (0.5f / PEER_SV) * a * (1.0f + erff(a * 0.7071067811865476f)); }
            f32x2 y[NT][8];
#pragma unroll
            for (int t = 0; t < NT; ++t)
#pragma unroll
                for (int i = 0; i < 8; ++i) y[t][i] = (f32x2){0.f, 0.f};
#define PEER_LOADB(buf, st_) do { _Pragma("unroll") for (int t = 0; t < NT; ++t) { const unsigned em_ = ((st_) & 32) ? 0xFFFFFFFFu : 0u; const unsigned esel = e[t][0] ^ ((e[t][0] ^ e[t][1]) & em_); \
                _Pragma("unroll") for (int q = 0; q < 2; ++q) { const unsigned id = (unsigned)__builtin_amdgcn_readlane((int)esel, 2 * ((st_) & 31) + q) >> 16; \
                    buf[t][q] = ((const GAS v4u*)(V8 + (size_t)id * D))[lane]; } } } while (0)
#define PEER_AXPY(buf, st_) do { _Pragma("unroll") for (int t = 0; t < NT; ++t) { const unsigned wm_ = ((st_) & 32) ? 0xFFFFFFFFu : 0u; const unsigned w0_ = __builtin_bit_cast(unsigned, wv[t][0]), w1_ = __builtin_bit_cast(unsigned, wv[t][1]); const unsigned wsel = w0_ ^ ((w0_ ^ w1_) & wm_); \
                _Pragma("unroll") for (int q = 0; q < 2; ++q) { const float wi = __builtin_bit_cast(float, __builtin_amdgcn_readlane((int)wsel, 2 * ((st_) & 31) + q)); const f32x2 w2 = {wi, wi}; \
                    const unsigned vw_[4] = {buf[t][q].x, buf[t][q].y, buf[t][q].z, buf[t][q].w}; \
                    _Pragma("unroll") for (int j = 0; j < 4; ++j) { y[t][2 * j] = __builtin_elementwise_fma(__builtin_amdgcn_cvt_pk_f32_fp8((int)vw_[j], false), w2, y[t][2 * j]); y[t][2 * j + 1] = __builtin_elementwise_fma(__builtin_amdgcn_cvt_pk_f32_fp8((int)vw_[j], true), w2, y[t][2 * j + 1]); } } } } while (0)
            {
                v4u va[NT][2], vbb[NT][2];
                PEER_LOADB(va, 0);
                for (int st = 0; st < 64; st += 2) {
                    PEER_LOADB(vbb, st + 1);
                    PEER_AXPY(va, st);
                    if (st + 2 < 64) PEER_LOADB(va, st + 2);
                    PEER_AXPY(vbb, st + 1);
                }
            }
#pragma unroll
            for (int t = 0; t < NT; ++t) { const size_t tok = (size_t)(tok0 + t);
                const GAS v4u* xr = (const GAS v4u*)(X1 + tok * D); const v4u xa = __builtin_nontemporal_load(xr + lane), xb = __builtin_nontemporal_load(xr + 64 + lane);
                const float xf[16] = {bf_lo(xa.x), bf_hi(xa.x), bf_lo(xa.y), bf_hi(xa.y), bf_lo(xa.z), bf_hi(xa.z), bf_lo(xa.w), bf_hi(xa.w),
                                      bf_lo(xb.x), bf_hi(xb.x), bf_lo(xb.y), bf_hi(xb.y), bf_lo(xb.z), bf_hi(xb.z), bf_lo(xb.w), bf_hi(xb.w)};
                float yy[16]; float ss = 0.f;
#pragma unroll
                for (int i = 0; i < 8; ++i) { yy[2 * i] = y[t][i].x + xf[2 * i]; yy[2 * i + 1] = y[t][i].y + xf[2 * i + 1]; ss += yy[2 * i] * yy[2 * i] + yy[2 * i + 1] * yy[2 * i + 1]; }
                ss = wave_sum(ss);
                const float r = 1.0f / sqrtf(ss * (1.0f / D) + EPS);
                const GAS f32x4* nfp = (const GAS f32x4*)norm_f; const f32x4 n0 = nfp[2 * lane], n1 = nfp[2 * lane + 1], n2 = nfp[128 + 2 * lane], n3 = nfp[128 + 2 * lane + 1];
                GAS f32x4* op = (GAS f32x4*)(out + tok * D);
                __builtin_nontemporal_store((f32x4){yy[0] * r * n0.x, yy[1] * r * n0.y, yy[2] * r * n0.z, yy[3] * r * n0.w}, op + 2 * lane);
                __builtin_nontemporal_store((f32x4){yy[4] * r * n1.x, yy[5] * r * n1.y, yy[6] * r * n1.z, yy[7] * r * n1.w}, op + 2 * lane + 1);
                __builtin_nontemporal_store((f32x4){yy[8] * r * n2.x, yy[9] * r * n2.y, yy[10] * r * n2.z, yy[11] * r * n2.w}, op + 128 + 2 * lane);
                __builtin_nontemporal_store((f32x4){yy[12] * r * n3.x, yy[13] * r * n3.y, yy[14] * r * n3.z, yy[15] * r * n3.w}, op + 128 + 2 * lane + 1); }
        }
    }

#undef IN
#undef BOTH
}

extern "C" void kernel_launch(void* const* d_in, const int* in_sizes, int n_in, void* d_out, int out_size, void* d_ws, size_t ws_size, hipStream_t stream) {
    static int grid = 0;
    if (grid == 0) {
        if (n_in != 14 || in_sizes[0] != T * D || out_size != T * D || ws_size < WS_END) { fprintf(stderr, "kernel_launch: unexpected shapes (n_in %d, in0 %d, out %d, ws %zu); nothing launched\n", n_in, n_in > 0 ? in_sizes[0] : -1, out_size, ws_size); grid = -1; return; }
        int dev = 0, cus = 0, per_cu = 0;
        if (hipGetDevice(&dev) != hipSuccess || hipDeviceGetAttribute(&cus, hipDeviceAttributeMultiprocessorCount, dev) != hipSuccess) { grid = -1; return; }
        if (hipFuncSetAttribute((const void*)hymba_fwd, hipFuncAttributeMaxDynamicSharedMemorySize, LDS_BYTES) != hipSuccess) { fprintf(stderr, "kernel_launch: hipFuncSetAttribute failed\n"); grid = -1; return; }
        if (hipOccupancyMaxActiveBlocksPerMultiprocessor(&per_cu, (const void*)hymba_fwd, NWAVES * 64, LDS_BYTES) != hipSuccess || per_cu < 1) { fprintf(stderr, "kernel_launch: occupancy query says %d blocks per CU\n", per_cu); (void)hipGetLastError(); grid = -1; return; }
        grid = cus;
    }
    if (grid < 0) return;
    if (hipMemsetAsync((char*)d_ws + WS_CTL, 0, CTL_ZERO_BYTES, stream) != hipSuccess) { fprintf(stderr, "kernel_launch: hipMemsetAsync failed\n"); return; }
    Args a{};
    for (int i = 0; i < 14; ++i) a.in[i] = (const float*)d_in[i];
    a.out = (float*)d_out; a.ws = (unsigned char*)d_ws;
    if (N_LAUNCHES == 1) {
        a.ph_lo = 0; a.ph_hi = NPHASES; a.li = 0;
        void* kargs[] = {&a};
        const hipError_t e = hipLaunchCooperativeKernel((const void*)hymba_fwd, dim3(grid), dim3(NWAVES * 64), kargs, LDS_BYTES, stream);
        if (e != hipSuccess) fprintf(stderr, "kernel_launch: cooperative launch failed: %s (grid %d)\n", hipGetErrorString(e), grid);
    } else {
        for (int li = 0; li < NPHASES; ++li) {
            a.ph_lo = li; a.ph_hi = li + 1; a.li = li;
            hipLaunchKernelGGL(hymba_fwd, dim3(grid), dim3(NWAVES * 64), LDS_BYTES, stream, a);
            const hipError_t le = hipPeekAtLastError();
            if (le != hipSuccess) { fprintf(stderr, "kernel_launch: launch %d failed: %s\n", li, hipGetErrorName(le)); break; }
        }
    }
}
```

```cpp
#include <hip/hip_runtime.h>
#include <cstdio>
#include <cstdint>
namespace pg8 {
#define PG8_LAS __attribute__((address_space(3)))
typedef unsigned short bf16_t;
typedef short bf16x8 __attribute__((ext_vector_type(8)));
typedef float f32x4 __attribute__((ext_vector_type(4)));
typedef unsigned u32x4 __attribute__((ext_vector_type(4)));
constexpr int BM = 256, BK = 64, HALF = 128, HTB = HALF * BK * 2  , STAGE_BYTES = 8 * HTB, NXCD = 8, WGM = 8;

__host__ __device__ __forceinline__ int lds_byte(int r, int c) { const int st = (r >> 4) * 2 + (c >> 5), rr = r & 15, cc = c & 31, ob = rr * 64 + cc * 2; return st * 1024 + (ob ^ (((ob >> 9) & 1) << 5)); }
__host__ __device__ __forceinline__ void stage_rc(int b, int& R, int& C) { const int st = b / 1024, sb = b % 1024, swz = sb ^ (((sb >> 9) & 1) << 5); R = (st >> 1) * 16 + swz / 64; C = (st & 1) * 32 + (swz % 64) / 2; }
__host__ __device__ __forceinline__ int perm32(int rho) { const int n = rho >> 4, i = rho & 15; return 8 * (i >> 2) + 4 * n + (i & 3); }

struct Unit { int pm, pn; };
struct Gemm { const bf16_t* A; const bf16_t* Bt; int M, N, K; };

struct StaticOrder {
    int nM, nN, nwg, G, c;
    __host__ __device__ void init(int M, int N, int G_, int c_) { nM = M / BM; nN = N / BM; nwg = nM * nN; G = G_; c = c_; }
    __host__ __device__ bool next(int i, Unit& u) const {
        const long L = (long)i * G + c; if (L >= nwg) return false;
        int wgid = (int)L; { const int q = nwg / NXCD, r = nwg % NXCD, xcd = wgid % NXCD, off = wgid / NXCD; wgid = (xcd < r ? xcd * (q + 1) : r * (q + 1) + (xcd - r) * q) + off; }
        const int nig = WGM * nN, gid = wgid / nig, fm = gid * WGM, gsz = (nM - fm) < WGM ? (nM - fm) : WGM;
        u.pm = fm + ((wgid % nig) % gsz); u.pn = (wgid % nig) / gsz; return true;
    }
    __device__ __forceinline__ void a_ready(const Unit&) const {}
    __device__ __forceinline__ void done(const Unit&) const {}
};

__device__ __forceinline__ unsigned cvt_pk_bf16(float lo, float hi) { unsigned r; asm volatile("v_cvt_pk_bf16_f32 %0, %1, %2" : "=v"(r) : "v"(lo), "v"(hi)); return r; }

template <int MODE> struct EpiScaleBf16 {
    static constexpr bool PERM = true, AFTER_DRAIN = false;
    bf16_t* O; int ldc; const float* rowv;
    __device__ __forceinline__ void operator()(const f32x4 (&acc)[2][2][4][2], const Unit& u, int wr, int wc, int fr, int fq) const {
        const int row0 = u.pm * BM + wr * 64 + fr, col0 = u.pn * BM + wc * 32 + 8 * fq;
#pragma unroll
        for (int ai = 0; ai < 2; ++ai)
#pragma unroll
            for (int m = 0; m < 4; ++m) { const int row = row0 + ai * HALF + m * 16; float s = rowv[row]; if (MODE >= 1) s = __builtin_amdgcn_rsqf(s * (1.0f / 1024.0f) + 1e-6f);
                bf16_t* rowp = O + (size_t)row * ldc + col0;
#pragma unroll
                for (int bj = 0; bj < 2; ++bj) { const f32x4 v0 = acc[ai][bj][m][0] * s, v1 = acc[ai][bj][m][1] * s;
                    u32x4 w;
                    if (MODE == 2) { w.x = __builtin_bit_cast(unsigned, __builtin_amdgcn_cvt_pkrtz(v0[0], v0[1])); w.y = __builtin_bit_cast(unsigned, __builtin_amdgcn_cvt_pkrtz(v0[2], v0[3])); w.z = __builtin_bit_cast(unsigned, __builtin_amdgcn_cvt_pkrtz(v1[0], v1[1])); w.w = __builtin_bit_cast(unsigned, __builtin_amdgcn_cvt_pkrtz(v1[2], v1[3])); }
                    else { w.x = cvt_pk_bf16(v0[0], v0[1]); w.y = cvt_pk_bf16(v0[2], v0[3]); w.z = cvt_pk_bf16(v1[0], v1[1]); w.w = cvt_pk_bf16(v1[2], v1[3]); }
                    *(u32x4*)(rowp + bj * HALF) = w; } }
    }
};
struct EpiProj {
    static constexpr bool PERM = true, AFTER_DRAIN = false;
    bf16_t* O; const float* rowv; const float* lbl; float* dec;
    template <int CTRL> static __device__ __forceinline__ float dppm(float v) { return __builtin_bit_cast(float, __builtin_amdgcn_update_dpp(0x3f800000, __builtin_bit_cast(int, v), CTRL, 0xF, 0xF, false)); }
    static __device__ __forceinline__ float scan16(float x) { x *= dppm<0x111>(x); x *= dppm<0x112>(x); x *= dppm<0x114>(x); x *= dppm<0x118>(x); return x; }
    static __device__ __forceinline__ float prod16(float x) { x *= dppm<0xB1>(x); x *= dppm<0x4E>(x); x *= dppm<0x141>(x); x *= dppm<0x140>(x); return x; }
    static __device__ __forceinline__ float sigm(float x) { return __builtin_amdgcn_rcpf(1.0f + __expf(-x)); }
    __device__ __forceinline__ void operator()(const f32x4 (&acc)[2][2][4][2], const Unit& u, int wr, int wc, int fr, int fq) const {
        const int row0 = u.pm * BM + wr * 64 + fr, colw = wc * 32 + 8 * fq;
        if (u.pn >= 6 && u.pn < 10) {
            const int h = u.pn - 6;
            float lb[8];
#pragma unroll
            for (int j = 0; j < 8; ++j) { const int c = h * 128 + colw + j; lb[j] = __builtin_amdgcn_rcpf(1.0f + __expf(lbl[512 + c] - lbl[c])); }
#pragma unroll
            for (int ai = 0; ai < 2; ++ai)
#pragma unroll
                for (int mp = 0; mp < 2; ++mp) {
                    const int rowe = row0 + ai * HALF + (2 * mp) * 16, rowo = rowe + 16; const float se = rowv[rowe], so = rowv[rowo];
                    float qe[8], qo[8], ke[8], ko[8], dc[8];
#pragma unroll
                    for (int j = 0; j < 8; ++j) { const int n = j >> 2, jj = j & 3;
                        const float fe = lb[j] + (1.0f - lb[j]) * sigm(acc[ai][1][2 * mp][n][jj] * se), fo = lb[j] + (1.0f - lb[j]) * sigm(acc[ai][1][2 * mp + 1][n][jj] * so);
                        const float Ge = scan16(fe), Go = prod16(fe) * scan16(fo);
                        const float xe = acc[ai][0][2 * mp][n][jj] * se, xo = acc[ai][0][2 * mp + 1][n][jj] * so;
                        qe[j] = xe * sigm(xe) * 0.08838834764831845f * Ge; qo[j] = xo * sigm(xo) * 0.08838834764831845f * Go;
                        ke[j] = (1.0f - fe) * __builtin_amdgcn_rcpf(Ge); ko[j] = (1.0f - fo) * __builtin_amdgcn_rcpf(Go); dc[j] = Go; }
                    bf16_t* pe = O + (size_t)rowe * 3072 + 1024 + h * 128 + colw; bf16_t* po = pe + (size_t)16 * 3072;
                    u32x4 w; w.x = cvt_pk_bf16(qe[0], qe[1]); w.y = cvt_pk_bf16(qe[2], qe[3]); w.z = cvt_pk_bf16(qe[4], qe[5]); w.w = cvt_pk_bf16(qe[6], qe[7]); *(u32x4*)pe = w;
                    w.x = cvt_pk_bf16(ke[0], ke[1]); w.y = cvt_pk_bf16(ke[2], ke[3]); w.z = cvt_pk_bf16(ke[4], ke[5]); w.w = cvt_pk_bf16(ke[6], ke[7]); *(u32x4*)(pe + 512) = w;
                    w.x = cvt_pk_bf16(qo[0], qo[1]); w.y = cvt_pk_bf16(qo[2], qo[3]); w.z = cvt_pk_bf16(qo[4], qo[5]); w.w = cvt_pk_bf16(qo[6], qo[7]); *(u32x4*)po = w;
                    w.x = cvt_pk_bf16(ko[0], ko[1]); w.y = cvt_pk_bf16(ko[2], ko[3]); w.z = cvt_pk_bf16(ko[4], ko[5]); w.w = cvt_pk_bf16(ko[6], ko[7]); *(u32x4*)(po + 512) = w;
                    if (fr == 15) { const int chunk = (u.pm * BM + ai * HALF + wr * 64 + mp * 32) >> 5;
                        float* dp = dec + ((size_t)chunk * 4 + h) * 128 + colw; *(f32x4*)dp = (f32x4){dc[0], dc[1], dc[2], dc[3]}; *(f32x4*)(dp + 4) = (f32x4){dc[4], dc[5], dc[6], dc[7]}; }
                }
            return;
        }
#pragma unroll
        for (int ai = 0; ai < 2; ++ai)
#pragma unroll
            for (int m = 0; m < 4; ++m) { const int row = row0 + ai * HALF + m * 16; const float s = rowv[row];
                bf16_t* rowp = O + (size_t)row * 3072 + colw;
                if (u.pn < 4) { const f32x4 v0 = (acc[ai][0][m][0] * s) * (acc[ai][1][m][0] * s), v1 = (acc[ai][0][m][1] * s) * (acc[ai][1][m][1] * s);
                    u32x4 w; w.x = cvt_pk_bf16(v0[0], v0[1]); w.y = cvt_pk_bf16(v0[2], v0[3]); w.z = cvt_pk_bf16(v1[0], v1[1]); w.w = cvt_pk_bf16(v1[2], v1[3]);
                    *(u32x4*)(rowp + u.pn * HALF) = w; }
                else {
#pragma unroll
                    for (int bj = 0; bj < 2; ++bj) { const f32x4 v0 = acc[ai][bj][m][0] * s, v1 = acc[ai][bj][m][1] * s;
                        u32x4 w; w.x = cvt_pk_bf16(v0[0], v0[1]); w.y = cvt_pk_bf16(v0[2], v0[3]); w.z = cvt_pk_bf16(v1[0], v1[1]); w.w = cvt_pk_bf16(v1[2], v1[3]);
                        *(u32x4*)(rowp + u.pn * BM - 512 + bj * HALF) = w; } } }
    }
};
struct EpiResid {
    static constexpr bool PERM = true, AFTER_DRAIN = false;
    const bf16_t* X; bf16_t* O; float* ss;
    __device__ __forceinline__ void operator()(const f32x4 (&acc)[2][2][4][2], const Unit& u, int wr, int wc, int fr, int fq) const {
        const int row0 = u.pm * BM + wr * 64 + fr, col0 = u.pn * BM + wc * 32 + 8 * fq;
#pragma unroll
        for (int ai = 0; ai < 2; ++ai)
#pragma unroll
            for (int m = 0; m < 4; ++m) { const int row = row0 + ai * HALF + m * 16; float part = 0.f;
#pragma unroll
                for (int bj = 0; bj < 2; ++bj) { const u32x4 xw = *(const u32x4*)(X + (size_t)row * 1024 + col0 + bj * HALF);
                    const f32x4 x0 = {__builtin_bit_cast(float, xw.x << 16), __builtin_bit_cast(float, xw.x & 0xffff0000u), __builtin_bit_cast(float, xw.y << 16), __builtin_bit_cast(float, xw.y & 0xffff0000u)};
                    const f32x4 x1 = {__builtin_bit_cast(float, xw.z << 16), __builtin_bit_cast(float, xw.z & 0xffff0000u), __builtin_bit_cast(float, xw.w << 16), __builtin_bit_cast(float, xw.w & 0xffff0000u)};
                    const f32x4 v0 = acc[ai][bj][m][0] + x0, v1 = acc[ai][bj][m][1] + x1;
                    part += (v0[0] * v0[0] + v0[1] * v0[1]) + (v0[2] * v0[2] + v0[3] * v0[3]) + (v1[0] * v1[0] + v1[1] * v1[1]) + (v1[2] * v1[2] + v1[3] * v1[3]);
                    u32x4 w; w.x = cvt_pk_bf16(v0[0], v0[1]); w.y = cvt_pk_bf16(v0[2], v0[3]); w.z = cvt_pk_bf16(v1[0], v1[1]); w.w = cvt_pk_bf16(v1[2], v1[3]);
                    *(u32x4*)(O + (size_t)row * 1024 + col0 + bj * HALF) = w; }
                part += __shfl_xor(part, 16); part += __shfl_xor(part, 32);
                if (fq == 0) (void)__builtin_amdgcn_global_atomic_fadd_f32((__attribute__((address_space(1))) float*)(ss + row), part); }
    }
};

template <class Epi, class Sched, bool ALIGN_EPI = false, bool SP2 = false>
__device__ __forceinline__ void gemm_phase(PG8_LAS unsigned char* lds, const Gemm g, const Sched& S, const Epi& E) {
    const int tid = threadIdx.x, wid = __builtin_amdgcn_readfirstlane(tid >> 6), lane = tid & 63, wr = wid >> 2, wc = wid & 3, fr = lane & 15, fq = lane >> 4;
    const int K = g.K, nt = K / BK;
    unsigned voffA[2], voffB[2];
#pragma unroll
    for (int i = 0; i < 2; ++i) { int R, C; stage_rc(tid * 16 + i * 8192, R, C); const int Rb = Epi::PERM ? ((R & ~31) + perm32(R & 31)) : R;
        voffA[i] = (unsigned)(R * K + C) * 2u; voffB[i] = (unsigned)(Rb * K + C) * 2u; }
    const size_t kstep = (size_t)(BK * 2);
    const size_t hstep = (size_t)HALF * K * 2;
    const size_t tstep = 2 * hstep;
    const unsigned ldsw = (unsigned)wid * 1024u;
    const int aoff = lds_byte(wr * 64 + fr, fq * 8), boff = lds_byte(wc * 32 + fr, fq * 8);
#define PG8_SA(b, h) (((b) * 2 + (h)) * HTB)
#define PG8_SB(b, h) ((4 + (b) * 2 + (h)) * HTB)
#define PG8_STAGE(bufoff, gbase, voff) do { _Pragma("unroll") for (int _i = 0; _i < 2; ++_i) \
        __builtin_amdgcn_global_load_lds((const unsigned*)((const char*)(gbase) + (voff)[_i]), (PG8_LAS unsigned*)(lds + (bufoff) + ldsw + _i * 8192), 16, 0, 0); } while (0)
#define PG8_LDA(dst, b, h) do { _Pragma("unroll") for (int m = 0; m < 4; ++m) _Pragma("unroll") for (int k = 0; k < 2; ++k) dst[m][k] = *(const PG8_LAS bf16x8*)(lds + PG8_SA(b, h) + aoff + m * 2048 + k * 1024); } while (0)
#define PG8_LDB(dst, b, h) do { _Pragma("unroll") for (int n = 0; n < 2; ++n) _Pragma("unroll") for (int k = 0; k < 2; ++k) dst[n][k] = *(const PG8_LAS bf16x8*)(lds + PG8_SB(b, h) + boff + n * 2048 + k * 1024); } while (0)
#define PG8_MMA(ai, bj, At, Bt) do { __builtin_amdgcn_s_setprio(1); _Pragma("unroll") for (int m = 0; m < 4; ++m) _Pragma("unroll") for (int n = 0; n < 2; ++n) _Pragma("unroll") for (int k = 0; k < 2; ++k) \
        acc[ai][bj][m][n] = __builtin_amdgcn_mfma_f32_16x16x32_bf16(Bt[n][k], At[m][k], acc[ai][bj][m][n], 0, 0, 0); __builtin_amdgcn_s_setprio(0); } while (0)
#define PG8_WAIT_V(n) asm volatile("s_waitcnt vmcnt(" #n ")" ::: "memory")
#define PG8_WAIT_L(n) asm volatile("s_waitcnt lgkmcnt(" #n ")" ::: "memory")
#define PG8_BAR __builtin_amdgcn_s_barrier()
#define PG8_SCHED __builtin_amdgcn_sched_barrier(0)
    Unit cur, nxt; int ui = 0;
    if (!S.next(0, cur)) return;
    f32x4 acc[2][2][4][2];
#pragma unroll
    for (int a = 0; a < 2; ++a)
#pragma unroll
        for (int b = 0; b < 2; ++b)
#pragma unroll
            for (int m = 0; m < 4; ++m)
#pragma unroll
                for (int n = 0; n < 2; ++n) acc[a][b][m][n] = (f32x4){0.f, 0.f, 0.f, 0.f};
    bf16x8 At[4][2], B0[2][2], B1[2][2];
    const char* cA = (const char*)g.A + (size_t)cur.pm * tstep; const char* cB = (const char*)g.Bt + (size_t)cur.pn * tstep;
    S.a_ready(cur);
    if constexpr (SP2) {
        PG8_STAGE(PG8_SB(0, 0), cB, voffB); PG8_STAGE(PG8_SB(0, 1), cB + hstep, voffB); PG8_STAGE(PG8_SA(0, 0), cA, voffA); PG8_STAGE(PG8_SA(0, 1), cA + hstep, voffA);
        if (wr == 1) PG8_BAR;
        PG8_WAIT_V(2); PG8_BAR;
        PG8_STAGE(PG8_SB(1, 0), cB + kstep, voffB); PG8_STAGE(PG8_SA(1, 0), cA + kstep, voffA); PG8_STAGE(PG8_SB(1, 1), cB + hstep + kstep, voffB);
        PG8_WAIT_V(6); PG8_BAR;
    } else {
        PG8_STAGE(PG8_SB(0, 0), cB, voffB); PG8_STAGE(PG8_SA(0, 0), cA, voffA); PG8_STAGE(PG8_SB(0, 1), cB + hstep, voffB); PG8_STAGE(PG8_SA(0, 1), cA + hstep, voffA);
        if (wr == 1) PG8_BAR;
        PG8_WAIT_V(4); PG8_BAR;
        PG8_STAGE(PG8_SB(1, 0), cB + kstep, voffB); PG8_STAGE(PG8_SA(1, 0), cA + kstep, voffA); PG8_STAGE(PG8_SB(1, 1), cB + hstep + kstep, voffB);
        PG8_WAIT_V(6); PG8_BAR;
    }
    for (;;) {
        const bool has_next = S.next(ui + 1, nxt);
        const char* nA = has_next ? (const char*)g.A + (size_t)nxt.pm * tstep : cA; const char* nB = has_next ? (const char*)g.Bt + (size_t)nxt.pn * tstep : cB;
        for (int t = 0; t < nt; t += 2) {
            const bool last = (t == nt - 2);
            const char* a1 = cA + (size_t)(t + 1) * kstep;
            const char* a2 = last ? nA : cA + (size_t)(t + 2) * kstep; const char* b2 = last ? nB : cB + (size_t)(t + 2) * kstep;
            const char* a3 = a2 + kstep; const char* b3 = b2 + kstep;
            if (last && has_next) S.a_ready(nxt);
            if constexpr (SP2) {
            PG8_LDB(B0, 0, 0); PG8_LDB(B1, 0, 1); PG8_SCHED; PG8_LDA(At, 0, 0); PG8_STAGE(PG8_SA(1, 1), a1 + hstep, voffA);
            PG8_WAIT_V(8); PG8_WAIT_L(0); PG8_BAR; PG8_MMA(0, 0, At, B0); PG8_MMA(0, 1, At, B1); PG8_BAR; PG8_SCHED;
            PG8_LDA(At, 0, 1); PG8_STAGE(PG8_SB(0, 0), b2, voffB); PG8_STAGE(PG8_SB(0, 1), b2 + hstep, voffB); PG8_STAGE(PG8_SA(0, 0), a2, voffA);
            PG8_WAIT_V(8); PG8_WAIT_L(0); PG8_BAR; PG8_MMA(1, 0, At, B0); PG8_MMA(1, 1, At, B1); PG8_BAR; PG8_SCHED;
            PG8_LDB(B0, 1, 0); PG8_LDB(B1, 1, 1); PG8_SCHED; PG8_LDA(At, 1, 0); PG8_STAGE(PG8_SA(0, 1), a2 + hstep, voffA);
            PG8_WAIT_V(8); PG8_WAIT_L(0); PG8_BAR; PG8_MMA(0, 0, At, B0); PG8_MMA(0, 1, At, B1); PG8_BAR; PG8_SCHED;
            PG8_LDA(At, 1, 1); PG8_STAGE(PG8_SB(1, 0), b3, voffB); PG8_STAGE(PG8_SB(1, 1), b3 + hstep, voffB); PG8_STAGE(PG8_SA(1, 0), a3, voffA);
            PG8_WAIT_V(8); PG8_WAIT_L(0); PG8_BAR; PG8_MMA(1, 0, At, B0); PG8_MMA(1, 1, At, B1); PG8_BAR; PG8_SCHED;
            } else {
            PG8_LDB(B0, 0, 0); PG8_SCHED; PG8_LDA(At, 0, 0); PG8_STAGE(PG8_SA(1, 1), a1 + hstep, voffA);
            PG8_WAIT_L(8); PG8_BAR; PG8_WAIT_L(0); PG8_MMA(0, 0, At, B0); PG8_BAR; PG8_SCHED;
            PG8_LDB(B1, 0, 1); PG8_STAGE(PG8_SB(0, 0), b2, voffB);
            PG8_BAR; PG8_WAIT_L(0); PG8_MMA(0, 1, At, B1); PG8_BAR;
            PG8_LDA(At, 0, 1); PG8_STAGE(PG8_SA(0, 0), a2, voffA);
            PG8_BAR; PG8_WAIT_L(0); PG8_MMA(1, 0, At, B0); PG8_BAR; PG8_SCHED;
            PG8_STAGE(PG8_SB(0, 1), b2 + hstep, voffB);
            PG8_WAIT_V(6); PG8_BAR; PG8_MMA(1, 1, At, B1); PG8_BAR;
            PG8_LDB(B0, 1, 0); PG8_SCHED; PG8_LDA(At, 1, 0); PG8_STAGE(PG8_SA(0, 1), a2 + hstep, voffA);
            PG8_WAIT_L(8); PG8_BAR; PG8_WAIT_L(0); PG8_MMA(0, 0, At, B0); PG8_BAR; PG8_SCHED;
            PG8_LDB(B1, 1, 1); PG8_STAGE(PG8_SB(1, 0), b3, voffB);
            PG8_BAR; PG8_WAIT_L(0); PG8_MMA(0, 1, At, B1); PG8_BAR;
            PG8_LDA(At, 1, 1); PG8_STAGE(PG8_SA(1, 0), a3, voffA);
            PG8_BAR; PG8_WAIT_L(0); PG8_MMA(1, 0, At, B0); PG8_BAR; PG8_SCHED;
            PG8_STAGE(PG8_SB(1, 1), b3 + hstep, voffB);
            PG8_WAIT_V(6); PG8_BAR; PG8_MMA(1, 1, At, B1); PG8_BAR;
            }
        }
        if constexpr (ALIGN_EPI) { if (wr == 0) PG8_BAR; }
        if constexpr (!Epi::AFTER_DRAIN) { E(acc, cur, wr, wc, fr, fq); S.done(cur); }
        if (!has_next) break;
#pragma unroll
        for (int a = 0; a < 2; ++a)
#pragma unroll
            for (int b = 0; b < 2; ++b)
#pragma unroll
                for (int m = 0; m < 4; ++m)
#pragma unroll
                    for (int n = 0; n < 2; ++n) acc[a][b][m][n] = (f32x4){0.f, 0.f, 0.f, 0.f};
        cur = nxt; cA = nA; cB = nB; ++ui;
        if constexpr (ALIGN_EPI) { if (wr == 1) PG8_BAR; }
    }
    PG8_WAIT_V(0);
    if constexpr (!ALIGN_EPI) { if (wr == 0) PG8_BAR; }
    PG8_BAR;
    if constexpr (Epi::AFTER_DRAIN) { E.fused(acc, cur, wr, wc, fr, fq, lds, wid, lane); S.done(cur); }
#undef PG8_SA
#undef PG8_SB
#undef PG8_STAGE
#undef PG8_LDA
#undef PG8_LDB
#undef PG8_MMA
#undef PG8_WAIT_V
#undef PG8_WAIT_L
#undef PG8_BAR
#undef PG8_SCHED
}
}

#ifndef PG8_SP2
#define PG8_SP2 true
#endif
#ifndef PG8_ALIGN
#define PG8_ALIGN true
#endif
#ifndef MK_N_LAUNCHES
#define MK_N_LAUNCHES 1
#endif
constexpr int NWAVES = 8;
constexpr int NPHASES = 8;
constexpr int N_LAUNCHES = MK_N_LAUNCHES;

constexpr int NB = 32, SEQ = 2048, T = NB * SEQ, D = 1024, DIN = 3584;
constexpr int DPR = 3072;
constexpr int PC_U = 0, PC_B = 512, PC_Q = 1024, PC_F = 1536, PC_V = 2048, PC_G = 2560;
constexpr int NEXP = 16384;
constexpr float EPS = 1e-6f;
constexpr float PEER_SU = 640.0f, PEER_SV = 64.0f;

constexpr size_t MiB = 1u << 20;
constexpr size_t WS_CTL = 0, CTL_ZERO_BYTES = 1 * MiB;
constexpr size_t WS_W1T = 2 * MiB, WS_WOT = 10 * MiB, WS_WQT = 12 * MiB, WS_RS1 = 16 * MiB, WS_SS2 = 17 * MiB;
constexpr size_t WS_KEYB = 18 * MiB;
constexpr size_t WS_U16 = 32 * MiB, WS_V16 = 64 * MiB, WS_EXP = 96 * MiB;
constexpr size_t WS_XB = 128 * MiB;
constexpr size_t WS_X1 = 256 * MiB;
constexpr size_t WS_PROJ = 384 * MiB;
constexpr size_t WS_F = 832 * MiB;
constexpr size_t WS_MIX = 848 * MiB;
constexpr size_t WS_END = 976 * MiB;
constexpr int CW_BAR = 4096;

constexpr int RING_OFF = 0, RING_BYTES = 131072;
constexpr int LDSCTL_OFF = RING_BYTES, MISC_OFF = LDSCTL_OFF + 320;
constexpr int LDS_BYTES = 147456;

#define GAS __attribute__((address_space(1)))
#define LAS __attribute__((address_space(3)))
typedef unsigned short bf16;
typedef unsigned v4u __attribute__((ext_vector_type(4)));
typedef unsigned v2u __attribute__((ext_vector_type(2)));
typedef float f32x4 __attribute__((ext_vector_type(4)));
typedef float f32x2 __attribute__((ext_vector_type(2)));
typedef _Float16 h2_t __attribute__((ext_vector_type(2)));
typedef GAS unsigned gu32;
#define RLX_AGENT __ATOMIC_RELAXED, __HIP_MEMORY_SCOPE_AGENT
#define LDS_WAIT() asm volatile("s_waitcnt lgkmcnt(0)" ::: "memory")
#define VM_WAIT() asm volatile("s_waitcnt vmcnt(0)" ::: "memory")
__device__ __forceinline__ unsigned f2bf(float f) { unsigned u = __builtin_bit_cast(unsigned, f); return (u + 0x7fffu + ((u >> 16) & 1u)) >> 16; }
typedef __bf16 bf16x2_t __attribute__((ext_vector_type(2)));
__device__ __forceinline__ unsigned pk2(float lo, float hi) { f32x2 v = {lo, hi}; bf16x2_t b = __builtin_convertvector(v, bf16x2_t); return __builtin_bit_cast(unsigned, b); }
__device__ __forceinline__ float bf_lo(unsigned w) { return __builtin_bit_cast(float, w << 16); }
__device__ __forceinline__ float bf_hi(unsigned w) { return __builtin_bit_cast(float, w & 0xffff0000u); }
__device__ __forceinline__ float bf1(bf16 v) { return __builtin_bit_cast(float, (unsigned)v << 16); }
__device__ __forceinline__ unsigned pkh2(float lo, float hi) { f32x2 v = {lo, hi}; h2_t h = __builtin_convertvector(v, h2_t); return __builtin_bit_cast(unsigned, h); }
__device__ __forceinline__ h2_t h2_of(unsigned w) { return __builtin_bit_cast(h2_t, w); }
__device__ __forceinline__ float swap32_add(float a, float b) { const v2u r = __builtin_amdgcn_permlane32_swap(__builtin_bit_cast(unsigned, a), __builtin_bit_cast(unsigned, b), false, false);
    const unsigned rx = r.x, ry = r.y; return __builtin_bit_cast(float, rx) + __builtin_bit_cast(float, ry); }
__device__ __forceinline__ float swap16_add(float a, float b) { const v2u r = __builtin_amdgcn_permlane16_swap(__builtin_bit_cast(unsigned, a), __builtin_bit_cast(unsigned, b), false, false);
    const unsigned rx = r.x, ry = r.y; return __builtin_bit_cast(float, rx) + __builtin_bit_cast(float, ry); }
template <int CTRL> __device__ __forceinline__ float dpp_f(float v) { return __builtin_bit_cast(float, __builtin_amdgcn_update_dpp(0, __builtin_bit_cast(int, v), CTRL, 0xF, 0xF, false)); }
template <int CTRL> __device__ __forceinline__ unsigned dpp_u(unsigned v) { return (unsigned)__builtin_amdgcn_update_dpp(0, (int)v, CTRL, 0xF, 0xF, false); }
__device__ __forceinline__ float wave_sum(float v) {
    v += dpp_f<0xB1>(v); v += dpp_f<0x4E>(v); v += dpp_f<0x124>(v); v += dpp_f<0x128>(v);
    v = swap16_add(v, v); v = swap32_add(v, v);
    return v;
}
typedef float f32x16 __attribute__((ext_vector_type(16)));
__device__ __forceinline__ unsigned cvtpk(float lo, float hi) { f32x2 v = {lo, hi}; bf16x2_t b = __builtin_convertvector(v, bf16x2_t); return __builtin_bit_cast(unsigned, b); }
__device__ __forceinline__ pg8::bf16x8 pack8(const f32x16& x, int s) {
    v4u p; p.x = cvtpk(x[8 * s], x[8 * s + 1]); p.y = cvtpk(x[8 * s + 2], x[8 * s + 3]); p.z = cvtpk(x[8 * s + 4], x[8 * s + 5]); p.w = cvtpk(x[8 * s + 6], x[8 * s + 7]);
    return __builtin_bit_cast(pg8::bf16x8, p); }
__device__ __forceinline__ void ce_desc(unsigned& a, unsigned& b) { const unsigned mx = a > b ? a : b, mn = a > b ? b : a; a = mx; b = mn; }
__device__ __forceinline__ void sort16_desc(unsigned (&a)[16]) {
#pragma unroll
    for (int k = 2; k <= 16; k <<= 1)
#pragma unroll
        for (int j = k >> 1; j > 0; j >>= 1)
#pragma unroll
            for (int i = 0; i < 16; ++i) { const int l = i ^ j; if (l > i) { if ((i & k) == 0) ce_desc(a[i], a[l]); else ce_desc(a[l], a[i]); } }
}
__device__ __forceinline__ void merge16_desc(unsigned (&a)[16], const unsigned (&b)[16]) {
#pragma unroll
    for (int i = 0; i < 16; ++i) a[i] = a[i] > b[15 - i] ? a[i] : b[15 - i];
#pragma unroll
    for (int j = 8; j > 0; j >>= 1)
#pragma unroll
        for (int i = 0; i < 16; ++i) { const int l = i ^ j; if (l > i) ce_desc(a[i], a[l]); }
}
__device__ __forceinline__ void sort16_desc2(unsigned (&a)[16], unsigned (&b)[16]) {
    constexpr int NW[60][2] = {{0,13},{1,12},{2,15},{3,14},{4,8},{5,6},{7,11},{9,10}, {0,5},{1,7},{2,9},{3,4},{6,13},{8,14},{10,15},{11,12}, {0,1},{2,3},{4,5},{6,8},{7,9},{10,11},{12,13},{14,15},
        {0,2},{1,3},{4,10},{5,11},{6,7},{8,9},{12,14},{13,15}, {1,2},{3,12},{4,6},{5,7},{8,10},{9,11},{13,14}, {1,4},{2,6},{5,8},{7,10},{9,13},{11,14}, {2,4},{3,6},{9,12},{11,13}, {3,5},{6,8},{7,9},{10,12}, {3,4},{5,6},{7,8},{9,10},{11,12}, {6,7},{8,9}};
#pragma unroll
    for (int c = 0; c < 60; ++c) { ce_desc(a[NW[c][0]], a[NW[c][1]]); ce_desc(b[NW[c][0]], b[NW[c][1]]); }
}
__device__ __forceinline__ void merge16_desc2(unsigned (&a)[16], const unsigned (&x)[16], unsigned (&b)[16], const unsigned (&y)[16]) {
#pragma unroll
    for (int i = 0; i < 16; ++i) { a[i] = a[i] > x[15 - i] ? a[i] : x[15 - i]; b[i] = b[i] > y[15 - i] ? b[i] : y[15 - i]; }
#pragma unroll
    for (int j = 8; j > 0; j >>= 1)
#pragma unroll
        for (int i = 0; i < 16; ++i) { const int l = i ^ j; if (l > i) { ce_desc(a[i], a[l]); ce_desc(b[i], b[l]); } }
}
__device__ __forceinline__ float unkey(unsigned a) { a = (a & 0x80000000u) ? (a & 0x7FFFFFFFu) : ~a; return __builtin_bit_cast(float, a); }
__device__ __forceinline__ float unkey16(unsigned a) { a >>= 16; a = (a & 0x8000u) ? (a & 0x7FFFu) : (~a & 0xFFFFu); return (float)__builtin_bit_cast(_Float16, (unsigned short)a); }
__device__ __forceinline__ unsigned ckey(float s, int flat) { unsigned u = __builtin_bit_cast(unsigned, s); u ^= (unsigned)((int)u >> 31) | 0x80000000u; return (u & ~0xFFu) | (unsigned)(255 - flat); }
template <int J> __device__ __forceinline__ unsigned xor_lane(unsigned x, int lane) {
    if (J == 1) return dpp_u<0xB1>(x);
    if (J == 2) return dpp_u<0x4E>(x);
    if (J == 8) return dpp_u<0x128>(x);
    if (J == 16) { const v2u r = __builtin_amdgcn_permlane16_swap(x, x, false, false); const unsigned rx = r.x, ry = r.y; return (lane & 16) ? rx : ry; }
    if (J == 32) { const v2u r = __builtin_amdgcn_permlane32_swap(x, x, false, false); const unsigned rx = r.x, ry = r.y; return (lane & 32) ? rx : ry; }
    return (unsigned)__shfl_xor((int)x, J);
}
template <int K, int J, int N> __device__ __forceinline__ void sort128_stage(unsigned (&e)[N][2], int lane) {
#pragma unroll
    for (int t = 0; t < N; ++t) {
        if (J == 64) { const unsigned mn = e[t][0] < e[t][1] ? e[t][0] : e[t][1], mx = e[t][0] < e[t][1] ? e[t][1] : e[t][0]; e[t][0] = mn; e[t][1] = mx; }
        else {
            const unsigned p0 = xor_lane<J>(e[t][0], lane), p1 = xor_lane<J>(e[t][1], lane);
            const bool lower = (lane & J) == 0;
            const bool up0 = (K >= 64) ? true : ((lane & K) == 0);
            const bool up1 = (K == 128) ? true : (K == 64 ? false : ((lane & K) == 0));
            const unsigned mn0 = e[t][0] < p0 ? e[t][0] : p0, mx0 = e[t][0] < p0 ? p0 : e[t][0], mn1 = e[t][1] < p1 ? e[t][1] : p1, mx1 = e[t][1] < p1 ? p1 : e[t][1];
            e[t][0] = (lower == up0) ? mn0 : mx0; e[t][1] = (lower == up1) ? mn1 : mx1;
        }
    }
}
template <int N> __device__ __forceinline__ void sort128_asc(unsigned (&e)[N][2], int lane) {
#define S_(K, J) sort128_stage<K, J, N>(e, lane)
    S_(2, 1); S_(4, 2); S_(4, 1); S_(8, 4); S_(8, 2); S_(8, 1); S_(16, 8); S_(16, 4); S_(16, 2); S_(16, 1);
    S_(32, 16); S_(32, 8); S_(32, 4); S_(32, 2); S_(32, 1); S_(64, 32); S_(64, 16); S_(64, 8); S_(64, 4); S_(64, 2); S_(64, 1);
    S_(128, 64); S_(128, 32); S_(128, 16); S_(128, 8); S_(128, 4); S_(128, 2); S_(128, 1);
#undef S_
}
__device__ __forceinline__ float wave_max(float v) {
    v = fmaxf(v, dpp_f<0xB1>(v)); v = fmaxf(v, dpp_f<0x4E>(v)); v = fmaxf(v, dpp_f<0x124>(v)); v = fmaxf(v, dpp_f<0x128>(v));
    { const v2u r = __builtin_amdgcn_permlane16_swap(__builtin_bit_cast(unsigned, v), __builtin_bit_cast(unsigned, v), false, false); const unsigned rx = r.x, ry = r.y; v = fmaxf(__builtin_bit_cast(float, rx), __builtin_bit_cast(float, ry)); }
    { const v2u r = __builtin_amdgcn_permlane32_swap(__builtin_bit_cast(unsigned, v), __builtin_bit_cast(unsigned, v), false, false); const unsigned rx = r.x, ry = r.y; v = fmaxf(__builtin_bit_cast(float, rx), __builtin_bit_cast(float, ry)); }
    return v;
}
__device__ __forceinline__ int swap32_addi(int a, int b) { const v2u r = __builtin_amdgcn_permlane32_swap((unsigned)a, (unsigned)b, false, false); const unsigned rx = r.x, ry = r.y; return (int)(rx + ry); }
__device__ __forceinline__ int swap16_addi(int a, int b) { const v2u r = __builtin_amdgcn_permlane16_swap((unsigned)a, (unsigned)b, false, false); const unsigned rx = r.x, ry = r.y; return (int)(rx + ry); }
__device__ __forceinline__ int reduce16i(const int (&p)[16], int lane) {
    int q[8], r[4], u[2];
    const bool b3 = (lane & 8) != 0, b2 = (lane & 4) != 0;
#pragma unroll
    for (int i = 0; i < 8; ++i) q[i] = swap32_addi(p[2 * i], p[2 * i + 1]);
#pragma unroll
    for (int i = 0; i < 4; ++i) r[i] = swap16_addi(q[2 * i], q[2 * i + 1]);
#pragma unroll
    for (int i = 0; i < 2; ++i) { const int keep = b3 ? r[2 * i + 1] : r[2 * i], send = b3 ? r[2 * i] : r[2 * i + 1]; u[i] = keep + (int)dpp_u<0x128>((unsigned)send); }
    const int keep = b2 ? u[1] : u[0], send = b2 ? u[0] : u[1];
    int v = keep + __shfl_xor(send, 4);
    v += (int)dpp_u<0x4E>((unsigned)v); v += (int)dpp_u<0xB1>((unsigned)v);
    return v;
}
__device__ __forceinline__ float reduce16(const float (&p)[16], int lane) {
    float q[8], r[4], u[2];
    const bool b3 = (lane & 8) != 0, b2 = (lane & 4) != 0;
#pragma unroll
    for (int i = 0; i < 8; ++i) q[i] = swap32_add(p[2 * i], p[2 * i + 1]);
#pragma unroll
    for (int i = 0; i < 4; ++i) r[i] = swap16_add(q[2 * i], q[2 * i + 1]);
#pragma unroll
    for (int i = 0; i < 2; ++i) { const float keep = b3 ? r[2 * i + 1] : r[2 * i], send = b3 ? r[2 * i] : r[2 * i + 1]; u[i] = keep + dpp_f<0x128>(send); }
    const float keep = b2 ? u[1] : u[0], send = b2 ? u[0] : u[1];
    float v = keep + __shfl_xor(send, 4);
    v += dpp_f<0x4E>(v);
    v += dpp_f<0xB1>(v);
    return v;
}
__device__ __forceinline__ unsigned scan_off(unsigned row, unsigned ch) { return 256u * row + 16u * (ch ^ (((row & 3u) << 2) | ((row >> 2) & 3u))); }
typedef short v4i16_t __attribute__((ext_vector_type(4)));
__device__ __forceinline__ pg8::bf16x8 scan_tr(const LAS unsigned char* tile, unsigned row, unsigned ch, unsigned half) {
    const v4i16_t lo = __builtin_amdgcn_ds_read_tr16_b64_v4i16((LAS v4i16_t*)(tile + scan_off(row, ch) + 8u * half));
    const v4i16_t hi = __builtin_amdgcn_ds_read_tr16_b64_v4i16((LAS v4i16_t*)(tile + scan_off(row + 8u, ch) + 8u * half));
    return __builtin_shufflevector(lo, hi, 0, 1, 2, 3, 4, 5, 6, 7);
}
__device__ __forceinline__ int swap23(int k) { return (k & ~12) | ((k & 4) << 1) | ((k & 8) >> 1); }
__device__ __forceinline__ float sigmoidf_(float x) { return __builtin_amdgcn_rcpf(1.0f + __expf(-x)); }

#define XB_TMO      128
#define XB_XCNT(j)  (256  + 64 * (j))
#define XB_XSUB(j)  (1280 + 64 * (j))
#define XB_XGEN(j)  (2304 + 64 * (j))
#define XB_TOP      3328
#define XB_TOPGEN   3392
#define XCD_BAR_WORDS 3456
#define XB_SPIN_CAP (1u << 18)

__device__ __forceinline__ unsigned xb_ld(unsigned* p)              { return __hip_atomic_load(p, __ATOMIC_RELAXED, __HIP_MEMORY_SCOPE_AGENT); }
__device__ __forceinline__ unsigned xb_add(unsigned* p, unsigned v) { return __hip_atomic_fetch_add(p, v, __ATOMIC_RELAXED, __HIP_MEMORY_SCOPE_AGENT); }
__device__ __forceinline__ unsigned xb_xcc_id() { return (unsigned)__builtin_amdgcn_s_getreg((3 << 11) | 20) & 0xFu; }
#define XB_SPIN(cond, bar) do { unsigned _sp = 0; while (cond) { __builtin_amdgcn_s_sleep(1); \
    if ((++_sp & 255u) == 0u) { if (xb_ld(&(bar)[XB_TMO])) break; if (_sp > XB_SPIN_CAP) { atomicAdd(&(bar)[XB_TMO], 1u); break; } } } } while (0)

struct XcdBarrier {
    unsigned* bar; unsigned x;
    volatile LAS unsigned* st;
};

__device__ __forceinline__ XcdBarrier xcd_barrier_post(unsigned* bar, volatile LAS unsigned* st) {
    XcdBarrier b; b.bar = bar; b.x = xb_xcc_id(); b.st = st;
    if (threadIdx.x == 0) (void)xb_add(&bar[XB_XCNT(b.x)], 1u);
    return b;
}
__device__ __forceinline__ void xcd_barrier_complete(unsigned* bar, unsigned x, unsigned& nloc, unsigned& nx) {
    const unsigned G = gridDim.x * gridDim.y * gridDim.z;
    unsigned sum, cnt, mine, sp = 0u;
    for (;;) {
        sum = 0u; cnt = 0u; mine = 0u;
#pragma unroll
        for (unsigned j = 0; j < 16; ++j) { const unsigned c = xb_ld(&bar[XB_XCNT(j)]); sum += c; cnt += (c > 0u) ? 1u : 0u; mine = (j == x) ? c : mine; }
        if (sum == G) break;
        __builtin_amdgcn_s_sleep(1);
        if ((++sp & 255u) == 0u) { if (xb_ld(&bar[XB_TMO])) break; if (sp > XB_SPIN_CAP) { atomicAdd(&bar[XB_TMO], 1u); break; } }
    }
    nloc = mine > 0u ? mine : 1u; nx = cnt > 0u ? cnt : 1u;
}

__device__ __forceinline__ void xcd_barrier(const XcdBarrier& b) {
    asm volatile("s_waitcnt vmcnt(0)" ::: "memory");
    __syncthreads();
    if (threadIdx.x == 0) {
        unsigned* bar = b.bar;
        __builtin_amdgcn_s_waitcnt(0);
        unsigned nloc = b.st[0], nx = b.st[1];
        if (nloc == 0u) { xcd_barrier_complete(bar, b.x, nloc, nx); b.st[0] = nloc; b.st[1] = nx; }
        const unsigned old = xb_add(&bar[XB_XSUB(b.x)], 1u);
        const unsigned gen = old / nloc;
        if (old + 1u == (gen + 1u) * nloc) {
            __builtin_amdgcn_fence(__ATOMIC_RELEASE, "agent");
            asm volatile("s_waitcnt vmcnt(0)" ::: "memory");
            const unsigned og = xb_add(&bar[XB_TOP], 1u);
            const unsigned tg = og / nx;
            if (og + 1u == (tg + 1u) * nx) xb_add(&bar[XB_TOPGEN], 1u);
            else XB_SPIN(xb_ld(&bar[XB_TOPGEN]) == tg, bar);
            __builtin_amdgcn_fence(__ATOMIC_ACQUIRE, "agent");
            xb_add(&bar[XB_XGEN(b.x)], 1u);
            asm volatile("s_waitcnt vmcnt(0)" ::: "memory");
        } else {
            XB_SPIN(xb_ld(&bar[XB_XGEN(b.x)]) == gen, bar);
            __builtin_amdgcn_fence(__ATOMIC_ACQUIRE, "agent");
            asm volatile("s_waitcnt vmcnt(0)" ::: "memory");
        }
    }
    __syncthreads();
}


template <bool REMAP> __device__ __forceinline__ void p0_transpose_item(const float* W, int K, int N, const float* gain, bf16* WT, LAS float* scr, int item, int lane) {
    const int nblk = N / 32, kb = item / nblk, nb = item % nblk, k0 = 64 * kb, n0 = 32 * nb;
#pragma unroll 8
    for (int i = 0; i < 32; ++i) { const int kk = 2 * i + (lane >> 5); const float g = gain ? gain[k0 + kk] : 1.0f; scr[kk * 33 + (lane & 31)] = W[(size_t)(k0 + kk) * N + n0 + (lane & 31)] * g; }
    LDS_WAIT(); asm volatile("" ::: "memory");
    const int c = lane & 7;
#pragma unroll
    for (int j = 0; j < 4; ++j) { const int n = (lane >> 3) + 8 * j; const LAS float* s = scr + (8 * c) * 33 + n;
        v4u o; o.x = pk2(s[0 * 33], s[1 * 33]); o.y = pk2(s[2 * 33], s[3 * 33]); o.z = pk2(s[4 * 33], s[5 * 33]); o.w = pk2(s[6 * 33], s[7 * 33]);
        int nr = n0 + n; if (REMAP && nr < 1024) nr = ((nr & 511) >> 7) * 256 + (nr >> 9) * 128 + (nr & 127);
        else if (REMAP && nr >= 1536 && nr < 2560) { const int m_ = nr - 1536; nr = 1536 + ((m_ & 511) >> 7) * 256 + (m_ >> 9) * 128 + (m_ & 127); }
        *(GAS v4u*)(WT + (size_t)nr * K + k0 + 8 * c) = o; }
    LDS_WAIT(); asm volatile("" ::: "memory");
}

struct Args { const float* in[14]; float* out; unsigned char* ws; int ph_lo, ph_hi, li, pad; };

__global__ void __launch_bounds__(NWAVES * 64, 2) hymba_fwd(Args args) {
    extern __shared__ __attribute__((aligned(16))) unsigned char lds_raw[];
    LAS unsigned char* lds = (LAS unsigned char*)lds_raw;
    volatile LAS unsigned* MISC = (volatile LAS unsigned*)(lds + MISC_OFF);
    const int tid = threadIdx.x, lane = tid & 63, wave = __builtin_amdgcn_readfirstlane(tid >> 6);
    const int G = gridDim.x;
    const int gw = (int)blockIdx.x * NWAVES + wave, NGW = G * NWAVES;
    unsigned char* ws = args.ws;
    gu32* ctl = (gu32*)(ws + WS_CTL);
    const float* x = args.in[0]; const float* norm_mix = args.in[1]; const float* w_in = args.in[2]; const float* conv_w = args.in[3]; const float* conv_gain = args.in[4];
    const float* hg_lb = args.in[5]; const float* hg_gain = args.in[6]; const float* w_out = args.in[7]; const float* norm_ffn = args.in[8]; const float* peer_wq = args.in[9];
    const float* peer_keys = args.in[10]; const float* peer_u = args.in[11]; const float* peer_v = args.in[12]; const float* norm_f = args.in[13];
    float* out = args.out;
    bf16* W1T = (bf16*)(ws + WS_W1T); bf16* WOT = (bf16*)(ws + WS_WOT); bf16* WQT = (bf16*)(ws + WS_WQT);
    float* RS1 = (float*)(ws + WS_RS1); float* SS2 = (float*)(ws + WS_SS2);
    unsigned char* U8 = ws + WS_U16; unsigned char* V8 = ws + WS_V16; unsigned* EXPT = (unsigned*)(ws + WS_EXP); bf16* KEYB = (bf16*)(ws + WS_KEYB);
    bf16* XB = (bf16*)(ws + WS_XB); bf16* MIX = (bf16*)(ws + WS_MIX); bf16* X1 = (bf16*)(ws + WS_X1);
    bf16* PROJ = (bf16*)(ws + WS_PROJ); bf16* QB = (bf16*)(ws + WS_PROJ); float* DEC = (float*)(ws + WS_F);

    for (int u = tid; u < (LDS_BYTES - LDSCTL_OFF) / 4; u += NWAVES * 64) ((LAS unsigned*)(lds + LDSCTL_OFF))[u] = 0u;
    __syncthreads();
    XcdBarrier bar; bar.bar = (unsigned*)(ctl + CW_BAR); bar.x = 0; bar.st = nullptr;
    if (N_LAUNCHES == 1) bar = xcd_barrier_post((unsigned*)(ctl + CW_BAR), MISC + 8);
#define GRID_BAR() do { if (N_LAUNCHES == 1) xcd_barrier(bar); } while (0)
    const int lo = args.ph_lo, hi = args.ph_hi;
#define IN(k) (lo <= (k) && (k) < hi)
#define BOTH(k) (IN(k) && IN((k) + 1))

    if (IN(0)) {
        LAS float* scr = (LAS float*)(lds + RING_OFF + wave * 16384);
        constexpr int I_1 = (D / 64) * (DIN / 32);
        for (int it = gw; it < I_1; it += NGW) p0_transpose_item<true>(w_in, D, DIN, norm_mix, W1T, scr, it, lane);
        for (int m = gw; m < T; m += NGW) {
            const GAS f32x4* xr = (const GAS f32x4*)(x + (size_t)m * D) + lane; f32x4 v[4]; float s = 0.f;
#pragma unroll
            for (int j = 0; j < 4; ++j) { v[j] = xr[64 * j]; s += (v[j].x * v[j].x + v[j].y * v[j].y) + (v[j].z * v[j].z + v[j].w * v[j].w); }
            s = wave_sum(s);
            if (lane == 0) RS1[m] = 1.0f / sqrtf(s * (1.0f / D) + EPS);
            GAS unsigned long long* o8 = (GAS unsigned long long*)(XB + (size_t)m * D) + lane;
#pragma unroll
            for (int j = 0; j < 4; ++j) o8[64 * j] = (unsigned long long)pk2(v[j].x, v[j].y) | ((unsigned long long)pk2(v[j].z, v[j].w) << 32);
        }
        for (int i = (int)blockIdx.x * NWAVES * 64 + tid; i < T; i += G * NWAVES * 64) SS2[i] = 0.f;
        if (BOTH(0)) GRID_BAR();
    }

    if (IN(1)) {
        pg8::Gemm g{XB, W1T, T, DIN, D}; pg8::StaticOrder S; S.init(T, DIN, G, (int)blockIdx.x);
        pg8::EpiProj E{PROJ, RS1, hg_lb, DEC};
        pg8::gemm_phase<pg8::EpiProj, pg8::StaticOrder, PG8_ALIGN, PG8_SP2>(lds + RING_OFF, g, S, E);
        if (BOTH(1)) GRID_BAR();
    }


    if (IN(3)) {
        constexpr int BUFB = 25600, OB0 = 2 * BUFB;
        for (int it = (int)blockIdx.x; it < NB * 4; it += G) {
            const int b = it >> 2, h = it & 3;
            const int lt = tid & 255, r = lane & 31, hh = lane >> 5, sl = wave;
            v4u stA[7], stB[7];
#define SCAN_LOAD(st, n_) do { const size_t tk0 = (size_t)b * SEQ + (n_) * 32; \
                _Pragma("unroll") for (int i = 0; i < 2; ++i) { const int q = lt + 256 * i, row = q >> 4, cc = q & 15; const bf16* pr = PROJ + (tk0 + row) * DPR + h * 128 + cc * 8; \
                    st[i] = *(const GAS v4u*)(pr + PC_Q); st[2 + i] = *(const GAS v4u*)(pr + PC_F); st[4 + i] = *(const GAS v4u*)(pr + PC_V); } \
                if (lt < 32) st[6] = ((const GAS v4u*)(DEC + (size_t)((b * 64 + (n_)) * 4 + h) * 128))[lt]; } while (0)
#define SCAN_COMMIT(st, n_) do { LAS unsigned char* Bf = lds + RING_OFF + ((n_) & 1) * BUFB; \
                _Pragma("unroll") for (int i = 0; i < 2; ++i) { const int q = lt + 256 * i; const unsigned o_ = scan_off((unsigned)(q >> 4), (unsigned)(q & 15)); \
                    *(LAS v4u*)(Bf + o_) = st[i]; *(LAS v4u*)(Bf + 8192 + o_) = st[2 + i]; *(LAS v4u*)(Bf + 16384 + o_) = st[4 + i]; } \
                if (lt < 32) *(LAS v4u*)(Bf + 24576 + lt * 16) = st[6]; } while (0)
#define SCAN_POST(n_) do { const int pos = lt >> 3, vg = lt & 7; const LAS f32x4* ob = (const LAS f32x4*)(lds + RING_OFF + OB0 + ((n_) & 1) * 16384 + (pos * 128 + vg * 16) * 4); \
                const f32x4 o0 = ob[0], o1 = ob[1], o2 = ob[2], o3 = ob[3]; \
                float ss = (o0.x * o0.x + o0.y * o0.y) + (o0.z * o0.z + o0.w * o0.w) + (o1.x * o1.x + o1.y * o1.y) + (o1.z * o1.z + o1.w * o1.w) \
                         + (o2.x * o2.x + o2.y * o2.y) + (o2.z * o2.z + o2.w * o2.w) + (o3.x * o3.x + o3.y * o3.y) + (o3.z * o3.z + o3.w * o3.w); \
                ss += dpp_f<0xB1>(ss); ss += dpp_f<0x4E>(ss); ss += dpp_f<0x141>(ss);     \
                const float rr = __builtin_amdgcn_rsqf(ss * (1.0f / 128.0f) + EPS); \
                const size_t tk = (size_t)b * SEQ + (n_) * 32 + pos; const v4u g0 = gp0, g1 = gp1; \
                const float ov[16] = {o0.x, o0.y, o0.z, o0.w, o1.x, o1.y, o1.z, o1.w, o2.x, o2.y, o2.z, o2.w, o3.x, o3.y, o3.z, o3.w}; \
                const float gf[16] = {bf_lo(g0.x), bf_hi(g0.x), bf_lo(g0.y), bf_hi(g0.y), bf_lo(g0.z), bf_hi(g0.z), bf_lo(g0.w), bf_hi(g0.w), bf_lo(g1.x), bf_hi(g1.x), bf_lo(g1.y), bf_hi(g1.y), bf_lo(g1.z), bf_hi(g1.z), bf_lo(g1.w), bf_hi(g1.w)}; \
                float yv[16]; _Pragma("unroll") for (int i = 0; i < 16; ++i) yv[i] = ov[i] * rr * gnl[i] * (gf[i] * sigmoidf_(gf[i])); \
                GAS v4u* mp = (GAS v4u*)(MIX + tk * D + 512 + h * 128 + vg * 16); \
                mp[0] = (v4u){pk2(yv[0], yv[1]), pk2(yv[2], yv[3]), pk2(yv[4], yv[5]), pk2(yv[6], yv[7])}; mp[1] = (v4u){pk2(yv[8], yv[9]), pk2(yv[10], yv[11]), pk2(yv[12], yv[13]), pk2(yv[14], yv[15])}; } while (0)
#define SCAN_GLOAD(n_) do { const GAS v4u* gp = (const GAS v4u*)(PROJ + ((size_t)b * SEQ + (n_) * 32 + (lt >> 3)) * DPR + PC_G + h * 128 + (lt & 7) * 16); gq0 = gp[0]; gq1 = gp[1]; } while (0)
#define SCAN_BAR() do { asm volatile("s_waitcnt lgkmcnt(0)" ::: "memory"); __builtin_amdgcn_s_barrier(); asm volatile("" ::: "memory"); } while (0)
            if (wave >= 4) {
                v4u gp0 = {0u, 0u, 0u, 0u}, gp1 = {0u, 0u, 0u, 0u}, gq0, gq1;
                float gnl[16];
#pragma unroll
                for (int i = 0; i < 16; ++i) gnl[i] = hg_gain[(lt & 7) * 16 + i];
                SCAN_LOAD(stA, 0); SCAN_LOAD(stB, 1); SCAN_COMMIT(stA, 0);
                SCAN_BAR();
                for (int n = 0; n < 64; n += 2) {
                    if (n + 2 < 64) SCAN_LOAD(stA, n + 2);
                    SCAN_GLOAD(n);
                    if (n >= 1) SCAN_POST(n - 1);
                    SCAN_COMMIT(stB, n + 1);
                    gp0 = gq0; gp1 = gq1;
                    SCAN_BAR();
                    if (n + 3 < 64) SCAN_LOAD(stB, n + 3);
                    SCAN_GLOAD(n + 1);
                    SCAN_POST(n);
                    if (n + 2 < 64) SCAN_COMMIT(stA, n + 2);
                    gp0 = gq0; gp1 = gq1;
                    SCAN_BAR();
                }
                SCAN_POST(63);
                SCAN_BAR();
            } else {
                f32x16 S0, S1, S2, S3;
#pragma unroll
                for (int i = 0; i < 16; ++i) { S0[i] = 0.f; S1[i] = 0.f; S2[i] = 0.f; S3[i] = 0.f; }
                SCAN_BAR();
                for (int n = 0; n < 64; ++n) {
                    const LAS unsigned char* Bf = lds + RING_OFF + (n & 1) * BUFB;
                    const unsigned qg = (unsigned)(lane & 15) >> 2, pg = (unsigned)lane & 3u, bk = ((unsigned)lane >> 4) & 1u;
                    pg8::bf16x8 qd[8], kd[8], qp[8], vt[2];
#pragma unroll
                    for (int ks = 0; ks < 8; ++ks) { const unsigned o_ = scan_off((unsigned)r, (unsigned)(2 * ks + hh)); qd[ks] = *(const LAS pg8::bf16x8*)(Bf + o_); kd[ks] = *(const LAS pg8::bf16x8*)(Bf + 8192 + o_); }
                    f32x16 X, O;
#pragma unroll
                    for (int i = 0; i < 16; ++i) { X[i] = 0.f; O[i] = 0.f; }
#pragma unroll
                    for (int ks = 0; ks < 8; ++ks) X = __builtin_amdgcn_mfma_f32_32x32x16_bf16(kd[ks], qd[ks], X, 0, 0, 0);
#pragma unroll
                    for (int ks = 0; ks < 8; ++ks) { const v2u a0 = *(const LAS v2u*)(Bf + scan_off((unsigned)r, (unsigned)(2 * ks)) + 8 * hh), a1 = *(const LAS v2u*)(Bf + scan_off((unsigned)r, (unsigned)(2 * ks + 1)) + 8 * hh);
                        qp[ks] = __builtin_bit_cast(pg8::bf16x8, (v4u){a0.x, a0.y, a1.x, a1.y}); }
#pragma unroll
                    for (int sp = 0; sp < 2; ++sp) vt[sp] = scan_tr(Bf + 16384, (unsigned)(16 * sp + 4 * hh) + qg, (unsigned)(4 * sl) + 2u * bk + (pg >> 1), pg & 1u);
                    O = __builtin_amdgcn_mfma_f32_32x32x16_bf16(qp[0], pack8(S0, 0), O, 0, 0, 0); O = __builtin_amdgcn_mfma_f32_32x32x16_bf16(qp[1], pack8(S0, 1), O, 0, 0, 0);
                    O = __builtin_amdgcn_mfma_f32_32x32x16_bf16(qp[2], pack8(S1, 0), O, 0, 0, 0); O = __builtin_amdgcn_mfma_f32_32x32x16_bf16(qp[3], pack8(S1, 1), O, 0, 0, 0);
                    O = __builtin_amdgcn_mfma_f32_32x32x16_bf16(qp[4], pack8(S2, 0), O, 0, 0, 0); O = __builtin_amdgcn_mfma_f32_32x32x16_bf16(qp[5], pack8(S2, 1), O, 0, 0, 0);
                    O = __builtin_amdgcn_mfma_f32_32x32x16_bf16(qp[6], pack8(S3, 0), O, 0, 0, 0); O = __builtin_amdgcn_mfma_f32_32x32x16_bf16(qp[7], pack8(S3, 1), O, 0, 0, 0);
#define SCAN_SUPD(Sx, rt_) do { _Pragma("unroll") for (int sp = 0; sp < 2; ++sp) { \
                            const pg8::bf16x8 kt = scan_tr(Bf + 8192, (unsigned)(16 * sp + 4 * hh) + qg, (unsigned)(4 * (rt_)) + 2u * bk + (pg >> 1), pg & 1u); \
                            Sx = __builtin_amdgcn_mfma_f32_32x32x16_bf16(kt, vt[sp], Sx, 0, 0, 0); } \
                        _Pragma("unroll") for (int g = 0; g < 4; ++g) { const f32x4 dv = *(const LAS f32x4*)(Bf + 24576 + (32 * (rt_) + 8 * g + 4 * hh) * 4); \
                            Sx[4 * g] *= dv.x; Sx[4 * g + 1] *= dv.y; Sx[4 * g + 2] *= dv.z; Sx[4 * g + 3] *= dv.w; } } while (0)
                    SCAN_SUPD(S0, 0); SCAN_SUPD(S1, 1); SCAN_SUPD(S2, 2); SCAN_SUPD(S3, 3);
#pragma unroll
                    for (int i = 0; i < 16; ++i) { const int s_ = (i & 3) + 8 * (i >> 2) + 4 * hh; X[i] = (s_ <= r) ? X[i] : 0.f; }
                    O = __builtin_amdgcn_mfma_f32_32x32x16_bf16(pack8(X, 0), vt[0], O, 0, 0, 0); O = __builtin_amdgcn_mfma_f32_32x32x16_bf16(pack8(X, 1), vt[1], O, 0, 0, 0);
                    LAS float* ob = (LAS float*)(lds + RING_OFF + OB0 + (n & 1) * 16384);
#pragma unroll
                    for (int i = 0; i < 16; ++i) ob[((i & 3) + 8 * (i >> 2) + 4 * hh) * 128 + 32 * sl + r] = O[i];
                    SCAN_BAR();
                }
                SCAN_BAR();
            }
        }
        {
            const int cb = (G > NB * 4) ? (int)blockIdx.x - NB * 4 : (int)blockIdx.x, ncb = (G > NB * 4) ? G - NB * 4 : G;
            if (cb >= 0) for (int item = cb * NWAVES + wave; item < NB * 32; item += ncb * NWAVES) {
                const int seg = item & 31, b = item >> 5, c0 = 8 * lane, t0 = seg * 64;
                float w0[8], w1[8], w2[8], gn[8], u1[8], u2[8];
#pragma unroll
                for (int j = 0; j < 8; ++j) { w0[j] = conv_w[c0 + j]; w1[j] = conv_w[512 + c0 + j]; w2[j] = conv_w[1024 + c0 + j]; gn[j] = conv_gain[c0 + j]; u1[j] = 0.f; u2[j] = 0.f; }
                if (t0 > 0) { const bf16* p2 = PROJ + (size_t)(b * SEQ + t0 - 2) * DPR; const bf16* p1 = p2 + DPR;
                    const v4u ua = *(const GAS v4u*)(p2 + PC_U + c0), ub = *(const GAS v4u*)(p1 + PC_U + c0);
                    const unsigned uaw[4] = {ua.x, ua.y, ua.z, ua.w}, ubw[4] = {ub.x, ub.y, ub.z, ub.w};
#pragma unroll
                    for (int j = 0; j < 4; ++j) { u2[2 * j] = bf_lo(uaw[j]); u2[2 * j + 1] = bf_hi(uaw[j]); u1[2 * j] = bf_lo(ubw[j]); u1[2 * j + 1] = bf_hi(ubw[j]); } }
                for (int tb = t0; tb < t0 + 64; tb += 4) {
                    v4u uw[4], bw[4];
#pragma unroll
                    for (int i = 0; i < 4; ++i) { const bf16* pr = PROJ + ((size_t)b * SEQ + tb + i) * DPR; uw[i] = *(const GAS v4u*)(pr + PC_U + c0); bw[i] = *(const GAS v4u*)(pr + PC_B + c0); }
#pragma unroll
                    for (int i = 0; i < 4; ++i) { const unsigned uc[4] = {uw[i].x, uw[i].y, uw[i].z, uw[i].w}, bc[4] = {bw[i].x, bw[i].y, bw[i].z, bw[i].w};
                        float y[8], u[8]; float ss = 0.f;
#pragma unroll
                        for (int j = 0; j < 4; ++j) { u[2 * j] = bf_lo(uc[j]); u[2 * j + 1] = bf_hi(uc[j]);
                            y[2 * j] = bf_lo(bc[j]) * (w0[2 * j] * u2[2 * j] + w1[2 * j] * u1[2 * j] + w2[2 * j] * u[2 * j]); y[2 * j + 1] = bf_hi(bc[j]) * (w0[2 * j + 1] * u2[2 * j + 1] + w1[2 * j + 1] * u1[2 * j + 1] + w2[2 * j + 1] * u[2 * j + 1]);
                            ss += y[2 * j] * y[2 * j] + y[2 * j + 1] * y[2 * j + 1]; }
                        ss += dpp_f<0xB1>(ss); ss += dpp_f<0x4E>(ss); ss += dpp_f<0x141>(ss);
                        const float r = __builtin_amdgcn_rsqf(ss * (1.0f / 64.0f) + EPS);
                        *(GAS v4u*)(MIX + ((size_t)b * SEQ + tb + i) * D + c0) = (v4u){pk2(y[0] * r * gn[0], y[1] * r * gn[1]), pk2(y[2] * r * gn[2], y[3] * r * gn[3]), pk2(y[4] * r * gn[4], y[5] * r * gn[5]), pk2(y[6] * r * gn[6], y[7] * r * gn[7])};
#pragma unroll
                        for (int j = 0; j < 8; ++j) { u2[j] = u1[j]; u1[j] = u[j]; } }
                }
            }
        }
        {
            const int cb = (G > NB * 4) ? (int)blockIdx.x - NB * 4 : (int)blockIdx.x, ncb = (G > NB * 4) ? G - NB * 4 : G;
            if (cb >= 0) {
                const int dw = cb * NWAVES + wave, ndw = ncb * NWAVES;
                LAS float* scr = (LAS float*)(lds + RING_OFF + wave * 16384);
                constexpr int I_O = (D / 64) * (D / 32);
                for (int it = dw; it < I_O; it += ndw) p0_transpose_item<false>(w_out, D, D, nullptr, WOT, scr, it, lane);
                for (int it = dw; it < 16 * 32 * 2; it += ndw) {
                    const int hp = it >> 6, kt = (it >> 1) & 31, nh = it & 1, rr = lane & 31, h8 = lane >> 5;
                    const int k = kt * 32 + rr; const float gk = norm_ffn[k];
                    pg8::bf16x8 af[8];
#pragma unroll
                    for (int ks = 0; ks < 8; ++ks) { const GAS f32x4* ap = (const GAS f32x4*)(peer_wq + (size_t)k * 2048 + hp * 128 + 16 * ks + 8 * h8); const f32x4 a0 = ap[0] * gk, a1 = ap[1] * gk;
                        v4u p_; p_.x = cvtpk(a0.x, a0.y); p_.y = cvtpk(a0.z, a0.w); p_.z = cvtpk(a1.x, a1.y); p_.w = cvtpk(a1.z, a1.w); af[ks] = __builtin_bit_cast(pg8::bf16x8, p_); }
#pragma unroll
                    for (int nt = 0; nt < 2; ++nt) {
                        const int n = nh * 64 + nt * 32 + rr;
                        f32x16 acc;
#pragma unroll
                        for (int i = 0; i < 16; ++i) acc[i] = 0.f;
#pragma unroll
                        for (int ks = 0; ks < 8; ++ks) { const GAS f32x4* bp = (const GAS f32x4*)(peer_keys + ((size_t)hp * 128 + n) * 128 + 16 * ks + 8 * h8); const f32x4 b0 = bp[0], b1 = bp[1];
                            v4u p_; p_.x = cvtpk(b0.x, b0.y); p_.y = cvtpk(b0.z, b0.w); p_.z = cvtpk(b1.x, b1.y); p_.w = cvtpk(b1.z, b1.w);
                            acc = __builtin_amdgcn_mfma_f32_32x32x16_bf16(af[ks], __builtin_bit_cast(pg8::bf16x8, p_), acc, 0, 0, 0); }
                        GAS unsigned* op = (GAS unsigned*)(WQT + ((size_t)hp * 128 + n) * D + kt * 32 + 4 * h8);
#pragma unroll
                        for (int g = 0; g < 4; ++g) { typedef unsigned v2u_t __attribute__((ext_vector_type(2)));
                            *(GAS v2u_t*)(op + 4 * g) = (v2u_t){cvtpk(acc[4 * g], acc[4 * g + 1]), cvtpk(acc[4 * g + 2], acc[4 * g + 3])}; }
                    }
                }
                for (int r = dw; r < 2 * NEXP; r += ndw) {
                    const int tb = r / NEXP, e = r % NEXP; const float sc = tb ? PEER_SV : PEER_SU;
                    const GAS f32x4* src = (const GAS f32x4*)((tb ? peer_v : peer_u) + (size_t)e * D);
                    f32x4 v[4] = {src[2 * lane], src[2 * lane + 1], src[128 + 2 * lane], src[128 + 2 * lane + 1]};
                    if (!tb) { const GAS f32x4* gp = (const GAS f32x4*)norm_ffn; v[0] = v[0] * gp[2 * lane]; v[1] = v[1] * gp[2 * lane + 1]; v[2] = v[2] * gp[128 + 2 * lane]; v[3] = v[3] * gp[128 + 2 * lane + 1]; }
                    unsigned o[4];
        #pragma unroll
                    for (int j = 0; j < 4; ++j) { f32x4 w = v[j] * sc;
                        if (tb) { w.x = fminf(fmaxf(w.x, -240.f), 240.f); w.y = fminf(fmaxf(w.y, -240.f), 240.f); w.z = fminf(fmaxf(w.z, -240.f), 240.f); w.w = fminf(fmaxf(w.w, -240.f), 240.f);
                            int pk = 0; pk = __builtin_amdgcn_cvt_pk_fp8_f32(w.x, w.y, pk, false); pk = __builtin_amdgcn_cvt_pk_fp8_f32(w.z, w.w, pk, true); o[j] = (unsigned)pk; }
                        else { const int i0 = (int)rintf(fminf(fmaxf(w.x, -127.f), 127.f)), i1 = (int)rintf(fminf(fmaxf(w.y, -127.f), 127.f)), i2 = (int)rintf(fminf(fmaxf(w.z, -127.f), 127.f)), i3 = (int)rintf(fminf(fmaxf(w.w, -127.f), 127.f));
                            o[j] = ((unsigned)i0 & 0xFFu) | (((unsigned)i1 & 0xFFu) << 8) | (((unsigned)i2 & 0xFFu) << 16) | (((unsigned)i3 & 0xFFu) << 24); } }
                    ((GAS v4u*)((tb ? V8 : U8) + (size_t)e * D))[lane] = (v4u){o[0], o[1], o[2], o[3]};
                }
            }
        }
        if (BOTH(3)) GRID_BAR();
    }


    if (IN(4)) {
        pg8::Gemm g{MIX, WOT, T, D, D}; pg8::StaticOrder S; S.init(T, D, G, (int)blockIdx.x);
        pg8::EpiResid E{XB, X1, SS2};
        pg8::gemm_phase<pg8::EpiResid, pg8::StaticOrder, PG8_ALIGN, PG8_SP2>(lds + RING_OFF, g, S, E);
        if (BOTH(4)) GRID_BAR();
    }

    if (IN(5)) {
        pg8::Gemm g{X1, WQT, T, 2048, D}; pg8::StaticOrder S; S.init(T, 2048, G, (int)blockIdx.x);
        pg8::EpiScaleBf16<2> E{QB, 2048, SS2};
        pg8::gemm_phase<pg8::EpiScaleBf16<2>, pg8::StaticOrder, PG8_ALIGN, PG8_SP2>(lds + RING_OFF, g, S, E);
        if (BOTH(5)) GRID_BAR();
    }

    if (IN(6)) {
        const int r = lane & 31, hh = lane >> 5;
        for (int tg0 = 0; tg0 < T / 32; tg0 += NGW) {
          const int tgi = (tg0 + gw < T / 32) ? tg0 + gw : tg0 + gw - NGW;
          const int tok = tgi * 32 + r;
          LAS unsigned char* sbuf = lds + RING_OFF + wave * 16384;
#define P6_DMA(s_) do { const GAS unsigned char* g_ = (const GAS unsigned char*)QB + ((size_t)tgi * 32) * 4096 + (size_t)(s_) * 256; LAS unsigned char* l_ = sbuf + ((s_) & 1) * 8192; \
            _Pragma("unroll") for (int j_ = 0; j_ < 8; ++j_) { const int row_ = 4 * j_ + (lane >> 4), c_ = (lane & 15) ^ (row_ & 15); \
                __builtin_amdgcn_global_load_lds((const GAS unsigned*)(g_ + (size_t)row_ * 4096 + c_ * 16), (LAS unsigned*)(l_ + j_ * 1024), 16, 0, 0); } } while (0)
          P6_DMA(0);
          for (int h = 0; h < 8; ++h) {
            unsigned L[2][16];
#pragma unroll
            for (int p = 0; p < 2; ++p) {
                const int st = 2 * h + p;
                asm volatile("s_waitcnt vmcnt(0)" ::: "memory");
                if (st + 1 < 16) P6_DMA(st + 1);
                v4u sa[8];
                { const LAS unsigned char* rb = sbuf + (st & 1) * 8192 + r * 256;
#pragma unroll
                  for (int i = 0; i < 8; ++i) sa[i] = *(const LAS v4u*)(rb + (((8 * hh + i) ^ (r & 15)) << 4)); }
#pragma unroll
                for (int np = 0; np < 2; ++np) {
                    unsigned c0[16], c1[16];
#pragma unroll
                    for (int j = 0; j < 8; ++j) {
                        const v4u qa = sa[4 * np + (j >> 2)], qb = sa[4 * np + 2 + (j >> 2)];
                        const unsigned wa = (j & 3) == 0 ? qa.x : (j & 3) == 1 ? qa.y : (j & 3) == 2 ? qa.z : qa.w, wb = (j & 3) == 0 ? qb.x : (j & 3) == 1 ? qb.y : (j & 3) == 2 ? qb.z : qb.w;
                        typedef short s2_t __attribute__((ext_vector_type(2)));
                        const s2_t ma = __builtin_bit_cast(s2_t, wa) >> (s2_t){15, 15}, mb = __builtin_bit_cast(s2_t, wb) >> (s2_t){15, 15};
                        const unsigned ka = wa ^ (__builtin_bit_cast(unsigned, ma) | 0x80008000u), kb = wb ^ (__builtin_bit_cast(unsigned, mb) | 0x80008000u);
                        const unsigned pay = (unsigned)(63 - (32 * np + 2 * j));
                        c0[2 * j] = (ka << 16) | pay; c0[2 * j + 1] = (ka & 0xFFFF0000u) | (pay - 1u);
                        c1[2 * j] = (kb << 16) | (pay - 16u); c1[2 * j + 1] = (kb & 0xFFFF0000u) | (pay - 17u); }
                    sort16_desc2(c0, c1);
                    merge16_desc(c0, c1);
                    if (np == 0) {
#pragma unroll
                        for (int i = 0; i < 16; ++i) L[p][i] = c0[i];
                    } else merge16_desc(L[p], c0);
                }
                unsigned o[16];
#pragma unroll
                for (int i = 0; i < 16; ++i) { L[p][i] |= hh ? 0u : 64u; o[i] = (unsigned)__shfl_xor((int)L[p][i], 32); }
                merge16_desc(L[p], o);
            }
            float v1[16], v2[16];
#pragma unroll
            for (int j = 0; j < 16; ++j) { v1[j] = unkey16(L[0][j]); v2[j] = unkey16(L[1][j]); }
            const unsigned hm = 0u - (unsigned)hh;
            unsigned ct[16];
#pragma unroll
            for (int t = 0; t < 16; ++t) { const unsigned rk = ckey(v1[0] + v2[t], t), ck = (t < 15) ? ckey(v1[t + 1] + v2[0], 16 * (t + 1)) : 0u; ct[t] = rk ^ ((rk ^ ck) & hm); }
            {
                constexpr int CI[20] = {1, 1, 1, 1, 1, 1, 1, 2, 3, 4,   5, 6, 7, 2, 2, 2, 3, 3, 4, 0};
                constexpr int CJ[20] = {1, 2, 3, 4, 5, 6, 7, 1, 1, 1,   1, 1, 1, 2, 3, 4, 2, 3, 2, 0};
#pragma unroll
                for (int s_ = 0; s_ < 10; ++s_) {
                    const int ia = CI[s_], ja = CJ[s_], ib = CI[10 + s_], jb = CJ[10 + s_];
                    const unsigned xa = __builtin_bit_cast(unsigned, v1[ia]), xb = __builtin_bit_cast(unsigned, v1[ib]), ya = __builtin_bit_cast(unsigned, v2[ja]), yb = __builtin_bit_cast(unsigned, v2[jb]);
                    const float xs = __builtin_bit_cast(float, xa ^ ((xa ^ xb) & hm)), ys = __builtin_bit_cast(float, ya ^ ((ya ^ yb) & hm));
                    const unsigned pa = 255u - (unsigned)(ia * 16 + ja), pb = 255u - (unsigned)(ib * 16 + jb);
                    const float sm = xs + ys; unsigned u = __builtin_bit_cast(unsigned, sm); u ^= (unsigned)((int)u >> 31) | 0x80000000u;
                    unsigned key = (u & ~0xFFu) | (pa ^ ((pa ^ pb) & hm));
                    if (s_ == 9) key &= ~hm;
#pragma unroll
                    for (int t = 0; t < 16; ++t) { const unsigned mx = ct[t] > key ? ct[t] : key; key = ct[t] > key ? key : ct[t]; ct[t] = mx; }
                }
                unsigned oc[16];
#pragma unroll
                for (int t = 0; t < 16; ++t) oc[t] = (unsigned)__shfl_xor((int)ct[t], 32);
                merge16_desc(ct, oc);
            }
            float den = 0.f, ex[16]; const float cmax = unkey(ct[0] & ~0xFFu);
#pragma unroll
            for (int t = 0; t < 16; ++t) { ex[t] = __expf(unkey(ct[t] & ~0xFFu) - cmax); den += ex[t]; }
            const float inv = 1.0f / den;
            unsigned b1[4], b2[4];
#pragma unroll
            for (int w = 0; w < 4; ++w) { b1[w] = (L[0][4 * w] & 0x7Fu) | ((L[0][4 * w + 1] & 0x7Fu) << 8) | ((L[0][4 * w + 2] & 0x7Fu) << 16) | ((L[0][4 * w + 3] & 0x7Fu) << 24);
                b2[w] = (L[1][4 * w] & 0x7Fu) | ((L[1][4 * w + 1] & 0x7Fu) << 8) | ((L[1][4 * w + 2] & 0x7Fu) << 16) | ((L[1][4 * w + 3] & 0x7Fu) << 24); }
            unsigned ent[8];
#pragma unroll
            for (int t = 0; t < 8; ++t) {
                const unsigned ck = ct[t] ^ ((ct[t] ^ ct[8 + t]) & hm); const unsigned e0 = __builtin_bit_cast(unsigned, ex[t]), e1 = __builtin_bit_cast(unsigned, ex[8 + t]);
                const float gt = __builtin_bit_cast(float, e0 ^ ((e0 ^ e1) & hm)) * inv;
                const unsigned flat = 255u - (ck & 0xFFu), ii = flat >> 4, jj = flat & 15u;
                const unsigned w1 = (ii & 8u) ? ((ii & 4u) ? b1[3] : b1[2]) : ((ii & 4u) ? b1[1] : b1[0]), w2 = (jj & 8u) ? ((jj & 4u) ? b2[3] : b2[2]) : ((jj & 4u) ? b2[1] : b2[0]);
                const unsigned n1 = 127u - ((w1 >> (8u * (ii & 3u))) & 0x7Fu), n2 = 127u - ((w2 >> (8u * (jj & 3u))) & 0x7Fu);
                ent[t] = (n1 * 128u + n2) | (pkh2(gt, 0.f) << 16); }
            GAS v4u* ep = (GAS v4u*)(EXPT + (size_t)tok * 128 + h * 16 + 8 * hh);
            ep[0] = (v4u){ent[0], ent[1], ent[2], ent[3]}; ep[1] = (v4u){ent[4], ent[5], ent[6], ent[7]};
          }
        }
        if (BOTH(6)) asm volatile("s_waitcnt vmcnt(0)" ::: "memory");
    }


    if (IN(7)) {
        constexpr int NT = 8;
        unsigned pace_round = 0u;
        unsigned* pace_cnt = (unsigned*)(ctl + 16384) + 64 * bar.x;
        const unsigned pace_n = (N_LAUNCHES == 1) ? MISC[8] : 0u;
#define PEER_PACE() do { if (pace_n) { ++pace_round; __syncthreads(); if (tid == 0) { (void)__hip_atomic_fetch_add(pace_cnt, 1u, __ATOMIC_RELAXED, __HIP_MEMORY_SCOPE_WORKGROUP); unsigned sp_ = 0; \
            for (;;) { unsigned cur_; const unsigned z_ = 0u; asm volatile("global_atomic_add %0, %1, %2, %3 sc0\n\ts_waitcnt vmcnt(0)" : "=&v"(cur_) : "v"(z_), "v"(z_), "s"(pace_cnt) : "memory");     \
                if (cur_ >= pace_n * pace_round || ++sp_ >= 20000u) break; __builtin_amdgcn_s_sleep(1); } } __syncthreads(); } } while (0)
        const unsigned srcl = (unsigned)(32 * (lane & 1)) << 2;
        for (int tg0 = 0; tg0 < T / 32; tg0 += NGW)
          for (int kb = 0; kb < 32 / NT; ++kb) {
            const int tgi = (tg0 + gw < T / 32) ? tg0 + gw : tg0 + gw - NGW;
            const int tok0 = tgi * 32 + kb * NT;
            unsigned e[NT][2]; float sc[NT]; int hx[NT][4];
#pragma unroll
            for (int t = 0; t < NT; ++t) { const unsigned r0 = EXPT[(size_t)(tok0 + t) * 128 + lane], r1 = EXPT[(size_t)(tok0 + t) * 128 + 64 + lane];
                e[t][0] = (r0 << 16) | (r0 >> 16); e[t][1] = (r1 << 16) | (r1 >> 16);
                const GAS v4u* xr = (const GAS v4u*)(X1 + (size_t)(tok0 + t) * D); const v4u xa = __builtin_nontemporal_load(xr + lane), xb = __builtin_nontemporal_load(xr + 64 + lane);
                const float xv[16] = {bf_lo(xa.x), bf_hi(xa.x), bf_lo(xa.y), bf_hi(xa.y), bf_lo(xa.z), bf_hi(xa.z), bf_lo(xa.w), bf_hi(xa.w), bf_lo(xb.x), bf_hi(xb.x), bf_lo(xb.y), bf_hi(xb.y), bf_lo(xb.z), bf_hi(xb.z), bf_lo(xb.w), bf_hi(xb.w)};
                float am = 0.f;
#pragma unroll
                for (int i = 0; i < 16; ++i) am = fmaxf(am, fabsf(xv[i]));
                am = fmaxf(wave_max(am), 1e-20f); const float sx = 127.0f / am;
                sc[t] = am * (1.0f / 127.0f) * (1.0f / PEER_SU) / sqrtf(SS2[tok0 + t] * (1.0f / D) + EPS);
#pragma unroll
                for (int w = 0; w < 4; ++w) { const int i0 = (int)rintf(xv[4 * w] * sx), i1 = (int)rintf(xv[4 * w + 1] * sx), i2 = (int)rintf(xv[4 * w + 2] * sx), i3 = (int)rintf(xv[4 * w + 3] * sx);
                    hx[t][w] = (int)(((unsigned)i0 & 0xFFu) | (((unsigned)i1 & 0xFFu) << 8) | (((unsigned)i2 & 0xFFu) << 16) | (((unsigned)i3 & 0xFFu) << 24)); } }
            sort128_asc<NT>(e, lane);
            PEER_PACE();
            int ah[NT][2];
#pragma unroll
            for (int t = 0; t < NT; ++t) { ah[t][0] = 0; ah[t][1] = 0; }
#define PEER_LOAD(buf, TAB, st_) do { _Pragma("unroll") for (int t = 0; t < NT; ++t) { const unsigned em_ = ((st_) & 32) ? 0xFFFFFFFFu : 0u; const unsigned esel = e[t][0] ^ ((e[t][0] ^ e[t][1]) & em_); \
                _Pragma("unroll") for (int q = 0; q < 2; ++q) { const unsigned id = (unsigned)__builtin_amdgcn_readlane((int)esel, 2 * ((st_) & 31) + q) >> 16; \
                    const unsigned char* rp_ = TAB + (size_t)id * D; asm volatile("" : "+s"(rp_)); buf[t][q] = ((const GAS v4u*)rp_)[lane]; } } } while (0)
            for (int st = 0; st < 64; ++st) { if (st == 32) PEER_PACE();
                v4u ub[NT][2];
                PEER_LOAD(ub, U8, st);
                int p[16];
#pragma unroll
                for (int t = 0; t < NT; ++t)
#pragma unroll
                    for (int q = 0; q < 2; ++q) { const int d0 = __builtin_amdgcn_sdot4((int)ub[t][q].x, hx[t][0], 0, false), d1 = __builtin_amdgcn_sdot4((int)ub[t][q].z, hx[t][2], 0, false);
                        p[2 * t + q] = __builtin_amdgcn_sdot4((int)ub[t][q].y, hx[t][1], d0, false) + __builtin_amdgcn_sdot4((int)ub[t][q].w, hx[t][3], d1, false); }
                const int red = reduce16i(p, lane); const bool hit = (lane >> 1) == (st & 31), hi = (st & 32) != 0;
#pragma unroll
                for (int t = 0; t < NT; ++t) { const int got = __builtin_amdgcn_ds_bpermute((int)(srcl + (unsigned)((16 * (t & 1) + 8 * ((t >> 1) & 1) + 4 * (t >> 2)) << 2)), red);
                    ah[t][0] = (hit && !hi) ? got : ah[t][0]; ah[t][1] = (hit && hi) ? got : ah[t][1]; }
            }
            unsigned wv[NT][2];
#pragma unroll
            for (int t = 0; t < NT; ++t)
#pragma unroll
                for (int g = 0; g < 2; ++g) { const float a = (float)ah[t][g] * sc[t]; const float gate = (float)h2_of(e[t][g] & 0xFFFFu).x;
                    const float w = gate * (0.5f / PEER_SV) * a * (1.0f + erff(a * 0.7071067811865476f)); wv[t][g] = pkh2(w, w); }
            PEER_PACE();
            h2_t y[NT][8];
#pragma unroll
            for (int t = 0; t < NT; ++t)
#pragma unroll
                for (int i = 0; i < 8; ++i) y[t][i] = (h2_t){(_Float16)0.f, (_Float16)0.f};
            for (int st = 0; st < 64; ++st) { if (st == 32) PEER_PACE();
                v4u vb[NT][2];
                PEER_LOAD(vb, V8, st);
#pragma unroll
                for (int t = 0; t < NT; ++t) { const unsigned wm_ = (st & 32) ? 0xFFFFFFFFu : 0u; const unsigned wsel = wv[t][0] ^ ((wv[t][0] ^ wv[t][1]) & wm_);
#pragma unroll
                    for (int q = 0; q < 2; ++q) { const h2_t w2 = h2_of((unsigned)__builtin_amdgcn_readlane((int)wsel, 2 * (st & 31) + q));
                        const unsigned vw_[4] = {vb[t][q].x, vb[t][q].y, vb[t][q].z, vb[t][q].w};
#pragma unroll
                        for (int j = 0; j < 4; ++j) { y[t][2 * j] = __builtin_elementwise_fma(__builtin_bit_cast(h2_t, __builtin_amdgcn_cvt_scalef32_pk_f16_fp8((int)vw_[j], 1.0f, false)), w2, y[t][2 * j]);
                            y[t][2 * j + 1] = __builtin_elementwise_fma(__builtin_bit_cast(h2_t, __builtin_amdgcn_cvt_scalef32_pk_f16_fp8((int)vw_[j], 1.0f, true)), w2, y[t][2 * j + 1]); } } }
            }
#pragma unroll
            for (int t = 0; t < NT; ++t) { int tki = tok0 + t; asm volatile("" : "+s"(tki));
                const size_t tok = (size_t)tki;
                const GAS v4u* xr = (const GAS v4u*)(X1 + tok * D); const v4u xa = __builtin_nontemporal_load(xr + lane), xb = __builtin_nontemporal_load(xr + 64 + lane);
                const float xf[16] = {bf_lo(xa.x), bf_hi(xa.x), bf_lo(xa.y), bf_hi(xa.y), bf_lo(xa.z), bf_hi(xa.z), bf_lo(xa.w), bf_hi(xa.w),
                                      bf_lo(xb.x), bf_hi(xb.x), bf_lo(xb.y), bf_hi(xb.y), bf_lo(xb.z), bf_hi(xb.z), bf_lo(xb.w), bf_hi(xb.w)};
                float yy[16]; float ss = 0.f;
#pragma unroll
                for (int i = 0; i < 8; ++i) { yy[2 * i] = (float)y[t][i].x + xf[2 * i]; yy[2 * i + 1] = (float)y[t][i].y + xf[2 * i + 1]; ss += yy[2 * i] * yy[2 * i] + yy[2 * i + 1] * yy[2 * i + 1]; }
                ss = wave_sum(ss);
                const float r = 1.0f / sqrtf(ss * (1.0f / D) + EPS);
                const GAS f32x4* nfp = (const GAS f32x4*)norm_f; const f32x4 n0 = nfp[2 * lane], n1 = nfp[2 * lane + 1], n2 = nfp[128 + 2 * lane], n3 = nfp[128 + 2 * lane + 1];
                GAS f32x4* op = (GAS f32x4*)(out + tok * D);
                __builtin_nontemporal_store((f32x4){yy[0] * r * n0.x, yy[1] * r * n0.y, yy[2] * r * n0.z, yy[3] * r * n0.w}, op + 2 * lane);
                __builtin_nontemporal_store((f32x4){yy[4] * r * n1.x, yy[5] * r * n1.y, yy[6] * r * n1.z, yy[7] * r * n1.w}, op + 2 * lane + 1);
                __builtin_nontemporal_store((f32x4){yy[8] * r * n2.x, yy[9] * r * n2.y, yy[10] * r * n2.z, yy[11] * r * n2.w}, op + 128 + 2 * lane);
                __builtin_nontemporal_store((f32x4){yy[12] * r * n3.x, yy[13] * r * n3.y, yy[14] * r * n3.z, yy[15] * r * n3.w}, op + 128 + 2 * lane + 1); }
        }
    }

#undef IN
#undef BOTH
}

extern "C" void kernel_launch(void* const* d_in, const int* in_sizes, int n_in, void* d_out, int out_size, void* d_ws, size_t ws_size, hipStream_t stream) {
    static int grid = 0;
    if (grid == 0) {
        if (n_in != 14 || in_sizes[0] != T * D || out_size != T * D || ws_size < WS_END) { fprintf(stderr, "kernel_launch: unexpected shapes (n_in %d, in0 %d, out %d, ws %zu); nothing launched\n", n_in, n_in > 0 ? in_sizes[0] : -1, out_size, ws_size); grid = -1; return; }
        int dev = 0, cus = 0, per_cu = 0;
        if (hipGetDevice(&dev) != hipSuccess || hipDeviceGetAttribute(&cus, hipDeviceAttributeMultiprocessorCount, dev) != hipSuccess) { grid = -1; return; }
        if (hipFuncSetAttribute((const void*)hymba_fwd, hipFuncAttributeMaxDynamicSharedMemorySize, LDS_BYTES) != hipSuccess) { fprintf(stderr, "kernel_launch: hipFuncSetAttribute failed\n"); grid = -1; return; }
        if (hipOccupancyMaxActiveBlocksPerMultiprocessor(&per_cu, (const void*)hymba_fwd, NWAVES * 64, LDS_BYTES) != hipSuccess || per_cu < 1) { fprintf(stderr, "kernel_launch: occupancy query says %d blocks per CU\n", per_cu); (void)hipGetLastError(); grid = -1; return; }
        grid = cus;
    }
    if (grid < 0) return;
    if (hipMemsetAsync((char*)d_ws + WS_CTL, 0, CTL_ZERO_BYTES, stream) != hipSuccess) { fprintf(stderr, "kernel_launch: hipMemsetAsync failed\n"); return; }
    Args a{};
    for (int i = 0; i < 14; ++i) a.in[i] = (const float*)d_in[i];
    a.out = (float*)d_out; a.ws = (unsigned char*)d_ws;
    if (N_LAUNCHES == 1) {
        a.ph_lo = 0; a.ph_hi = NPHASES; a.li = 0;
        void* kargs[] = {&a};
        const hipError_t e = hipLaunchCooperativeKernel((const void*)hymba_fwd, dim3(grid), dim3(NWAVES * 64), kargs, LDS_BYTES, stream);
        if (e != hipSuccess) fprintf(stderr, "kernel_launch: cooperative launch failed: %s (grid %d)\n", hipGetErrorString(e), grid);
    } else {
        for (int li = 0; li < NPHASES; ++li) {
            a.ph_lo = li; a.ph_hi = li + 1; a.li = li;
            hipLaunchKernelGGL(hymba_fwd, dim3(grid), dim3(NWAVES * 64), LDS_BYTES, stream, a);
            const hipError_t le = hipPeekAtLastError();
            if (le != hipSuccess) { fprintf(stderr, "kernel_launch: launch %d failed: %s\n", li, hipGetErrorName(le)); break; }
        }
    }
}
```

```cpp
#include <hip/hip_runtime.h>
#include <cstdio>
#include <cstdint>
namespace pg8 {
#define PG8_LAS __attribute__((address_space(3)))
typedef unsigned short bf16_t;
typedef short bf16x8 __attribute__((ext_vector_type(8)));
typedef float f32x4 __attribute__((ext_vector_type(4)));
typedef unsigned u32x4 __attribute__((ext_vector_type(4)));
constexpr int BM = 256, BK = 64, HALF = 128, HTB = HALF * BK * 2  , STAGE_BYTES = 8 * HTB, NXCD = 8, WGM = 8;

__host__ __device__ __forceinline__ int lds_byte(int r, int c) { const int st = (r >> 4) * 2 + (c >> 5), rr = r & 15, cc = c & 31, ob = rr * 64 + cc * 2; return st * 1024 + (ob ^ (((ob >> 9) & 1) << 5)); }
__host__ __device__ __forceinline__ void stage_rc(int b, int& R, int& C) { const int st = b / 1024, sb = b % 1024, swz = sb ^ (((sb >> 9) & 1) << 5); R = (st >> 1) * 16 + swz / 64; C = (st & 1) * 32 + (swz % 64) / 2; }
__host__ __device__ __forceinline__ int perm32(int rho) { const int n = rho >> 4, i = rho & 15; return 8 * (i >> 2) + 4 * n + (i & 3); }

struct Unit { int pm, pn; };
struct Gemm { const bf16_t* A; const bf16_t* Bt; int M, N, K; };

struct StaticOrder {
    int nM, nN, nwg, G, c;
    __host__ __device__ void init(int M, int N, int G_, int c_) { nM = M / BM; nN = N / BM; nwg = nM * nN; G = G_; c = c_; }
    __host__ __device__ bool next(int i, Unit& u) const {
        const long L = (long)i * G + c; if (L >= nwg) return false;
        int wgid = (int)L; { const int q = nwg / NXCD, r = nwg % NXCD, xcd = wgid % NXCD, off = wgid / NXCD; wgid = (xcd < r ? xcd * (q + 1) : r * (q + 1) + (xcd - r) * q) + off; }
        const int nig = WGM * nN, gid = wgid / nig, fm = gid * WGM, gsz = (nM - fm) < WGM ? (nM - fm) : WGM;
        u.pm = fm + ((wgid % nig) % gsz); u.pn = (wgid % nig) / gsz; return true;
    }
    __device__ __forceinline__ void a_ready(const Unit&) const {}
    __device__ __forceinline__ void done(const Unit&) const {}
};

__device__ __forceinline__ unsigned cvt_pk_bf16(float lo, float hi) { unsigned r; asm volatile("v_cvt_pk_bf16_f32 %0, %1, %2" : "=v"(r) : "v"(lo), "v"(hi)); return r; }

template <int MODE> struct EpiScaleBf16 {
    static constexpr bool PERM = true, AFTER_DRAIN = false;
    bf16_t* O; int ldc; const float* rowv;
    __device__ __forceinline__ void operator()(const f32x4 (&acc)[2][2][4][2], const Unit& u, int wr, int wc, int fr, int fq) const {
        const int row0 = u.pm * BM + wr * 64 + fr, col0 = u.pn * BM + wc * 32 + 8 * fq;
#pragma unroll
        for (int ai = 0; ai < 2; ++ai)
#pragma unroll
            for (int m = 0; m < 4; ++m) { const int row = row0 + ai * HALF + m * 16; float s = rowv[row]; if (MODE >= 1) s = __builtin_amdgcn_rsqf(s * (1.0f / 1024.0f) + 1e-6f);
                bf16_t* rowp = O + (size_t)row * ldc + col0;
#pragma unroll
                for (int bj = 0; bj < 2; ++bj) { const f32x4 v0 = acc[ai][bj][m][0] * s, v1 = acc[ai][bj][m][1] * s;
                    u32x4 w;
                    if (MODE == 2) { w.x = __builtin_bit_cast(unsigned, __builtin_amdgcn_cvt_pkrtz(v0[0], v0[1])); w.y = __builtin_bit_cast(unsigned, __builtin_amdgcn_cvt_pkrtz(v0[2], v0[3])); w.z = __builtin_bit_cast(unsigned, __builtin_amdgcn_cvt_pkrtz(v1[0], v1[1])); w.w = __builtin_bit_cast(unsigned, __builtin_amdgcn_cvt_pkrtz(v1[2], v1[3])); }
                    else { w.x = cvt_pk_bf16(v0[0], v0[1]); w.y = cvt_pk_bf16(v0[2], v0[3]); w.z = cvt_pk_bf16(v1[0], v1[1]); w.w = cvt_pk_bf16(v1[2], v1[3]); }
                    *(u32x4*)(rowp + bj * HALF) = w; } }
    }
};
struct EpiProj {
    static constexpr bool PERM = true, AFTER_DRAIN = false;
    bf16_t* O; const float* rowv; const float* lbl; float* dec;
    template <int CTRL> static __device__ __forceinline__ float dppm(float v) { return __builtin_bit_cast(float, __builtin_amdgcn_update_dpp(0x3f800000, __builtin_bit_cast(int, v), CTRL, 0xF, 0xF, false)); }
    static __device__ __forceinline__ float scan16(float x) { x *= dppm<0x111>(x); x *= dppm<0x112>(x); x *= dppm<0x114>(x); x *= dppm<0x118>(x); return x; }
    static __device__ __forceinline__ float prod16(float x) { x *= dppm<0xB1>(x); x *= dppm<0x4E>(x); x *= dppm<0x141>(x); x *= dppm<0x140>(x); return x; }
    static __device__ __forceinline__ float sigm(float x) { return __builtin_amdgcn_rcpf(1.0f + __expf(-x)); }
    __device__ __forceinline__ void operator()(const f32x4 (&acc)[2][2][4][2], const Unit& u, int wr, int wc, int fr, int fq) const {
        const int row0 = u.pm * BM + wr * 64 + fr, colw = wc * 32 + 8 * fq;
        if (u.pn >= 6 && u.pn < 10) {
            const int h = u.pn - 6;
            float lb[8];
#pragma unroll
            for (int j = 0; j < 8; ++j) { const int c = h * 128 + colw + j; lb[j] = __builtin_amdgcn_rcpf(1.0f + __expf(lbl[512 + c] - lbl[c])); }
#pragma unroll
            for (int ai = 0; ai < 2; ++ai)
#pragma unroll
                for (int mp = 0; mp < 2; ++mp) {
                    const int rowe = row0 + ai * HALF + (2 * mp) * 16, rowo = rowe + 16; const float se = rowv[rowe], so = rowv[rowo];
                    float qe[8], qo[8], ke[8], ko[8], dc[8];
#pragma unroll
                    for (int j = 0; j < 8; ++j) { const int n = j >> 2, jj = j & 3;
                        const float fe = lb[j] + (1.0f - lb[j]) * sigm(acc[ai][1][2 * mp][n][jj] * se), fo = lb[j] + (1.0f - lb[j]) * sigm(acc[ai][1][2 * mp + 1][n][jj] * so);
                        const float Ge = scan16(fe), Go = prod16(fe) * scan16(fo);
                        const float xe = acc[ai][0][2 * mp][n][jj] * se, xo = acc[ai][0][2 * mp + 1][n][jj] * so;
                        qe[j] = xe * sigm(xe) * 0.08838834764831845f * Ge; qo[j] = xo * sigm(xo) * 0.08838834764831845f * Go;
                        ke[j] = (1.0f - fe) * __builtin_amdgcn_rcpf(Ge); ko[j] = (1.0f - fo) * __builtin_amdgcn_rcpf(Go); dc[j] = Go; }
                    bf16_t* pe = O + (size_t)rowe * 3072 + 1024 + h * 512 + colw; bf16_t* po = pe + (size_t)16 * 3072;
                    u32x4 w; w.x = cvt_pk_bf16(qe[0], qe[1]); w.y = cvt_pk_bf16(qe[2], qe[3]); w.z = cvt_pk_bf16(qe[4], qe[5]); w.w = cvt_pk_bf16(qe[6], qe[7]); *(u32x4*)pe = w;
                    w.x = cvt_pk_bf16(ke[0], ke[1]); w.y = cvt_pk_bf16(ke[2], ke[3]); w.z = cvt_pk_bf16(ke[4], ke[5]); w.w = cvt_pk_bf16(ke[6], ke[7]); *(u32x4*)(pe + 128) = w;
                    w.x = cvt_pk_bf16(qo[0], qo[1]); w.y = cvt_pk_bf16(qo[2], qo[3]); w.z = cvt_pk_bf16(qo[4], qo[5]); w.w = cvt_pk_bf16(qo[6], qo[7]); *(u32x4*)po = w;
                    w.x = cvt_pk_bf16(ko[0], ko[1]); w.y = cvt_pk_bf16(ko[2], ko[3]); w.z = cvt_pk_bf16(ko[4], ko[5]); w.w = cvt_pk_bf16(ko[6], ko[7]); *(u32x4*)(po + 128) = w;
                    if (fr == 15) { const int chunk = (u.pm * BM + ai * HALF + wr * 64 + mp * 32) >> 5;
                        float* dp = dec + ((size_t)chunk * 4 + h) * 128 + colw; *(f32x4*)dp = (f32x4){dc[0], dc[1], dc[2], dc[3]}; *(f32x4*)(dp + 4) = (f32x4){dc[4], dc[5], dc[6], dc[7]}; }
                }
            return;
        }
#pragma unroll
        for (int ai = 0; ai < 2; ++ai)
#pragma unroll
            for (int m = 0; m < 4; ++m) { const int row = row0 + ai * HALF + m * 16; const float s = rowv[row];
                bf16_t* rowp = O + (size_t)row * 3072 + colw;
                if (u.pn < 4) { const f32x4 v0 = (acc[ai][0][m][0] * s) * (acc[ai][1][m][0] * s), v1 = (acc[ai][0][m][1] * s) * (acc[ai][1][m][1] * s);
                    u32x4 w; w.x = cvt_pk_bf16(v0[0], v0[1]); w.y = cvt_pk_bf16(v0[2], v0[3]); w.z = cvt_pk_bf16(v1[0], v1[1]); w.w = cvt_pk_bf16(v1[2], v1[3]);
                    *(u32x4*)(rowp + u.pn * HALF) = w; }
                else {
#pragma unroll
                    for (int bj = 0; bj < 2; ++bj) { const f32x4 v0 = acc[ai][bj][m][0] * s, v1 = acc[ai][bj][m][1] * s;
                        u32x4 w; w.x = cvt_pk_bf16(v0[0], v0[1]); w.y = cvt_pk_bf16(v0[2], v0[3]); w.z = cvt_pk_bf16(v1[0], v1[1]); w.w = cvt_pk_bf16(v1[2], v1[3]);
                        const int off = (u.pn < 10) ? (u.pn * BM - 512 + bj * HALF) : (1024 + (2 * ((u.pn - 10) & 1) + bj) * 512 + (u.pn < 12 ? 256 : 384));
                        *(u32x4*)(rowp + off) = w; } } }
    }
};
struct EpiResid {
    static constexpr bool PERM = true, AFTER_DRAIN = false;
    const bf16_t* X; bf16_t* O; float* ss;
    __device__ __forceinline__ void operator()(const f32x4 (&acc)[2][2][4][2], const Unit& u, int wr, int wc, int fr, int fq) const {
        const int row0 = u.pm * BM + wr * 64 + fr, col0 = u.pn * BM + wc * 32 + 8 * fq;
#pragma unroll
        for (int ai = 0; ai < 2; ++ai) {
            float pm_[4];
#pragma unroll
            for (int m = 0; m < 4; ++m) { const int row = row0 + ai * HALF + m * 16; float part = 0.f;
#pragma unroll
                for (int bj = 0; bj < 2; ++bj) { const u32x4 xw = *(const u32x4*)(X + (size_t)row * 1024 + col0 + bj * HALF);
                    const f32x4 x0 = {__builtin_bit_cast(float, xw.x << 16), __builtin_bit_cast(float, xw.x & 0xffff0000u), __builtin_bit_cast(float, xw.y << 16), __builtin_bit_cast(float, xw.y & 0xffff0000u)};
                    const f32x4 x1 = {__builtin_bit_cast(float, xw.z << 16), __builtin_bit_cast(float, xw.z & 0xffff0000u), __builtin_bit_cast(float, xw.w << 16), __builtin_bit_cast(float, xw.w & 0xffff0000u)};
                    const f32x4 v0 = acc[ai][bj][m][0] + x0, v1 = acc[ai][bj][m][1] + x1;
                    part += (v0[0] * v0[0] + v0[1] * v0[1]) + (v0[2] * v0[2] + v0[3] * v0[3]) + (v1[0] * v1[0] + v1[1] * v1[1]) + (v1[2] * v1[2] + v1[3] * v1[3]);
                    u32x4 w; w.x = cvt_pk_bf16(v0[0], v0[1]); w.y = cvt_pk_bf16(v0[2], v0[3]); w.z = cvt_pk_bf16(v1[0], v1[1]); w.w = cvt_pk_bf16(v1[2], v1[3]);
                    *(u32x4*)(O + (size_t)row * 1024 + col0 + bj * HALF) = w; }
                part += __shfl_xor(part, 16); part += __shfl_xor(part, 32);
                pm_[m] = part; }
            const float val = fq == 0 ? pm_[0] : fq == 1 ? pm_[1] : fq == 2 ? pm_[2] : pm_[3];
            (void)__builtin_amdgcn_global_atomic_fadd_f32((__attribute__((address_space(1))) float*)(ss + row0 + ai * HALF + fq * 16), val); }
    }
};

template <class Epi, class Sched, bool ALIGN_EPI = false, bool SP2 = false>
__device__ __forceinline__ void gemm_phase(PG8_LAS unsigned char* lds, const Gemm g, const Sched& S, const Epi& E) {
    const int tid = threadIdx.x, wid = __builtin_amdgcn_readfirstlane(tid >> 6), lane = tid & 63, wr = wid >> 2, wc = wid & 3, fr = lane & 15, fq = lane >> 4;
    const int K = g.K, nt = K / BK;
    unsigned voffA[2], voffB[2];
#pragma unroll
    for (int i = 0; i < 2; ++i) { int R, C; stage_rc(tid * 16 + i * 8192, R, C); const int Rb = Epi::PERM ? ((R & ~31) + perm32(R & 31)) : R;
        voffA[i] = (unsigned)(R * K + C) * 2u; voffB[i] = (unsigned)(Rb * K + C) * 2u; }
    const size_t kstep = (size_t)(BK * 2);
    const size_t hstep = (size_t)HALF * K * 2;
    const size_t tstep = 2 * hstep;
    const unsigned ldsw = (unsigned)wid * 1024u;
    const int aoff = lds_byte(wr * 64 + fr, fq * 8), boff = lds_byte(wc * 32 + fr, fq * 8);
#define PG8_SA(b, h) (((b) * 2 + (h)) * HTB)
#define PG8_SB(b, h) ((4 + (b) * 2 + (h)) * HTB)
#define PG8_STAGE(bufoff, gbase, voff) do { _Pragma("unroll") for (int _i = 0; _i < 2; ++_i) \
        __builtin_amdgcn_global_load_lds((const unsigned*)((const char*)(gbase) + (voff)[_i]), (PG8_LAS unsigned*)(lds + (bufoff) + ldsw + _i * 8192), 16, 0, 0); } while (0)
#define PG8_LDA(dst, b, h) do { _Pragma("unroll") for (int m = 0; m < 4; ++m) _Pragma("unroll") for (int k = 0; k < 2; ++k) dst[m][k] = *(const PG8_LAS bf16x8*)(lds + PG8_SA(b, h) + aoff + m * 2048 + k * 1024); } while (0)
#define PG8_LDB(dst, b, h) do { _Pragma("unroll") for (int n = 0; n < 2; ++n) _Pragma("unroll") for (int k = 0; k < 2; ++k) dst[n][k] = *(const PG8_LAS bf16x8*)(lds + PG8_SB(b, h) + boff + n * 2048 + k * 1024); } while (0)
#define PG8_MMA(ai, bj, At, Bt) do { __builtin_amdgcn_s_setprio(1); _Pragma("unroll") for (int m = 0; m < 4; ++m) _Pragma("unroll") for (int n = 0; n < 2; ++n) _Pragma("unroll") for (int k = 0; k < 2; ++k) \
        acc[ai][bj][m][n] = __builtin_amdgcn_mfma_f32_16x16x32_bf16(Bt[n][k], At[m][k], acc[ai][bj][m][n], 0, 0, 0); __builtin_amdgcn_s_setprio(0); } while (0)
#define PG8_WAIT_V(n) asm volatile("s_waitcnt vmcnt(" #n ")" ::: "memory")
#define PG8_WAIT_L(n) asm volatile("s_waitcnt lgkmcnt(" #n ")" ::: "memory")
#define PG8_BAR __builtin_amdgcn_s_barrier()
#define PG8_SCHED __builtin_amdgcn_sched_barrier(0)
    Unit cur, nxt; int ui = 0;
    if (!S.next(0, cur)) return;
    f32x4 acc[2][2][4][2];
#pragma unroll
    for (int a = 0; a < 2; ++a)
#pragma unroll
        for (int b = 0; b < 2; ++b)
#pragma unroll
            for (int m = 0; m < 4; ++m)
#pragma unroll
                for (int n = 0; n < 2; ++n) acc[a][b][m][n] = (f32x4){0.f, 0.f, 0.f, 0.f};
    bf16x8 At[4][2], B0[2][2], B1[2][2];
    const char* cA = (const char*)g.A + (size_t)cur.pm * tstep; const char* cB = (const char*)g.Bt + (size_t)cur.pn * tstep;
    S.a_ready(cur);
    if constexpr (SP2) {
        PG8_STAGE(PG8_SB(0, 0), cB, voffB); PG8_STAGE(PG8_SB(0, 1), cB + hstep, voffB); PG8_STAGE(PG8_SA(0, 0), cA, voffA); PG8_STAGE(PG8_SA(0, 1), cA + hstep, voffA);
        if (wr == 1) PG8_BAR;
        PG8_WAIT_V(2); PG8_BAR;
        PG8_STAGE(PG8_SB(1, 0), cB + kstep, voffB); PG8_STAGE(PG8_SA(1, 0), cA + kstep, voffA); PG8_STAGE(PG8_SB(1, 1), cB + hstep + kstep, voffB);
        PG8_WAIT_V(6); PG8_BAR;
    } else {
        PG8_STAGE(PG8_SB(0, 0), cB, voffB); PG8_STAGE(PG8_SA(0, 0), cA, voffA); PG8_STAGE(PG8_SB(0, 1), cB + hstep, voffB); PG8_STAGE(PG8_SA(0, 1), cA + hstep, voffA);
        if (wr == 1) PG8_BAR;
        PG8_WAIT_V(4); PG8_BAR;
        PG8_STAGE(PG8_SB(1, 0), cB + kstep, voffB); PG8_STAGE(PG8_SA(1, 0), cA + kstep, voffA); PG8_STAGE(PG8_SB(1, 1), cB + hstep + kstep, voffB);
        PG8_WAIT_V(6); PG8_BAR;
    }
    for (;;) {
        const bool has_next = S.next(ui + 1, nxt);
        const char* nA = has_next ? (const char*)g.A + (size_t)nxt.pm * tstep : cA; const char* nB = has_next ? (const char*)g.Bt + (size_t)nxt.pn * tstep : cB;
        for (int t = 0; t < nt; t += 2) {
            const bool last = (t == nt - 2);
            const char* a1 = cA + (size_t)(t + 1) * kstep;
            const char* a2 = last ? nA : cA + (size_t)(t + 2) * kstep; const char* b2 = last ? nB : cB + (size_t)(t + 2) * kstep;
            const char* a3 = a2 + kstep; const char* b3 = b2 + kstep;
            if (last && has_next) S.a_ready(nxt);
            if constexpr (SP2) {
            PG8_LDB(B0, 0, 0); PG8_LDB(B1, 0, 1); PG8_SCHED; PG8_LDA(At, 0, 0); PG8_STAGE(PG8_SA(1, 1), a1 + hstep, voffA);
            PG8_WAIT_V(8); PG8_WAIT_L(0); PG8_BAR; PG8_MMA(0, 0, At, B0); PG8_MMA(0, 1, At, B1); PG8_BAR; PG8_SCHED;
            PG8_LDA(At, 0, 1); PG8_STAGE(PG8_SB(0, 0), b2, voffB); PG8_STAGE(PG8_SB(0, 1), b2 + hstep, voffB); PG8_STAGE(PG8_SA(0, 0), a2, voffA);
            PG8_WAIT_V(8); PG8_WAIT_L(0); PG8_BAR; PG8_MMA(1, 0, At, B0); PG8_MMA(1, 1, At, B1); PG8_BAR; PG8_SCHED;
            PG8_LDB(B0, 1, 0); PG8_LDB(B1, 1, 1); PG8_SCHED; PG8_LDA(At, 1, 0); PG8_STAGE(PG8_SA(0, 1), a2 + hstep, voffA);
            PG8_WAIT_V(8); PG8_WAIT_L(0); PG8_BAR; PG8_MMA(0, 0, At, B0); PG8_MMA(0, 1, At, B1); PG8_BAR; PG8_SCHED;
            PG8_LDA(At, 1, 1); PG8_STAGE(PG8_SB(1, 0), b3, voffB); PG8_STAGE(PG8_SB(1, 1), b3 + hstep, voffB); PG8_STAGE(PG8_SA(1, 0), a3, voffA);
            PG8_WAIT_V(8); PG8_WAIT_L(0); PG8_BAR; PG8_MMA(1, 0, At, B0); PG8_MMA(1, 1, At, B1); PG8_BAR; PG8_SCHED;
            } else {
            PG8_LDB(B0, 0, 0); PG8_SCHED; PG8_LDA(At, 0, 0); PG8_STAGE(PG8_SA(1, 1), a1 + hstep, voffA);
            PG8_WAIT_L(8); PG8_BAR; PG8_WAIT_L(0); PG8_MMA(0, 0, At, B0); PG8_BAR; PG8_SCHED;
            PG8_LDB(B1, 0, 1); PG8_STAGE(PG8_SB(0, 0), b2, voffB);
            PG8_BAR; PG8_WAIT_L(0); PG8_MMA(0, 1, At, B1); PG8_BAR;
            PG8_LDA(At, 0, 1); PG8_STAGE(PG8_SA(0, 0), a2, voffA);
            PG8_BAR; PG8_WAIT_L(0); PG8_MMA(1, 0, At, B0); PG8_BAR; PG8_SCHED;
            PG8_STAGE(PG8_SB(0, 1), b2 + hstep, voffB);
            PG8_WAIT_V(6); PG8_BAR; PG8_MMA(1, 1, At, B1); PG8_BAR;
            PG8_LDB(B0, 1, 0); PG8_SCHED; PG8_LDA(At, 1, 0); PG8_STAGE(PG8_SA(0, 1), a2 + hstep, voffA);
            PG8_WAIT_L(8); PG8_BAR; PG8_WAIT_L(0); PG8_MMA(0, 0, At, B0); PG8_BAR; PG8_SCHED;
            PG8_LDB(B1, 1, 1); PG8_STAGE(PG8_SB(1, 0), b3, voffB);
            PG8_BAR; PG8_WAIT_L(0); PG8_MMA(0, 1, At, B1); PG8_BAR;
            PG8_LDA(At, 1, 1); PG8_STAGE(PG8_SA(1, 0), a3, voffA);
            PG8_BAR; PG8_WAIT_L(0); PG8_MMA(1, 0, At, B0); PG8_BAR; PG8_SCHED;
            PG8_STAGE(PG8_SB(1, 1), b3 + hstep, voffB);
            PG8_WAIT_V(6); PG8_BAR; PG8_MMA(1, 1, At, B1); PG8_BAR;
            }
        }
        if constexpr (ALIGN_EPI) { if (wr == 0) PG8_BAR; }
        if constexpr (!Epi::AFTER_DRAIN) { E(acc, cur, wr, wc, fr, fq); S.done(cur); }
        if (!has_next) break;
#pragma unroll
        for (int a = 0; a < 2; ++a)
#pragma unroll
            for (int b = 0; b < 2; ++b)
#pragma unroll
                for (int m = 0; m < 4; ++m)
#pragma unroll
                    for (int n = 0; n < 2; ++n) acc[a][b][m][n] = (f32x4){0.f, 0.f, 0.f, 0.f};
        cur = nxt; cA = nA; cB = nB; ++ui;
        if constexpr (ALIGN_EPI) { if (wr == 1) PG8_BAR; }
    }
    PG8_WAIT_V(0);
    if constexpr (!ALIGN_EPI) { if (wr == 0) PG8_BAR; }
    PG8_BAR;
    if constexpr (Epi::AFTER_DRAIN) { E.fused(acc, cur, wr, wc, fr, fq, lds, wid, lane); S.done(cur); }
#undef PG8_SA
#undef PG8_SB
#undef PG8_STAGE
#undef PG8_LDA
#undef PG8_LDB
#undef PG8_MMA
#undef PG8_WAIT_V
#undef PG8_WAIT_L
#undef PG8_BAR
#undef PG8_SCHED
}
}

#ifndef PG8_SP2
#define PG8_SP2 true
#endif
#ifndef PG8_ALIGN
#define PG8_ALIGN true
#endif
#ifndef MK_N_LAUNCHES
#define MK_N_LAUNCHES 1
#endif
constexpr int NWAVES = 8;
constexpr int NPHASES = 8;
constexpr int N_LAUNCHES = MK_N_LAUNCHES;

constexpr int NB = 32, SEQ = 2048, T = NB * SEQ, D = 1024, DIN = 3584;
constexpr int DPR = 3072;
constexpr int PC_U = 0, PC_B = 512, PC_Q = 1024, PC_F = 1536, PC_V = 2048, PC_G = 2560;
constexpr int NEXP = 16384;
constexpr float EPS = 1e-6f;
constexpr float PEER_SU = 640.0f, PEER_SV = 64.0f;

constexpr size_t MiB = 1u << 20;
constexpr size_t WS_CTL = 0, CTL_ZERO_BYTES = 1 * MiB;
constexpr size_t WS_W1T = 2 * MiB, WS_WOT = 10 * MiB, WS_WQT = 12 * MiB, WS_RS1 = 16 * MiB, WS_SS2 = 17 * MiB;
constexpr size_t WS_KEYB = 18 * MiB;
constexpr size_t WS_U16 = 32 * MiB, WS_V16 = 64 * MiB, WS_EXP = 96 * MiB;
constexpr size_t WS_XB = 128 * MiB;
constexpr size_t WS_X1 = 256 * MiB;
constexpr size_t WS_PROJ = 384 * MiB;
constexpr size_t WS_F = 832 * MiB;
constexpr size_t WS_MIX = 848 * MiB;
constexpr size_t WS_END = 976 * MiB;
constexpr int CW_BAR = 4096;

constexpr int RING_OFF = 0, RING_BYTES = 131072;
constexpr int LDSCTL_OFF = RING_BYTES, MISC_OFF = LDSCTL_OFF + 320;
constexpr int LDS_BYTES = 147456;

#define GAS __attribute__((address_space(1)))
#define LAS __attribute__((address_space(3)))
typedef unsigned short bf16;
typedef unsigned v4u __attribute__((ext_vector_type(4)));
typedef unsigned v2u __attribute__((ext_vector_type(2)));
typedef float f32x4 __attribute__((ext_vector_type(4)));
typedef float f32x2 __attribute__((ext_vector_type(2)));
typedef _Float16 h2_t __attribute__((ext_vector_type(2)));
typedef GAS unsigned gu32;
#define RLX_AGENT __ATOMIC_RELAXED, __HIP_MEMORY_SCOPE_AGENT
#define LDS_WAIT() asm volatile("s_waitcnt lgkmcnt(0)" ::: "memory")
#define VM_WAIT() asm volatile("s_waitcnt vmcnt(0)" ::: "memory")
__device__ __forceinline__ unsigned f2bf(float f) { unsigned u = __builtin_bit_cast(unsigned, f); return (u + 0x7fffu + ((u >> 16) & 1u)) >> 16; }
typedef __bf16 bf16x2_t __attribute__((ext_vector_type(2)));
__device__ __forceinline__ unsigned pk2(float lo, float hi) { f32x2 v = {lo, hi}; bf16x2_t b = __builtin_convertvector(v, bf16x2_t); return __builtin_bit_cast(unsigned, b); }
__device__ __forceinline__ float bf_lo(unsigned w) { return __builtin_bit_cast(float, w << 16); }
__device__ __forceinline__ float bf_hi(unsigned w) { return __builtin_bit_cast(float, w & 0xffff0000u); }
__device__ __forceinline__ float bf1(bf16 v) { return __builtin_bit_cast(float, (unsigned)v << 16); }
__device__ __forceinline__ unsigned pkh2(float lo, float hi) { f32x2 v = {lo, hi}; h2_t h = __builtin_convertvector(v, h2_t); return __builtin_bit_cast(unsigned, h); }
__device__ __forceinline__ h2_t h2_of(unsigned w) { return __builtin_bit_cast(h2_t, w); }
__device__ __forceinline__ float swap32_add(float a, float b) { const v2u r = __builtin_amdgcn_permlane32_swap(__builtin_bit_cast(unsigned, a), __builtin_bit_cast(unsigned, b), false, false);
    const unsigned rx = r.x, ry = r.y; return __builtin_bit_cast(float, rx) + __builtin_bit_cast(float, ry); }
__device__ __forceinline__ float swap16_add(float a, float b) { const v2u r = __builtin_amdgcn_permlane16_swap(__builtin_bit_cast(unsigned, a), __builtin_bit_cast(unsigned, b), false, false);
    const unsigned rx = r.x, ry = r.y; return __builtin_bit_cast(float, rx) + __builtin_bit_cast(float, ry); }
template <int CTRL> __device__ __forceinline__ float dpp_f(float v) { return __builtin_bit_cast(float, __builtin_amdgcn_update_dpp(0, __builtin_bit_cast(int, v), CTRL, 0xF, 0xF, false)); }
template <int CTRL> __device__ __forceinline__ unsigned dpp_u(unsigned v) { return (unsigned)__builtin_amdgcn_update_dpp(0, (int)v, CTRL, 0xF, 0xF, false); }
__device__ __forceinline__ float wave_sum(float v) {
    v += dpp_f<0xB1>(v); v += dpp_f<0x4E>(v); v += dpp_f<0x124>(v); v += dpp_f<0x128>(v);
    v = swap16_add(v, v); v = swap32_add(v, v);
    return v;
}
typedef float f32x16 __attribute__((ext_vector_type(16)));
__device__ __forceinline__ unsigned cvtpk(float lo, float hi) { f32x2 v = {lo, hi}; bf16x2_t b = __builtin_convertvector(v, bf16x2_t); return __builtin_bit_cast(unsigned, b); }
__device__ __forceinline__ pg8::bf16x8 pack8(const f32x16& x, int s) {
    v4u p; p.x = cvtpk(x[8 * s], x[8 * s + 1]); p.y = cvtpk(x[8 * s + 2], x[8 * s + 3]); p.z = cvtpk(x[8 * s + 4], x[8 * s + 5]); p.w = cvtpk(x[8 * s + 6], x[8 * s + 7]);
    return __builtin_bit_cast(pg8::bf16x8, p); }
__device__ __forceinline__ void ce_desc(unsigned& a, unsigned& b) { const unsigned mx = a > b ? a : b, mn = a > b ? b : a; a = mx; b = mn; }
__device__ __forceinline__ void sort16_desc(unsigned (&a)[16]) {
#pragma unroll
    for (int k = 2; k <= 16; k <<= 1)
#pragma unroll
        for (int j = k >> 1; j > 0; j >>= 1)
#pragma unroll
            for (int i = 0; i < 16; ++i) { const int l = i ^ j; if (l > i) { if ((i & k) == 0) ce_desc(a[i], a[l]); else ce_desc(a[l], a[i]); } }
}
__device__ __forceinline__ void merge16_desc(unsigned (&a)[16], const unsigned (&b)[16]) {
#pragma unroll
    for (int i = 0; i < 16; ++i) a[i] = a[i] > b[15 - i] ? a[i] : b[15 - i];
#pragma unroll
    for (int j = 8; j > 0; j >>= 1)
#pragma unroll
        for (int i = 0; i < 16; ++i) { const int l = i ^ j; if (l > i) ce_desc(a[i], a[l]); }
}
__device__ __forceinline__ void sort16_desc2(unsigned (&a)[16], unsigned (&b)[16]) {
    constexpr int NW[60][2] = {{0,13},{1,12},{2,15},{3,14},{4,8},{5,6},{7,11},{9,10}, {0,5},{1,7},{2,9},{3,4},{6,13},{8,14},{10,15},{11,12}, {0,1},{2,3},{4,5},{6,8},{7,9},{10,11},{12,13},{14,15},
        {0,2},{1,3},{4,10},{5,11},{6,7},{8,9},{12,14},{13,15}, {1,2},{3,12},{4,6},{5,7},{8,10},{9,11},{13,14}, {1,4},{2,6},{5,8},{7,10},{9,13},{11,14}, {2,4},{3,6},{9,12},{11,13}, {3,5},{6,8},{7,9},{10,12}, {3,4},{5,6},{7,8},{9,10},{11,12}, {6,7},{8,9}};
#pragma unroll
    for (int c = 0; c < 60; ++c) { ce_desc(a[NW[c][0]], a[NW[c][1]]); ce_desc(b[NW[c][0]], b[NW[c][1]]); }
}
__device__ __forceinline__ void sort16_desc1(unsigned (&a)[16]) {
    constexpr int NW[60][2] = {{0,13},{1,12},{2,15},{3,14},{4,8},{5,6},{7,11},{9,10}, {0,5},{1,7},{2,9},{3,4},{6,13},{8,14},{10,15},{11,12}, {0,1},{2,3},{4,5},{6,8},{7,9},{10,11},{12,13},{14,15},
        {0,2},{1,3},{4,10},{5,11},{6,7},{8,9},{12,14},{13,15}, {1,2},{3,12},{4,6},{5,7},{8,10},{9,11},{13,14}, {1,4},{2,6},{5,8},{7,10},{9,13},{11,14}, {2,4},{3,6},{9,12},{11,13}, {3,5},{6,8},{7,9},{10,12}, {3,4},{5,6},{7,8},{9,10},{11,12}, {6,7},{8,9}};
#pragma unroll
    for (int c = 0; c < 60; ++c) ce_desc(a[NW[c][0]], a[NW[c][1]]);
}
__device__ __forceinline__ void merge16_desc2(unsigned (&a)[16], const unsigned (&x)[16], unsigned (&b)[16], const unsigned (&y)[16]) {
#pragma unroll
    for (int i = 0; i < 16; ++i) { a[i] = a[i] > x[15 - i] ? a[i] : x[15 - i]; b[i] = b[i] > y[15 - i] ? b[i] : y[15 - i]; }
#pragma unroll
    for (int j = 8; j > 0; j >>= 1)
#pragma unroll
        for (int i = 0; i < 16; ++i) { const int l = i ^ j; if (l > i) { ce_desc(a[i], a[l]); ce_desc(b[i], b[l]); } }
}
__device__ __forceinline__ float unkey(unsigned a) { a = (a & 0x80000000u) ? (a & 0x7FFFFFFFu) : ~a; return __builtin_bit_cast(float, a); }
__device__ __forceinline__ float unkey16(unsigned a) { a >>= 16; a = (a & 0x8000u) ? (a & 0x7FFFu) : (~a & 0xFFFFu); return (float)__builtin_bit_cast(_Float16, (unsigned short)a); }
__device__ __forceinline__ unsigned ckey(float s, int flat) { unsigned u = __builtin_bit_cast(unsigned, s); u ^= (unsigned)((int)u >> 31) | 0x80000000u; return (u & ~0xFFu) | (unsigned)(255 - flat); }
template <int J> __device__ __forceinline__ unsigned xor_lane(unsigned x, int lane) {
    if (J == 1) return dpp_u<0xB1>(x);
    if (J == 2) return dpp_u<0x4E>(x);
    if (J == 8) return dpp_u<0x128>(x);
    if (J == 16) { const v2u r = __builtin_amdgcn_permlane16_swap(x, x, false, false); const unsigned rx = r.x, ry = r.y; return (lane & 16) ? rx : ry; }
    if (J == 32) { const v2u r = __builtin_amdgcn_permlane32_swap(x, x, false, false); const unsigned rx = r.x, ry = r.y; return (lane & 32) ? rx : ry; }
    return (unsigned)__shfl_xor((int)x, J);
}
template <int K, int J, int N> __device__ __forceinline__ void sort128_stage(unsigned (&e)[N][2], int lane) {
#pragma unroll
    for (int t = 0; t < N; ++t) {
        if (J == 64) { const unsigned mn = e[t][0] < e[t][1] ? e[t][0] : e[t][1], mx = e[t][0] < e[t][1] ? e[t][1] : e[t][0]; e[t][0] = mn; e[t][1] = mx; }
        else {
            const unsigned p0 = xor_lane<J>(e[t][0], lane), p1 = xor_lane<J>(e[t][1], lane);
            const bool lower = (lane & J) == 0;
            const bool up0 = (K >= 64) ? true : ((lane & K) == 0);
            const bool up1 = (K == 128) ? true : (K == 64 ? false : ((lane & K) == 0));
            const unsigned mn0 = e[t][0] < p0 ? e[t][0] : p0, mx0 = e[t][0] < p0 ? p0 : e[t][0], mn1 = e[t][1] < p1 ? e[t][1] : p1, mx1 = e[t][1] < p1 ? p1 : e[t][1];
            e[t][0] = (lower == up0) ? mn0 : mx0; e[t][1] = (lower == up1) ? mn1 : mx1;
        }
    }
}
template <int N> __device__ __forceinline__ void sort128_asc(unsigned (&e)[N][2], int lane) {
#define S_(K, J) sort128_stage<K, J, N>(e, lane)
    S_(2, 1); S_(4, 2); S_(4, 1); S_(8, 4); S_(8, 2); S_(8, 1); S_(16, 8); S_(16, 4); S_(16, 2); S_(16, 1);
    S_(32, 16); S_(32, 8); S_(32, 4); S_(32, 2); S_(32, 1); S_(64, 32); S_(64, 16); S_(64, 8); S_(64, 4); S_(64, 2); S_(64, 1);
    S_(128, 64); S_(128, 32); S_(128, 16); S_(128, 8); S_(128, 4); S_(128, 2); S_(128, 1);
#undef S_
}
__device__ __forceinline__ float wave_max(float v) {
    v = fmaxf(v, dpp_f<0xB1>(v)); v = fmaxf(v, dpp_f<0x4E>(v)); v = fmaxf(v, dpp_f<0x124>(v)); v = fmaxf(v, dpp_f<0x128>(v));
    { const v2u r = __builtin_amdgcn_permlane16_swap(__builtin_bit_cast(unsigned, v), __builtin_bit_cast(unsigned, v), false, false); const unsigned rx = r.x, ry = r.y; v = fmaxf(__builtin_bit_cast(float, rx), __builtin_bit_cast(float, ry)); }
    { const v2u r = __builtin_amdgcn_permlane32_swap(__builtin_bit_cast(unsigned, v), __builtin_bit_cast(unsigned, v), false, false); const unsigned rx = r.x, ry = r.y; v = fmaxf(__builtin_bit_cast(float, rx), __builtin_bit_cast(float, ry)); }
    return v;
}
__device__ __forceinline__ int swap32_addi(int a, int b) { const v2u r = __builtin_amdgcn_permlane32_swap((unsigned)a, (unsigned)b, false, false); const unsigned rx = r.x, ry = r.y; return (int)(rx + ry); }
__device__ __forceinline__ int swap16_addi(int a, int b) { const v2u r = __builtin_amdgcn_permlane16_swap((unsigned)a, (unsigned)b, false, false); const unsigned rx = r.x, ry = r.y; return (int)(rx + ry); }
__device__ __forceinline__ int reduce16i(const int (&p)[16], int lane) {
    int q[8], r[4], u[2];
    const bool b3 = (lane & 8) != 0, b2 = (lane & 4) != 0;
#pragma unroll
    for (int i = 0; i < 8; ++i) q[i] = swap32_addi(p[2 * i], p[2 * i + 1]);
#pragma unroll
    for (int i = 0; i < 4; ++i) r[i] = swap16_addi(q[2 * i], q[2 * i + 1]);
#pragma unroll
    for (int i = 0; i < 2; ++i) { const int keep = b3 ? r[2 * i + 1] : r[2 * i], send = b3 ? r[2 * i] : r[2 * i + 1]; u[i] = keep + (int)dpp_u<0x128>((unsigned)send); }
    const int keep = b2 ? u[1] : u[0], send = b2 ? u[0] : u[1];
    int v = keep + __shfl_xor(send, 4);
    v += (int)dpp_u<0x4E>((unsigned)v); v += (int)dpp_u<0xB1>((unsigned)v);
    return v;
}
__device__ __forceinline__ float reduce16(const float (&p)[16], int lane) {
    float q[8], r[4], u[2];
    const bool b3 = (lane & 8) != 0, b2 = (lane & 4) != 0;
#pragma unroll
    for (int i = 0; i < 8; ++i) q[i] = swap32_add(p[2 * i], p[2 * i + 1]);
#pragma unroll
    for (int i = 0; i < 4; ++i) r[i] = swap16_add(q[2 * i], q[2 * i + 1]);
#pragma unroll
    for (int i = 0; i < 2; ++i) { const float keep = b3 ? r[2 * i + 1] : r[2 * i], send = b3 ? r[2 * i] : r[2 * i + 1]; u[i] = keep + dpp_f<0x128>(send); }
    const float keep = b2 ? u[1] : u[0], send = b2 ? u[0] : u[1];
    float v = keep + __shfl_xor(send, 4);
    v += dpp_f<0x4E>(v);
    v += dpp_f<0xB1>(v);
    return v;
}
__device__ __forceinline__ unsigned scan_off(unsigned row, unsigned ch) { return 256u * row + 16u * (ch ^ (((row & 3u) << 2) | ((row >> 2) & 3u))); }
typedef short v4i16_t __attribute__((ext_vector_type(4)));
__device__ __forceinline__ pg8::bf16x8 scan_tr(const LAS unsigned char* tile, unsigned row, unsigned ch, unsigned half) {
    const v4i16_t lo = __builtin_amdgcn_ds_read_tr16_b64_v4i16((LAS v4i16_t*)(tile + scan_off(row, ch) + 8u * half));
    const v4i16_t hi = __builtin_amdgcn_ds_read_tr16_b64_v4i16((LAS v4i16_t*)(tile + scan_off(row + 8u, ch) + 8u * half));
    return __builtin_shufflevector(lo, hi, 0, 1, 2, 3, 4, 5, 6, 7);
}
__device__ __forceinline__ int swap23(int k) { return (k & ~12) | ((k & 4) << 1) | ((k & 8) >> 1); }
__device__ __forceinline__ float sigmoidf_(float x) { return __builtin_amdgcn_rcpf(1.0f + __expf(-x)); }

#define XB_TMO      128
#define XB_XCNT(j)  (256  + 64 * (j))
#define XB_XSUB(j)  (1280 + 64 * (j))
#define XB_XGEN(j)  (2304 + 64 * (j))
#define XB_TOP      3328
#define XB_TOPGEN   3392
#define XCD_BAR_WORDS 3456
#define XB_SPIN_CAP (1u << 18)

__device__ __forceinline__ unsigned xb_ld(unsigned* p)              { return __hip_atomic_load(p, __ATOMIC_RELAXED, __HIP_MEMORY_SCOPE_AGENT); }
__device__ __forceinline__ unsigned xb_add(unsigned* p, unsigned v) { return __hip_atomic_fetch_add(p, v, __ATOMIC_RELAXED, __HIP_MEMORY_SCOPE_AGENT); }
__device__ __forceinline__ unsigned xb_xcc_id() { return (unsigned)__builtin_amdgcn_s_getreg((3 << 11) | 20) & 0xFu; }
#define XB_SPIN(cond, bar) do { unsigned _sp = 0; while (cond) { __builtin_amdgcn_s_sleep(1); \
    if ((++_sp & 255u) == 0u) { if (xb_ld(&(bar)[XB_TMO])) break; if (_sp > XB_SPIN_CAP) { atomicAdd(&(bar)[XB_TMO], 1u); break; } } } } while (0)

struct XcdBarrier {
    unsigned* bar; unsigned x;
    volatile LAS unsigned* st;
};

__device__ __forceinline__ XcdBarrier xcd_barrier_post(unsigned* bar, volatile LAS unsigned* st) {
    XcdBarrier b; b.bar = bar; b.x = xb_xcc_id(); b.st = st;
    if (threadIdx.x == 0) (void)xb_add(&bar[XB_XCNT(b.x)], 1u);
    return b;
}
__device__ __forceinline__ void xcd_barrier_complete(unsigned* bar, unsigned x, unsigned& nloc, unsigned& nx) {
    const unsigned G = gridDim.x * gridDim.y * gridDim.z;
    unsigned sum, cnt, mine, sp = 0u;
    for (;;) {
        sum = 0u; cnt = 0u; mine = 0u;
#pragma unroll
        for (unsigned j = 0; j < 16; ++j) { const unsigned c = xb_ld(&bar[XB_XCNT(j)]); sum += c; cnt += (c > 0u) ? 1u : 0u; mine = (j == x) ? c : mine; }
        if (sum == G) break;
        __builtin_amdgcn_s_sleep(1);
        if ((++sp & 255u) == 0u) { if (xb_ld(&bar[XB_TMO])) break; if (sp > XB_SPIN_CAP) { atomicAdd(&bar[XB_TMO], 1u); break; } }
    }
    nloc = mine > 0u ? mine : 1u; nx = cnt > 0u ? cnt : 1u;
}

__device__ __forceinline__ void xcd_barrier(const XcdBarrier& b) {
    asm volatile("s_waitcnt vmcnt(0)" ::: "memory");
    __syncthreads();
    if (threadIdx.x == 0) {
        unsigned* bar = b.bar;
        __builtin_amdgcn_s_waitcnt(0);
        unsigned nloc = b.st[0], nx = b.st[1];
        if (nloc == 0u) { xcd_barrier_complete(bar, b.x, nloc, nx); b.st[0] = nloc; b.st[1] = nx; }
        const unsigned old = xb_add(&bar[XB_XSUB(b.x)], 1u);
        const unsigned gen = old / nloc;
        if (old + 1u == (gen + 1u) * nloc) {
            __builtin_amdgcn_fence(__ATOMIC_RELEASE, "agent");
            asm volatile("s_waitcnt vmcnt(0)" ::: "memory");
            const unsigned og = xb_add(&bar[XB_TOP], 1u);
            const unsigned tg = og / nx;
            if (og + 1u == (tg + 1u) * nx) xb_add(&bar[XB_TOPGEN], 1u);
            else XB_SPIN(xb_ld(&bar[XB_TOPGEN]) == tg, bar);
            __builtin_amdgcn_fence(__ATOMIC_ACQUIRE, "agent");
            xb_add(&bar[XB_XGEN(b.x)], 1u);
            asm volatile("s_waitcnt vmcnt(0)" ::: "memory");
        } else {
            XB_SPIN(xb_ld(&bar[XB_XGEN(b.x)]) == gen, bar);
            __builtin_amdgcn_fence(__ATOMIC_ACQUIRE, "agent");
            asm volatile("s_waitcnt vmcnt(0)" ::: "memory");
        }
    }
    __syncthreads();
}


template <bool REMAP> __device__ __forceinline__ void p0_transpose_item(const float* W, int K, int N, const float* gain, bf16* WT, LAS float* scr, int item, int lane) {
    const int nblk = N / 32, kb = item / nblk, nb = item % nblk, k0 = 64 * kb, n0 = 32 * nb;
#pragma unroll 8
    for (int i = 0; i < 32; ++i) { const int kk = 2 * i + (lane >> 5); const float g = gain ? gain[k0 + kk] : 1.0f; scr[kk * 33 + (lane & 31)] = W[(size_t)(k0 + kk) * N + n0 + (lane & 31)] * g; }
    LDS_WAIT(); asm volatile("" ::: "memory");
    const int c = lane & 7;
#pragma unroll
    for (int j = 0; j < 4; ++j) { const int n = (lane >> 3) + 8 * j; const LAS float* s = scr + (8 * c) * 33 + n;
        v4u o; o.x = pk2(s[0 * 33], s[1 * 33]); o.y = pk2(s[2 * 33], s[3 * 33]); o.z = pk2(s[4 * 33], s[5 * 33]); o.w = pk2(s[6 * 33], s[7 * 33]);
        int nr = n0 + n; if (REMAP && nr < 1024) nr = ((nr & 511) >> 7) * 256 + (nr >> 9) * 128 + (nr & 127);
        else if (REMAP && nr >= 1536 && nr < 2560) { const int m_ = nr - 1536; nr = 1536 + ((m_ & 511) >> 7) * 256 + (m_ >> 9) * 128 + (m_ & 127); }
        *(GAS v4u*)(WT + (size_t)nr * K + k0 + 8 * c) = o; }
    LDS_WAIT(); asm volatile("" ::: "memory");
}

struct Args { const float* in[14]; float* out; unsigned char* ws; int ph_lo, ph_hi, li, pad; };

__global__ void __launch_bounds__(NWAVES * 64, 2) hymba_fwd(Args args) {
    extern __shared__ __attribute__((aligned(16))) unsigned char lds_raw[];
    LAS unsigned char* lds = (LAS unsigned char*)lds_raw;
    volatile LAS unsigned* MISC = (volatile LAS unsigned*)(lds + MISC_OFF);
    const int tid = threadIdx.x, lane = tid & 63, wave = __builtin_amdgcn_readfirstlane(tid >> 6);
    const int G = gridDim.x;
    const int gw = (int)blockIdx.x * NWAVES + wave, NGW = G * NWAVES;
    unsigned char* ws = args.ws;
    gu32* ctl = (gu32*)(ws + WS_CTL);
    const float* x = args.in[0]; const float* norm_mix = args.in[1]; const float* w_in = args.in[2]; const float* conv_w = args.in[3]; const float* conv_gain = args.in[4];
    const float* hg_lb = args.in[5]; const float* hg_gain = args.in[6]; const float* w_out = args.in[7]; const float* norm_ffn = args.in[8]; const float* peer_wq = args.in[9];
    const float* peer_keys = args.in[10]; const float* peer_u = args.in[11]; const float* peer_v = args.in[12]; const float* norm_f = args.in[13];
    float* out = args.out;
    bf16* W1T = (bf16*)(ws + WS_W1T); bf16* WOT = (bf16*)(ws + WS_WOT); bf16* WQT = (bf16*)(ws + WS_WQT);
    float* RS1 = (float*)(ws + WS_RS1); float* SS2 = (float*)(ws + WS_SS2);
    unsigned char* U8 = ws + WS_U16; unsigned char* V8 = ws + WS_V16; unsigned* EXPT = (unsigned*)(ws + WS_EXP); bf16* KEYB = (bf16*)(ws + WS_KEYB);
    bf16* XB = (bf16*)(ws + WS_XB); bf16* MIX = (bf16*)(ws + WS_MIX); bf16* X1 = (bf16*)(ws + WS_X1);
    bf16* PROJ = (bf16*)(ws + WS_PROJ); bf16* QB = (bf16*)(ws + WS_PROJ); float* DEC = (float*)(ws + WS_F);

    for (int u = tid; u < (LDS_BYTES - LDSCTL_OFF) / 4; u += NWAVES * 64) ((LAS unsigned*)(lds + LDSCTL_OFF))[u] = 0u;
    __syncthreads();
    XcdBarrier bar; bar.bar = (unsigned*)(ctl + CW_BAR); bar.x = 0; bar.st = nullptr;
    if (N_LAUNCHES == 1) bar = xcd_barrier_post((unsigned*)(ctl + CW_BAR), MISC + 8);
#define GRID_BAR() do { if (N_LAUNCHES == 1) xcd_barrier(bar); } while (0)
    const int lo = args.ph_lo, hi = args.ph_hi;
#define IN(k) (lo <= (k) && (k) < hi)
#define BOTH(k) (IN(k) && IN((k) + 1))

    if (IN(0)) {
        LAS float* scr = (LAS float*)(lds + RING_OFF + wave * 16384);
        constexpr int I_1 = (D / 64) * (DIN / 32);
        for (int it = gw; it < I_1; it += NGW) p0_transpose_item<true>(w_in, D, DIN, norm_mix, W1T, scr, it, lane);
        for (int m = gw; m < T; m += NGW) {
            const GAS f32x4* xr = (const GAS f32x4*)(x + (size_t)m * D) + lane; f32x4 v[4]; float s = 0.f;
#pragma unroll
            for (int j = 0; j < 4; ++j) { v[j] = xr[64 * j]; s += (v[j].x * v[j].x + v[j].y * v[j].y) + (v[j].z * v[j].z + v[j].w * v[j].w); }
            s = wave_sum(s);
            if (lane == 0) RS1[m] = 1.0f / sqrtf(s * (1.0f / D) + EPS);
            GAS unsigned long long* o8 = (GAS unsigned long long*)(XB + (size_t)m * D) + lane;
#pragma unroll
            for (int j = 0; j < 4; ++j) o8[64 * j] = (unsigned long long)pk2(v[j].x, v[j].y) | ((unsigned long long)pk2(v[j].z, v[j].w) << 32);
        }
        for (int i = (int)blockIdx.x * NWAVES * 64 + tid; i < T; i += G * NWAVES * 64) SS2[i] = 0.f;
        if (BOTH(0)) GRID_BAR();
    }

    if (IN(1)) {
        pg8::Gemm g{XB, W1T, T, DIN, D}; pg8::StaticOrder S; S.init(T, DIN, G, (int)blockIdx.x);
        pg8::EpiProj E{PROJ, RS1, hg_lb, DEC};
        pg8::gemm_phase<pg8::EpiProj, pg8::StaticOrder, PG8_ALIGN, PG8_SP2>(lds + RING_OFF, g, S, E);
        if (BOTH(1)) GRID_BAR();
    }


    if (IN(3)) {
        constexpr int BUFB = 25600, OB0 = 2 * BUFB, GB0 = OB0 + 32768;
        for (int it = (int)blockIdx.x; it < NB * 4; it += G) {
            const int b = it >> 2, h = it & 3;
            const int lt = tid & 255, r = lane & 31, hh = lane >> 5, sl = wave;
            v4u stA[9], stB[9];
#define SCAN_LOAD(st, n_) do { const size_t tk0 = (size_t)b * SEQ + (n_) * 32; \
                _Pragma("unroll") for (int j = 0; j < 8; ++j) st[j] = *(const GAS v4u*)(PROJ + (tk0 + 4 * j + (wave - 4)) * DPR + 1024 + h * 512 + lane * 8); \
                if (lt < 32) st[8] = ((const GAS v4u*)(DEC + (size_t)((b * 64 + (n_)) * 4 + h) * 128))[lt]; } while (0)
#define SCAN_COMMIT(st, n_) do { const unsigned part_ = (unsigned)lane >> 4, cc_ = (unsigned)lane & 15u; \
                _Pragma("unroll") for (int j = 0; j < 8; ++j) { const unsigned row_ = 4u * j + (unsigned)(wave - 4); \
                    const unsigned o_ = (part_ < 3u) ? (unsigned)(((n_) & 1) * BUFB) + part_ * 8192u + scan_off(row_, cc_) : (unsigned)GB0 + (unsigned)((n_) & 3) * 8192u + row_ * 256u + cc_ * 16u; \
                    *(LAS v4u*)(lds + RING_OFF + o_) = st[j]; } \
                if (lt < 32) *(LAS v4u*)(lds + RING_OFF + ((n_) & 1) * BUFB + 24576 + lt * 16) = st[8]; } while (0)
#define SCAN_POST(n_) do { const int pos = lt >> 3, vg = lt & 7; const LAS f32x4* ob = (const LAS f32x4*)(lds + RING_OFF + OB0 + ((n_) & 1) * 16384 + (pos * 128 + vg * 16) * 4); \
                const f32x4 o0 = ob[0], o1 = ob[1], o2 = ob[2], o3 = ob[3]; \
                float ss = (o0.x * o0.x + o0.y * o0.y) + (o0.z * o0.z + o0.w * o0.w) + (o1.x * o1.x + o1.y * o1.y) + (o1.z * o1.z + o1.w * o1.w) \
                         + (o2.x * o2.x + o2.y * o2.y) + (o2.z * o2.z + o2.w * o2.w) + (o3.x * o3.x + o3.y * o3.y) + (o3.z * o3.z + o3.w * o3.w); \
                ss += dpp_f<0xB1>(ss); ss += dpp_f<0x4E>(ss); ss += dpp_f<0x141>(ss);     \
                const float rr = __builtin_amdgcn_rsqf(ss * (1.0f / 128.0f) + EPS); \
                const size_t tk = (size_t)b * SEQ + (n_) * 32 + pos; const LAS v4u* gl_ = (const LAS v4u*)(lds + RING_OFF + GB0 + ((n_) & 3) * 8192 + pos * 256 + vg * 32); const v4u g0 = gl_[0], g1 = gl_[1]; \
                const float ov[16] = {o0.x, o0.y, o0.z, o0.w, o1.x, o1.y, o1.z, o1.w, o2.x, o2.y, o2.z, o2.w, o3.x, o3.y, o3.z, o3.w}; \
                const float gf[16] = {bf_lo(g0.x), bf_hi(g0.x), bf_lo(g0.y), bf_hi(g0.y), bf_lo(g0.z), bf_hi(g0.z), bf_lo(g0.w), bf_hi(g0.w), bf_lo(g1.x), bf_hi(g1.x), bf_lo(g1.y), bf_hi(g1.y), bf_lo(g1.z), bf_hi(g1.z), bf_lo(g1.w), bf_hi(g1.w)}; \
                float yv[16]; _Pragma("unroll") for (int i = 0; i < 16; ++i) yv[i] = ov[i] * rr * gnl[i] * (gf[i] * sigmoidf_(gf[i])); \
                GAS v4u* mp = (GAS v4u*)(MIX + tk * D + 512 + h * 128 + vg * 16); \
                mp[0] = (v4u){pk2(yv[0], yv[1]), pk2(yv[2], yv[3]), pk2(yv[4], yv[5]), pk2(yv[6], yv[7])}; mp[1] = (v4u){pk2(yv[8], yv[9]), pk2(yv[10], yv[11]), pk2(yv[12], yv[13]), pk2(yv[14], yv[15])}; } while (0)
#define SCAN_BAR() do { asm volatile("s_waitcnt lgkmcnt(0)" ::: "memory"); __builtin_amdgcn_s_barrier(); asm volatile("" ::: "memory"); } while (0)
            if (wave >= 4) {
                float gnl[16];
#pragma unroll
                for (int i = 0; i < 16; ++i) gnl[i] = hg_gain[(lt & 7) * 16 + i];
                SCAN_LOAD(stA, 0); SCAN_LOAD(stB, 1); SCAN_COMMIT(stA, 0);
                SCAN_BAR();
                for (int n = 0; n < 64; n += 2) {
                    if (n + 2 < 64) SCAN_LOAD(stA, n + 2);
                    if (n >= 1) SCAN_POST(n - 1);
                    SCAN_COMMIT(stB, n + 1);
                    SCAN_BAR();
                    if (n + 3 < 64) SCAN_LOAD(stB, n + 3);
                    SCAN_POST(n);
                    if (n + 2 < 64) SCAN_COMMIT(stA, n + 2);
                    SCAN_BAR();
                }
                SCAN_POST(63);
                SCAN_BAR();
            } else {
                f32x16 S0, S1, S2, S3;
#pragma unroll
                for (int i = 0; i < 16; ++i) { S0[i] = 0.f; S1[i] = 0.f; S2[i] = 0.f; S3[i] = 0.f; }
                SCAN_BAR();
                for (int n = 0; n < 64; ++n) {
                    const LAS unsigned char* Bf = lds + RING_OFF + (n & 1) * BUFB;
                    const unsigned qg = (unsigned)(lane & 15) >> 2, pg = (unsigned)lane & 3u, bk = ((unsigned)lane >> 4) & 1u;
                    pg8::bf16x8 qd[8], kd[8], qp[8], vt[2];
#pragma unroll
                    for (int ks = 0; ks < 8; ++ks) { const unsigned o_ = scan_off((unsigned)r, (unsigned)(2 * ks + hh)); qd[ks] = *(const LAS pg8::bf16x8*)(Bf + o_); kd[ks] = *(const LAS pg8::bf16x8*)(Bf + 8192 + o_); }
                    f32x16 X, O;
#pragma unroll
                    for (int i = 0; i < 16; ++i) { X[i] = 0.f; O[i] = 0.f; }
#pragma unroll
                    for (int ks = 0; ks < 8; ++ks) X = __builtin_amdgcn_mfma_f32_32x32x16_bf16(kd[ks], qd[ks], X, 0, 0, 0);
#pragma unroll
                    for (int ks = 0; ks < 8; ++ks) { const v2u a0 = *(const LAS v2u*)(Bf + scan_off((unsigned)r, (unsigned)(2 * ks)) + 8 * hh), a1 = *(const LAS v2u*)(Bf + scan_off((unsigned)r, (unsigned)(2 * ks + 1)) + 8 * hh);
                        qp[ks] = __builtin_bit_cast(pg8::bf16x8, (v4u){a0.x, a0.y, a1.x, a1.y}); }
#pragma unroll
                    for (int sp = 0; sp < 2; ++sp) vt[sp] = scan_tr(Bf + 16384, (unsigned)(16 * sp + 4 * hh) + qg, (unsigned)(4 * sl) + 2u * bk + (pg >> 1), pg & 1u);
                    O = __builtin_amdgcn_mfma_f32_32x32x16_bf16(qp[0], pack8(S0, 0), O, 0, 0, 0); O = __builtin_amdgcn_mfma_f32_32x32x16_bf16(qp[1], pack8(S0, 1), O, 0, 0, 0);
                    O = __builtin_amdgcn_mfma_f32_32x32x16_bf16(qp[2], pack8(S1, 0), O, 0, 0, 0); O = __builtin_amdgcn_mfma_f32_32x32x16_bf16(qp[3], pack8(S1, 1), O, 0, 0, 0);
                    O = __builtin_amdgcn_mfma_f32_32x32x16_bf16(qp[4], pack8(S2, 0), O, 0, 0, 0); O = __builtin_amdgcn_mfma_f32_32x32x16_bf16(qp[5], pack8(S2, 1), O, 0, 0, 0);
                    O = __builtin_amdgcn_mfma_f32_32x32x16_bf16(qp[6], pack8(S3, 0), O, 0, 0, 0); O = __builtin_amdgcn_mfma_f32_32x32x16_bf16(qp[7], pack8(S3, 1), O, 0, 0, 0);
#define SCAN_SUPD(Sx, rt_) do { _Pragma("unroll") for (int sp = 0; sp < 2; ++sp) { \
                            const pg8::bf16x8 kt = scan_tr(Bf + 8192, (unsigned)(16 * sp + 4 * hh) + qg, (unsigned)(4 * (rt_)) + 2u * bk + (pg >> 1), pg & 1u); \
                            Sx = __builtin_amdgcn_mfma_f32_32x32x16_bf16(kt, vt[sp], Sx, 0, 0, 0); } \
                        _Pragma("unroll") for (int g = 0; g < 4; ++g) { const f32x4 dv = *(const LAS f32x4*)(Bf + 24576 + (32 * (rt_) + 8 * g + 4 * hh) * 4); \
                            Sx[4 * g] *= dv.x; Sx[4 * g + 1] *= dv.y; Sx[4 * g + 2] *= dv.z; Sx[4 * g + 3] *= dv.w; } } while (0)
                    SCAN_SUPD(S0, 0); SCAN_SUPD(S1, 1); SCAN_SUPD(S2, 2); SCAN_SUPD(S3, 3);
#pragma unroll
                    for (int i = 0; i < 16; ++i) { const int s_ = (i & 3) + 8 * (i >> 2) + 4 * hh; X[i] = (s_ <= r) ? X[i] : 0.f; }
                    O = __builtin_amdgcn_mfma_f32_32x32x16_bf16(pack8(X, 0), vt[0], O, 0, 0, 0); O = __builtin_amdgcn_mfma_f32_32x32x16_bf16(pack8(X, 1), vt[1], O, 0, 0, 0);
                    LAS float* ob = (LAS float*)(lds + RING_OFF + OB0 + (n & 1) * 16384);
#pragma unroll
                    for (int i = 0; i < 16; ++i) ob[((i & 3) + 8 * (i >> 2) + 4 * hh) * 128 + 32 * sl + r] = O[i];
                    SCAN_BAR();
                }
                SCAN_BAR();
            }
        }
        {
            const int cb = (G > NB * 4) ? (int)blockIdx.x - NB * 4 : (int)blockIdx.x, ncb = (G > NB * 4) ? G - NB * 4 : G;
            if (cb >= 0) for (int item = cb * NWAVES + wave; item < NB * 32; item += ncb * NWAVES) {
                const int seg = item & 31, b = item >> 5, c0 = 8 * lane, t0 = seg * 64;
                float w0[8], w1[8], w2[8], gn[8], u1[8], u2[8];
#pragma unroll
                for (int j = 0; j < 8; ++j) { w0[j] = conv_w[c0 + j]; w1[j] = conv_w[512 + c0 + j]; w2[j] = conv_w[1024 + c0 + j]; gn[j] = conv_gain[c0 + j]; u1[j] = 0.f; u2[j] = 0.f; }
                if (t0 > 0) { const bf16* p2 = PROJ + (size_t)(b * SEQ + t0 - 2) * DPR; const bf16* p1 = p2 + DPR;
                    const v4u ua = *(const GAS v4u*)(p2 + PC_U + c0), ub = *(const GAS v4u*)(p1 + PC_U + c0);
                    const unsigned uaw[4] = {ua.x, ua.y, ua.z, ua.w}, ubw[4] = {ub.x, ub.y, ub.z, ub.w};
#pragma unroll
                    for (int j = 0; j < 4; ++j) { u2[2 * j] = bf_lo(uaw[j]); u2[2 * j + 1] = bf_hi(uaw[j]); u1[2 * j] = bf_lo(ubw[j]); u1[2 * j + 1] = bf_hi(ubw[j]); } }
                v4u uw[4], bw[4];
#pragma unroll
                for (int i = 0; i < 4; ++i) { const bf16* pr = PROJ + ((size_t)b * SEQ + t0 + i) * DPR; uw[i] = *(const GAS v4u*)(pr + PC_U + c0); bw[i] = *(const GAS v4u*)(pr + PC_B + c0); }
                for (int tb = t0; tb < t0 + 64; tb += 4) {
                    v4u un[4], bn[4];
                    if (tb + 4 < t0 + 64) {
#pragma unroll
                        for (int i = 0; i < 4; ++i) { const bf16* pr = PROJ + ((size_t)b * SEQ + tb + 4 + i) * DPR; un[i] = *(const GAS v4u*)(pr + PC_U + c0); bn[i] = *(const GAS v4u*)(pr + PC_B + c0); }
                    }
#pragma unroll
                    for (int i = 0; i < 4; ++i) { const unsigned uc[4] = {uw[i].x, uw[i].y, uw[i].z, uw[i].w}, bc[4] = {bw[i].x, bw[i].y, bw[i].z, bw[i].w};
                        float y[8], u[8]; float ss = 0.f;
#pragma unroll
                        for (int j = 0; j < 4; ++j) { u[2 * j] = bf_lo(uc[j]); u[2 * j + 1] = bf_hi(uc[j]);
                            y[2 * j] = bf_lo(bc[j]) * (w0[2 * j] * u2[2 * j] + w1[2 * j] * u1[2 * j] + w2[2 * j] * u[2 * j]); y[2 * j + 1] = bf_hi(bc[j]) * (w0[2 * j + 1] * u2[2 * j + 1] + w1[2 * j + 1] * u1[2 * j + 1] + w2[2 * j + 1] * u[2 * j + 1]);
                            ss += y[2 * j] * y[2 * j] + y[2 * j + 1] * y[2 * j + 1]; }
                        ss += dpp_f<0xB1>(ss); ss += dpp_f<0x4E>(ss); ss += dpp_f<0x141>(ss);
                        const float r = __builtin_amdgcn_rsqf(ss * (1.0f / 64.0f) + EPS);
                        *(GAS v4u*)(MIX + ((size_t)b * SEQ + tb + i) * D + c0) = (v4u){pk2(y[0] * r * gn[0], y[1] * r * gn[1]), pk2(y[2] * r * gn[2], y[3] * r * gn[3]), pk2(y[4] * r * gn[4], y[5] * r * gn[5]), pk2(y[6] * r * gn[6], y[7] * r * gn[7])};
#pragma unroll
                        for (int j = 0; j < 8; ++j) { u2[j] = u1[j]; u1[j] = u[j]; } }
#pragma unroll
                    for (int i = 0; i < 4; ++i) { uw[i] = un[i]; bw[i] = bn[i]; }
                }
            }
        }
        {
            const int cb = (G > NB * 4) ? (int)blockIdx.x - NB * 4 : (int)blockIdx.x, ncb = (G > NB * 4) ? G - NB * 4 : G;
            if (cb >= 0) {
                const int dw = cb * NWAVES + wave, ndw = ncb * NWAVES;
                LAS float* scr = (LAS float*)(lds + RING_OFF + wave * 16384);
                constexpr int I_O = (D / 64) * (D / 32);
                for (int it = dw; it < I_O; it += ndw) p0_transpose_item<false>(w_out, D, D, nullptr, WOT, scr, it, lane);
                for (int it = dw; it < 16 * 32 * 2; it += ndw) {
                    const int hp = it >> 6, kt = (it >> 1) & 31, nh = it & 1, rr = lane & 31, h8 = lane >> 5;
                    const int k = kt * 32 + rr; const float gk = norm_ffn[k];
                    pg8::bf16x8 af[8];
#pragma unroll
                    for (int ks = 0; ks < 8; ++ks) { const GAS f32x4* ap = (const GAS f32x4*)(peer_wq + (size_t)k * 2048 + hp * 128 + 16 * ks + 8 * h8); const f32x4 a0 = ap[0] * gk, a1 = ap[1] * gk;
                        v4u p_; p_.x = cvtpk(a0.x, a0.y); p_.y = cvtpk(a0.z, a0.w); p_.z = cvtpk(a1.x, a1.y); p_.w = cvtpk(a1.z, a1.w); af[ks] = __builtin_bit_cast(pg8::bf16x8, p_); }
#pragma unroll
                    for (int nt = 0; nt < 2; ++nt) {
                        const int n = nh * 64 + nt * 32 + rr;
                        f32x16 acc;
#pragma unroll
                        for (int i = 0; i < 16; ++i) acc[i] = 0.f;
#pragma unroll
                        for (int ks = 0; ks < 8; ++ks) { const GAS f32x4* bp = (const GAS f32x4*)(peer_keys + ((size_t)hp * 128 + n) * 128 + 16 * ks + 8 * h8); const f32x4 b0 = bp[0], b1 = bp[1];
                            v4u p_; p_.x = cvtpk(b0.x, b0.y); p_.y = cvtpk(b0.z, b0.w); p_.z = cvtpk(b1.x, b1.y); p_.w = cvtpk(b1.z, b1.w);
                            acc = __builtin_amdgcn_mfma_f32_32x32x16_bf16(af[ks], __builtin_bit_cast(pg8::bf16x8, p_), acc, 0, 0, 0); }
                        GAS unsigned* op = (GAS unsigned*)(WQT + ((size_t)hp * 128 + n) * D + kt * 32 + 4 * h8);
#pragma unroll
                        for (int g = 0; g < 4; ++g) { typedef unsigned v2u_t __attribute__((ext_vector_type(2)));
                            *(GAS v2u_t*)(op + 4 * g) = (v2u_t){cvtpk(acc[4 * g], acc[4 * g + 1]), cvtpk(acc[4 * g + 2], acc[4 * g + 3])}; }
                    }
                }
                for (int r = dw; r < 2 * NEXP; r += ndw) {
                    const int tb = r / NEXP, e = r % NEXP; const float sc = tb ? PEER_SV : PEER_SU;
                    const GAS f32x4* src = (const GAS f32x4*)((tb ? peer_v : peer_u) + (size_t)e * D);
                    f32x4 v[4] = {src[2 * lane], src[2 * lane + 1], src[128 + 2 * lane], src[128 + 2 * lane + 1]};
                    if (!tb) { const GAS f32x4* gp = (const GAS f32x4*)norm_ffn; v[0] = v[0] * gp[2 * lane]; v[1] = v[1] * gp[2 * lane + 1]; v[2] = v[2] * gp[128 + 2 * lane]; v[3] = v[3] * gp[128 + 2 * lane + 1]; }
                    unsigned o[4];
        #pragma unroll
                    for (int j = 0; j < 4; ++j) { f32x4 w = v[j] * sc;
                        if (tb) { w.x = fminf(fmaxf(w.x, -240.f), 240.f); w.y = fminf(fmaxf(w.y, -240.f), 240.f); w.z = fminf(fmaxf(w.z, -240.f), 240.f); w.w = fminf(fmaxf(w.w, -240.f), 240.f);
                            int pk = 0; pk = __builtin_amdgcn_cvt_pk_fp8_f32(w.x, w.y, pk, false); pk = __builtin_amdgcn_cvt_pk_fp8_f32(w.z, w.w, pk, true); o[j] = (unsigned)pk; }
                        else { const int i0 = (int)rintf(fminf(fmaxf(w.x, -127.f), 127.f)), i1 = (int)rintf(fminf(fmaxf(w.y, -127.f), 127.f)), i2 = (int)rintf(fminf(fmaxf(w.z, -127.f), 127.f)), i3 = (int)rintf(fminf(fmaxf(w.w, -127.f), 127.f));
                            o[j] = ((unsigned)i0 & 0xFFu) | (((unsigned)i1 & 0xFFu) << 8) | (((unsigned)i2 & 0xFFu) << 16) | (((unsigned)i3 & 0xFFu) << 24); } }
                    ((GAS v4u*)((tb ? V8 : U8) + (size_t)e * D))[lane] = (v4u){o[0], o[1], o[2], o[3]};
                }
            }
        }
        if (BOTH(3)) GRID_BAR();
    }


    if (IN(4)) {
        pg8::Gemm g{MIX, WOT, T, D, D}; pg8::StaticOrder S; S.init(T, D, G, (int)blockIdx.x);
        pg8::EpiResid E{XB, X1, SS2};
        pg8::gemm_phase<pg8::EpiResid, pg8::StaticOrder, PG8_ALIGN, PG8_SP2>(lds + RING_OFF, g, S, E);
        if (BOTH(4)) GRID_BAR();
    }

    if (IN(5)) {
        pg8::Gemm g{X1, WQT, T, 2048, D}; pg8::StaticOrder S; S.init(T, 2048, G, (int)blockIdx.x);
        pg8::EpiScaleBf16<2> E{QB, 2048, SS2};
        pg8::gemm_phase<pg8::EpiScaleBf16<2>, pg8::StaticOrder, PG8_ALIGN, PG8_SP2>(lds + RING_OFF, g, S, E);
        if (BOTH(5)) GRID_BAR();
    }

    if (IN(6)) {
        const int r = lane & 31, hh = lane >> 5;
        for (int tg0 = 0; tg0 < T / 32; tg0 += NGW) {
          const int tgi = (tg0 + gw < T / 32) ? tg0 + gw : tg0 + gw - NGW;
          const int tok = tgi * 32 + r;
          LAS unsigned char* sbuf = lds + RING_OFF + wave * 16384;
#define P6_DMA(h_) do { const GAS unsigned char* g_ = (const GAS unsigned char*)QB + ((size_t)tgi * 32) * 4096 + (size_t)(h_) * 512; \
            _Pragma("unroll") for (int j_ = 0; j_ < 16; ++j_) { const int row_ = 2 * j_ + (lane >> 5), c_ = (lane & 15) ^ (row_ & 15); \
                __builtin_amdgcn_global_load_lds((const GAS unsigned*)(g_ + (size_t)row_ * 4096 + ((lane >> 4) & 1) * 256 + c_ * 16), (LAS unsigned*)(sbuf + j_ * 1024), 16, 0, 0); } } while (0)
          P6_DMA(0);
          v4u pend0 = {0u, 0u, 0u, 0u}, pend1 = {0u, 0u, 0u, 0u};
          for (int h = 0; h < 8; ++h) {
            unsigned L[2][16];
#pragma unroll
            for (int p = 0; p < 2; ++p) {
                const int st = 2 * h + p;
                if (p == 0) asm volatile("s_waitcnt vmcnt(0)" ::: "memory");
                if (p == 0 && h > 0) { GAS v4u* ep = (GAS v4u*)(EXPT + (size_t)tok * 128 + (h - 1) * 16 + 8 * hh); ep[0] = pend0; ep[1] = pend1; }
                v4u sa[8];
                { const LAS unsigned char* rb = sbuf + r * 512 + p * 256;
#pragma unroll
                  for (int i = 0; i < 8; ++i) sa[i] = *(const LAS v4u*)(rb + (((8 * hh + i) ^ (r & 15)) << 4)); }
                if (p == 1 && h + 1 < 8) { asm volatile("s_waitcnt lgkmcnt(0)" ::: "memory"); P6_DMA(h + 1); }
#pragma unroll
                for (int np = 0; np < 2; ++np) {
                    unsigned c0[16], c1[16];
#pragma unroll
                    for (int j = 0; j < 8; ++j) {
                        const v4u qa = sa[4 * np + (j >> 2)], qb = sa[4 * np + 2 + (j >> 2)];
                        const unsigned wa = (j & 3) == 0 ? qa.x : (j & 3) == 1 ? qa.y : (j & 3) == 2 ? qa.z : qa.w, wb = (j & 3) == 0 ? qb.x : (j & 3) == 1 ? qb.y : (j & 3) == 2 ? qb.z : qb.w;
                        typedef short s2_t __attribute__((ext_vector_type(2)));
                        const s2_t ma = __builtin_bit_cast(s2_t, wa) >> (s2_t){15, 15}, mb = __builtin_bit_cast(s2_t, wb) >> (s2_t){15, 15};
                        const unsigned ka = wa ^ (__builtin_bit_cast(unsigned, ma) | 0x80008000u), kb = wb ^ (__builtin_bit_cast(unsigned, mb) | 0x80008000u);
                        const unsigned pay = (unsigned)(63 - (32 * np + 2 * j));
                        c0[2 * j] = (ka << 16) | pay; c0[2 * j + 1] = (ka & 0xFFFF0000u) | (pay - 1u);
                        c1[2 * j] = (kb << 16) | (pay - 16u); c1[2 * j + 1] = (kb & 0xFFFF0000u) | (pay - 17u); }
                    sort16_desc2(c0, c1);
                    merge16_desc(c0, c1);
                    if (np == 0) {
#pragma unroll
                        for (int i = 0; i < 16; ++i) L[p][i] = c0[i];
                    } else merge16_desc(L[p], c0);
                }
                unsigned o[16];
#pragma unroll
                for (int i = 0; i < 16; ++i) { L[p][i] |= hh ? 0u : 64u; o[i] = xor_lane<32>(L[p][i], lane); }
                merge16_desc(L[p], o);
            }
            float v1[16], v2[16];
#pragma unroll
            for (int j = 0; j < 16; ++j) { v1[j] = unkey16(L[0][j]); v2[j] = unkey16(L[1][j]); }
            const unsigned hm = 0u - (unsigned)hh;
            unsigned ct[16];
#pragma unroll
            for (int t = 0; t < 16; ++t) { const unsigned rk = ckey(v1[0] + v2[t], t), ck = (t < 15) ? ckey(v1[t + 1] + v2[0], 16 * (t + 1)) : 0u; ct[t] = rk ^ ((rk ^ ck) & hm); }
            {
                constexpr int CI[20] = {1, 1, 1, 1, 1, 1, 1, 2, 3, 4,   5, 6, 7, 2, 2, 2, 3, 3, 4, 0};
                constexpr int CJ[20] = {1, 2, 3, 4, 5, 6, 7, 1, 1, 1,   1, 1, 1, 2, 3, 4, 2, 3, 2, 0};
                unsigned cd[16];
#pragma unroll
                for (int t = 10; t < 16; ++t) cd[t] = 0u;
#pragma unroll
                for (int s_ = 0; s_ < 10; ++s_) {
                    const int ia = CI[s_], ja = CJ[s_], ib = CI[10 + s_], jb = CJ[10 + s_];
                    const unsigned xa = __builtin_bit_cast(unsigned, v1[ia]), xb = __builtin_bit_cast(unsigned, v1[ib]), ya = __builtin_bit_cast(unsigned, v2[ja]), yb = __builtin_bit_cast(unsigned, v2[jb]);
                    const float xs = __builtin_bit_cast(float, xa ^ ((xa ^ xb) & hm)), ys = __builtin_bit_cast(float, ya ^ ((ya ^ yb) & hm));
                    const unsigned pa = 255u - (unsigned)(ia * 16 + ja), pb = 255u - (unsigned)(ib * 16 + jb);
                    const float sm = xs + ys; unsigned u = __builtin_bit_cast(unsigned, sm); u ^= (unsigned)((int)u >> 31) | 0x80000000u;
                    unsigned key = (u & ~0xFFu) | (pa ^ ((pa ^ pb) & hm));
                    if (s_ == 9) key &= ~hm;
                    cd[s_] = key;
                }
                sort16_desc1(cd);
                merge16_desc(ct, cd);
                unsigned oc[16];
#pragma unroll
                for (int t = 0; t < 16; ++t) oc[t] = xor_lane<32>(ct[t], lane);
                merge16_desc(ct, oc);
            }
            float den = 0.f, ex[16]; const float cmax = unkey(ct[0] & ~0xFFu);
#pragma unroll
            for (int t = 0; t < 16; ++t) { ex[t] = __expf(unkey(ct[t] & ~0xFFu) - cmax); den += ex[t]; }
            const float inv = 1.0f / den;
            unsigned b1[4], b2[4];
#pragma unroll
            for (int w = 0; w < 4; ++w) { b1[w] = (L[0][4 * w] & 0x7Fu) | ((L[0][4 * w + 1] & 0x7Fu) << 8) | ((L[0][4 * w + 2] & 0x7Fu) << 16) | ((L[0][4 * w + 3] & 0x7Fu) << 24);
                b2[w] = (L[1][4 * w] & 0x7Fu) | ((L[1][4 * w + 1] & 0x7Fu) << 8) | ((L[1][4 * w + 2] & 0x7Fu) << 16) | ((L[1][4 * w + 3] & 0x7Fu) << 24); }
            unsigned ent[8];
#pragma unroll
            for (int t = 0; t < 8; ++t) {
                const unsigned ck = ct[t] ^ ((ct[t] ^ ct[8 + t]) & hm); const unsigned e0 = __builtin_bit_cast(unsigned, ex[t]), e1 = __builtin_bit_cast(unsigned, ex[8 + t]);
                const float gt = __builtin_bit_cast(float, e0 ^ ((e0 ^ e1) & hm)) * inv;
                const unsigned flat = 255u - (ck & 0xFFu), ii = flat >> 4, jj = flat & 15u;
                const unsigned w1 = (ii & 8u) ? ((ii & 4u) ? b1[3] : b1[2]) : ((ii & 4u) ? b1[1] : b1[0]), w2 = (jj & 8u) ? ((jj & 4u) ? b2[3] : b2[2]) : ((jj & 4u) ? b2[1] : b2[0]);
                const unsigned n1 = 127u - ((w1 >> (8u * (ii & 3u))) & 0x7Fu), n2 = 127u - ((w2 >> (8u * (jj & 3u))) & 0x7Fu);
                ent[t] = (n1 * 128u + n2) | (pkh2(gt, 0.f) << 16); }
            pend0 = (v4u){ent[0], ent[1], ent[2], ent[3]}; pend1 = (v4u){ent[4], ent[5], ent[6], ent[7]};
          }
          { GAS v4u* ep = (GAS v4u*)(EXPT + (size_t)tok * 128 + 7 * 16 + 8 * hh); ep[0] = pend0; ep[1] = pend1; }
        }
        if (BOTH(6)) asm volatile("s_waitcnt vmcnt(0)" ::: "memory");
    }


    if (IN(7)) {
        constexpr int NT = 8;
        unsigned pace_round = 0u;
        unsigned* pace_cnt = (unsigned*)(ctl + 16384) + 64 * bar.x;
        const unsigned pace_n = (N_LAUNCHES == 1) ? MISC[8] : 0u;
#define PEER_PACE() do { if (pace_n) { ++pace_round; __syncthreads(); if (tid == 0) { (void)__hip_atomic_fetch_add(pace_cnt, 1u, __ATOMIC_RELAXED, __HIP_MEMORY_SCOPE_WORKGROUP); unsigned sp_ = 0; \
            for (;;) { unsigned cur_; const unsigned z_ = 0u; asm volatile("global_atomic_add %0, %1, %2, %3 sc0\n\ts_waitcnt vmcnt(0)" : "=&v"(cur_) : "v"(z_), "v"(z_), "s"(pace_cnt) : "memory");     \
                if (cur_ >= pace_n * pace_round || ++sp_ >= 20000u) break; __builtin_amdgcn_s_sleep(1); } } __syncthreads(); } } while (0)
        const unsigned srcl = (unsigned)(32 * (lane & 1)) << 2;
        for (int tg0 = 0; tg0 < T / 32; tg0 += NGW)
          for (int kb = 0; kb < 32 / NT; ++kb) {
            const int tgi = (tg0 + gw < T / 32) ? tg0 + gw : tg0 + gw - NGW;
            const int tok0 = tgi * 32 + kb * NT;
            unsigned e[NT][2]; float sc[NT]; int hx[NT][4];
#pragma unroll
            for (int t = 0; t < NT; ++t) { const unsigned r0 = EXPT[(size_t)(tok0 + t) * 128 + lane], r1 = EXPT[(size_t)(tok0 + t) * 128 + 64 + lane];
                e[t][0] = (r0 << 16) | (r0 >> 16); e[t][1] = (r1 << 16) | (r1 >> 16);
                const GAS v4u* xr = (const GAS v4u*)(X1 + (size_t)(tok0 + t) * D); const v4u xa = __builtin_nontemporal_load(xr + lane), xb = __builtin_nontemporal_load(xr + 64 + lane);
                const float xv[16] = {bf_lo(xa.x), bf_hi(xa.x), bf_lo(xa.y), bf_hi(xa.y), bf_lo(xa.z), bf_hi(xa.z), bf_lo(xa.w), bf_hi(xa.w), bf_lo(xb.x), bf_hi(xb.x), bf_lo(xb.y), bf_hi(xb.y), bf_lo(xb.z), bf_hi(xb.z), bf_lo(xb.w), bf_hi(xb.w)};
                float am = 0.f;
#pragma unroll
                for (int i = 0; i < 16; ++i) am = fmaxf(am, fabsf(xv[i]));
                am = fmaxf(wave_max(am), 1e-20f); const float sx = 127.0f / am;
                sc[t] = am * (1.0f / 127.0f) * (1.0f / PEER_SU) / sqrtf(SS2[tok0 + t] * (1.0f / D) + EPS);
#pragma unroll
                for (int w = 0; w < 4; ++w) { const int i0 = (int)rintf(xv[4 * w] * sx), i1 = (int)rintf(xv[4 * w + 1] * sx), i2 = (int)rintf(xv[4 * w + 2] * sx), i3 = (int)rintf(xv[4 * w + 3] * sx);
                    hx[t][w] = (int)(((unsigned)i0 & 0xFFu) | (((unsigned)i1 & 0xFFu) << 8) | (((unsigned)i2 & 0xFFu) << 16) | (((unsigned)i3 & 0xFFu) << 24)); } }
            sort128_asc<NT>(e, lane);
            PEER_PACE();
            int ah[NT][2];
#pragma unroll
            for (int t = 0; t < NT; ++t) { ah[t][0] = 0; ah[t][1] = 0; }
#define PEER_LOAD(buf, TAB, st_) do { _Pragma("unroll") for (int t = 0; t < NT; ++t) { const unsigned em_ = ((st_) & 32) ? 0xFFFFFFFFu : 0u; const unsigned esel = e[t][0] ^ ((e[t][0] ^ e[t][1]) & em_); \
                _Pragma("unroll") for (int q = 0; q < 2; ++q) { const unsigned id = (unsigned)__builtin_amdgcn_readlane((int)esel, 2 * ((st_) & 31) + q) >> 16; \
                    const unsigned char* rp_ = TAB + (size_t)id * D; asm volatile("" : "+s"(rp_)); buf[t][q] = ((const GAS v4u*)rp_)[lane]; } } } while (0)
            for (int st = 0; st < 64; ++st) { if (st == 32) PEER_PACE();
                v4u ub[NT][2];
                PEER_LOAD(ub, U8, st);
                int p[16];
#pragma unroll
                for (int t = 0; t < NT; ++t)
#pragma unroll
                    for (int q = 0; q < 2; ++q) { const int d0 = __builtin_amdgcn_sdot4((int)ub[t][q].x, hx[t][0], 0, false), d1 = __builtin_amdgcn_sdot4((int)ub[t][q].z, hx[t][2], 0, false);
                        p[2 * t + q] = __builtin_amdgcn_sdot4((int)ub[t][q].y, hx[t][1], d0, false) + __builtin_amdgcn_sdot4((int)ub[t][q].w, hx[t][3], d1, false); }
                const int red = reduce16i(p, lane); const bool hit = (lane >> 1) == (st & 31), hi = (st & 32) != 0;
#pragma unroll
                for (int t = 0; t < NT; ++t) { const int got = __builtin_amdgcn_ds_bpermute((int)(srcl + (unsigned)((16 * (t & 1) + 8 * ((t >> 1) & 1) + 4 * (t >> 2)) << 2)), red);
                    ah[t][0] = (hit && !hi) ? got : ah[t][0]; ah[t][1] = (hit && hi) ? got : ah[t][1]; }
            }
            unsigned wv[NT][2];
#pragma unroll
            for (int t = 0; t < NT; ++t)
#pragma unroll
                for (int g = 0; g < 2; ++g) { const float a = (float)ah[t][g] * sc[t]; const float gate = (float)h2_of(e[t][g] & 0xFFFFu).x;
                    const float w = gate * (0.5f / PEER_SV) * a * (1.0f + erff(a * 0.7071067811865476f)); wv[t][g] = pkh2(w, w); }
            PEER_PACE();
            h2_t y[NT][8];
#pragma unroll
            for (int t = 0; t < NT; ++t)
#pragma unroll
                for (int i = 0; i < 8; ++i) y[t][i] = (h2_t){(_Float16)0.f, (_Float16)0.f};
            for (int st = 0; st < 64; ++st) { if (st == 32) PEER_PACE();
                v4u vb[NT][2];
                PEER_LOAD(vb, V8, st);
#pragma unroll
                for (int t = 0; t < NT; ++t) { const unsigned wm_ = (st & 32) ? 0xFFFFFFFFu : 0u; const unsigned wsel = wv[t][0] ^ ((wv[t][0] ^ wv[t][1]) & wm_);
#pragma unroll
                    for (int q = 0; q < 2; ++q) { const h2_t w2 = h2_of((unsigned)__builtin_amdgcn_readlane((int)wsel, 2 * (st & 31) + q));
                        const unsigned vw_[4] = {vb[t][q].x, vb[t][q].y, vb[t][q].z, vb[t][q].w};
#pragma unroll
                        for (int j = 0; j < 4; ++j) { y[t][2 * j] = __builtin_elementwise_fma(__builtin_bit_cast(h2_t, __builtin_amdgcn_cvt_scalef32_pk_f16_fp8((int)vw_[j], 1.0f, false)), w2, y[t][2 * j]);
                            y[t][2 * j + 1] = __builtin_elementwise_fma(__builtin_bit_cast(h2_t, __builtin_amdgcn_cvt_scalef32_pk_f16_fp8((int)vw_[j], 1.0f, true)), w2, y[t][2 * j + 1]); } } }
            }
#pragma unroll
            for (int t = 0; t < NT; ++t) { int tki = tok0 + t; asm volatile("" : "+s"(tki));
                const size_t tok = (size_t)tki;
                const GAS v4u* xr = (const GAS v4u*)(X1 + tok * D); const v4u xa = __builtin_nontemporal_load(xr + lane), xb = __builtin_nontemporal_load(xr + 64 + lane);
                const float xf[16] = {bf_lo(xa.x), bf_hi(xa.x), bf_lo(xa.y), bf_hi(xa.y), bf_lo(xa.z), bf_hi(xa.z), bf_lo(xa.w), bf_hi(xa.w),
                                      bf_lo(xb.x), bf_hi(xb.x), bf_lo(xb.y), bf_hi(xb.y), bf_lo(xb.z), bf_hi(xb.z), bf_lo(xb.w), bf_hi(xb.w)};
                float yy[16]; float ss = 0.f;
#pragma unroll
                for (int i = 0; i < 8; ++i) { yy[2 * i] = (float)y[t][i].x + xf[2 * i]; yy[2 * i + 1] = (float)y[t][i].y + xf[2 * i + 1]; ss += yy[2 * i] * yy[2 * i] + yy[2 * i + 1] * yy[2 * i + 1]; }
                ss = wave_sum(ss);
                const float r = 1.0f / sqrtf(ss * (1.0f / D) + EPS);
                const GAS f32x4* nfp = (const GAS f32x4*)norm_f; const f32x4 n0 = nfp[2 * lane], n1 = nfp[2 * lane + 1], n2 = nfp[128 + 2 * lane], n3 = nfp[128 + 2 * lane + 1];
                GAS f32x4* op = (GAS f32x4*)(out + tok * D);
                __builtin_nontemporal_store((f32x4){yy[0] * r * n0.x, yy[1] * r * n0.y, yy[2] * r * n0.z, yy[3] * r * n0.w}, op + 2 * lane);
                __builtin_nontemporal_store((f32x4){yy[4] * r * n1.x, yy[5] * r * n1.y, yy[6] * r * n1.z, yy[7] * r * n1.w}, op + 2 * lane + 1);
                __builtin_nontemporal_store((f32x4){yy[8] * r * n2.x, yy[9] * r * n2.y, yy[10] * r * n2.z, yy[11] * r * n2.w}, op + 128 + 2 * lane);
                __builtin_nontemporal_store((f32x4){yy[12] * r * n3.x, yy[13] * r * n3.y, yy[14] * r * n3.z, yy[15] * r * n3.w}, op + 128 + 2 * lane + 1); }
        }
    }

#undef IN
#undef BOTH
}

extern "C" void kernel_launch(void* const* d_in, const int* in_sizes, int n_in, void* d_out, int out_size, void* d_ws, size_t ws_size, hipStream_t stream) {
    static int grid = 0;
    if (grid == 0) {
        if (n_in != 14 || in_sizes[0] != T * D || out_size != T * D || ws_size < WS_END) { fprintf(stderr, "kernel_launch: unexpected shapes (n_in %d, in0 %d, out %d, ws %zu); nothing launched\n", n_in, n_in > 0 ? in_sizes[0] : -1, out_size, ws_size); grid = -1; return; }
        int dev = 0, cus = 0, per_cu = 0;
        if (hipGetDevice(&dev) != hipSuccess || hipDeviceGetAttribute(&cus, hipDeviceAttributeMultiprocessorCount, dev) != hipSuccess) { grid = -1; return; }
        if (hipFuncSetAttribute((const void*)hymba_fwd, hipFuncAttributeMaxDynamicSharedMemorySize, LDS_BYTES) != hipSuccess) { fprintf(stderr, "kernel_launch: hipFuncSetAttribute failed\n"); grid = -1; return; }
        if (hipOccupancyMaxActiveBlocksPerMultiprocessor(&per_cu, (const void*)hymba_fwd, NWAVES * 64, LDS_BYTES) != hipSuccess || per_cu < 1) { fprintf(stderr, "kernel_launch: occupancy query says %d blocks per CU\n", per_cu); (void)hipGetLastError(); grid = -1; return; }
        grid = cus;
    }
    if (grid < 0) return;
    if (hipMemsetAsync((char*)d_ws + WS_CTL, 0, CTL_ZERO_BYTES, stream) != hipSuccess) { fprintf(stderr, "kernel_launch: hipMemsetAsync failed\n"); return; }
    Args a{};
    for (int i = 0; i < 14; ++i) a.in[i] = (const float*)d_in[i];
    a.out = (float*)d_out; a.ws = (unsigned char*)d_ws;
    if (N_LAUNCHES == 1) {
        a.ph_lo = 0; a.ph_hi = NPHASES; a.li = 0;
        void* kargs[] = {&a};
        const hipError_t e = hipLaunchCooperativeKernel((const void*)hymba_fwd, dim3(grid), dim3(NWAVES * 64), kargs, LDS_BYTES, stream);
        if (e != hipSuccess) fprintf(stderr, "kernel_launch: cooperative launch failed: %s (grid %d)\n", hipGetErrorString(e), grid);
    } else {
        for (int li = 0; li < NPHASES; ++li) {
            a.ph_lo = li; a.ph_hi = li + 1; a.li = li;
            hipLaunchKernelGGL(hymba_fwd, dim3(grid), dim3(NWAVES * 64), LDS_BYTES, stream, a);
            const hipError_t le = hipPeekAtLastError();
            if (le != hipSuccess) { fprintf(stderr, "kernel_launch: launch %d failed: %s\n", li, hipGetErrorName(le)); break; }
        }
    }
}
```
